# Optimizing an MI355X kernel written in HIP

```python
import numpy as np
import jax, jax.numpy as jnp
from jax import lax

D_MODEL = 1024
BATCH = 4
SEQ = 8192
DEPTH = 1

ATT_HEADS = 8
ATT_HEAD_DIM = 64
ATT_KV_GROUPS = 2
ATT_HPG = ATT_HEADS // ATT_KV_GROUPS
ATT_WIDTH = ATT_HEADS * ATT_HEAD_DIM
KV_WIDTH = ATT_KV_GROUPS * ATT_HEAD_DIM
N_BRANCH = 3
L_CMP = 32
STRIDE_CMP = 16
CMP_HIDDEN = 256
L_SEL = 64
N_SELECT = 16
N_FORCED_LOCAL = 2
FORCE_BONUS = 1000.0
WINDOW = 512
Q_BLOCK = 128
ROPE_THETA = 500000.0
ROPE_DIM = ATT_HEAD_DIM // 4

HG_HEADS = 4
HG_DK = 128
HG_DV = 128
HG_WIDTH = HG_HEADS * HG_DV
HG_CHUNK = 64

MIX_WIDTH = ATT_WIDTH + HG_WIDTH
IN_SIZES = (ATT_WIDTH, KV_WIDTH, KV_WIDTH, KV_WIDTH, KV_WIDTH, KV_WIDTH, KV_WIDTH,
            ATT_HEADS * N_BRANCH, HG_HEADS * HG_DK, HG_HEADS * HG_DK, HG_WIDTH, HG_WIDTH)
IN_WIDTH = sum(IN_SIZES)

N_EXPERTS = 32
TOP_K = 4
D_FF = 1024
SWIGLU_LIMIT = 7.0
SWIGLU_ALPHA = 1.702
MOE_BLOCK = 256

DN_ALPHA = (2 * DEPTH) ** 0.25
DN_BETA = (8 * DEPTH) ** -0.25
LN_EPS = 1e-5
RMS_EPS = 1e-6

kernel_name = "hymba_nsa_hgrn2_moe_deepnorm"

F32 = jnp.float32


def layer_norm(x, g, b):
    xf = x.astype(F32)
    mu = jnp.mean(xf, axis=-1, keepdims=True)
    var = jnp.mean(jnp.square(xf - mu), axis=-1, keepdims=True)
    return ((xf - mu) * lax.rsqrt(var + LN_EPS) * g.astype(F32) + b.astype(F32)).astype(x.dtype)


def rope_partial(x, pos):
    half = ROPE_DIM // 2
    inv = ROPE_THETA ** (-jnp.arange(0, ROPE_DIM, 2, dtype=F32) / ROPE_DIM)
    ang = pos.astype(F32)[..., None] * inv
    cos = jnp.cos(ang)[:, :, None, :]
    sin = jnp.sin(ang)[:, :, None, :]
    xr = x[..., :ROPE_DIM].astype(F32)
    x1, x2 = xr[..., :half], xr[..., half:]
    rot = jnp.concatenate([x1 * cos - x2 * sin, x2 * cos + x1 * sin], axis=-1).astype(x.dtype)
    return jnp.concatenate([rot, x[..., ROPE_DIM:]], axis=-1)


def masked_softmax(s, mask):
    s = jnp.where(mask, s, -1e30)
    m = jnp.max(s, axis=-1, keepdims=True)
    p = jnp.exp(s - m) * mask
    return p / jnp.maximum(jnp.sum(p, axis=-1, keepdims=True), 1e-20)


def nsa_attention(q, k_cmp, v_cmp, k_sel, v_sel, k_win, v_win, gate_logits, pos,
                  pe_cmp, w_ck1, w_ck2, w_cv1, w_cv2):
    B, S = q.shape[0], q.shape[1]
    G, dh = ATT_KV_GROUPS, ATT_HEAD_DIM
    scale = dh ** -0.5
    q = rope_partial(q.reshape(B, S, ATT_HEADS, dh), pos).reshape(B, S, G, ATT_HPG, dh)
    k_cmp, v_cmp, k_sel, v_sel, k_win, v_win = [t.reshape(B, S, G, dh) for t in
                                                (k_cmp, v_cmp, k_sel, v_sel, k_win, v_win)]
    k_sel = rope_partial(k_sel, pos)
    k_win = rope_partial(k_win, pos)

    n_cmp = (S - L_CMP) // STRIDE_CMP + 1
    blk_idx = np.arange(n_cmp)[:, None] * STRIDE_CMP + np.arange(L_CMP)[None, :]
    cmp_end = blk_idx[:, -1]

    def compress(t, w1, w2):
        tb = t[:, blk_idx] + pe_cmp[None, None, :, None, :]
        tb = jnp.moveaxis(tb, 3, 2).reshape(B, n_cmp, G, L_CMP * dh)
        return jax.nn.gelu(tb @ w1) @ w2

    kc = rope_partial(compress(k_cmp, w_ck1, w_ck2), pos[:, cmp_end])
    vc = compress(v_cmp, w_cv1, w_cv2)

    n_blk = S // L_SEL
    n_pick = min(N_SELECT, n_blk)
    kbl = k_sel.reshape(B, n_blk, L_SEL, G, dh).transpose(0, 3, 1, 2, 4)
    vbl = v_sel.reshape(B, n_blk, L_SEL, G, dh).transpose(0, 3, 1, 2, 4)
    cs = np.arange(n_cmp) * STRIDE_CMP
    ss = np.arange(n_blk) * L_SEL
    overlap = jnp.asarray(((cs[:, None] < ss[None, :] + L_SEL) &
                           (ss[None, :] < cs[:, None] + L_CMP)).astype(np.float32))
    gather = jax.vmap(jax.vmap(lambda tb, ix: tb[ix]))

    kwp = jnp.pad(k_win, ((0, 0), (WINDOW, 0), (0, 0), (0, 0)))
    vwp = jnp.pad(v_win, ((0, 0), (WINDOW, 0), (0, 0), (0, 0)))
    gates = jax.nn.sigmoid(gate_logits.astype(F32)).reshape(B, S, G, ATT_HPG, N_BRANCH)
    blk_ids = jnp.arange(n_blk)

    def block(qb):
        s0 = qb * Q_BLOCK
        qblk = lax.dynamic_slice_in_dim(q, s0, Q_BLOCK, axis=1)
        t_pos = s0 + jnp.arange(Q_BLOCK)

        s = jnp.einsum('btgnd,bcgd->bgntc', qblk, kc, preferred_element_type=F32) * scale
        p_c = masked_softmax(s, cmp_end[None, :] <= t_pos[:, None])
        o_c = jnp.einsum('bgntc,bcgd->btgnd', p_c.astype(vc.dtype), vc)

        imp = jnp.einsum('bgntc,cj->bgtj', p_c, overlap)
        cur = t_pos // L_SEL
        dist = cur[:, None] - blk_ids[None, :]
        causal_blk = dist >= 0
        forced = (blk_ids[None, :] == 0) | (causal_blk & (dist < N_FORCED_LOCAL))
        imp = jnp.where(causal_blk, imp + FORCE_BONUS * forced, -1.0)
        _, sel = lax.top_k(imp, n_pick)
        ks = gather(kbl, sel).reshape(B, G, Q_BLOCK, n_pick * L_SEL, dh)
        vs = gather(vbl, sel).reshape(B, G, Q_BLOCK, n_pick * L_SEL, dh)
        kpos = (sel[..., None] * L_SEL + jnp.arange(L_SEL)).reshape(B, G, Q_BLOCK, n_pick * L_SEL)
        s = jnp.einsum('btgnd,bgtkd->bgntk', qblk, ks, preferred_element_type=F32) * scale
        p_s = masked_softmax(s, (kpos <= t_pos[None, None, :, None])[:, :, None])
        o_s = jnp.einsum('bgntk,bgtkd->btgnd', p_s.astype(vs.dtype), vs)

        kw = lax.dynamic_slice_in_dim(kwp, s0, WINDOW + Q_BLOCK, axis=1)
        vw = lax.dynamic_slice_in_dim(vwp, s0, WINDOW + Q_BLOCK, axis=1)
        kp = s0 - WINDOW + jnp.arange(WINDOW + Q_BLOCK)
        m_w = ((kp[None, :] <= t_pos[:, None]) & (kp[None, :] > t_pos[:, None] - WINDOW)
               & (kp[None, :] >= 0))
        s = jnp.einsum('btgnd,bkgd->bgntk', qblk, kw, preferred_element_type=F32) * scale
        p_w = masked_softmax(s, m_w)
        o_w = jnp.einsum('bgntk,bkgd->btgnd', p_w.astype(vw.dtype), vw)

        gb = lax.dynamic_slice_in_dim(gates, s0, Q_BLOCK, axis=1)
        o = gb[..., 0:1] * o_c + gb[..., 1:2] * o_s + gb[..., 2:3] * o_w
        return o.astype(q.dtype)

    out = lax.map(block, jnp.arange(S // Q_BLOCK))
    return jnp.moveaxis(out, 0, 1).reshape(B, S, ATT_WIDTH)


def hgrn2(q, zf, inp, g, lb, norm_g):
    B, S = q.shape[0], q.shape[1]
    H, dk, dv, C = HG_HEADS, HG_DK, HG_DV, HG_CHUNK
    f_hat = jax.nn.sigmoid(zf.astype(F32))
    logf = jnp.log(lb + (1.0 - lb) * f_hat)
    k = (1.0 - lb) * (1.0 - f_hat)

    def heads(t, d):
        return t.reshape(B, S // C, C, H, d).transpose(1, 0, 3, 2, 4)

    qs, ks, ls, vs = heads(q.astype(F32), dk), heads(k, dk), heads(logf, dk), heads(inp.astype(F32), dv)
    causal = jnp.asarray(np.tril(np.ones((C, C), dtype=bool)))[:, :, None]

    def step(state, xs):
        qc, kc, lc, vc = xs
        b = jnp.cumsum(lc, axis=2)
        o_inter = jnp.einsum('bhtk,bhkv->bhtv', qc * jnp.exp(b), state)
        diff = b[:, :, :, None, :] - b[:, :, None, :, :]
        decay = jnp.where(causal, jnp.exp(jnp.where(causal, diff, 0.0)), 0.0)
        A = jnp.einsum('bhtk,bhsk,bhtsk->bhts', qc, kc, decay)
        o = o_inter + jnp.einsum('bhts,bhsv->bhtv', A, vc)
        b_last = b[:, :, -1]
        state = (jnp.exp(b_last)[..., None] * state +
                 jnp.einsum('bhsk,bhsv->bhkv', kc * jnp.exp(b_last[:, :, None] - b), vc))
        return state, o

    state0 = jnp.zeros((B, H, dk, dv), F32)
    _, o = lax.scan(step, state0, (qs, ks, ls, vs))
    o = o.transpose(1, 0, 3, 2, 4).reshape(B, S, H, dv)
    o = o * lax.rsqrt(jnp.mean(jnp.square(o), axis=-1, keepdims=True) + RMS_EPS) * norm_g.astype(F32)
    o = o.reshape(B, S, HG_WIDTH) * jax.nn.silu(g.astype(F32))
    return o.astype(q.dtype)


def moe(x, w_r, b_r, w_gu, b_gu, w_dn, b_dn):
    B, S, D = x.shape
    N = B * S
    A = N * TOP_K
    xf = x.reshape(N, D)
    logits = (xf @ w_r + b_r).astype(F32)
    top_v, top_i = lax.top_k(logits, TOP_K)
    top_w = jax.nn.softmax(top_v, axis=-1)
    e_flat = top_i.reshape(A)
    tok_flat = jnp.arange(A) // TOP_K
    w_flat = top_w.reshape(A)
    order = jnp.argsort(e_flat)
    e_sorted, tok_sorted, w_sorted = e_flat[order], tok_flat[order], w_flat[order]
    counts = jnp.bincount(e_flat, length=N_EXPERTS)
    padded = (counts + MOE_BLOCK - 1) // MOE_BLOCK * MOE_BLOCK
    starts = jnp.cumsum(counts) - counts
    pends = jnp.cumsum(padded)
    pstarts = pends - padded
    dest = pstarts[e_sorted] + jnp.arange(A) - starts[e_sorted]
    n_blk = -(-(A + N_EXPERTS * (MOE_BLOCK - 1)) // MOE_BLOCK)
    P = n_blk * MOE_BLOCK
    row_tok = jnp.zeros((P,), jnp.int32).at[dest].set(tok_sorted)
    row_w = jnp.zeros((P,), F32).at[dest].set(w_sorted)
    blk_expert = jnp.clip(jnp.searchsorted(pends, jnp.arange(n_blk) * MOE_BLOCK, side='right'),
                          0, N_EXPERTS - 1)
    xs = xf[row_tok].reshape(n_blk, MOE_BLOCK, D)

    def expert_block(args):
        xb, e = args
        h = xb @ w_gu[e] + b_gu[e]
        gate = jnp.minimum(h[:, :D_FF], SWIGLU_LIMIT)
        up = jnp.clip(h[:, D_FF:], -SWIGLU_LIMIT, SWIGLU_LIMIT)
        act = gate * jax.nn.sigmoid(SWIGLU_ALPHA * gate) * (up + 1.0)
        return act @ w_dn[e] + b_dn[e]

    ys = lax.map(expert_block, (xs, blk_expert)).reshape(P, D)
    out = jnp.zeros((N, D), F32).at[row_tok].add(ys.astype(F32) * row_w[:, None])
    return out.astype(x.dtype).reshape(B, S, D)


def setup_inputs(seed: int = 0) -> dict:
    key = jax.random.key(seed)
    ks = jax.random.split(key, 24)
    nrm = lambda k, shape, s: jax.random.normal(k, shape, F32) * s
    L, D, dh = DEPTH, D_MODEL, ATT_HEAD_DIM
    return {
        "x": nrm(ks[0], (BATCH, SEQ, D), 1.0),
        "positions": jnp.broadcast_to(jnp.arange(SEQ, dtype=jnp.int32), (BATCH, SEQ)),
        "w_in": nrm(ks[1], (L, D, IN_WIDTH), D ** -0.5),
        "pe_cmp": nrm(ks[2], (L, L_CMP, dh), 0.1),
        "w_ck1": nrm(ks[3], (L, L_CMP * dh, CMP_HIDDEN), (L_CMP * dh) ** -0.5),
        "w_ck2": nrm(ks[4], (L, CMP_HIDDEN, dh), CMP_HIDDEN ** -0.5),
        "w_cv1": nrm(ks[5], (L, L_CMP * dh, CMP_HIDDEN), (L_CMP * dh) ** -0.5),
        "w_cv2": nrm(ks[6], (L, CMP_HIDDEN, dh), CMP_HIDDEN ** -0.5),
        "hg_lb": nrm(ks[7], (L + 1, HG_HEADS * HG_DK), 0.1),
        "hg_norm_g": 1.0 + nrm(ks[8], (L, HG_DV), 0.01),
        "w_o": nrm(ks[9], (L, MIX_WIDTH, D), MIX_WIDTH ** -0.5 * DN_BETA),
        "ln1_g": 1.0 + nrm(ks[10], (L, D), 0.01),
        "ln1_b": nrm(ks[11], (L, D), 0.01),
        "w_router": nrm(ks[12], (L, D, N_EXPERTS), D ** -0.5),
        "b_router": nrm(ks[13], (L, N_EXPERTS), 0.01),
        "w_gate_up": nrm(ks[14], (L, N_EXPERTS, D, 2 * D_FF), D ** -0.5),
        "b_gate_up": nrm(ks[15], (L, N_EXPERTS, 2 * D_FF), 0.01),
        "w_down": nrm(ks[16], (L, N_EXPERTS, D_FF, D), D_FF ** -0.5 * DN_BETA),
        "b_down": nrm(ks[17], (L, N_EXPERTS, D), 0.01),
        "ln2_g": 1.0 + nrm(ks[18], (L, D), 0.01),
        "ln2_b": nrm(ks[19], (L, D), 0.01),
    }


def reference(x, positions, w_in, pe_cmp, w_ck1, w_ck2, w_cv1, w_cv2, hg_lb, hg_norm_g,
              w_o, ln1_g, ln1_b, w_router, b_router, w_gate_up, b_gate_up, w_down, b_down,
              ln2_g, ln2_b):
    lbs = jnp.cumsum(jax.nn.softmax(hg_lb.astype(F32), axis=0), axis=0)
    split_at = np.cumsum(IN_SIZES)[:-1].tolist()
    h = x
    for l in range(DEPTH):
        proj = h @ w_in[l]
        (q_a, k_c, v_c, k_s, v_s, k_w, v_w, g_a, q_h, f_h, i_h, g_h) = jnp.split(proj, split_at, axis=-1)
        att = nsa_attention(q_a, k_c, v_c, k_s, v_s, k_w, v_w, g_a, positions,
                            pe_cmp[l], w_ck1[l], w_ck2[l], w_cv1[l], w_cv2[l])
        rec = hgrn2(q_h, f_h, i_h, g_h, lbs[l], hg_norm_g[l])
        mix = jnp.concatenate([att, rec], axis=-1) @ w_o[l]
        h = layer_norm(DN_ALPHA * h + mix, ln1_g[l], ln1_b[l])
        ffn = moe(h, w_router[l], b_router[l], w_gate_up[l], b_gate_up[l], w_down[l], b_down[l])
        h = layer_norm(DN_ALPHA * h + ffn, ln2_g[l], ln2_b[l])
    return h
```

```cpp
#include <hip/hip_runtime.h>
#include <hip/hip_cooperative_groups.h>
#include <stdint.h>
#include <stdio.h>
namespace cg = cooperative_groups;

typedef unsigned short u16;
typedef __attribute__((ext_vector_type(8))) short bf16x8;
typedef __attribute__((ext_vector_type(4))) float f32x4;
typedef __attribute__((ext_vector_type(16))) float f32x16;
#define DEVI __device__ __forceinline__

#ifndef N_LAUNCH_MODE
#define N_LAUNCH_MODE 1
#endif

constexpr int NTOK = 32768, SEQ = 8192, NB = 4;
constexpr int SP = 8224;
constexpr int NPHASE = 10;
constexpr int SMEM_BYTES = 65536;
constexpr float DN_ALPHA = 1.189207115002721f;

constexpr size_t MB = 1ull << 20;
constexpr size_t OFF_WIN = 0;
constexpr size_t OFF_WCK1 = 7 * MB;
constexpr size_t OFF_WCV1 = 8 * MB;
constexpr size_t OFF_WCK2 = 9 * MB;
constexpr size_t OFF_WCV2 = 9 * MB + 65536;
constexpr size_t OFF_WO = 10 * MB;
constexpr size_t OFF_ROPE = 12 * MB;
constexpr size_t OFF_GATES = 14 * MB;
constexpr size_t OFF_MISC = 17 * MB;
constexpr size_t OFF_LISTA = 18 * MB;
constexpr size_t OFF_LISTW = 22 * MB;
constexpr size_t OFF_HID = 26 * MB;
constexpr size_t OFF_KC = 30 * MB;
constexpr size_t OFF_VCT = 30 * MB + 524288;
constexpr size_t OFF_DG = 31 * MB;
constexpr size_t OFF_WGU = 32 * MB;
constexpr size_t OFF_WDN = 160 * MB;
constexpr size_t OFF_H1 = 224 * MB;
constexpr size_t OFF_H1B = 352 * MB;
constexpr size_t OFF_X = 416 * MB;
constexpr size_t OFF_XB = OFF_X;
constexpr size_t OFF_Q = OFF_X + 64 * MB;
constexpr size_t OFF_KCR = OFF_X + 96 * MB;
constexpr size_t OFF_VCR = OFF_X + 105 * MB;
constexpr size_t OFF_KS = OFF_X + 114 * MB;
constexpr size_t OFF_KW = OFF_X + 123 * MB;
constexpr size_t OFF_VST = OFF_X + 132 * MB;
constexpr size_t OFF_VWT = OFF_X + 141 * MB;
constexpr size_t OFF_QH = OFF_X + 150 * MB;
constexpr size_t OFF_LOGF = OFF_X + 182 * MB;
constexpr size_t OFF_VTH = OFF_X + 246 * MB;
constexpr size_t OFF_GH = OFF_X + 278 * MB;
constexpr size_t OFF_LBUF = OFF_X + 310 * MB;
constexpr size_t OFF_MIX = OFF_X + 374 * MB;
constexpr size_t OFF_PRE = OFF_X;
constexpr size_t OFF_ACT = OFF_X;
constexpr size_t OFF_Y = OFF_X + 256 * MB;
constexpr size_t WS_NEED = OFF_Y + 256 * MB;

struct Params {
    const float* x; const int* pos; const float* w_in; const float* pe;
    const float* w_ck1; const float* w_ck2; const float* w_cv1; const float* w_cv2;
    const float* hg_lb; const float* hg_ng; const float* w_o; const float* ln1g; const float* ln1b;
    const float* w_r; const float* b_r; const float* w_gu; const float* b_gu; const float* w_dn; const float* b_dn;
    const float* ln2g; const float* ln2b;
    float* out; char* ws;
    int ph_lo, ph_hi;
};

DEVI u16 f2bf(float f) { uint32_t u = __float_as_uint(f); u += 0x7fffu + ((u >> 16) & 1u); return (u16)(u >> 16); }
DEVI float bf2f(u16 h) { return __uint_as_float(((uint32_t)h) << 16); }
DEVI uint32_t pack2(float a, float b) { return (uint32_t)f2bf(a) | ((uint32_t)f2bf(b) << 16); }
DEVI bf16x8 pack8(f32x4 a, f32x4 b) {
    union { bf16x8 v; uint32_t u[4]; } r;
    r.u[0] = pack2(a[0], a[1]); r.u[1] = pack2(a[2], a[3]); r.u[2] = pack2(b[0], b[1]); r.u[3] = pack2(b[2], b[3]);
    return r.v;
}
DEVI uint2 pack4(f32x4 a) { uint2 r; r.x = pack2(a[0], a[1]); r.y = pack2(a[2], a[3]); return r; }
DEVI f32x4 mfma16(bf16x8 a, bf16x8 b, f32x4 c) { return __builtin_amdgcn_mfma_f32_16x16x32_bf16(a, b, c, 0, 0, 0); }
DEVI bf16x8 ld8(const u16* p) { return *reinterpret_cast<const bf16x8*>(p); }
DEVI bf16x8 zero8() { bf16x8 z = {0, 0, 0, 0, 0, 0, 0, 0}; return z; }
DEVI float sigmoidf_(float v) { return 1.f / (1.f + __expf(-v)); }
DEVI float xor16_max(float v) { v = fmaxf(v, __shfl_xor(v, 16)); v = fmaxf(v, __shfl_xor(v, 32)); return v; }
DEVI float xor16_sum(float v) { v += __shfl_xor(v, 16); v += __shfl_xor(v, 32); return v; }
DEVI float wave_sum(float v) {
#pragma unroll
    for (int o = 32; o > 0; o >>= 1) v += __shfl_xor(v, o);
    return v;
}
DEVI void glds16(const u16* g, u16* l) {
    __builtin_amdgcn_global_load_lds((const unsigned*)g, (__attribute__((address_space(3))) unsigned*)l, 16, 0, 0);
}

template <class AFn>
DEVI void gemm128(AFn arow, const u16* __restrict__ Bt, size_t ldb, int K, char* smem, f32x4 (&acc)[4][4]) {
    const int tid = threadIdx.x, lane = tid & 63, wid = tid >> 6, wr = wid >> 1, wc = wid & 1, fr = lane & 15, fq = lane >> 4;
    u16* SA = (u16*)smem; u16* SB = (u16*)(smem + 8192);
    const int r0 = tid >> 2, c0 = (tid & 3) * 8;
    const u16* a0 = arow(r0) + c0; const u16* a1 = arow(r0 + 64) + c0;
    const u16* b0 = Bt + (size_t)r0 * ldb + c0; const u16* b1 = Bt + (size_t)(r0 + 64) * ldb + c0;
#pragma unroll
    for (int m = 0; m < 4; ++m)
#pragma unroll
        for (int n = 0; n < 4; ++n) acc[m][n] = f32x4{0.f, 0.f, 0.f, 0.f};
    for (int kt = 0; kt < K; kt += 32) {
        glds16(a0 + kt, SA + tid * 8); glds16(a1 + kt, SA + 2048 + tid * 8);
        glds16(b0 + kt, SB + tid * 8); glds16(b1 + kt, SB + 2048 + tid * 8);
        asm volatile("s_waitcnt vmcnt(0)" ::: "memory");
        __syncthreads();
        bf16x8 af[4], bfr[4];
#pragma unroll
        for (int m = 0; m < 4; ++m) af[m] = ld8(SA + (wr * 64 + m * 16 + fr) * 32 + fq * 8);
#pragma unroll
        for (int n = 0; n < 4; ++n) bfr[n] = ld8(SB + (wc * 64 + n * 16 + fr) * 32 + fq * 8);
#pragma unroll
        for (int m = 0; m < 4; ++m)
#pragma unroll
            for (int n = 0; n < 4; ++n) acc[m][n] = mfma16(af[m], bfr[n], acc[m][n]);
        __syncthreads();
    }
}

template <class CM>
DEVI void tconv_tile(const float* __restrict__ src, size_t ld, u16* __restrict__ dst, size_t ldd, int r0, int k0, CM colmap, char* smem) {
    float (*t)[65] = (float (*)[65])smem;
    const int tid = threadIdx.x;
    {
        const int n = tid & 63; const int col = colmap(r0 + n);
#pragma unroll 4
        for (int i = 0; i < 16; ++i) {
            const int k = (tid >> 6) + 4 * i;
            t[k][n] = (col >= 0) ? src[(size_t)(k0 + k) * ld + col] : 0.f;
        }
    }
    __syncthreads();
    {
        const int k2 = (tid & 31) * 2;
#pragma unroll 4
        for (int i = 0; i < 8; ++i) {
            const int n = (tid >> 5) + 8 * i;
            *(uint32_t*)(dst + (size_t)(r0 + n) * ldd + k0 + k2) = pack2(t[k2][n], t[k2 + 1][n]);
        }
    }
    __syncthreads();
}

DEVI void phase_prep(const Params& p, char* smem) {
    char* ws = p.ws;
    constexpr int J_WIN = 54 * 16;
    constexpr int J_WCK1 = 4 * 32;
    constexpr int J_WC2 = 2 * 4;
    constexpr int J_WO = 16 * 16;
    constexpr int J_WGU = 32 * 32 * 16;
    constexpr int J_WDN = 32 * 16 * 16;
    constexpr int J_XB = 16384;
    constexpr int J_ROPE = 1024;
    constexpr int J0 = 0, J1 = J0 + J_WIN, J2 = J1 + 2 * J_WCK1, J3 = J2 + 2 * J_WC2, J4 = J3 + J_WO, J5 = J4 + J_WGU,
                  J6 = J5 + J_WDN, J7 = J6 + J_XB, J8 = J7 + J_ROPE, J9 = J8 + 1;
    for (int job = blockIdx.x; job < J9; job += gridDim.x) {
        const int tid = threadIdx.x;
        if (job < J1) {
            const int j = job - J0, rt = j / 16, kt = j % 16;
            auto cm = [](int r) { return r < 1280 ? r : (r < 3328 ? r + 24 : (r < 3352 ? 1280 + (r - 3328) : -1)); };
            tconv_tile(p.w_in, 3352, (u16*)(ws + OFF_WIN), 1024, rt * 64, kt * 64, cm, smem);
        } else if (job < J2) {
            int j = job - J1; const int which = j / J_WCK1; j %= J_WCK1; const int rt = j / 32, kt = j % 32;
            auto cm = [](int r) { return r; };
            tconv_tile(which ? p.w_cv1 : p.w_ck1, 256, (u16*)(ws + (which ? OFF_WCV1 : OFF_WCK1)), 2048, rt * 64, kt * 64, cm, smem);
        } else if (job < J3) {
            int j = job - J2; const int which = j / J_WC2; j %= J_WC2; const int rt = j / 4, kt = j % 4;
            auto cm = [](int r) { return r < 64 ? r : -1; };
            tconv_tile(which ? p.w_cv2 : p.w_ck2, 64, (u16*)(ws + (which ? OFF_WCV2 : OFF_WCK2)), 256, rt * 64, kt * 64, cm, smem);
        } else if (job < J4) {
            const int j = job - J3, rt = j / 16, kt = j % 16;
            auto cm = [](int r) { return r; };
            tconv_tile(p.w_o, 1024, (u16*)(ws + OFF_WO), 1024, rt * 64, kt * 64, cm, smem);
        } else if (job < J5) {
            int j = job - J4; const int e = j / 512; j %= 512; const int rt = j / 16, kt = j % 16;
            auto cm = [](int r) { const int ct = r >> 7, f = (r >> 4) & 7, jj = r & 15; return ((f & 1) ? 1024 : 0) + 64 * ct + 16 * (f >> 1) + jj; };
            tconv_tile(p.w_gu + (size_t)e * 1024 * 2048, 2048, (u16*)(ws + OFF_WGU) + (size_t)e * 2048 * 1024, 1024, rt * 64, kt * 64, cm, smem);
        } else if (job < J6) {
            int j = job - J5; const int e = j / 256; j %= 256; const int rt = j / 16, kt = j % 16;
            auto cm = [](int r) { return r; };
            tconv_tile(p.w_dn + (size_t)e * 1024 * 1024, 1024, (u16*)(ws + OFF_WDN) + (size_t)e * 1024 * 1024, 1024, rt * 64, kt * 64, cm, smem);
        } else if (job < J7) {
            const size_t base = (size_t)(job - J6) * 2048 + (size_t)tid * 8;
            const float4 a = *(const float4*)(p.x + base), b = *(const float4*)(p.x + base + 4);
            uint4 o; o.x = pack2(a.x, a.y); o.y = pack2(a.z, a.w); o.z = pack2(b.x, b.y); o.w = pack2(b.z, b.w);
            *(uint4*)((u16*)(ws + OFF_XB) + base) = o;
        } else if (job < J8) {
            const int idx = (job - J7) * 256 + tid;
            const int n = idx >> 3, i = idx & 7;
            const float inv = powf(500000.f, -(float)i / 8.f);
            const float ang = (float)p.pos[n] * inv;
            float s, c; sincosf(ang, &s, &c);
            float* ct = (float*)(ws + OFF_ROPE);
            ct[idx] = c; ct[NTOK * 8 + idx] = s;
        } else {
            float* misc = (float*)(ws + OFF_MISC);
            float sk = 0.f, sv = 0.f;
            for (int i = 0; i < 2048; ++i) { const float pe = p.pe[i]; sk += pe * p.w_ck1[(size_t)i * 256 + tid]; sv += pe * p.w_cv1[(size_t)i * 256 + tid]; }
            misc[tid] = sk; misc[256 + tid] = sv;
            for (int i = tid; i < 512; i += 256) { const float a0 = p.hg_lb[i], a1 = p.hg_lb[512 + i]; misc[512 + i] = 1.f / (1.f + expf(a1 - a0)); }
            if (tid < 32) ((int*)(misc + 1024))[tid] = 0;
        }
    }
}

DEVI f32x4 rope4(f32x4 v, int fr, const float* __restrict__ cs, int i0, int i1, int i2, int i3) {
    const int i = fr & 7; const float sg = (fr & 8) ? 1.f : -1.f;
    const int idx[4] = {i0, i1, i2, i3};
    f32x4 o;
#pragma unroll
    for (int j = 0; j < 4; ++j) {
        const float partner = __shfl_xor(v[j], 8);
        const float c = cs[(size_t)idx[j] * 8 + i], s = cs[(size_t)NTOK * 8 + (size_t)idx[j] * 8 + i];
        o[j] = v[j] * c + sg * partner * s;
    }
    return o;
}

DEVI void phase_proj(const Params& p, char* smem) {
    char* ws = p.ws;
    const u16* XB = (const u16*)(ws + OFF_XB); const u16* WIN = (const u16*)(ws + OFF_WIN);
    const float* cs = (const float*)(ws + OFF_ROPE); const float* lb = (const float*)(ws + OFF_MISC) + 512;
    const int tid = threadIdx.x, lane = tid & 63, wid = tid >> 6, wr = wid >> 1, wc = wid & 1, fr = lane & 15, fq = lane >> 4;
    for (int tile = blockIdx.x; tile < 256 * 27; tile += gridDim.x) {
        const int rt = tile / 27, ct = tile % 27;
        auto arow = [&](int r) { return XB + (size_t)(rt * 128 + r) * 1024; };
        f32x4 acc[4][4];
        gemm128(arow, WIN + (size_t)ct * 128 * 1024, 1024, 1024, smem, acc);
#pragma unroll
        for (int m = 0; m < 4; ++m) {
            const int tok = rt * 128 + wr * 64 + m * 16 + fq * 4;
            const int b = tok >> 13, s = tok & 8191;
#pragma unroll
            for (int n = 0; n < 4; ++n) {
                const int cc = wc * 64 + n * 16 + fr; const int d = n * 16 + fr;
                f32x4 v = acc[m][n];
                if (ct < 4) {
                    if (n == 0) v = rope4(v, fr, cs, tok, tok + 1, tok + 2, tok + 3);
                    u16* Q = (u16*)(ws + OFF_Q);
#pragma unroll
                    for (int j = 0; j < 4; ++j) Q[(size_t)(tok + j) * 512 + ct * 128 + cc] = f2bf(v[j] * 0.125f);
                } else if (ct == 4 || ct == 5) {
                    u16* dst = (u16*)(ws + (ct == 4 ? OFF_KCR : OFF_VCR));
#pragma unroll
                    for (int j = 0; j < 4; ++j) dst[((size_t)(b * 2 + wc) * SP + s + j) * 64 + d] = f2bf(v[j]);
                } else if (ct == 6 || ct == 8) {
                    if (n == 0) v = rope4(v, fr, cs, tok, tok + 1, tok + 2, tok + 3);
                    u16* dst = (u16*)(ws + (ct == 6 ? OFF_KS : OFF_KW));
#pragma unroll
                    for (int j = 0; j < 4; ++j) dst[((size_t)(b * 2 + wc) * 8192 + s + j) * 64 + d] = f2bf(v[j]);
                } else if (ct == 7 || ct == 9) {
                    u16* dst = (u16*)(ws + (ct == 7 ? OFF_VST : OFF_VWT));
                    *(uint2*)(dst + (((size_t)(b * 2 + wc) * 128 + (s >> 6)) * 64 + d) * 64 + (s & 63)) = pack4(v);
                } else if (ct < 14) {
                    u16* dst = (u16*)(ws + OFF_QH);
#pragma unroll
                    for (int j = 0; j < 4; ++j) dst[(size_t)(tok + j) * 512 + (ct - 10) * 128 + cc] = f2bf(v[j]);
                } else if (ct < 18) {
                    const int hk = (ct - 14) * 128 + cc; const float lbv = lb[hk];
                    float* dst = (float*)(ws + OFF_LOGF);
#pragma unroll
                    for (int j = 0; j < 4; ++j) {
                        const float fh = 1.f / (1.f + expf(-v[j]));
                        dst[(size_t)(tok + j) * 512 + hk] = logf(lbv + (1.f - lbv) * fh);
                    }
                } else if (ct < 22) {
                    u16* dst = (u16*)(ws + OFF_VTH);
                    *(uint2*)(dst + (((size_t)(b * 4 + (ct - 18)) * 128 + (s >> 6)) * 128 + cc) * 64 + (s & 63)) = pack4(v);
                } else if (ct < 26) {
                    u16* dst = (u16*)(ws + OFF_GH);
#pragma unroll
                    for (int j = 0; j < 4; ++j) dst[(size_t)(tok + j) * 512 + (ct - 22) * 128 + cc] = f2bf(v[j] / (1.f + expf(-v[j])));
                } else {
                    if (cc < 24) {
                        float* dst = (float*)(ws + OFF_GATES);
#pragma unroll
                        for (int j = 0; j < 4; ++j) dst[(size_t)(tok + j) * 24 + cc] = 1.f / (1.f + expf(-v[j]));
                    }
                }
            }
        }
    }
}

template <class F>
DEVI void hgrn_cumsum(const float* __restrict__ lfp  , char* smem_tot, float& blast, F f) {
    float* tot = (float*)smem_tot;
    const int tid = threadIdx.x, k = tid & 127, half = tid >> 7;
    float run = 0.f;
#pragma unroll 8
    for (int i = 0; i < 32; ++i) run += lfp[(size_t)(32 * half + i) * 512 + k];
    tot[half * 128 + k] = run;
    __syncthreads();
    const float t0 = tot[k], t1 = tot[128 + k];
    blast = t0 + t1;
    float bcur = half ? t0 : 0.f;
#pragma unroll 4
    for (int i = 0; i < 32; ++i) {
        const float lf = lfp[(size_t)(32 * half + i) * 512 + k];
        bcur += lf;
        f(32 * half + i, lf, bcur);
    }
}

DEVI void hgrn_local_tile(const Params& p, char* smem, int tile) {
    char* ws = p.ws;
    const int bh = tile >> 7, chunk = tile & 127, b = bh >> 2, h = bh & 3;
    const int tid = threadIdx.x, lane = tid & 63, w = tid >> 6, fr = lane & 15, fq = lane >> 4;
    const size_t n0 = (size_t)b * 8192 + chunk * 64;
    const float* lfp = (const float*)(ws + OFF_LOGF) + n0 * 512 + h * 128;
    u16* khT = (u16*)(smem + 1024);
    float blast;
    float* totp = (float*)smem;
    {
        const int k = tid & 127, half = tid >> 7;
        float run = 0.f;
#pragma unroll 8
        for (int i = 0; i < 32; ++i) run += lfp[(size_t)(32 * half + i) * 512 + k];
        totp[half * 128 + k] = run;
        __syncthreads();
        const float t0 = totp[k], t1 = totp[128 + k];
        blast = t0 + t1;
        float bcur = half ? t0 : 0.f;
#pragma unroll 4
        for (int i = 0; i < 32; ++i) {
            const float lf = lfp[(size_t)(32 * half + i) * 512 + k];
            bcur += lf;
            const float kh = (1.f - expf(lf)) * expf(blast - bcur);
            khT[k * 72 + 32 * half + i] = f2bf(kh);
        }
        if (half == 0) ((float*)(ws + OFF_DG))[(size_t)tile * 128 + k] = expf(blast);
    }
    __syncthreads();
    const u16* vT = (const u16*)(ws + OFF_VTH) + (size_t)tile * 128 * 64;
    f32x4 acc[2][8];
#pragma unroll
    for (int m = 0; m < 2; ++m)
#pragma unroll
        for (int n = 0; n < 8; ++n) acc[m][n] = f32x4{0.f, 0.f, 0.f, 0.f};
#pragma unroll
    for (int ks = 0; ks < 2; ++ks) {
        bf16x8 a[2];
#pragma unroll
        for (int m = 0; m < 2; ++m) a[m] = ld8(khT + (32 * w + 16 * m + fr) * 72 + 32 * ks + 8 * fq);
#pragma unroll
        for (int n = 0; n < 8; ++n) {
            const bf16x8 bv = ld8(vT + (size_t)(16 * n + fr) * 64 + 32 * ks + 8 * fq);
#pragma unroll
            for (int m = 0; m < 2; ++m) acc[m][n] = mfma16(a[m], bv, acc[m][n]);
        }
    }
    u16* L = (u16*)(ws + OFF_LBUF) + (size_t)tile * 128 * 128;
#pragma unroll
    for (int m = 0; m < 2; ++m)
#pragma unroll
        for (int n = 0; n < 8; ++n) *(uint2*)(L + (size_t)(16 * n + fr) * 128 + 32 * w + 16 * m + 4 * fq) = pack4(acc[m][n]);
    __syncthreads();
}

DEVI void hgrn_scan_task(const Params& p, int task) {
    char* ws = p.ws;
    const int gid = task * 256 + threadIdx.x;
    const int bh = gid >> 13, v = (gid >> 6) & 127, kp = gid & 63;
    uint32_t* L = (uint32_t*)(ws + OFF_LBUF) + ((size_t)bh * 128 * 128 * 128 + (size_t)v * 128) / 2 + kp;
    const float2* Dg = (const float2*)(ws + OFF_DG) + (size_t)bh * 128 * 64 + kp;
    float s0 = 0.f, s1 = 0.f;
#pragma unroll 8
    for (int c = 0; c < 128; ++c) {
        const uint32_t l = L[(size_t)c * 8192];
        const float2 d = Dg[(size_t)c * 64];
        L[(size_t)c * 8192] = pack2(s0, s1);
        s0 = d.x * s0 + __uint_as_float(l << 16);
        s1 = d.y * s1 + __uint_as_float(l & 0xffff0000u);
    }
}

DEVI void hgrn_out_tile(const Params& p, char* smem, int tile) {
    char* ws = p.ws;
    const int bh = tile >> 7, chunk = tile & 127, b = bh >> 2, h = bh & 3;
    const int tid = threadIdx.x, lane = tid & 63, w = tid >> 6, fr = lane & 15, fq = lane >> 4;
    const size_t n0 = (size_t)b * 8192 + chunk * 64;
    const float* lfp = (const float*)(ws + OFF_LOGF) + n0 * 512 + h * 128;
    const u16* qh = (const u16*)(ws + OFF_QH) + n0 * 512 + h * 128;
    float* totp = (float*)smem;
    u16* qt = (u16*)(smem + 1024);
    u16* kt = qt + 64 * 136;
    {
        const int k = tid & 127, half = tid >> 7;
        float run = 0.f;
#pragma unroll 8
        for (int i = 0; i < 32; ++i) run += lfp[(size_t)(32 * half + i) * 512 + k];
        totp[half * 128 + k] = run;
        __syncthreads();
        float bcur = half ? totp[k] : 0.f;
#pragma unroll 4
        for (int i = 0; i < 32; ++i) {
            const int t = 32 * half + i;
            const float lf = lfp[(size_t)t * 512 + k];
            bcur += lf;
            const float q = bf2f(qh[(size_t)t * 512 + k]);
            qt[t * 136 + k] = f2bf(q * expf(bcur));
            kt[t * 136 + k] = f2bf((1.f - expf(lf)) * expf(-bcur));
        }
    }
    __syncthreads();
    bf16x8 qb[4];
#pragma unroll
    for (int ks = 0; ks < 4; ++ks) qb[ks] = ld8(qt + (16 * w + fr) * 136 + 32 * ks + 8 * fq);
    f32x4 at[4];
#pragma unroll
    for (int sf = 0; sf < 4; ++sf) {
        const int srow = 32 * (sf >> 1) + 8 * (fr >> 2) + 4 * (sf & 1) + (fr & 3);
        f32x4 a = f32x4{0.f, 0.f, 0.f, 0.f};
#pragma unroll
        for (int ks = 0; ks < 4; ++ks) a = mfma16(ld8(kt + srow * 136 + 32 * ks + 8 * fq), qb[ks], a);
        const int tcol = 16 * w + fr;
#pragma unroll
        for (int r = 0; r < 4; ++r) { const int s = 32 * (sf >> 1) + 8 * fq + 4 * (sf & 1) + r; if (s > tcol) a[r] = 0.f; }
        at[sf] = a;
    }
    const u16* vT = (const u16*)(ws + OFF_VTH) + (size_t)tile * 128 * 64;
    const u16* ST = (const u16*)(ws + OFF_LBUF) + (size_t)tile * 128 * 128;
    f32x4 o[8];
#pragma unroll
    for (int mf = 0; mf < 8; ++mf) o[mf] = f32x4{0.f, 0.f, 0.f, 0.f};
#pragma unroll
    for (int sc = 0; sc < 2; ++sc) {
        const bf16x8 pb = pack8(at[2 * sc], at[2 * sc + 1]);
#pragma unroll
        for (int mf = 0; mf < 8; ++mf) o[mf] = mfma16(ld8(vT + (size_t)(16 * mf + fr) * 64 + 32 * sc + 8 * fq), pb, o[mf]);
    }
#pragma unroll
    for (int ks = 0; ks < 4; ++ks)
#pragma unroll
        for (int mf = 0; mf < 8; ++mf) o[mf] = mfma16(ld8(ST + (size_t)(16 * mf + fr) * 128 + 32 * ks + 8 * fq), qb[ks], o[mf]);
    float ss = 0.f;
#pragma unroll
    for (int mf = 0; mf < 8; ++mf)
#pragma unroll
        for (int r = 0; r < 4; ++r) ss += o[mf][r] * o[mf][r];
    ss = xor16_sum(ss);
    const float rn = rsqrtf(ss * (1.f / 128.f) + 1e-6f);
    const size_t tok = n0 + 16 * w + fr;
    const u16* gh = (const u16*)(ws + OFF_GH) + tok * 512 + h * 128;
    u16* mix = (u16*)(ws + OFF_MIX) + tok * 1024 + 512 + h * 128;
#pragma unroll
    for (int mf = 0; mf < 8; ++mf) {
        const int v0 = 16 * mf + 4 * fq;
        const uint2 g2 = *(const uint2*)(gh + v0);
        const float4 ng = *(const float4*)(p.hg_ng + v0);
        f32x4 r;
        r[0] = o[mf][0] * rn * ng.x * __uint_as_float(g2.x << 16);
        r[1] = o[mf][1] * rn * ng.y * __uint_as_float(g2.x & 0xffff0000u);
        r[2] = o[mf][2] * rn * ng.z * __uint_as_float(g2.y << 16);
        r[3] = o[mf][3] * rn * ng.w * __uint_as_float(g2.y & 0xffff0000u);
        *(uint2*)(mix + v0) = pack4(r);
    }
    __syncthreads();
}

DEVI float gelu_tanh(float x) { const float u = 0.7978845608028654f * (x + 0.044715f * x * x * x); return 0.5f * x * (1.f + tanhf(u)); }

DEVI void cmp1_tile(const Params& p, char* smem, int tile) {
    char* ws = p.ws;
    const int which = tile >> 6, rt = (tile >> 1) & 31, ct = tile & 1;
    const int tid = threadIdx.x, lane = tid & 63, wid = tid >> 6, wr = wid >> 1, wc = wid & 1, fr = lane & 15, fq = lane >> 4;
    const u16* src = (const u16*)(ws + (which ? OFF_VCR : OFF_KCR));
    auto arow = [&](int r) { const int m = rt * 128 + r; return src + ((size_t)(m >> 9) * SP + 16 * (m & 511)) * 64; };
    const u16* Bt = (const u16*)(ws + (which ? OFF_WCV1 : OFF_WCK1)) + (size_t)ct * 128 * 2048;
    f32x4 acc[4][4];
    gemm128(arow, Bt, 2048, 2048, smem, acc);
    const float* bias = (const float*)(ws + OFF_MISC) + which * 256;
    u16* hid = (u16*)(ws + OFF_HID) + (size_t)which * 4096 * 256;
#pragma unroll
    for (int m = 0; m < 4; ++m)
#pragma unroll
        for (int n = 0; n < 4; ++n) {
            const int row = rt * 128 + wr * 64 + m * 16 + fq * 4, col = ct * 128 + wc * 64 + n * 16 + fr;
            const float bv = bias[col];
#pragma unroll
            for (int j = 0; j < 4; ++j) hid[(size_t)(row + j) * 256 + col] = f2bf(gelu_tanh(acc[m][n][j] + bv));
        }
}

DEVI void cmp2_tile(const Params& p, char* smem, int tile) {
    char* ws = p.ws;
    const int which = tile >> 5, rt = tile & 31;
    const int tid = threadIdx.x, lane = tid & 63, wid = tid >> 6, wr = wid >> 1, wc = wid & 1, fr = lane & 15, fq = lane >> 4;
    const u16* hid = (const u16*)(ws + OFF_HID) + (size_t)which * 4096 * 256;
    auto arow = [&](int r) { return hid + (size_t)(rt * 128 + r) * 256; };
    const u16* Bt = (const u16*)(ws + (which ? OFF_WCV2 : OFF_WCK2));
    f32x4 acc[4][4];
    gemm128(arow, Bt, 256, 256, smem, acc);
    if (wc == 0) {
        const float* cs = (const float*)(ws + OFF_ROPE);
#pragma unroll
        for (int m = 0; m < 4; ++m) {
            const int row = rt * 128 + wr * 64 + m * 16 + fq * 4;
            const int bg = row >> 9, c = row & 511, b = bg >> 1;
#pragma unroll
            for (int n = 0; n < 4; ++n) {
                const int d = n * 16 + fr;
                f32x4 v = acc[m][n];
                if (which == 0) {
                    if (n == 0) {
                        int ix[4];
#pragma unroll
                        for (int j = 0; j < 4; ++j) { int sp = 16 * (c + j) + 31; sp = sp > 8191 ? 8191 : sp; ix[j] = b * 8192 + sp; }
                        v = rope4(v, fr, cs, ix[0], ix[1], ix[2], ix[3]);
                    }
                    u16* kc = (u16*)(ws + OFF_KC);
#pragma unroll
                    for (int j = 0; j < 4; ++j) kc[((size_t)bg * 512 + c + j) * 64 + d] = f2bf(v[j]);
                } else {
                    u16* vct = (u16*)(ws + OFF_VCT);
                    *(uint2*)(vct + (((size_t)bg * 8 + (c >> 6)) * 64 + d) * 64 + (c & 63)) = pack4(v);
                }
            }
        }
    }
}

DEVI uint64_t lowest_bits(uint64_t mask, int n) {
    uint64_t out = 0;
    while (n > 0 && mask) { const uint64_t b = mask & (~mask + 1); out |= b; mask ^= b; --n; }
    return out;
}

DEVI void nsa_tile(const Params& p, char* smem, int tile) {
    char* ws = p.ws;
    const int bg = tile & 7, cur = 127 - (tile >> 3), b = bg >> 1, g = bg & 1;
    const int tid = threadIdx.x, lane = tid & 63, w = tid >> 6, fr = lane & 15, fq = lane >> 4;
    const int t0 = cur * 64 + w * 16;
    const size_t n0 = (size_t)b * 8192 + t0;
    const int tok = t0 + fr;
    const u16* Qb = (const u16*)(ws + OFF_Q);
    const u16* Kc = (const u16*)(ws + OFF_KC) + (size_t)bg * 512 * 64;
    const u16* Vct = (const u16*)(ws + OFF_VCT) + (size_t)bg * 8 * 64 * 64;
    const u16* Ks = (const u16*)(ws + OFF_KS) + (size_t)bg * 8192 * 64;
    const u16* Kw = (const u16*)(ws + OFF_KW) + (size_t)bg * 8192 * 64;
    const u16* Vst = (const u16*)(ws + OFF_VST) + (size_t)bg * 128 * 64 * 64;
    const u16* Vwt = (const u16*)(ws + OFF_VWT) + (size_t)bg * 128 * 64 * 64;
    const float* gates = (const float*)(ws + OFF_GATES);
    float* wl = (float*)(smem + w * 16384);

    bf16x8 qf[4][2];
#pragma unroll
    for (int h = 0; h < 4; ++h)
#pragma unroll
        for (int ks = 0; ks < 2; ++ks) qf[h][ks] = ld8(Qb + (n0 + fr) * 512 + (g * 4 + h) * 64 + 32 * ks + 8 * fq);

    const int nc = t0 >> 4;
    const int nchunk = (nc + 31) >> 5;
    float mC[4], lC[4];
#pragma unroll
    for (int h = 0; h < 4; ++h) { mC[h] = -1e30f; lC[h] = 0.f; }
    for (int ch = 0; ch < nchunk; ++ch) {
        f32x4 s[4][2];
#pragma unroll
        for (int u = 0; u < 2; ++u) {
            const int crow = 32 * ch + 8 * (fr >> 2) + 4 * u + (fr & 3);
            const u16* kp = Kc + (size_t)crow * 64 + 8 * fq;
            const bf16x8 k0 = ld8(kp), k1 = ld8(kp + 32);
#pragma unroll
            for (int h = 0; h < 4; ++h) {
                f32x4 a = f32x4{0.f, 0.f, 0.f, 0.f};
                a = mfma16(k0, qf[h][0], a); a = mfma16(k1, qf[h][1], a);
                s[h][u] = a;
            }
        }
#pragma unroll
        for (int h = 0; h < 4; ++h) {
            float mx = -1e30f;
#pragma unroll
            for (int u = 0; u < 2; ++u)
#pragma unroll
                for (int r = 0; r < 4; ++r) {
                    const int c = 32 * ch + 8 * fq + 4 * u + r;
                    const float v = (16 * c + 31 <= tok) ? s[h][u][r] : -1e30f;
                    s[h][u][r] = v; mx = fmaxf(mx, v);
                }
            mx = xor16_max(mx);
            const float mn = fmaxf(mC[h], mx);
            float sum = 0.f;
#pragma unroll
            for (int u = 0; u < 2; ++u)
#pragma unroll
                for (int r = 0; r < 4; ++r) sum += (s[h][u][r] > -1e29f) ? __expf(s[h][u][r] - mn) : 0.f;
            lC[h] = lC[h] * __expf(mC[h] - mn) + sum; mC[h] = mn;
        }
    }
    float ilC[4];
#pragma unroll
    for (int h = 0; h < 4; ++h) { const float l = xor16_sum(lC[h]); ilC[h] = l > 0.f ? 1.f / l : 0.f; }
    f32x4 oc[4][4];
#pragma unroll
    for (int h = 0; h < 4; ++h)
#pragma unroll
        for (int mf = 0; mf < 4; ++mf) oc[h][mf] = f32x4{0.f, 0.f, 0.f, 0.f};
    for (int ch = 0; ch < nchunk; ++ch) {
        f32x4 s[4][2];
#pragma unroll
        for (int u = 0; u < 2; ++u) {
            const int crow = 32 * ch + 8 * (fr >> 2) + 4 * u + (fr & 3);
            const u16* kp = Kc + (size_t)crow * 64 + 8 * fq;
            const bf16x8 k0 = ld8(kp), k1 = ld8(kp + 32);
#pragma unroll
            for (int h = 0; h < 4; ++h) {
                f32x4 a = f32x4{0.f, 0.f, 0.f, 0.f};
                a = mfma16(k0, qf[h][0], a); a = mfma16(k1, qf[h][1], a);
                s[h][u] = a;
            }
        }
        float qs[2] = {0.f, 0.f}, p3[2] = {0.f, 0.f};
        bf16x8 pb[4];
#pragma unroll
        for (int h = 0; h < 4; ++h) {
#pragma unroll
            for (int u = 0; u < 2; ++u)
#pragma unroll
                for (int r = 0; r < 4; ++r) {
                    const int c = 32 * ch + 8 * fq + 4 * u + r;
                    const float pv = (16 * c + 31 <= tok) ? __expf(s[h][u][r] - mC[h]) * ilC[h] : 0.f;
                    s[h][u][r] = pv; qs[u] += pv; if (r == 3) p3[u] += pv;
                }
            pb[h] = pack8(s[h][0], s[h][1]);
        }
#pragma unroll
        for (int u = 0; u < 2; ++u) { const int j = 8 * ch + 2 * fq + u; wl[fr * 128 + j] = qs[u]; wl[2048 + fr * 128 + j] = p3[u]; }
#pragma unroll
        for (int mf = 0; mf < 4; ++mf) {
            const bf16x8 va = ld8(Vct + ((size_t)(ch >> 1) * 64 + 16 * mf + fr) * 64 + 32 * (ch & 1) + 8 * fq);
#pragma unroll
            for (int h = 0; h < 4; ++h) oc[h][mf] = mfma16(va, pb[h], oc[h][mf]);
        }
    }
    __syncthreads();
    uint64_t selA = 0, selB = 0;
    if (cur < 16) {
        selA = (2ull << cur) - 1ull; selB = 0;
    } else {
        for (int tau = 0; tau < 16; ++tau) {
            const int j0 = lane, j1 = lane + 64;
            const bool in0 = (j0 >= 1) && (j0 <= cur - 2), in1 = (j1 <= cur - 2);
            const float v0 = in0 ? wl[tau * 128 + j0] + wl[2048 + tau * 128 + j0 - 1] : 0.f;
            const float v1 = in1 ? wl[tau * 128 + j1] + wl[2048 + tau * 128 + j1 - 1] : 0.f;
            const uint32_t u0 = __float_as_uint(v0), u1 = __float_as_uint(v1);
            uint32_t res = 0;
            for (int bit = 30; bit >= 0; --bit) {
                const uint32_t cand = res | (1u << bit);
                const int cnt = __popcll(__ballot(in0 && u0 >= cand)) + __popcll(__ballot(in1 && u1 >= cand));
                if (cnt >= 13) res = cand;
            }
            const uint64_t g0 = __ballot(in0 && u0 > res), g1 = __ballot(in1 && u1 > res);
            const uint64_t e0 = __ballot(in0 && u0 == res), e1 = __ballot(in1 && u1 == res);
            int need = 13 - (__popcll(g0) + __popcll(g1));
            const int ne0 = __popcll(e0);
            uint64_t sa = g0 | lowest_bits(e0, need);
            need -= (need < ne0 ? need : ne0);
            uint64_t sb = g1 | lowest_bits(e1, need);
            sa |= 1ull;
            if (cur - 1 < 64) sa |= 1ull << (cur - 1); else sb |= 1ull << (cur - 1 - 64);
            if (cur < 64) sa |= 1ull << cur; else sb |= 1ull << (cur - 64);
            if (lane == tau) { selA = sa; selB = sb; }
        }
    }
    __syncthreads();
    {
        const float* gp = gates + (n0 + fr) * 24 + g * 12;
#pragma unroll
        for (int h = 0; h < 4; ++h) {
            const float gc = gp[h * 3 + 0];
#pragma unroll
            for (int mf = 0; mf < 4; ++mf) {
                const int d = (16 * mf + 4 * fq) ^ (fr << 2);
                float4 o4; o4.x = oc[h][mf][0] * gc; o4.y = oc[h][mf][1] * gc; o4.z = oc[h][mf][2] * gc; o4.w = oc[h][mf][3] * gc;
                *(float4*)(wl + fr * 256 + h * 64 + d) = o4;
            }
        }
    }
    {
        int kbeg = t0 - 511; kbeg = kbeg < 0 ? 0 : kbeg; kbeg &= ~31;
        const int nch = (t0 + 16 - kbeg + 31) >> 5;
        float mW[4], lW[4];
        f32x4 ow[4][4];
#pragma unroll
        for (int h = 0; h < 4; ++h) {
            mW[h] = -1e30f; lW[h] = 0.f;
#pragma unroll
            for (int mf = 0; mf < 4; ++mf) ow[h][mf] = f32x4{0.f, 0.f, 0.f, 0.f};
        }
        for (int ch = 0; ch < nch; ++ch) {
            const int kb = kbeg + 32 * ch;
            f32x4 s[4][2];
#pragma unroll
            for (int u = 0; u < 2; ++u) {
                const int krow = kb + 8 * (fr >> 2) + 4 * u + (fr & 3);
                const u16* kp = Kw + (size_t)krow * 64 + 8 * fq;
                const bf16x8 k0 = ld8(kp), k1 = ld8(kp + 32);
#pragma unroll
                for (int h = 0; h < 4; ++h) {
                    f32x4 a = f32x4{0.f, 0.f, 0.f, 0.f};
                    a = mfma16(k0, qf[h][0], a); a = mfma16(k1, qf[h][1], a);
                    s[h][u] = a;
                }
            }
            bf16x8 pb[4];
#pragma unroll
            for (int h = 0; h < 4; ++h) {
                float mx = -1e30f;
#pragma unroll
                for (int u = 0; u < 2; ++u)
#pragma unroll
                    for (int r = 0; r < 4; ++r) {
                        const int key = kb + 8 * fq + 4 * u + r;
                        const float v = (key <= tok && key > tok - 512) ? s[h][u][r] : -1e30f;
                        s[h][u][r] = v; mx = fmaxf(mx, v);
                    }
                mx = xor16_max(mx);
                const float mn = fmaxf(mW[h], mx);
                const float sc = __expf(mW[h] - mn);
                float sum = 0.f;
#pragma unroll
                for (int u = 0; u < 2; ++u)
#pragma unroll
                    for (int r = 0; r < 4; ++r) { const float pv = (s[h][u][r] > -1e29f) ? __expf(s[h][u][r] - mn) : 0.f; s[h][u][r] = pv; sum += pv; }
                lW[h] = lW[h] * sc + sum; mW[h] = mn;
#pragma unroll
                for (int mf = 0; mf < 4; ++mf) { ow[h][mf][0] *= sc; ow[h][mf][1] *= sc; ow[h][mf][2] *= sc; ow[h][mf][3] *= sc; }
                pb[h] = pack8(s[h][0], s[h][1]);
            }
#pragma unroll
            for (int mf = 0; mf < 4; ++mf) {
                const bf16x8 va = ld8(Vwt + ((size_t)(kb >> 6) * 64 + 16 * mf + fr) * 64 + (kb & 63) + 8 * fq);
#pragma unroll
                for (int h = 0; h < 4; ++h) ow[h][mf] = mfma16(va, pb[h], ow[h][mf]);
            }
        }
        const float* gp = gates + (n0 + fr) * 24 + g * 12;
#pragma unroll
        for (int h = 0; h < 4; ++h) {
            const float l = xor16_sum(lW[h]);
            const float gw = gp[h * 3 + 2] * (l > 0.f ? 1.f / l : 0.f);
#pragma unroll
            for (int mf = 0; mf < 4; ++mf) {
                const int d = (16 * mf + 4 * fq) ^ (fr << 2);
                float4 o4 = *(float4*)(wl + fr * 256 + h * 64 + d);
                o4.x += ow[h][mf][0] * gw; o4.y += ow[h][mf][1] * gw; o4.z += ow[h][mf][2] * gw; o4.w += ow[h][mf][3] * gw;
                *(float4*)(wl + fr * 256 + h * 64 + d) = o4;
            }
        }
    }
    __syncthreads();
    for (int tau = 0; tau < 16; ++tau) {
        const int t = t0 + tau;
        uint64_t sa = ((uint64_t)(uint32_t)__builtin_amdgcn_readlane((int)(selA & 0xffffffffu), tau)) |
                      ((uint64_t)(uint32_t)__builtin_amdgcn_readlane((int)(selA >> 32), tau) << 32);
        uint64_t sb = ((uint64_t)(uint32_t)__builtin_amdgcn_readlane((int)(selB & 0xffffffffu), tau)) |
                      ((uint64_t)(uint32_t)__builtin_amdgcn_readlane((int)(selB >> 32), tau) << 32);
        bf16x8 qb[2];
#pragma unroll
        for (int ks = 0; ks < 2; ++ks) qb[ks] = (fr < 4) ? ld8(Qb + (n0 + tau) * 512 + (g * 4 + fr) * 64 + 32 * ks + 8 * fq) : zero8();
        float mS = -1e30f, lS = 0.f;
        f32x4 os[4];
#pragma unroll
        for (int mf = 0; mf < 4; ++mf) os[mf] = f32x4{0.f, 0.f, 0.f, 0.f};
        while (sa | sb) {
            int jb;
            if (sa) { jb = __builtin_ctzll(sa); sa &= sa - 1; } else { jb = 64 + __builtin_ctzll(sb); sb &= sb - 1; }
            f32x4 s[2][2];
#pragma unroll
            for (int sc = 0; sc < 2; ++sc)
#pragma unroll
                for (int u = 0; u < 2; ++u) {
                    const int krow = 64 * jb + 32 * sc + 8 * (fr >> 2) + 4 * u + (fr & 3);
                    const u16* kp = Ks + (size_t)krow * 64 + 8 * fq;
                    f32x4 a = f32x4{0.f, 0.f, 0.f, 0.f};
                    a = mfma16(ld8(kp), qb[0], a); a = mfma16(ld8(kp + 32), qb[1], a);
                    s[sc][u] = a;
                }
            float mx = -1e30f;
#pragma unroll
            for (int sc = 0; sc < 2; ++sc)
#pragma unroll
                for (int u = 0; u < 2; ++u)
#pragma unroll
                    for (int r = 0; r < 4; ++r) {
                        const int key = 64 * jb + 32 * sc + 8 * fq + 4 * u + r;
                        const float v = (key <= t) ? s[sc][u][r] : -1e30f;
                        s[sc][u][r] = v; mx = fmaxf(mx, v);
                    }
            mx = xor16_max(mx);
            const float mn = fmaxf(mS, mx);
            const float scl = __expf(mS - mn);
            float sum = 0.f;
#pragma unroll
            for (int sc = 0; sc < 2; ++sc)
#pragma unroll
                for (int u = 0; u < 2; ++u)
#pragma unroll
                    for (int r = 0; r < 4; ++r) { const float pv = (s[sc][u][r] > -1e29f) ? __expf(s[sc][u][r] - mn) : 0.f; s[sc][u][r] = pv; sum += pv; }
            lS = lS * scl + sum; mS = mn;
#pragma unroll
            for (int mf = 0; mf < 4; ++mf) { os[mf][0] *= scl; os[mf][1] *= scl; os[mf][2] *= scl; os[mf][3] *= scl; }
#pragma unroll
            for (int sc = 0; sc < 2; ++sc) {
                const bf16x8 pb = pack8(s[sc][0], s[sc][1]);
#pragma unroll
                for (int mf = 0; mf < 4; ++mf) os[mf] = mfma16(ld8(Vst + ((size_t)jb * 64 + 16 * mf + fr) * 64 + 32 * sc + 8 * fq), pb, os[mf]);
            }
        }
        const float l = xor16_sum(lS);
        if (fr < 4) {
            const float gs = gates[(n0 + tau) * 24 + (g * 4 + fr) * 3 + 1] * (l > 0.f ? 1.f / l : 0.f);
#pragma unroll
            for (int mf = 0; mf < 4; ++mf) {
                const int d = (16 * mf + 4 * fq) ^ (tau << 2);
                float4 o4 = *(float4*)(wl + tau * 256 + fr * 64 + d);
                o4.x += os[mf][0] * gs; o4.y += os[mf][1] * gs; o4.z += os[mf][2] * gs; o4.w += os[mf][3] * gs;
                *(float4*)(wl + tau * 256 + fr * 64 + d) = o4;
            }
        }
    }
    __syncthreads();
    {
        u16* mix = (u16*)(ws + OFF_MIX) + (n0 + fr) * 1024 + g * 256;
#pragma unroll
        for (int h = 0; h < 4; ++h)
#pragma unroll
            for (int mf = 0; mf < 4; ++mf) {
                const int d = (16 * mf + 4 * fq) ^ (fr << 2);
                const float4 o4 = *(float4*)(wl + fr * 256 + h * 64 + d);
                f32x4 r; r[0] = o4.x; r[1] = o4.y; r[2] = o4.z; r[3] = o4.w;
                *(uint2*)(mix + h * 64 + 16 * mf + 4 * fq) = pack4(r);
            }
    }
    __syncthreads();
}

DEVI void wo_tile(const Params& p, char* smem, int tile) {
    char* ws = p.ws;
    const int rt = tile >> 3, ct = tile & 7;
    const int tid = threadIdx.x, lane = tid & 63, wid = tid >> 6, wr = wid >> 1, wc = wid & 1, fr = lane & 15, fq = lane >> 4;
    const u16* MIX = (const u16*)(ws + OFF_MIX);
    auto arow = [&](int r) { return MIX + (size_t)(rt * 128 + r) * 1024; };
    f32x4 acc[4][4];
    gemm128(arow, (const u16*)(ws + OFF_WO) + (size_t)ct * 128 * 1024, 1024, 1024, smem, acc);
    float* pre = (float*)(ws + OFF_PRE);
#pragma unroll
    for (int m = 0; m < 4; ++m)
#pragma unroll
        for (int n = 0; n < 4; ++n) {
            const int row = rt * 128 + wr * 64 + m * 16 + fq * 4, col = ct * 128 + wc * 64 + n * 16 + fr;
#pragma unroll
            for (int j = 0; j < 4; ++j) {
                const size_t ix = (size_t)(row + j) * 1024 + col;
                pre[ix] = DN_ALPHA * p.x[ix] + acc[m][n][j];
            }
        }
}

DEVI void ln1_router_tile(const Params& p, char* smem, int tile) {
    char* ws = p.ws;
    const int tid = threadIdx.x, lane = tid & 63, w = tid >> 6;
    const int tok0 = tile * 32;
    const float* pre = (const float*)(ws + OFF_PRE);
    float* H1 = (float*)(ws + OFF_H1); u16* H1B = (u16*)(ws + OFF_H1B);
    for (int i = 0; i < 8; ++i) {
        const size_t row = (size_t)tok0 + w * 8 + i;
        float4 v[4];
        float s = 0.f;
#pragma unroll
        for (int q = 0; q < 4; ++q) { v[q] = *(const float4*)(pre + row * 1024 + q * 256 + lane * 4); s += v[q].x + v[q].y + v[q].z + v[q].w; }
        const float mu = wave_sum(s) * (1.f / 1024.f);
        float ss = 0.f;
#pragma unroll
        for (int q = 0; q < 4; ++q) { v[q].x -= mu; v[q].y -= mu; v[q].z -= mu; v[q].w -= mu; ss += v[q].x * v[q].x + v[q].y * v[q].y + v[q].z * v[q].z + v[q].w * v[q].w; }
        const float rs = rsqrtf(wave_sum(ss) * (1.f / 1024.f) + 1e-5f);
#pragma unroll
        for (int q = 0; q < 4; ++q) {
            const int c = q * 256 + lane * 4;
            const float4 gq = *(const float4*)(p.ln1g + c), bq = *(const float4*)(p.ln1b + c);
            float4 o; o.x = v[q].x * rs * gq.x + bq.x; o.y = v[q].y * rs * gq.y + bq.y; o.z = v[q].z * rs * gq.z + bq.z; o.w = v[q].w * rs * gq.w + bq.w;
            *(float4*)(H1 + row * 1024 + c) = o;
            uint2 ob; ob.x = pack2(o.x, o.y); ob.y = pack2(o.z, o.w);
            *(uint2*)(H1B + row * 1024 + c) = ob;
        }
    }
    __threadfence();
    __syncthreads();
    float* part = (float*)smem;
    int* lcnt = (int*)(smem + 4 * 32 * 33 * 4);
    {
        f32x16 acc;
#pragma unroll
        for (int i = 0; i < 16; ++i) acc[i] = 0.f;
        const int i32 = lane & 31, hh = lane >> 5;
        const float* ap = H1 + ((size_t)tok0 + i32) * 1024 + 256 * w + 4 * hh;
        const float* bp = p.w_r + (size_t)(256 * w + 4 * hh) * 32 + i32;
#pragma unroll 2
        for (int m = 0; m < 32; ++m) {
            const float4 a = *(const float4*)(ap + 8 * m);
            const float b0 = bp[(size_t)(8 * m + 0) * 32], b1 = bp[(size_t)(8 * m + 1) * 32], b2 = bp[(size_t)(8 * m + 2) * 32], b3 = bp[(size_t)(8 * m + 3) * 32];
            acc = __builtin_amdgcn_mfma_f32_32x32x2f32(a.x, b0, acc, 0, 0, 0);
            acc = __builtin_amdgcn_mfma_f32_32x32x2f32(a.y, b1, acc, 0, 0, 0);
            acc = __builtin_amdgcn_mfma_f32_32x32x2f32(a.z, b2, acc, 0, 0, 0);
            acc = __builtin_amdgcn_mfma_f32_32x32x2f32(a.w, b3, acc, 0, 0, 0);
        }
#pragma unroll
        for (int r = 0; r < 16; ++r) {
            const int row = (r & 3) + 8 * (r >> 2) + 4 * hh;
            part[(w * 32 + row) * 33 + i32] = acc[r];
        }
    }
    if (tid < 32) lcnt[tid] = 0;
    __syncthreads();
    int e_sel[4]; float w_sel[4]; int rank[4];
    if (tid < 32) {
        float bestv[4]; int besti[4];
        uint32_t used = 0;
#pragma unroll
        for (int k = 0; k < 4; ++k) {
            float bv = -3.0e38f; int bi = 0;
            for (int j = 0; j < 32; ++j) {
                const float lg = part[(0 * 32 + tid) * 33 + j] + part[(1 * 32 + tid) * 33 + j] + part[(2 * 32 + tid) * 33 + j] + part[(3 * 32 + tid) * 33 + j] + p.b_r[j];
                if (!((used >> j) & 1u) && lg > bv) { bv = lg; bi = j; }
            }
            used |= 1u << bi; bestv[k] = bv; besti[k] = bi;
        }
        float den = 0.f;
#pragma unroll
        for (int k = 0; k < 4; ++k) { w_sel[k] = expf(bestv[k] - bestv[0]); den += w_sel[k]; }
#pragma unroll
        for (int k = 0; k < 4; ++k) { w_sel[k] /= den; e_sel[k] = besti[k]; rank[k] = atomicAdd(&lcnt[besti[k]], 1); }
    }
    __syncthreads();
    if (tid < 32) {
        const int c = lcnt[tid];
        int* counts = (int*)((float*)(ws + OFF_MISC) + 1024);
        lcnt[32 + tid] = c ? atomicAdd(&counts[tid], c) : 0;
    }
    __syncthreads();
    if (tid < 32) {
        int* la = (int*)(ws + OFF_LISTA); float* lw = (float*)(ws + OFF_LISTW);
#pragma unroll
        for (int k = 0; k < 4; ++k) {
            const size_t pos = (size_t)e_sel[k] * NTOK + lcnt[32 + e_sel[k]] + rank[k];
            la[pos] = (tok0 + tid) * 4 + k; lw[pos] = w_sel[k];
        }
    }
    __syncthreads();
}

struct MoeMap { int e, rt, ct, cnt, pbase; };
DEVI void moe_setup(const Params& p, int* sm  , int ctn) {
    const int tid = threadIdx.x;
    if (tid == 0) {
        const int* counts = (const int*)((const float*)(p.ws + OFF_MISC) + 1024);
        int tp = 0, cp = 0;
        for (int e = 0; e < 32; ++e) {
            const int c = counts[e];
            sm[e] = tp; sm[32 + e] = cp; sm[64 + e] = c;
            tp += ((c + 127) >> 7) * ctn; cp += c;
        }
        sm[96] = tp;
    }
    __syncthreads();
}
DEVI MoeMap moe_map(const int* sm, int tile, int ctn) {
    int e = 0;
#pragma unroll 1
    for (int i = 1; i < 32; ++i) if (sm[i] <= tile) e = i;
    MoeMap m; m.e = e; m.cnt = sm[64 + e]; m.pbase = sm[32 + e];
    const int tl = tile - sm[e], nrt = (m.cnt + 127) >> 7;
    m.ct = tl / nrt; m.rt = tl % nrt;
    return m;
}

DEVI void moe1_tile(const Params& p, char* smem, const MoeMap& mm) {
    char* ws = p.ws;
    const int tid = threadIdx.x, lane = tid & 63, wid = tid >> 6, wr = wid >> 1, wc = wid & 1, fr = lane & 15, fq = lane >> 4;
    const int* la = (const int*)(ws + OFF_LISTA) + (size_t)mm.e * NTOK;
    const u16* H1B = (const u16*)(ws + OFF_H1B);
    auto arow = [&](int r) { const int idx = mm.rt * 128 + r; const int tokn = idx < mm.cnt ? (la[idx] >> 2) : 0; return H1B + (size_t)tokn * 1024; };
    const u16* Bt = (const u16*)(ws + OFF_WGU) + ((size_t)mm.e * 2048 + (size_t)mm.ct * 128) * 1024;
    f32x4 acc[4][4];
    gemm128(arow, Bt, 1024, 1024, smem, acc);
    u16* act = (u16*)(ws + OFF_ACT);
    const float* bgu = p.b_gu + (size_t)mm.e * 2048;
#pragma unroll
    for (int m = 0; m < 4; ++m) {
        const int idx0 = mm.rt * 128 + wr * 64 + m * 16 + fq * 4;
#pragma unroll
        for (int i = 0; i < 2; ++i) {
            const int col = 64 * mm.ct + 32 * wc + 16 * i + fr;
            const float bg_ = bgu[col], bu_ = bgu[1024 + col];
#pragma unroll
            for (int j = 0; j < 4; ++j) {
                if (idx0 + j < mm.cnt) {
                    float gt = acc[m][2 * i][j] + bg_; gt = fminf(gt, 7.f);
                    float up = acc[m][2 * i + 1][j] + bu_; up = fminf(fmaxf(up, -7.f), 7.f);
                    const float a = gt * (1.f / (1.f + __expf(-1.702f * gt))) * (up + 1.f);
                    act[(size_t)(mm.pbase + idx0 + j) * 1024 + col] = f2bf(a);
                }
            }
        }
    }
}

DEVI void moe2_tile(const Params& p, char* smem, const MoeMap& mm) {
    char* ws = p.ws;
    const int tid = threadIdx.x, lane = tid & 63, wid = tid >> 6, wr = wid >> 1, wc = wid & 1, fr = lane & 15, fq = lane >> 4;
    const u16* act = (const u16*)(ws + OFF_ACT);
    auto arow = [&](int r) { return act + (size_t)(mm.pbase + mm.rt * 128 + r) * 1024; };
    const u16* Bt = (const u16*)(ws + OFF_WDN) + ((size_t)mm.e * 1024 + (size_t)mm.ct * 128) * 1024;
    f32x4 acc[4][4];
    gemm128(arow, Bt, 1024, 1024, smem, acc);
    const int* la = (const int*)(ws + OFF_LISTA) + (size_t)mm.e * NTOK;
    const float* lw = (const float*)(ws + OFF_LISTW) + (size_t)mm.e * NTOK;
    u16* Y = (u16*)(ws + OFF_Y);
    const float* bdn = p.b_dn + (size_t)mm.e * 1024;
#pragma unroll
    for (int m = 0; m < 4; ++m) {
        const int idx0 = mm.rt * 128 + wr * 64 + m * 16 + fq * 4;
#pragma unroll
        for (int j = 0; j < 4; ++j) {
            if (idx0 + j < mm.cnt) {
                const int a = la[idx0 + j]; const float wgt = lw[idx0 + j];
#pragma unroll
                for (int n = 0; n < 4; ++n) {
                    const int col = mm.ct * 128 + wc * 64 + n * 16 + fr;
                    Y[(size_t)a * 1024 + col] = f2bf((acc[m][n][j] + bdn[col]) * wgt);
                }
            }
        }
    }
}

DEVI void final_rows(const Params& p, int task) {
    char* ws = p.ws;
    const int tid = threadIdx.x, lane = tid & 63, w = tid >> 6;
    const float* H1 = (const float*)(ws + OFF_H1); const u16* Y = (const u16*)(ws + OFF_Y);
    for (int i = 0; i < 8; ++i) {
        const size_t row = (size_t)task * 32 + w * 8 + i;
        float4 v[4];
        float s = 0.f;
#pragma unroll
        for (int q = 0; q < 4; ++q) {
            const int c = q * 256 + lane * 4;
            float4 a = *(const float4*)(H1 + row * 1024 + c);
            a.x *= DN_ALPHA; a.y *= DN_ALPHA; a.z *= DN_ALPHA; a.w *= DN_ALPHA;
#pragma unroll
            for (int k = 0; k < 4; ++k) {
                const uint2 y = *(const uint2*)(Y + (row * 4 + k) * 1024 + c);
                a.x += __uint_as_float(y.x << 16); a.y += __uint_as_float(y.x & 0xffff0000u);
                a.z += __uint_as_float(y.y << 16); a.w += __uint_as_float(y.y & 0xffff0000u);
            }
            v[q] = a; s += a.x + a.y + a.z + a.w;
        }
        const float mu = wave_sum(s) * (1.f / 1024.f);
        float ss = 0.f;
#pragma unroll
        for (int q = 0; q < 4; ++q) { v[q].x -= mu; v[q].y -= mu; v[q].z -= mu; v[q].w -= mu; ss += v[q].x * v[q].x + v[q].y * v[q].y + v[q].z * v[q].z + v[q].w * v[q].w; }
        const float rs = rsqrtf(wave_sum(ss) * (1.f / 1024.f) + 1e-5f);
#pragma unroll
        for (int q = 0; q < 4; ++q) {
            const int c = q * 256 + lane * 4;
            const float4 gq = *(const float4*)(p.ln2g + c), bq = *(const float4*)(p.ln2b + c);
            float4 o; o.x = v[q].x * rs * gq.x + bq.x; o.y = v[q].y * rs * gq.y + bq.y; o.z = v[q].z * rs * gq.z + bq.z; o.w = v[q].w * rs * gq.w + bq.w;
            *(float4*)(p.out + row * 1024 + c) = o;
        }
    }
}

DEVI void run_phase(const Params& p, char* smem, int ph) {
    const int G = gridDim.x, B0 = blockIdx.x;
#ifdef ONLY_PHASE
    if (ph != ONLY_PHASE) return;
#endif
    switch (ph) {
    case 0: phase_prep(p, smem); break;
    case 1: phase_proj(p, smem); break;
    case 2:
        for (int t = B0; t < 128; t += G) cmp1_tile(p, smem, t);
        for (int t = B0; t < 2048; t += G) hgrn_local_tile(p, smem, t);
        break;
    case 3:
        for (int t = B0; t < 64; t += G) cmp2_tile(p, smem, t);
        for (int t = G - 1 - B0; t < 512; t += G) hgrn_scan_task(p, t);
        break;
    case 4:
#ifndef NO_NSA
        for (int t = B0; t < 1024; t += G) nsa_tile(p, smem, t);
#endif
#ifndef NO_HG3
        for (int t = G - 1 - B0; t < 2048; t += G) hgrn_out_tile(p, smem, t);
#endif
        break;
    case 5:
        for (int t = B0; t < 2048; t += G) wo_tile(p, smem, t);
        break;
    case 6:
        for (int t = B0; t < 1024; t += G) ln1_router_tile(p, smem, t);
        break;
    case 7: {
        int* sm = (int*)(smem + 32768);
        moe_setup(p, sm, 16);
        const int total = sm[96];
        for (int t = B0; t < total; t += G) { const MoeMap mm = moe_map(sm, t, 16); moe1_tile(p, smem, mm); }
        __syncthreads();
    } break;
    case 8: {
        int* sm = (int*)(smem + 32768);
        moe_setup(p, sm, 8);
        const int total = sm[96];
        for (int t = B0; t < total; t += G) { const MoeMap mm = moe_map(sm, t, 8); moe2_tile(p, smem, mm); }
        __syncthreads();
    } break;
    case 9:
        for (int t = B0; t < 1024; t += G) final_rows(p, t);
        break;
    }
}

#if N_LAUNCH_MODE == 1
__global__ void __launch_bounds__(256, 2) fwd_kernel(Params p) {
    extern __shared__ __attribute__((aligned(16))) char smem[];
    cg::grid_group grid = cg::this_grid();
    run_phase(p, smem, 0); grid.sync();
    run_phase(p, smem, 1); grid.sync();
    run_phase(p, smem, 2); grid.sync();
    run_phase(p, smem, 3); grid.sync();
    run_phase(p, smem, 4); grid.sync();
    run_phase(p, smem, 5); grid.sync();
    run_phase(p, smem, 6); grid.sync();
    run_phase(p, smem, 7); grid.sync();
    run_phase(p, smem, 8); grid.sync();
    run_phase(p, smem, 9);
}
#define KFN fwd_kernel
#else
template <int PH>
__global__ void __launch_bounds__(256, 2) phase_kernel(Params p) {
    extern __shared__ __attribute__((aligned(16))) char smem[];
    run_phase(p, smem, PH);
}
#define KFN phase_kernel<4>
#endif

extern "C" void kernel_launch(void* const* d_in, const int* in_sizes, int n_in, void* d_out, int out_size, void* d_ws, size_t ws_size,
                              hipStream_t stream) {
    static int grid = 0;
    if (grid == 0) {
        if (ws_size < WS_NEED) { fprintf(stderr, "kernel_launch: workspace too small: %zu < %zu\n", ws_size, (size_t)WS_NEED); grid = -1; return; }
        int dev = 0, cus = 0, per_cu = 0;
        (void)hipGetDevice(&dev);
        (void)hipDeviceGetAttribute(&cus, hipDeviceAttributeMultiprocessorCount, dev);
#if N_LAUNCH_MODE == 1
        (void)hipFuncSetAttribute((const void*)KFN, hipFuncAttributeMaxDynamicSharedMemorySize, SMEM_BYTES);
#else
#define SA_(PH) (void)hipFuncSetAttribute((const void*)phase_kernel<PH>, hipFuncAttributeMaxDynamicSharedMemorySize, SMEM_BYTES);
        SA_(0) SA_(1) SA_(2) SA_(3) SA_(4) SA_(5) SA_(6) SA_(7) SA_(8) SA_(9)
#undef SA_
#endif
        (void)hipOccupancyMaxActiveBlocksPerMultiprocessor(&per_cu, (const void*)KFN, 256, SMEM_BYTES);
        if (per_cu < 1) per_cu = 1;
        if (per_cu > 2) per_cu = 2;
        grid = cus * per_cu;
    }
    if (grid < 0) return;
    Params p{};
    p.x = (const float*)d_in[0]; p.pos = (const int*)d_in[1]; p.w_in = (const float*)d_in[2]; p.pe = (const float*)d_in[3];
    p.w_ck1 = (const float*)d_in[4]; p.w_ck2 = (const float*)d_in[5]; p.w_cv1 = (const float*)d_in[6]; p.w_cv2 = (const float*)d_in[7];
    p.hg_lb = (const float*)d_in[8]; p.hg_ng = (const float*)d_in[9]; p.w_o = (const float*)d_in[10]; p.ln1g = (const float*)d_in[11];
    p.ln1b = (const float*)d_in[12]; p.w_r = (const float*)d_in[13]; p.b_r = (const float*)d_in[14]; p.w_gu = (const float*)d_in[15];
    p.b_gu = (const float*)d_in[16]; p.w_dn = (const float*)d_in[17]; p.b_dn = (const float*)d_in[18]; p.ln2g = (const float*)d_in[19];
    p.ln2b = (const float*)d_in[20];
    p.out = (float*)d_out; p.ws = (char*)d_ws;
#if N_LAUNCH_MODE == 1
    p.ph_lo = 0; p.ph_hi = NPHASE;
    void* args[] = {&p};
    hipError_t e = hipLaunchCooperativeKernel((const void*)fwd_kernel, dim3(grid), dim3(256), args, SMEM_BYTES, stream);
    if (e != hipSuccess) fprintf(stderr, "cooperative launch failed: %s (grid %d)\n", hipGetErrorString(e), grid);
#else
    p.ph_lo = 0; p.ph_hi = NPHASE;
#define LP(PH) hipLaunchKernelGGL(phase_kernel<PH>, dim3(grid), dim3(256), SMEM_BYTES, stream, p);
    LP(0) LP(1) LP(2) LP(3) LP(4) LP(5) LP(6) LP(7) LP(8) LP(9)
#undef LP
#endif
}
```

```cpp
#include <hip/hip_runtime.h>
#include <hip/hip_cooperative_groups.h>
#include <stdint.h>
#include <stdio.h>
namespace cg = cooperative_groups;

typedef unsigned short u16;
typedef __attribute__((ext_vector_type(8))) short bf16x8;
typedef __attribute__((ext_vector_type(4))) float f32x4;
typedef __attribute__((ext_vector_type(16))) float f32x16;
#define DEVI __device__ __forceinline__

#ifndef N_LAUNCH_MODE
#define N_LAUNCH_MODE 1
#endif

constexpr int NTOK = 32768, SEQ = 8192, NB = 4;
constexpr int SP = 8224;
constexpr int NPHASE = 10;
constexpr int SMEM_BYTES = 65536;
constexpr float DN_ALPHA = 1.189207115002721f;

constexpr size_t MB = 1ull << 20;
constexpr size_t OFF_WIN = 0;
constexpr size_t OFF_WCK1 = 7 * MB;
constexpr size_t OFF_WCV1 = 8 * MB;
constexpr size_t OFF_WCK2 = 9 * MB;
constexpr size_t OFF_WCV2 = 9 * MB + 65536;
constexpr size_t OFF_WO = 10 * MB;
constexpr size_t OFF_ROPE = 12 * MB;
constexpr size_t OFF_GATES = 14 * MB;
constexpr size_t OFF_MISC = 17 * MB;
constexpr size_t OFF_LISTA = 18 * MB;
constexpr size_t OFF_LISTW = 22 * MB;
constexpr size_t OFF_HID = 26 * MB;
constexpr size_t OFF_KC = 30 * MB;
constexpr size_t OFF_VCT = 30 * MB + 524288;
constexpr size_t OFF_DG = 31 * MB;
constexpr size_t OFF_WGU = 32 * MB;
constexpr size_t OFF_WDN = 160 * MB;
constexpr size_t OFF_H1 = 224 * MB;
constexpr size_t OFF_H1B = 352 * MB;
constexpr size_t OFF_X = 416 * MB;
constexpr size_t OFF_XB = OFF_X;
constexpr size_t OFF_Q = OFF_X + 64 * MB;
constexpr size_t OFF_KCR = OFF_X + 96 * MB;
constexpr size_t OFF_VCR = OFF_X + 105 * MB;
constexpr size_t OFF_KS = OFF_X + 114 * MB;
constexpr size_t OFF_KW = OFF_X + 123 * MB;
constexpr size_t OFF_VST = OFF_X + 132 * MB;
constexpr size_t OFF_VWT = OFF_X + 141 * MB;
constexpr size_t OFF_QH = OFF_X + 150 * MB;
constexpr size_t OFF_LOGF = OFF_X + 182 * MB;
constexpr size_t OFF_VTH = OFF_X + 246 * MB;
constexpr size_t OFF_GH = OFF_X + 278 * MB;
constexpr size_t OFF_LBUF = OFF_X + 310 * MB;
constexpr size_t OFF_MIX = OFF_X + 374 * MB;
constexpr size_t OFF_PRE = OFF_X;
constexpr size_t OFF_ACT = OFF_X;
constexpr size_t OFF_Y = OFF_X + 256 * MB;
constexpr size_t WS_NEED = OFF_Y + 256 * MB;

struct Params {
    const float* x; const int* pos; const float* w_in; const float* pe;
    const float* w_ck1; const float* w_ck2; const float* w_cv1; const float* w_cv2;
    const float* hg_lb; const float* hg_ng; const float* w_o; const float* ln1g; const float* ln1b;
    const float* w_r; const float* b_r; const float* w_gu; const float* b_gu; const float* w_dn; const float* b_dn;
    const float* ln2g; const float* ln2b;
    float* out; char* ws;
    int ph_lo, ph_hi;
};

DEVI u16 f2bf(float f) { uint32_t u = __float_as_uint(f); u += 0x7fffu + ((u >> 16) & 1u); return (u16)(u >> 16); }
DEVI float bf2f(u16 h) { return __uint_as_float(((uint32_t)h) << 16); }
DEVI uint32_t pack2(float a, float b) { return (uint32_t)f2bf(a) | ((uint32_t)f2bf(b) << 16); }
DEVI bf16x8 pack8(f32x4 a, f32x4 b) {
    union { bf16x8 v; uint32_t u[4]; } r;
    r.u[0] = pack2(a[0], a[1]); r.u[1] = pack2(a[2], a[3]); r.u[2] = pack2(b[0], b[1]); r.u[3] = pack2(b[2], b[3]);
    return r.v;
}
DEVI uint2 pack4(f32x4 a) { uint2 r; r.x = pack2(a[0], a[1]); r.y = pack2(a[2], a[3]); return r; }
DEVI f32x4 mfma16(bf16x8 a, bf16x8 b, f32x4 c) { return __builtin_amdgcn_mfma_f32_16x16x32_bf16(a, b, c, 0, 0, 0); }
DEVI bf16x8 ld8(const u16* p) { return *reinterpret_cast<const bf16x8*>(p); }
DEVI bf16x8 zero8() { bf16x8 z = {0, 0, 0, 0, 0, 0, 0, 0}; return z; }
DEVI float sigmoidf_(float v) { return 1.f / (1.f + __expf(-v)); }
DEVI float xor16_max(float v) { v = fmaxf(v, __shfl_xor(v, 16)); v = fmaxf(v, __shfl_xor(v, 32)); return v; }
DEVI float xor16_sum(float v) { v += __shfl_xor(v, 16); v += __shfl_xor(v, 32); return v; }
DEVI float wave_sum(float v) {
#pragma unroll
    for (int o = 32; o > 0; o >>= 1) v += __shfl_xor(v, o);
    return v;
}
DEVI void glds16(const u16* g, u16* l) {
    __builtin_amdgcn_global_load_lds((const unsigned*)g, (__attribute__((address_space(3))) unsigned*)l, 16, 0, 0);
}

template <class AFn>
DEVI void gemm128(AFn arow, const u16* __restrict__ Bt, size_t ldb, int K, char* smem, f32x4 (&acc)[4][4]) {
    const int tid = threadIdx.x, lane = tid & 63, wid = tid >> 6, wr = wid >> 1, wc = wid & 1, fr = lane & 15, fq = lane >> 4;
    u16* SA = (u16*)smem; u16* SB = (u16*)(smem + 8192);
    const int r0 = tid >> 2, c0 = (tid & 3) * 8;
    const u16* a0 = arow(r0) + c0; const u16* a1 = arow(r0 + 64) + c0;
    const u16* b0 = Bt + (size_t)r0 * ldb + c0; const u16* b1 = Bt + (size_t)(r0 + 64) * ldb + c0;
#pragma unroll
    for (int m = 0; m < 4; ++m)
#pragma unroll
        for (int n = 0; n < 4; ++n) acc[m][n] = f32x4{0.f, 0.f, 0.f, 0.f};
    for (int kt = 0; kt < K; kt += 32) {
        glds16(a0 + kt, SA + tid * 8); glds16(a1 + kt, SA + 2048 + tid * 8);
        glds16(b0 + kt, SB + tid * 8); glds16(b1 + kt, SB + 2048 + tid * 8);
        asm volatile("s_waitcnt vmcnt(0)" ::: "memory");
        __syncthreads();
        bf16x8 af[4], bfr[4];
#pragma unroll
        for (int m = 0; m < 4; ++m) af[m] = ld8(SA + (wr * 64 + m * 16 + fr) * 32 + fq * 8);
#pragma unroll
        for (int n = 0; n < 4; ++n) bfr[n] = ld8(SB + (wc * 64 + n * 16 + fr) * 32 + fq * 8);
#pragma unroll
        for (int m = 0; m < 4; ++m)
#pragma unroll
            for (int n = 0; n < 4; ++n) acc[m][n] = mfma16(af[m], bfr[n], acc[m][n]);
        __syncthreads();
    }
}

template <class CM>
DEVI void tconv_tile(const float* __restrict__ src, size_t ld, u16* __restrict__ dst, size_t ldd, int r0, int k0, CM colmap, char* smem) {
    float (*t)[65] = (float (*)[65])smem;
    const int tid = threadIdx.x;
    {
        const int n = tid & 63; const int col = colmap(r0 + n);
#pragma unroll 4
        for (int i = 0; i < 16; ++i) {
            const int k = (tid >> 6) + 4 * i;
            t[k][n] = (col >= 0) ? src[(size_t)(k0 + k) * ld + col] : 0.f;
        }
    }
    __syncthreads();
    {
        const int k2 = (tid & 31) * 2;
#pragma unroll 4
        for (int i = 0; i < 8; ++i) {
            const int n = (tid >> 5) + 8 * i;
            *(uint32_t*)(dst + (size_t)(r0 + n) * ldd + k0 + k2) = pack2(t[k2][n], t[k2 + 1][n]);
        }
    }
    __syncthreads();
}

DEVI void phase_prep(const Params& p, char* smem) {
    char* ws = p.ws;
    constexpr int J_WIN = 54 * 16;
    constexpr int J_WCK1 = 4 * 32;
    constexpr int J_WC2 = 2 * 4;
    constexpr int J_WO = 16 * 16;
    constexpr int J_WGU = 32 * 32 * 16;
    constexpr int J_WDN = 32 * 16 * 16;
    constexpr int J_XB = 16384;
    constexpr int J_ROPE = 1024;
    constexpr int J0 = 0, J1 = J0 + J_WIN, J2 = J1 + 2 * J_WCK1, J3 = J2 + 2 * J_WC2, J4 = J3 + J_WO, J5 = J4 + J_WGU,
                  J6 = J5 + J_WDN, J7 = J6 + J_XB, J8 = J7 + J_ROPE, J9 = J8 + 1;
    for (int job = blockIdx.x; job < J9; job += gridDim.x) {
        const int tid = threadIdx.x;
        if (job < J1) {
            const int j = job - J0, rt = j / 16, kt = j % 16;
            auto cm = [](int r) { return r < 1280 ? r : (r < 3328 ? r + 24 : (r < 3352 ? 1280 + (r - 3328) : -1)); };
            tconv_tile(p.w_in, 3352, (u16*)(ws + OFF_WIN), 1024, rt * 64, kt * 64, cm, smem);
        } else if (job < J2) {
            int j = job - J1; const int which = j / J_WCK1; j %= J_WCK1; const int rt = j / 32, kt = j % 32;
            auto cm = [](int r) { return r; };
            tconv_tile(which ? p.w_cv1 : p.w_ck1, 256, (u16*)(ws + (which ? OFF_WCV1 : OFF_WCK1)), 2048, rt * 64, kt * 64, cm, smem);
        } else if (job < J3) {
            int j = job - J2; const int which = j / J_WC2; j %= J_WC2; const int rt = j / 4, kt = j % 4;
            auto cm = [](int r) { return r < 64 ? r : -1; };
            tconv_tile(which ? p.w_cv2 : p.w_ck2, 64, (u16*)(ws + (which ? OFF_WCV2 : OFF_WCK2)), 256, rt * 64, kt * 64, cm, smem);
        } else if (job < J4) {
            const int j = job - J3, rt = j / 16, kt = j % 16;
            auto cm = [](int r) { return r; };
            tconv_tile(p.w_o, 1024, (u16*)(ws + OFF_WO), 1024, rt * 64, kt * 64, cm, smem);
        } else if (job < J5) {
            int j = job - J4; const int e = j / 512; j %= 512; const int rt = j / 16, kt = j % 16;
            auto cm = [](int r) { const int ct = r >> 7, f = (r >> 4) & 7, jj = r & 15; return ((f & 1) ? 1024 : 0) + 64 * ct + 16 * (f >> 1) + jj; };
            tconv_tile(p.w_gu + (size_t)e * 1024 * 2048, 2048, (u16*)(ws + OFF_WGU) + (size_t)e * 2048 * 1024, 1024, rt * 64, kt * 64, cm, smem);
        } else if (job < J6) {
            int j = job - J5; const int e = j / 256; j %= 256; const int rt = j / 16, kt = j % 16;
            auto cm = [](int r) { return r; };
            tconv_tile(p.w_dn + (size_t)e * 1024 * 1024, 1024, (u16*)(ws + OFF_WDN) + (size_t)e * 1024 * 1024, 1024, rt * 64, kt * 64, cm, smem);
        } else if (job < J7) {
            const size_t base = (size_t)(job - J6) * 2048 + (size_t)tid * 8;
            const float4 a = *(const float4*)(p.x + base), b = *(const float4*)(p.x + base + 4);
            uint4 o; o.x = pack2(a.x, a.y); o.y = pack2(a.z, a.w); o.z = pack2(b.x, b.y); o.w = pack2(b.z, b.w);
            *(uint4*)((u16*)(ws + OFF_XB) + base) = o;
        } else if (job < J8) {
            const int idx = (job - J7) * 256 + tid;
            const int n = idx >> 3, i = idx & 7;
            const float inv = powf(500000.f, -(float)i / 8.f);
            const float ang = (float)p.pos[n] * inv;
            float s, c; sincosf(ang, &s, &c);
            float* ct = (float*)(ws + OFF_ROPE);
            ct[idx] = c; ct[NTOK * 8 + idx] = s;
        } else {
            float* misc = (float*)(ws + OFF_MISC);
            float sk = 0.f, sv = 0.f;
            for (int i = 0; i < 2048; ++i) { const float pe = p.pe[i]; sk += pe * p.w_ck1[(size_t)i * 256 + tid]; sv += pe * p.w_cv1[(size_t)i * 256 + tid]; }
            misc[tid] = sk; misc[256 + tid] = sv;
            for (int i = tid; i < 512; i += 256) { const float a0 = p.hg_lb[i], a1 = p.hg_lb[512 + i]; misc[512 + i] = 1.f / (1.f + expf(a1 - a0)); }
            if (tid < 32) ((int*)(misc + 1024))[tid] = 0;
        }
    }
}

DEVI f32x4 rope4(f32x4 v, int fr, const float* __restrict__ cs, int i0, int i1, int i2, int i3) {
    const int i = fr & 7; const float sg = (fr & 8) ? 1.f : -1.f;
    const int idx[4] = {i0, i1, i2, i3};
    f32x4 o;
#pragma unroll
    for (int j = 0; j < 4; ++j) {
        const float partner = __shfl_xor(v[j], 8);
        const float c = cs[(size_t)idx[j] * 8 + i], s = cs[(size_t)NTOK * 8 + (size_t)idx[j] * 8 + i];
        o[j] = v[j] * c + sg * partner * s;
    }
    return o;
}

DEVI void phase_proj(const Params& p, char* smem) {
    char* ws = p.ws;
    const u16* XB = (const u16*)(ws + OFF_XB); const u16* WIN = (const u16*)(ws + OFF_WIN);
    const float* cs = (const float*)(ws + OFF_ROPE); const float* lb = (const float*)(ws + OFF_MISC) + 512;
    const int tid = threadIdx.x, lane = tid & 63, wid = tid >> 6, wr = wid >> 1, wc = wid & 1, fr = lane & 15, fq = lane >> 4;
    for (int tile = blockIdx.x; tile < 256 * 27; tile += gridDim.x) {
        const int rt = tile / 27, ct = tile % 27;
        auto arow = [&](int r) { return XB + (size_t)(rt * 128 + r) * 1024; };
        f32x4 acc[4][4];
        gemm128(arow, WIN + (size_t)ct * 128 * 1024, 1024, 1024, smem, acc);
#pragma unroll
        for (int m = 0; m < 4; ++m) {
            const int tok = rt * 128 + wr * 64 + m * 16 + fq * 4;
            const int b = tok >> 13, s = tok & 8191;
#pragma unroll
            for (int n = 0; n < 4; ++n) {
                const int cc = wc * 64 + n * 16 + fr; const int d = n * 16 + fr;
                f32x4 v = acc[m][n];
                if (ct < 4) {
                    if (n == 0) v = rope4(v, fr, cs, tok, tok + 1, tok + 2, tok + 3);
                    u16* Q = (u16*)(ws + OFF_Q);
#pragma unroll
                    for (int j = 0; j < 4; ++j) Q[(size_t)(tok + j) * 512 + ct * 128 + cc] = f2bf(v[j] * 0.125f);
                } else if (ct == 4 || ct == 5) {
                    u16* dst = (u16*)(ws + (ct == 4 ? OFF_KCR : OFF_VCR));
#pragma unroll
                    for (int j = 0; j < 4; ++j) dst[((size_t)(b * 2 + wc) * SP + s + j) * 64 + d] = f2bf(v[j]);
                } else if (ct == 6 || ct == 8) {
                    if (n == 0) v = rope4(v, fr, cs, tok, tok + 1, tok + 2, tok + 3);
                    u16* dst = (u16*)(ws + (ct == 6 ? OFF_KS : OFF_KW));
#pragma unroll
                    for (int j = 0; j < 4; ++j) dst[((size_t)(b * 2 + wc) * 8192 + s + j) * 64 + d] = f2bf(v[j]);
                } else if (ct == 7 || ct == 9) {
                    u16* dst = (u16*)(ws + (ct == 7 ? OFF_VST : OFF_VWT));
                    *(uint2*)(dst + (((size_t)(b * 2 + wc) * 128 + (s >> 6)) * 64 + d) * 64 + (s & 63)) = pack4(v);
                } else if (ct < 14) {
                    u16* dst = (u16*)(ws + OFF_QH);
#pragma unroll
                    for (int j = 0; j < 4; ++j) dst[(size_t)(tok + j) * 512 + (ct - 10) * 128 + cc] = f2bf(v[j]);
                } else if (ct < 18) {
                    const int hk = (ct - 14) * 128 + cc; const float lbv = lb[hk];
                    float* dst = (float*)(ws + OFF_LOGF);
#pragma unroll
                    for (int j = 0; j < 4; ++j) {
                        const float fh = 1.f / (1.f + expf(-v[j]));
                        dst[(size_t)(tok + j) * 512 + hk] = logf(lbv + (1.f - lbv) * fh);
                    }
                } else if (ct < 22) {
                    u16* dst = (u16*)(ws + OFF_VTH);
                    *(uint2*)(dst + (((size_t)(b * 4 + (ct - 18)) * 128 + (s >> 6)) * 128 + cc) * 64 + (s & 63)) = pack4(v);
                } else if (ct < 26) {
                    u16* dst = (u16*)(ws + OFF_GH);
#pragma unroll
                    for (int j = 0; j < 4; ++j) dst[(size_t)(tok + j) * 512 + (ct - 22) * 128 + cc] = f2bf(v[j] / (1.f + expf(-v[j])));
                } else {
                    if (cc < 24) {
                        float* dst = (float*)(ws + OFF_GATES);
#pragma unroll
                        for (int j = 0; j < 4; ++j) dst[(size_t)(tok + j) * 24 + cc] = 1.f / (1.f + expf(-v[j]));
                    }
                }
            }
        }
    }
}

template <class F>
DEVI void hgrn_cumsum(const float* __restrict__ lfp  , char* smem_tot, float& blast, F f) {
    float* tot = (float*)smem_tot;
    const int tid = threadIdx.x, k = tid & 127, half = tid >> 7;
    float run = 0.f;
#pragma unroll 8
    for (int i = 0; i < 32; ++i) run += lfp[(size_t)(32 * half + i) * 512 + k];
    tot[half * 128 + k] = run;
    __syncthreads();
    const float t0 = tot[k], t1 = tot[128 + k];
    blast = t0 + t1;
    float bcur = half ? t0 : 0.f;
#pragma unroll 4
    for (int i = 0; i < 32; ++i) {
        const float lf = lfp[(size_t)(32 * half + i) * 512 + k];
        bcur += lf;
        f(32 * half + i, lf, bcur);
    }
}

DEVI void hgrn_local_tile(const Params& p, char* smem, int tile) {
    char* ws = p.ws;
    const int bh = tile >> 7, chunk = tile & 127, b = bh >> 2, h = bh & 3;
    const int tid = threadIdx.x, lane = tid & 63, w = tid >> 6, fr = lane & 15, fq = lane >> 4;
    const size_t n0 = (size_t)b * 8192 + chunk * 64;
    const float* lfp = (const float*)(ws + OFF_LOGF) + n0 * 512 + h * 128;
    u16* khT = (u16*)(smem + 1024);
    float blast;
    float* totp = (float*)smem;
    {
        const int k = tid & 127, half = tid >> 7;
        float run = 0.f;
#pragma unroll 8
        for (int i = 0; i < 32; ++i) run += lfp[(size_t)(32 * half + i) * 512 + k];
        totp[half * 128 + k] = run;
        __syncthreads();
        const float t0 = totp[k], t1 = totp[128 + k];
        blast = t0 + t1;
        float bcur = half ? t0 : 0.f;
#pragma unroll 4
        for (int i = 0; i < 32; ++i) {
            const float lf = lfp[(size_t)(32 * half + i) * 512 + k];
            bcur += lf;
            const float kh = (1.f - expf(lf)) * expf(blast - bcur);
            khT[k * 72 + 32 * half + i] = f2bf(kh);
        }
        if (half == 0) ((float*)(ws + OFF_DG))[(size_t)tile * 128 + k] = expf(blast);
    }
    __syncthreads();
    const u16* vT = (const u16*)(ws + OFF_VTH) + (size_t)tile * 128 * 64;
    f32x4 acc[2][8];
#pragma unroll
    for (int m = 0; m < 2; ++m)
#pragma unroll
        for (int n = 0; n < 8; ++n) acc[m][n] = f32x4{0.f, 0.f, 0.f, 0.f};
#pragma unroll
    for (int ks = 0; ks < 2; ++ks) {
        bf16x8 a[2];
#pragma unroll
        for (int m = 0; m < 2; ++m) a[m] = ld8(khT + (32 * w + 16 * m + fr) * 72 + 32 * ks + 8 * fq);
#pragma unroll
        for (int n = 0; n < 8; ++n) {
            const bf16x8 bv = ld8(vT + (size_t)(16 * n + fr) * 64 + 32 * ks + 8 * fq);
#pragma unroll
            for (int m = 0; m < 2; ++m) acc[m][n] = mfma16(a[m], bv, acc[m][n]);
        }
    }
    u16* L = (u16*)(ws + OFF_LBUF) + (size_t)tile * 128 * 128;
#pragma unroll
    for (int m = 0; m < 2; ++m)
#pragma unroll
        for (int n = 0; n < 8; ++n) *(uint2*)(L + (size_t)(16 * n + fr) * 128 + 32 * w + 16 * m + 4 * fq) = pack4(acc[m][n]);
    __syncthreads();
}

DEVI void hgrn_scan_task(const Params& p, int task) {
    char* ws = p.ws;
    const int gid = task * 256 + threadIdx.x;
    const int bh = gid >> 13, v = (gid >> 6) & 127, kp = gid & 63;
    uint32_t* L = (uint32_t*)(ws + OFF_LBUF) + ((size_t)bh * 128 * 128 * 128 + (size_t)v * 128) / 2 + kp;
    const float2* Dg = (const float2*)(ws + OFF_DG) + (size_t)bh * 128 * 64 + kp;
    float s0 = 0.f, s1 = 0.f;
#pragma unroll 8
    for (int c = 0; c < 128; ++c) {
        const uint32_t l = L[(size_t)c * 8192];
        const float2 d = Dg[(size_t)c * 64];
        L[(size_t)c * 8192] = pack2(s0, s1);
        s0 = d.x * s0 + __uint_as_float(l << 16);
        s1 = d.y * s1 + __uint_as_float(l & 0xffff0000u);
    }
}

DEVI void hgrn_out_tile(const Params& p, char* smem, int tile) {
    char* ws = p.ws;
    const int bh = tile >> 7, chunk = tile & 127, b = bh >> 2, h = bh & 3;
    const int tid = threadIdx.x, lane = tid & 63, w = tid >> 6, fr = lane & 15, fq = lane >> 4;
    const size_t n0 = (size_t)b * 8192 + chunk * 64;
    const float* lfp = (const float*)(ws + OFF_LOGF) + n0 * 512 + h * 128;
    const u16* qh = (const u16*)(ws + OFF_QH) + n0 * 512 + h * 128;
    float* totp = (float*)smem;
    u16* qt = (u16*)(smem + 1024);
    u16* kt = qt + 64 * 136;
    {
        const int k = tid & 127, half = tid >> 7;
        float run = 0.f;
#pragma unroll 8
        for (int i = 0; i < 32; ++i) run += lfp[(size_t)(32 * half + i) * 512 + k];
        totp[half * 128 + k] = run;
        __syncthreads();
        float bcur = half ? totp[k] : 0.f;
#pragma unroll 4
        for (int i = 0; i < 32; ++i) {
            const int t = 32 * half + i;
            const float lf = lfp[(size_t)t * 512 + k];
            bcur += lf;
            const float q = bf2f(qh[(size_t)t * 512 + k]);
            qt[t * 136 + k] = f2bf(q * expf(bcur));
            kt[t * 136 + k] = f2bf((1.f - expf(lf)) * expf(-bcur));
        }
    }
    __syncthreads();
    bf16x8 qb[4];
#pragma unroll
    for (int ks = 0; ks < 4; ++ks) qb[ks] = ld8(qt + (16 * w + fr) * 136 + 32 * ks + 8 * fq);
    f32x4 at[4];
#pragma unroll
    for (int sf = 0; sf < 4; ++sf) {
        const int srow = 32 * (sf >> 1) + 8 * (fr >> 2) + 4 * (sf & 1) + (fr & 3);
        f32x4 a = f32x4{0.f, 0.f, 0.f, 0.f};
#pragma unroll
        for (int ks = 0; ks < 4; ++ks) a = mfma16(ld8(kt + srow * 136 + 32 * ks + 8 * fq), qb[ks], a);
        const int tcol = 16 * w + fr;
#pragma unroll
        for (int r = 0; r < 4; ++r) { const int s = 32 * (sf >> 1) + 8 * fq + 4 * (sf & 1) + r; if (s > tcol) a[r] = 0.f; }
        at[sf] = a;
    }
    const u16* vT = (const u16*)(ws + OFF_VTH) + (size_t)tile * 128 * 64;
    const u16* ST = (const u16*)(ws + OFF_LBUF) + (size_t)tile * 128 * 128;
    f32x4 o[8];
#pragma unroll
    for (int mf = 0; mf < 8; ++mf) o[mf] = f32x4{0.f, 0.f, 0.f, 0.f};
#pragma unroll
    for (int sc = 0; sc < 2; ++sc) {
        const bf16x8 pb = pack8(at[2 * sc], at[2 * sc + 1]);
#pragma unroll
        for (int mf = 0; mf < 8; ++mf) o[mf] = mfma16(ld8(vT + (size_t)(16 * mf + fr) * 64 + 32 * sc + 8 * fq), pb, o[mf]);
    }
#pragma unroll
    for (int ks = 0; ks < 4; ++ks)
#pragma unroll
        for (int mf = 0; mf < 8; ++mf) o[mf] = mfma16(ld8(ST + (size_t)(16 * mf + fr) * 128 + 32 * ks + 8 * fq), qb[ks], o[mf]);
    float ss = 0.f;
#pragma unroll
    for (int mf = 0; mf < 8; ++mf)
#pragma unroll
        for (int r = 0; r < 4; ++r) ss += o[mf][r] * o[mf][r];
    ss = xor16_sum(ss);
    const float rn = rsqrtf(ss * (1.f / 128.f) + 1e-6f);
    const size_t tok = n0 + 16 * w + fr;
    const u16* gh = (const u16*)(ws + OFF_GH) + tok * 512 + h * 128;
    u16* mix = (u16*)(ws + OFF_MIX) + tok * 1024 + 512 + h * 128;
#pragma unroll
    for (int mf = 0; mf < 8; ++mf) {
        const int v0 = 16 * mf + 4 * fq;
        const uint2 g2 = *(const uint2*)(gh + v0);
        const float4 ng = *(const float4*)(p.hg_ng + v0);
        f32x4 r;
        r[0] = o[mf][0] * rn * ng.x * __uint_as_float(g2.x << 16);
        r[1] = o[mf][1] * rn * ng.y * __uint_as_float(g2.x & 0xffff0000u);
        r[2] = o[mf][2] * rn * ng.z * __uint_as_float(g2.y << 16);
        r[3] = o[mf][3] * rn * ng.w * __uint_as_float(g2.y & 0xffff0000u);
        *(uint2*)(mix + v0) = pack4(r);
    }
    __syncthreads();
}

DEVI float gelu_tanh(float x) { const float u = 0.7978845608028654f * (x + 0.044715f * x * x * x); return 0.5f * x * (1.f + tanhf(u)); }

DEVI void cmp1_tile(const Params& p, char* smem, int tile) {
    char* ws = p.ws;
    const int which = tile >> 6, rt = (tile >> 1) & 31, ct = tile & 1;
    const int tid = threadIdx.x, lane = tid & 63, wid = tid >> 6, wr = wid >> 1, wc = wid & 1, fr = lane & 15, fq = lane >> 4;
    const u16* src = (const u16*)(ws + (which ? OFF_VCR : OFF_KCR));
    auto arow = [&](int r) { const int m = rt * 128 + r; return src + ((size_t)(m >> 9) * SP + 16 * (m & 511)) * 64; };
    const u16* Bt = (const u16*)(ws + (which ? OFF_WCV1 : OFF_WCK1)) + (size_t)ct * 128 * 2048;
    f32x4 acc[4][4];
    gemm128(arow, Bt, 2048, 2048, smem, acc);
    const float* bias = (const float*)(ws + OFF_MISC) + which * 256;
    u16* hid = (u16*)(ws + OFF_HID) + (size_t)which * 4096 * 256;
#pragma unroll
    for (int m = 0; m < 4; ++m)
#pragma unroll
        for (int n = 0; n < 4; ++n) {
            const int row = rt * 128 + wr * 64 + m * 16 + fq * 4, col = ct * 128 + wc * 64 + n * 16 + fr;
            const float bv = bias[col];
#pragma unroll
            for (int j = 0; j < 4; ++j) hid[(size_t)(row + j) * 256 + col] = f2bf(gelu_tanh(acc[m][n][j] + bv));
        }
}

DEVI void cmp2_tile(const Params& p, char* smem, int tile) {
    char* ws = p.ws;
    const int which = tile >> 5, rt = tile & 31;
    const int tid = threadIdx.x, lane = tid & 63, wid = tid >> 6, wr = wid >> 1, wc = wid & 1, fr = lane & 15, fq = lane >> 4;
    const u16* hid = (const u16*)(ws + OFF_HID) + (size_t)which * 4096 * 256;
    auto arow = [&](int r) { return hid + (size_t)(rt * 128 + r) * 256; };
    const u16* Bt = (const u16*)(ws + (which ? OFF_WCV2 : OFF_WCK2));
    f32x4 acc[4][4];
    gemm128(arow, Bt, 256, 256, smem, acc);
    if (wc == 0) {
        const float* cs = (const float*)(ws + OFF_ROPE);
#pragma unroll
        for (int m = 0; m < 4; ++m) {
            const int row = rt * 128 + wr * 64 + m * 16 + fq * 4;
            const int bg = row >> 9, c = row & 511, b = bg >> 1;
#pragma unroll
            for (int n = 0; n < 4; ++n) {
                const int d = n * 16 + fr;
                f32x4 v = acc[m][n];
                if (which == 0) {
                    if (n == 0) {
                        int ix[4];
#pragma unroll
                        for (int j = 0; j < 4; ++j) { int sp = 16 * (c + j) + 31; sp = sp > 8191 ? 8191 : sp; ix[j] = b * 8192 + sp; }
                        v = rope4(v, fr, cs, ix[0], ix[1], ix[2], ix[3]);
                    }
                    u16* kc = (u16*)(ws + OFF_KC);
#pragma unroll
                    for (int j = 0; j < 4; ++j) kc[((size_t)bg * 512 + c + j) * 64 + d] = f2bf(v[j]);
                } else {
                    u16* vct = (u16*)(ws + OFF_VCT);
                    *(uint2*)(vct + (((size_t)bg * 8 + (c >> 6)) * 64 + d) * 64 + (c & 63)) = pack4(v);
                }
            }
        }
    }
}

DEVI uint64_t lowest_bits(uint64_t mask, int n) {
    uint64_t out = 0;
    while (n > 0 && mask) { const uint64_t b = mask & (~mask + 1); out |= b; mask ^= b; --n; }
    return out;
}

constexpr int NSA_NW = 4;
constexpr int NSA_NTT = NSA_NW / 2;
constexpr int NSA_TB = 16 * NSA_NTT;
constexpr int NSA_TILES = 8 * (SEQ / NSA_TB);
constexpr int NSA_STG = 18432;
constexpr int NSA_OFF_IMP = 2 * NSA_STG;
constexpr int NSA_OFF_SEL = NSA_OFF_IMP + NSA_NTT * 8192;

DEVI void nsa_tile(const Params& p, char* smem, int tile) {
    char* ws = p.ws;
    const int bg = tile & 7, tbi = (SEQ / NSA_TB - 1) - (tile >> 3), b = bg >> 1, g = bg & 1;
    const int tid = threadIdx.x, lane = tid & 63, w = tid >> 6, fr = lane & 15, fq = lane >> 4;
    const int tt = w >> 1, hp = w & 1;
    const int tbase = tbi * NSA_TB;
    const int t0 = tbase + tt * 16;
    const int cur = t0 >> 6;
    const int curmax = (tbase + NSA_TB - 1) >> 6;
    const size_t n0 = (size_t)b * 8192 + t0;
    const int tok = t0 + fr;
    const u16* Qb = (const u16*)(ws + OFF_Q);
    const u16* Kc = (const u16*)(ws + OFF_KC) + (size_t)bg * 512 * 64;
    const u16* Vct = (const u16*)(ws + OFF_VCT) + (size_t)bg * 8 * 64 * 64;
    const u16* Ks = (const u16*)(ws + OFF_KS) + (size_t)bg * 8192 * 64;
    const u16* Kw = (const u16*)(ws + OFF_KW) + (size_t)bg * 8192 * 64;
    const u16* Vst = (const u16*)(ws + OFF_VST) + (size_t)bg * 128 * 64 * 64;
    const u16* Vwt = (const u16*)(ws + OFF_VWT) + (size_t)bg * 128 * 64 * 64;
    const float* gp = (const float*)(ws + OFF_GATES) + (n0 + fr) * 24 + (g * 4 + 2 * hp) * 3;
    float* imp = (float*)(smem + NSA_OFF_IMP) + tt * 2048;
    unsigned long long* selm = (unsigned long long*)(smem + NSA_OFF_SEL) + tt * 32;

    for (int i = tid; i < NSA_NTT * 2048; i += 256) ((float*)(smem + NSA_OFF_IMP))[i] = 0.f;
    __syncthreads();

    bf16x8 qf[2][2];
#pragma unroll
    for (int hh = 0; hh < 2; ++hh)
#pragma unroll
        for (int ks = 0; ks < 2; ++ks) qf[hh][ks] = ld8(Qb + (n0 + fr) * 512 + (g * 4 + 2 * hp + hh) * 64 + 32 * ks + 8 * fq);
    f32x4 ot[2][4];
#pragma unroll
    for (int hh = 0; hh < 2; ++hh)
#pragma unroll
        for (int mf = 0; mf < 4; ++mf) ot[hh][mf] = f32x4{0.f, 0.f, 0.f, 0.f};

    {
        const int nc = t0 >> 4;
        const int nchunk = (nc + 31) >> 5;
        float mC[2], lC[2];
#pragma unroll
        for (int hh = 0; hh < 2; ++hh) { mC[hh] = -1e30f; lC[hh] = 0.f; }
        for (int ch = 0; ch < nchunk; ++ch) {
            f32x4 s[2][2];
#pragma unroll
            for (int u = 0; u < 2; ++u) {
                const int crow = 32 * ch + 8 * (fr >> 2) + 4 * u + (fr & 3);
                const u16* kp = Kc + (size_t)crow * 64 + 8 * fq;
                const bf16x8 k0 = ld8(kp), k1 = ld8(kp + 32);
#pragma unroll
                for (int hh = 0; hh < 2; ++hh) {
                    f32x4 a = f32x4{0.f, 0.f, 0.f, 0.f};
                    a = mfma16(k0, qf[hh][0], a); a = mfma16(k1, qf[hh][1], a);
                    s[hh][u] = a;
                }
            }
#pragma unroll
            for (int hh = 0; hh < 2; ++hh) {
                float mx = -1e30f;
#pragma unroll
                for (int u = 0; u < 2; ++u)
#pragma unroll
                    for (int r = 0; r < 4; ++r) {
                        const int c = 32 * ch + 8 * fq + 4 * u + r;
                        const float v = (16 * c + 31 <= tok) ? s[hh][u][r] : -1e30f;
                        s[hh][u][r] = v; mx = fmaxf(mx, v);
                    }
                mx = xor16_max(mx);
                const float mn = fmaxf(mC[hh], mx);
                float sum = 0.f;
#pragma unroll
                for (int u = 0; u < 2; ++u)
#pragma unroll
                    for (int r = 0; r < 4; ++r) sum += (s[hh][u][r] > -1e29f) ? __expf(s[hh][u][r] - mn) : 0.f;
                lC[hh] = lC[hh] * __expf(mC[hh] - mn) + sum; mC[hh] = mn;
            }
        }
        float ilC[2];
#pragma unroll
        for (int hh = 0; hh < 2; ++hh) { const float l = xor16_sum(lC[hh]); ilC[hh] = l > 0.f ? 1.f / l : 0.f; }
        f32x4 oc[2][4];
#pragma unroll
        for (int hh = 0; hh < 2; ++hh)
#pragma unroll
            for (int mf = 0; mf < 4; ++mf) oc[hh][mf] = f32x4{0.f, 0.f, 0.f, 0.f};
        for (int ch = 0; ch < nchunk; ++ch) {
            f32x4 s[2][2];
#pragma unroll
            for (int u = 0; u < 2; ++u) {
                const int crow = 32 * ch + 8 * (fr >> 2) + 4 * u + (fr & 3);
                const u16* kp = Kc + (size_t)crow * 64 + 8 * fq;
                const bf16x8 k0 = ld8(kp), k1 = ld8(kp + 32);
#pragma unroll
                for (int hh = 0; hh < 2; ++hh) {
                    f32x4 a = f32x4{0.f, 0.f, 0.f, 0.f};
                    a = mfma16(k0, qf[hh][0], a); a = mfma16(k1, qf[hh][1], a);
                    s[hh][u] = a;
                }
            }
            float qs[2] = {0.f, 0.f}, p3[2] = {0.f, 0.f};
            bf16x8 pb[2];
#pragma unroll
            for (int hh = 0; hh < 2; ++hh) {
#pragma unroll
                for (int u = 0; u < 2; ++u)
#pragma unroll
                    for (int r = 0; r < 4; ++r) {
                        const int c = 32 * ch + 8 * fq + 4 * u + r;
                        const float pv = (16 * c + 31 <= tok) ? __expf(s[hh][u][r] - mC[hh]) * ilC[hh] : 0.f;
                        s[hh][u][r] = pv; qs[u] += pv; if (r == 3) p3[u] += pv;
                    }
                pb[hh] = pack8(s[hh][0], s[hh][1]);
            }
#pragma unroll
            for (int u = 0; u < 2; ++u) {
                const int j = 8 * ch + 2 * fq + u;
                atomicAdd(&imp[fr * 128 + j], qs[u]);
                if (j + 1 < 128) atomicAdd(&imp[fr * 128 + j + 1], p3[u]);
            }
#pragma unroll
            for (int mf = 0; mf < 4; ++mf) {
                const bf16x8 va = ld8(Vct + ((size_t)(ch >> 1) * 64 + 16 * mf + fr) * 64 + 32 * (ch & 1) + 8 * fq);
#pragma unroll
                for (int hh = 0; hh < 2; ++hh) oc[hh][mf] = mfma16(va, pb[hh], oc[hh][mf]);
            }
        }
#pragma unroll
        for (int hh = 0; hh < 2; ++hh) {
            const float gc = gp[hh * 3 + 0];
#pragma unroll
            for (int mf = 0; mf < 4; ++mf) ot[hh][mf] += oc[hh][mf] * gc;
        }
    }
    __syncthreads();
    if (hp == 0) {
        if (cur < 16) {
            if (lane < 16) { selm[lane * 2] = (2ull << cur) - 1ull; selm[lane * 2 + 1] = 0ull; }
        } else {
            for (int tau = 0; tau < 16; ++tau) {
                const int j0 = lane, j1 = lane + 64;
                const bool in0 = (j0 >= 1) && (j0 <= cur - 2), in1 = (j1 <= cur - 2);
                const float v0 = in0 ? imp[tau * 128 + j0] : 0.f;
                const float v1 = in1 ? imp[tau * 128 + j1] : 0.f;
                const uint32_t u0 = __float_as_uint(v0), u1 = __float_as_uint(v1);
                uint32_t res = 0;
                for (int bit = 30; bit >= 0; --bit) {
                    const uint32_t cand = res | (1u << bit);
                    const int cnt = __popcll(__ballot(in0 && u0 >= cand)) + __popcll(__ballot(in1 && u1 >= cand));
                    if (cnt >= 13) res = cand;
                }
                const uint64_t g0 = __ballot(in0 && u0 > res), g1 = __ballot(in1 && u1 > res);
                const uint64_t e0 = __ballot(in0 && u0 == res), e1 = __ballot(in1 && u1 == res);
                int need = 13 - (__popcll(g0) + __popcll(g1));
                const int ne0 = __popcll(e0);
                uint64_t sa = g0 | lowest_bits(e0, need);
                need -= (need < ne0 ? need : ne0);
                uint64_t sb = g1 | lowest_bits(e1, need);
                sa |= 1ull;
                if (cur - 1 < 64) sa |= 1ull << (cur - 1); else sb |= 1ull << (cur - 1 - 64);
                if (cur < 64) sa |= 1ull << cur; else sb |= 1ull << (cur - 64);
                if (lane == 0) { selm[tau * 2] = sa; selm[tau * 2 + 1] = sb; }
            }
        }
    }
    {
        int kbeg = t0 - 511; kbeg = kbeg < 0 ? 0 : kbeg; kbeg &= ~31;
        const int nch = (t0 + 16 - kbeg + 31) >> 5;
        float mW[2], lW[2];
        f32x4 ow[2][4];
#pragma unroll
        for (int hh = 0; hh < 2; ++hh) {
            mW[hh] = -1e30f; lW[hh] = 0.f;
#pragma unroll
            for (int mf = 0; mf < 4; ++mf) ow[hh][mf] = f32x4{0.f, 0.f, 0.f, 0.f};
        }
        for (int ch = 0; ch < nch; ++ch) {
            const int kb = kbeg + 32 * ch;
            f32x4 s[2][2];
#pragma unroll
            for (int u = 0; u < 2; ++u) {
                const int krow = kb + 8 * (fr >> 2) + 4 * u + (fr & 3);
                const u16* kp = Kw + (size_t)krow * 64 + 8 * fq;
                const bf16x8 k0 = ld8(kp), k1 = ld8(kp + 32);
#pragma unroll
                for (int hh = 0; hh < 2; ++hh) {
                    f32x4 a = f32x4{0.f, 0.f, 0.f, 0.f};
                    a = mfma16(k0, qf[hh][0], a); a = mfma16(k1, qf[hh][1], a);
                    s[hh][u] = a;
                }
            }
            bf16x8 pb[2];
#pragma unroll
            for (int hh = 0; hh < 2; ++hh) {
                float mx = -1e30f;
#pragma unroll
                for (int u = 0; u < 2; ++u)
#pragma unroll
                    for (int r = 0; r < 4; ++r) {
                        const int key = kb + 8 * fq + 4 * u + r;
                        const float v = (key <= tok && key > tok - 512) ? s[hh][u][r] : -1e30f;
                        s[hh][u][r] = v; mx = fmaxf(mx, v);
                    }
                mx = xor16_max(mx);
                const float mn = fmaxf(mW[hh], mx);
                const float sc = __expf(mW[hh] - mn);
                float sum = 0.f;
#pragma unroll
                for (int u = 0; u < 2; ++u)
#pragma unroll
                    for (int r = 0; r < 4; ++r) { const float pv = (s[hh][u][r] > -1e29f) ? __expf(s[hh][u][r] - mn) : 0.f; s[hh][u][r] = pv; sum += pv; }
                lW[hh] = lW[hh] * sc + sum; mW[hh] = mn;
#pragma unroll
                for (int mf = 0; mf < 4; ++mf) { ow[hh][mf][0] *= sc; ow[hh][mf][1] *= sc; ow[hh][mf][2] *= sc; ow[hh][mf][3] *= sc; }
                pb[hh] = pack8(s[hh][0], s[hh][1]);
            }
#pragma unroll
            for (int mf = 0; mf < 4; ++mf) {
                const bf16x8 va = ld8(Vwt + ((size_t)(kb >> 6) * 64 + 16 * mf + fr) * 64 + (kb & 63) + 8 * fq);
#pragma unroll
                for (int hh = 0; hh < 2; ++hh) ow[hh][mf] = mfma16(va, pb[hh], ow[hh][mf]);
            }
        }
#pragma unroll
        for (int hh = 0; hh < 2; ++hh) {
            const float l = xor16_sum(lW[hh]);
            const float gw = gp[hh * 3 + 2] * (l > 0.f ? 1.f / l : 0.f);
#pragma unroll
            for (int mf = 0; mf < 4; ++mf) ot[hh][mf] += ow[hh][mf] * gw;
        }
    }
    __syncthreads();
    {
        const unsigned long long mA = selm[fr * 2], mB = selm[fr * 2 + 1];
        uint4 kr0, kr1, vr0, vr1;
        const int srow0 = tid >> 3, srow1 = srow0 + 32, sc8 = (tid & 7) * 8;
        const int rho0 = (srow0 & 32) | ((srow0 & 4) << 2) | ((srow0 & 24) >> 1) | (srow0 & 3);
        const int rho1 = (srow1 & 32) | ((srow1 & 4) << 2) | ((srow1 & 24) >> 1) | (srow1 & 3);
#define gload(JB) do { const int jb_ = (JB); \
            kr0 = *(const uint4*)(Ks + ((size_t)(64 * jb_ + srow0)) * 64 + sc8); kr1 = *(const uint4*)(Ks + ((size_t)(64 * jb_ + srow1)) * 64 + sc8); \
            vr0 = *(const uint4*)(Vst + ((size_t)jb_ * 64 + srow0) * 64 + sc8); vr1 = *(const uint4*)(Vst + ((size_t)jb_ * 64 + srow1) * 64 + sc8); } while (0)
#define lstore(BUF) do { char* sb_ = smem + (BUF) * NSA_STG; \
            *(uint4*)(sb_ + (rho0 * 72 + sc8) * 2) = kr0; *(uint4*)(sb_ + (rho1 * 72 + sc8) * 2) = kr1; \
            *(uint4*)(sb_ + 9216 + (srow0 * 72 + sc8) * 2) = vr0; *(uint4*)(sb_ + 9216 + (srow1 * 72 + sc8) * 2) = vr1; } while (0)
        gload(0); lstore(0);
        if (curmax >= 1) gload(1);
        __syncthreads();
        float mS[2], lS[2];
        f32x4 os[2][4];
#pragma unroll
        for (int hh = 0; hh < 2; ++hh) {
            mS[hh] = -1e30f; lS[hh] = 0.f;
#pragma unroll
            for (int mf = 0; mf < 4; ++mf) os[hh][mf] = f32x4{0.f, 0.f, 0.f, 0.f};
        }
        for (int jb = 0; jb <= curmax; ++jb) {
            const int buf = jb & 1;
            const u16* Kl = (const u16*)(smem + buf * NSA_STG);
            const u16* Vl = Kl + 4608;
            const bool on = ((jb < 64 ? (mA >> jb) : (mB >> (jb - 64))) & 1ull) != 0ull;
            if (__ballot(on)) {
#pragma unroll 1
                for (int sc = 0; sc < 2; ++sc) {
                    f32x4 s[2][2];
#pragma unroll
                    for (int u = 0; u < 2; ++u) {
                        const u16* kp = Kl + (32 * sc + 16 * u + fr) * 72 + 8 * fq;
                        const bf16x8 k0 = ld8(kp), k1 = ld8(kp + 32);
#pragma unroll
                        for (int hh = 0; hh < 2; ++hh) {
                            f32x4 a = f32x4{0.f, 0.f, 0.f, 0.f};
                            a = mfma16(k0, qf[hh][0], a); a = mfma16(k1, qf[hh][1], a);
                            s[hh][u] = a;
                        }
                    }
                    bf16x8 pb[2];
#pragma unroll
                    for (int hh = 0; hh < 2; ++hh) {
                        float mx = -1e30f;
#pragma unroll
                        for (int u = 0; u < 2; ++u)
#pragma unroll
                            for (int r = 0; r < 4; ++r) {
                                const int key = 64 * jb + 32 * sc + 8 * fq + 4 * u + r;
                                const float v = (on && key <= tok) ? s[hh][u][r] : -1e30f;
                                s[hh][u][r] = v; mx = fmaxf(mx, v);
                            }
                        mx = xor16_max(mx);
                        const float mn = fmaxf(mS[hh], mx);
                        const float scl = __expf(mS[hh] - mn);
                        float sum = 0.f;
#pragma unroll
                        for (int u = 0; u < 2; ++u)
#pragma unroll
                            for (int r = 0; r < 4; ++r) { const float pv = (s[hh][u][r] > -1e29f) ? __expf(s[hh][u][r] - mn) : 0.f; s[hh][u][r] = pv; sum += pv; }
                        lS[hh] = lS[hh] * scl + sum; mS[hh] = mn;
#pragma unroll
                        for (int mf = 0; mf < 4; ++mf) { os[hh][mf][0] *= scl; os[hh][mf][1] *= scl; os[hh][mf][2] *= scl; os[hh][mf][3] *= scl; }
                        pb[hh] = pack8(s[hh][0], s[hh][1]);
                    }
#pragma unroll
                    for (int mf = 0; mf < 4; ++mf) {
                        const bf16x8 va = ld8(Vl + (16 * mf + fr) * 72 + 32 * sc + 8 * fq);
#pragma unroll
                        for (int hh = 0; hh < 2; ++hh) os[hh][mf] = mfma16(va, pb[hh], os[hh][mf]);
                    }
                }
            }
            if (jb + 1 <= curmax) lstore(buf ^ 1);
            if (jb + 2 <= curmax) gload(jb + 2);
            __syncthreads();
        }
#undef gload
#undef lstore
#pragma unroll
        for (int hh = 0; hh < 2; ++hh) {
            const float l = xor16_sum(lS[hh]);
            const float gs = gp[hh * 3 + 1] * (l > 0.f ? 1.f / l : 0.f);
#pragma unroll
            for (int mf = 0; mf < 4; ++mf) ot[hh][mf] += os[hh][mf] * gs;
        }
    }
    {
        u16* mix = (u16*)(ws + OFF_MIX) + (n0 + fr) * 1024 + (g * 4 + 2 * hp) * 64;
#pragma unroll
        for (int hh = 0; hh < 2; ++hh)
#pragma unroll
            for (int mf = 0; mf < 4; ++mf) *(uint2*)(mix + hh * 64 + 16 * mf + 4 * fq) = pack4(ot[hh][mf]);
    }
    __syncthreads();
}

DEVI void wo_tile(const Params& p, char* smem, int tile) {
    char* ws = p.ws;
    const int rt = tile >> 3, ct = tile & 7;
    const int tid = threadIdx.x, lane = tid & 63, wid = tid >> 6, wr = wid >> 1, wc = wid & 1, fr = lane & 15, fq = lane >> 4;
    const u16* MIX = (const u16*)(ws + OFF_MIX);
    auto arow = [&](int r) { return MIX + (size_t)(rt * 128 + r) * 1024; };
    f32x4 acc[4][4];
    gemm128(arow, (const u16*)(ws + OFF_WO) + (size_t)ct * 128 * 1024, 1024, 1024, smem, acc);
    float* pre = (float*)(ws + OFF_PRE);
#pragma unroll
    for (int m = 0; m < 4; ++m)
#pragma unroll
        for (int n = 0; n < 4; ++n) {
            const int row = rt * 128 + wr * 64 + m * 16 + fq * 4, col = ct * 128 + wc * 64 + n * 16 + fr;
#pragma unroll
            for (int j = 0; j < 4; ++j) {
                const size_t ix = (size_t)(row + j) * 1024 + col;
                pre[ix] = DN_ALPHA * p.x[ix] + acc[m][n][j];
            }
        }
}

DEVI void ln1_router_tile(const Params& p, char* smem, int tile) {
    char* ws = p.ws;
    const int tid = threadIdx.x, lane = tid & 63, w = tid >> 6;
    const int tok0 = tile * 32;
    const float* pre = (const float*)(ws + OFF_PRE);
    float* H1 = (float*)(ws + OFF_H1); u16* H1B = (u16*)(ws + OFF_H1B);
    for (int i = 0; i < 8; ++i) {
        const size_t row = (size_t)tok0 + w * 8 + i;
        float4 v[4];
        float s = 0.f;
#pragma unroll
        for (int q = 0; q < 4; ++q) { v[q] = *(const float4*)(pre + row * 1024 + q * 256 + lane * 4); s += v[q].x + v[q].y + v[q].z + v[q].w; }
        const float mu = wave_sum(s) * (1.f / 1024.f);
        float ss = 0.f;
#pragma unroll
        for (int q = 0; q < 4; ++q) { v[q].x -= mu; v[q].y -= mu; v[q].z -= mu; v[q].w -= mu; ss += v[q].x * v[q].x + v[q].y * v[q].y + v[q].z * v[q].z + v[q].w * v[q].w; }
        const float rs = rsqrtf(wave_sum(ss) * (1.f / 1024.f) + 1e-5f);
#pragma unroll
        for (int q = 0; q < 4; ++q) {
            const int c = q * 256 + lane * 4;
            const float4 gq = *(const float4*)(p.ln1g + c), bq = *(const float4*)(p.ln1b + c);
            float4 o; o.x = v[q].x * rs * gq.x + bq.x; o.y = v[q].y * rs * gq.y + bq.y; o.z = v[q].z * rs * gq.z + bq.z; o.w = v[q].w * rs * gq.w + bq.w;
            *(float4*)(H1 + row * 1024 + c) = o;
            uint2 ob; ob.x = pack2(o.x, o.y); ob.y = pack2(o.z, o.w);
            *(uint2*)(H1B + row * 1024 + c) = ob;
        }
    }
    __threadfence();
    __syncthreads();
    float* part = (float*)smem;
    int* lcnt = (int*)(smem + 4 * 32 * 33 * 4);
    {
        f32x16 acc;
#pragma unroll
        for (int i = 0; i < 16; ++i) acc[i] = 0.f;
        const int i32 = lane & 31, hh = lane >> 5;
        const float* ap = H1 + ((size_t)tok0 + i32) * 1024 + 256 * w + 4 * hh;
        const float* bp = p.w_r + (size_t)(256 * w + 4 * hh) * 32 + i32;
#pragma unroll 2
        for (int m = 0; m < 32; ++m) {
            const float4 a = *(const float4*)(ap + 8 * m);
            const float b0 = bp[(size_t)(8 * m + 0) * 32], b1 = bp[(size_t)(8 * m + 1) * 32], b2 = bp[(size_t)(8 * m + 2) * 32], b3 = bp[(size_t)(8 * m + 3) * 32];
            acc = __builtin_amdgcn_mfma_f32_32x32x2f32(a.x, b0, acc, 0, 0, 0);
            acc = __builtin_amdgcn_mfma_f32_32x32x2f32(a.y, b1, acc, 0, 0, 0);
            acc = __builtin_amdgcn_mfma_f32_32x32x2f32(a.z, b2, acc, 0, 0, 0);
            acc = __builtin_amdgcn_mfma_f32_32x32x2f32(a.w, b3, acc, 0, 0, 0);
        }
#pragma unroll
        for (int r = 0; r < 16; ++r) {
            const int row = (r & 3) + 8 * (r >> 2) + 4 * hh;
            part[(w * 32 + row) * 33 + i32] = acc[r];
        }
    }
    if (tid < 32) lcnt[tid] = 0;
    __syncthreads();
    int e_sel[4]; float w_sel[4]; int rank[4];
    if (tid < 32) {
        float bestv[4]; int besti[4];
        uint32_t used = 0;
#pragma unroll
        for (int k = 0; k < 4; ++k) {
            float bv = -3.0e38f; int bi = 0;
            for (int j = 0; j < 32; ++j) {
                const float lg = part[(0 * 32 + tid) * 33 + j] + part[(1 * 32 + tid) * 33 + j] + part[(2 * 32 + tid) * 33 + j] + part[(3 * 32 + tid) * 33 + j] + p.b_r[j];
                if (!((used >> j) & 1u) && lg > bv) { bv = lg; bi = j; }
            }
            used |= 1u << bi; bestv[k] = bv; besti[k] = bi;
        }
        float den = 0.f;
#pragma unroll
        for (int k = 0; k < 4; ++k) { w_sel[k] = expf(bestv[k] - bestv[0]); den += w_sel[k]; }
#pragma unroll
        for (int k = 0; k < 4; ++k) { w_sel[k] /= den; e_sel[k] = besti[k]; rank[k] = atomicAdd(&lcnt[besti[k]], 1); }
    }
    __syncthreads();
    if (tid < 32) {
        const int c = lcnt[tid];
        int* counts = (int*)((float*)(ws + OFF_MISC) + 1024);
        lcnt[32 + tid] = c ? atomicAdd(&counts[tid], c) : 0;
    }
    __syncthreads();
    if (tid < 32) {
        int* la = (int*)(ws + OFF_LISTA); float* lw = (float*)(ws + OFF_LISTW);
#pragma unroll
        for (int k = 0; k < 4; ++k) {
            const size_t pos = (size_t)e_sel[k] * NTOK + lcnt[32 + e_sel[k]] + rank[k];
            la[pos] = (tok0 + tid) * 4 + k; lw[pos] = w_sel[k];
        }
    }
    __syncthreads();
}

struct MoeMap { int e, rt, ct, cnt, pbase; };
DEVI void moe_setup(const Params& p, int* sm  , int ctn) {
    const int tid = threadIdx.x;
    if (tid == 0) {
        const int* counts = (const int*)((const float*)(p.ws + OFF_MISC) + 1024);
        int tp = 0, cp = 0;
        for (int e = 0; e < 32; ++e) {
            const int c = counts[e];
            sm[e] = tp; sm[32 + e] = cp; sm[64 + e] = c;
            tp += ((c + 127) >> 7) * ctn; cp += c;
        }
        sm[96] = tp;
    }
    __syncthreads();
}
DEVI MoeMap moe_map(const int* sm, int tile, int ctn) {
    int e = 0;
#pragma unroll 1
    for (int i = 1; i < 32; ++i) if (sm[i] <= tile) e = i;
    MoeMap m; m.e = e; m.cnt = sm[64 + e]; m.pbase = sm[32 + e];
    const int tl = tile - sm[e], nrt = (m.cnt + 127) >> 7;
    m.ct = tl / nrt; m.rt = tl % nrt;
    return m;
}

DEVI void moe1_tile(const Params& p, char* smem, const MoeMap& mm) {
    char* ws = p.ws;
    const int tid = threadIdx.x, lane = tid & 63, wid = tid >> 6, wr = wid >> 1, wc = wid & 1, fr = lane & 15, fq = lane >> 4;
    const int* la = (const int*)(ws + OFF_LISTA) + (size_t)mm.e * NTOK;
    const u16* H1B = (const u16*)(ws + OFF_H1B);
    auto arow = [&](int r) { const int idx = mm.rt * 128 + r; const int tokn = idx < mm.cnt ? (la[idx] >> 2) : 0; return H1B + (size_t)tokn * 1024; };
    const u16* Bt = (const u16*)(ws + OFF_WGU) + ((size_t)mm.e * 2048 + (size_t)mm.ct * 128) * 1024;
    f32x4 acc[4][4];
    gemm128(arow, Bt, 1024, 1024, smem, acc);
    u16* act = (u16*)(ws + OFF_ACT);
    const float* bgu = p.b_gu + (size_t)mm.e * 2048;
#pragma unroll
    for (int m = 0; m < 4; ++m) {
        const int idx0 = mm.rt * 128 + wr * 64 + m * 16 + fq * 4;
#pragma unroll
        for (int i = 0; i < 2; ++i) {
            const int col = 64 * mm.ct + 32 * wc + 16 * i + fr;
            const float bg_ = bgu[col], bu_ = bgu[1024 + col];
#pragma unroll
            for (int j = 0; j < 4; ++j) {
                if (idx0 + j < mm.cnt) {
                    float gt = acc[m][2 * i][j] + bg_; gt = fminf(gt, 7.f);
                    float up = acc[m][2 * i + 1][j] + bu_; up = fminf(fmaxf(up, -7.f), 7.f);
                    const float a = gt * (1.f / (1.f + __expf(-1.702f * gt))) * (up + 1.f);
                    act[(size_t)(mm.pbase + idx0 + j) * 1024 + col] = f2bf(a);
                }
            }
        }
    }
}

DEVI void moe2_tile(const Params& p, char* smem, const MoeMap& mm) {
    char* ws = p.ws;
    const int tid = threadIdx.x, lane = tid & 63, wid = tid >> 6, wr = wid >> 1, wc = wid & 1, fr = lane & 15, fq = lane >> 4;
    const u16* act = (const u16*)(ws + OFF_ACT);
    auto arow = [&](int r) { return act + (size_t)(mm.pbase + mm.rt * 128 + r) * 1024; };
    const u16* Bt = (const u16*)(ws + OFF_WDN) + ((size_t)mm.e * 1024 + (size_t)mm.ct * 128) * 1024;
    f32x4 acc[4][4];
    gemm128(arow, Bt, 1024, 1024, smem, acc);
    const int* la = (const int*)(ws + OFF_LISTA) + (size_t)mm.e * NTOK;
    const float* lw = (const float*)(ws + OFF_LISTW) + (size_t)mm.e * NTOK;
    u16* Y = (u16*)(ws + OFF_Y);
    const float* bdn = p.b_dn + (size_t)mm.e * 1024;
#pragma unroll
    for (int m = 0; m < 4; ++m) {
        const int idx0 = mm.rt * 128 + wr * 64 + m * 16 + fq * 4;
#pragma unroll
        for (int j = 0; j < 4; ++j) {
            if (idx0 + j < mm.cnt) {
                const int a = la[idx0 + j]; const float wgt = lw[idx0 + j];
#pragma unroll
                for (int n = 0; n < 4; ++n) {
                    const int col = mm.ct * 128 + wc * 64 + n * 16 + fr;
                    Y[(size_t)a * 1024 + col] = f2bf((acc[m][n][j] + bdn[col]) * wgt);
                }
            }
        }
    }
}

DEVI void final_rows(const Params& p, int task) {
    char* ws = p.ws;
    const int tid = threadIdx.x, lane = tid & 63, w = tid >> 6;
    const float* H1 = (const float*)(ws + OFF_H1); const u16* Y = (const u16*)(ws + OFF_Y);
    for (int i = 0; i < 8; ++i) {
        const size_t row = (size_t)task * 32 + w * 8 + i;
        float4 v[4];
        float s = 0.f;
#pragma unroll
        for (int q = 0; q < 4; ++q) {
            const int c = q * 256 + lane * 4;
            float4 a = *(const float4*)(H1 + row * 1024 + c);
            a.x *= DN_ALPHA; a.y *= DN_ALPHA; a.z *= DN_ALPHA; a.w *= DN_ALPHA;
#pragma unroll
            for (int k = 0; k < 4; ++k) {
                const uint2 y = *(const uint2*)(Y + (row * 4 + k) * 1024 + c);
                a.x += __uint_as_float(y.x << 16); a.y += __uint_as_float(y.x & 0xffff0000u);
                a.z += __uint_as_float(y.y << 16); a.w += __uint_as_float(y.y & 0xffff0000u);
            }
            v[q] = a; s += a.x + a.y + a.z + a.w;
        }
        const float mu = wave_sum(s) * (1.f / 1024.f);
        float ss = 0.f;
#pragma unroll
        for (int q = 0; q < 4; ++q) { v[q].x -= mu; v[q].y -= mu; v[q].z -= mu; v[q].w -= mu; ss += v[q].x * v[q].x + v[q].y * v[q].y + v[q].z * v[q].z + v[q].w * v[q].w; }
        const float rs = rsqrtf(wave_sum(ss) * (1.f / 1024.f) + 1e-5f);
#pragma unroll
        for (int q = 0; q < 4; ++q) {
            const int c = q * 256 + lane * 4;
            const float4 gq = *(const float4*)(p.ln2g + c), bq = *(const float4*)(p.ln2b + c);
            float4 o; o.x = v[q].x * rs * gq.x + bq.x; o.y = v[q].y * rs * gq.y + bq.y; o.z = v[q].z * rs * gq.z + bq.z; o.w = v[q].w * rs * gq.w + bq.w;
            *(float4*)(p.out + row * 1024 + c) = o;
        }
    }
}

DEVI void run_phase(const Params& p, char* smem, int ph) {
    const int G = gridDim.x, B0 = blockIdx.x;
#ifdef ONLY_PHASE
    if (ph != ONLY_PHASE) return;
#endif
    switch (ph) {
    case 0: phase_prep(p, smem); break;
    case 1: phase_proj(p, smem); break;
    case 2:
        for (int t = B0; t < 128; t += G) cmp1_tile(p, smem, t);
        for (int t = B0; t < 2048; t += G) hgrn_local_tile(p, smem, t);
        break;
    case 3:
        for (int t = B0; t < 64; t += G) cmp2_tile(p, smem, t);
        for (int t = G - 1 - B0; t < 512; t += G) hgrn_scan_task(p, t);
        break;
    case 4:
#ifndef NO_NSA
        for (int t = B0; t < NSA_TILES; t += G) nsa_tile(p, smem, t);
#endif
#ifndef NO_HG3
        for (int t = G - 1 - B0; t < 2048; t += G) hgrn_out_tile(p, smem, t);
#endif
        break;
    case 5:
        for (int t = B0; t < 2048; t += G) wo_tile(p, smem, t);
        break;
    case 6:
        for (int t = B0; t < 1024; t += G) ln1_router_tile(p, smem, t);
        break;
    case 7: {
        int* sm = (int*)(smem + 32768);
        moe_setup(p, sm, 16);
        const int total = sm[96];
        for (int t = B0; t < total; t += G) { const MoeMap mm = moe_map(sm, t, 16); moe1_tile(p, smem, mm); }
        __syncthreads();
    } break;
    case 8: {
        int* sm = (int*)(smem + 32768);
        moe_setup(p, sm, 8);
        const int total = sm[96];
        for (int t = B0; t < total; t += G) { const MoeMap mm = moe_map(sm, t, 8); moe2_tile(p, smem, mm); }
        __syncthreads();
    } break;
    case 9:
        for (int t = B0; t < 1024; t += G) final_rows(p, t);
        break;
    }
}

#if N_LAUNCH_MODE == 1
__global__ void __launch_bounds__(256, 2) fwd_kernel(Params p) {
    extern __shared__ __attribute__((aligned(16))) char smem[];
    cg::grid_group grid = cg::this_grid();
#ifndef PROBE_REP
#define PROBE_REP -1
#endif
#define RP(k) run_phase(p, smem, k); grid.sync(); if (PROBE_REP == k) { run_phase(p, smem, k); grid.sync(); }
    RP(0) RP(1) RP(2)
    run_phase(p, smem, 3); grid.sync();
    if (PROBE_REP == 23) { run_phase(p, smem, 2); grid.sync(); run_phase(p, smem, 3); grid.sync(); }
    RP(4) RP(5)
    run_phase(p, smem, 6); grid.sync();
    if (PROBE_REP == 6) {
        if (blockIdx.x == 0 && threadIdx.x < 32) ((int*)((float*)(p.ws + OFF_MISC) + 1024))[threadIdx.x] = 0;
        grid.sync(); run_phase(p, smem, 6); grid.sync();
    }
    RP(7) RP(8)
    run_phase(p, smem, 9);
    if (PROBE_REP == 9) { grid.sync(); run_phase(p, smem, 9); }
#undef RP
}
#define KFN fwd_kernel
#else
template <int PH>
__global__ void __launch_bounds__(256, 2) phase_kernel(Params p) {
    extern __shared__ __attribute__((aligned(16))) char smem[];
    run_phase(p, smem, PH);
}
#define KFN phase_kernel<4>
#endif

extern "C" void kernel_launch(void* const* d_in, const int* in_sizes, int n_in, void* d_out, int out_size, void* d_ws, size_t ws_size,
                              hipStream_t stream) {
    static int grid = 0;
    if (grid == 0) {
        if (ws_size < WS_NEED) { fprintf(stderr, "kernel_launch: workspace too small: %zu < %zu\n", ws_size, (size_t)WS_NEED); grid = -1; return; }
        int dev = 0, cus = 0, per_cu = 0;
        (void)hipGetDevice(&dev);
        (void)hipDeviceGetAttribute(&cus, hipDeviceAttributeMultiprocessorCount, dev);
#if N_LAUNCH_MODE == 1
        (void)hipFuncSetAttribute((const void*)KFN, hipFuncAttributeMaxDynamicSharedMemorySize, SMEM_BYTES);
#else
#define SA_(PH) (void)hipFuncSetAttribute((const void*)phase_kernel<PH>, hipFuncAttributeMaxDynamicSharedMemorySize, SMEM_BYTES);
        SA_(0) SA_(1) SA_(2) SA_(3) SA_(4) SA_(5) SA_(6) SA_(7) SA_(8) SA_(9)
#undef SA_
#endif
        (void)hipOccupancyMaxActiveBlocksPerMultiprocessor(&per_cu, (const void*)KFN, 256, SMEM_BYTES);
        if (per_cu < 1) per_cu = 1;
        if (per_cu > 2) per_cu = 2;
        grid = cus * per_cu;
    }
    if (grid < 0) return;
    Params p{};
    p.x = (const float*)d_in[0]; p.pos = (const int*)d_in[1]; p.w_in = (const float*)d_in[2]; p.pe = (const float*)d_in[3];
    p.w_ck1 = (const float*)d_in[4]; p.w_ck2 = (const float*)d_in[5]; p.w_cv1 = (const float*)d_in[6]; p.w_cv2 = (const float*)d_in[7];
    p.hg_lb = (const float*)d_in[8]; p.hg_ng = (const float*)d_in[9]; p.w_o = (const float*)d_in[10]; p.ln1g = (const float*)d_in[11];
    p.ln1b = (const float*)d_in[12]; p.w_r = (const float*)d_in[13]; p.b_r = (const float*)d_in[14]; p.w_gu = (const float*)d_in[15];
    p.b_gu = (const float*)d_in[16]; p.w_dn = (const float*)d_in[17]; p.b_dn = (const float*)d_in[18]; p.ln2g = (const float*)d_in[19];
    p.ln2b = (const float*)d_in[20];
    p.out = (float*)d_out; p.ws = (char*)d_ws;
#if N_LAUNCH_MODE == 1
    p.ph_lo = 0; p.ph_hi = NPHASE;
    void* args[] = {&p};
    hipError_t e = hipLaunchCooperativeKernel((const void*)fwd_kernel, dim3(grid), dim3(256), args, SMEM_BYTES, stream);
    if (e != hipSuccess) fprintf(stderr, "cooperative launch failed: %s (grid %d)\n", hipGetErrorString(e), grid);
#else
    p.ph_lo = 0; p.ph_hi = NPHASE;
#define LP(PH) hipLaunchKernelGGL(phase_kernel<PH>, dim3(grid), dim3(256), SMEM_BYTES, stream, p);
    LP(0) LP(1) LP(2) LP(3) LP(4) LP(5) LP(6) LP(7) LP(8) LP(9)
#undef LP
#endif
}
```

```cpp
#include <hip/hip_runtime.h>
#include <hip/hip_cooperative_groups.h>
#include <stdint.h>
#include <stdio.h>
namespace cg = cooperative_groups;

typedef unsigned short u16;
typedef __attribute__((ext_vector_type(8))) short bf16x8;
typedef __attribute__((ext_vector_type(4))) float f32x4;
typedef __attribute__((ext_vector_type(16))) float f32x16;
#define DEVI __device__ __forceinline__
static __device__ __forceinline__ int laneid_() { int r; asm volatile("v_mbcnt_lo_u32_b32 %0, -1, 0\n\tv_mbcnt_hi_u32_b32 %0, -1, %0" : "=v"(r)); return r; }
#define LANEID (laneid_())
#define TIDX (p.ph_lo * 64 + LANEID)
#define VTID ((p.ph_lo & 3) * 64 + LANEID)
#define VBID ((int)(blockIdx.x * 2 + (p.ph_lo >> 2)))
#define VGRID ((int)(gridDim.x * 2))

#ifndef N_LAUNCH_MODE
#define N_LAUNCH_MODE 1
#endif

constexpr int NTOK = 32768, SEQ = 8192, NB = 4;
constexpr int SP = 8224;
constexpr int NPHASE = 10;
constexpr int SMEM_BYTES = 131072 + 1024;
constexpr float DN_ALPHA = 1.189207115002721f;

constexpr size_t MB = 1ull << 20;
constexpr size_t OFF_WIN = 0;
constexpr size_t OFF_WCK1 = 7 * MB;
constexpr size_t OFF_WCV1 = 8 * MB;
constexpr size_t OFF_WCK2 = 9 * MB;
constexpr size_t OFF_WCV2 = 9 * MB + 65536;
constexpr size_t OFF_WO = 10 * MB;
constexpr size_t OFF_ROPE = 12 * MB;
constexpr size_t OFF_GATES = 14 * MB;
constexpr size_t OFF_MISC = 17 * MB;
constexpr size_t OFF_LISTA = 18 * MB;
constexpr size_t OFF_LISTW = 22 * MB;
constexpr size_t OFF_HID = 26 * MB;
constexpr size_t OFF_KC = 30 * MB;
constexpr size_t OFF_VCT = 30 * MB + 524288;
constexpr size_t OFF_DG = 31 * MB;
constexpr size_t OFF_WGU = 32 * MB;
constexpr size_t OFF_WDN = 160 * MB;
constexpr size_t OFF_H1 = 224 * MB;
constexpr size_t OFF_H1B = 352 * MB;
constexpr size_t OFF_X = 416 * MB;
constexpr size_t OFF_XB = OFF_X;
constexpr size_t OFF_Q = OFF_X + 64 * MB;
constexpr size_t OFF_KCR = OFF_X + 96 * MB;
constexpr size_t OFF_VCR = OFF_X + 105 * MB;
constexpr size_t OFF_KS = OFF_X + 114 * MB;
constexpr size_t OFF_KW = OFF_X + 123 * MB;
constexpr size_t OFF_VST = OFF_X + 132 * MB;
constexpr size_t OFF_VWT = OFF_X + 141 * MB;
constexpr size_t OFF_QH = OFF_X + 150 * MB;
constexpr size_t OFF_LOGF = OFF_X + 182 * MB;
constexpr size_t OFF_VTH = OFF_X + 246 * MB;
constexpr size_t OFF_GH = OFF_X + 278 * MB;
constexpr size_t OFF_LBUF = OFF_X + 310 * MB;
constexpr size_t OFF_MIX = OFF_X + 374 * MB;
constexpr size_t OFF_PRE = OFF_X;
constexpr size_t OFF_ACT = OFF_X;
constexpr size_t OFF_Y = OFF_X + 256 * MB;
constexpr size_t WS_NEED = OFF_Y + 256 * MB;

struct Params {
    const float* x; const int* pos; const float* w_in; const float* pe;
    const float* w_ck1; const float* w_ck2; const float* w_cv1; const float* w_cv2;
    const float* hg_lb; const float* hg_ng; const float* w_o; const float* ln1g; const float* ln1b;
    const float* w_r; const float* b_r; const float* w_gu; const float* b_gu; const float* w_dn; const float* b_dn;
    const float* ln2g; const float* ln2b;
    float* out; char* ws;
    int ph_lo, ph_hi;
};

DEVI u16 f2bf(float f) { uint32_t u = __float_as_uint(f); u += 0x7fffu + ((u >> 16) & 1u); return (u16)(u >> 16); }
DEVI float bf2f(u16 h) { return __uint_as_float(((uint32_t)h) << 16); }
typedef float f32x2_t __attribute__((ext_vector_type(2)));
typedef __bf16 bf16x2_t __attribute__((ext_vector_type(2)));
DEVI uint32_t pack2(float a, float b) { f32x2_t v = {a, b}; bf16x2_t r = __builtin_convertvector(v, bf16x2_t); return __builtin_bit_cast(uint32_t, r); }
DEVI bf16x8 pack8(f32x4 a, f32x4 b) {
    union { bf16x8 v; uint32_t u[4]; } r;
    r.u[0] = pack2(a[0], a[1]); r.u[1] = pack2(a[2], a[3]); r.u[2] = pack2(b[0], b[1]); r.u[3] = pack2(b[2], b[3]);
    return r.v;
}
DEVI uint2 pack4(f32x4 a) { uint2 r; r.x = pack2(a[0], a[1]); r.y = pack2(a[2], a[3]); return r; }
DEVI f32x4 mfma16(bf16x8 a, bf16x8 b, f32x4 c) { return __builtin_amdgcn_mfma_f32_16x16x32_bf16(a, b, c, 0, 0, 0); }
DEVI bf16x8 ld8(const u16* p) { return *reinterpret_cast<const bf16x8*>(p); }
DEVI bf16x8 zero8() { bf16x8 z = {0, 0, 0, 0, 0, 0, 0, 0}; return z; }
DEVI float sigmoidf_(float v) { return 1.f / (1.f + __expf(-v)); }
DEVI float xor16_max(float v) { v = fmaxf(v, __shfl_xor(v, 16)); v = fmaxf(v, __shfl_xor(v, 32)); return v; }
DEVI float xor16_sum(float v) { v += __shfl_xor(v, 16); v += __shfl_xor(v, 32); return v; }
DEVI float wave_sum(float v) {
#pragma unroll
    for (int o = 32; o > 0; o >>= 1) v += __shfl_xor(v, o);
    return v;
}
DEVI void glds16(const u16* g, u16* l) {
    __builtin_amdgcn_global_load_lds((const unsigned*)g, (__attribute__((address_space(3))) unsigned*)l, 16, 0, 0);
}

template <class AFn>
DEVI void gemm128(const int tid, AFn arow, const u16* __restrict__ Bt, size_t ldb, int K, char* smem, f32x4 (&acc)[4][4]) {
    const int lane = tid & 63, wid = tid >> 6, wr = wid >> 1, wc = wid & 1, fr = lane & 15, fq = lane >> 4;
    u16* SA = (u16*)smem; u16* SB = (u16*)(smem + 8192);
    const int r0 = tid >> 2, c0 = (tid & 3) * 8;
    const u16* a0 = arow(r0) + c0; const u16* a1 = arow(r0 + 64) + c0;
    const u16* b0 = Bt + (size_t)r0 * ldb + c0; const u16* b1 = Bt + (size_t)(r0 + 64) * ldb + c0;
#pragma unroll
    for (int m = 0; m < 4; ++m)
#pragma unroll
        for (int n = 0; n < 4; ++n) acc[m][n] = f32x4{0.f, 0.f, 0.f, 0.f};
    for (int kt = 0; kt < K; kt += 32) {
        glds16(a0 + kt, SA + tid * 8); glds16(a1 + kt, SA + 2048 + tid * 8);
        glds16(b0 + kt, SB + tid * 8); glds16(b1 + kt, SB + 2048 + tid * 8);
        asm volatile("s_waitcnt vmcnt(0)" ::: "memory");
        __syncthreads();
        bf16x8 af[4], bfr[4];
#pragma unroll
        for (int m = 0; m < 4; ++m) af[m] = ld8(SA + (wr * 64 + m * 16 + fr) * 32 + fq * 8);
#pragma unroll
        for (int n = 0; n < 4; ++n) bfr[n] = ld8(SB + (wc * 64 + n * 16 + fr) * 32 + fq * 8);
#pragma unroll
        for (int m = 0; m < 4; ++m)
#pragma unroll
            for (int n = 0; n < 4; ++n) acc[m][n] = mfma16(af[m], bfr[n], acc[m][n]);
        __syncthreads();
    }
}

template <class CM>
DEVI void tconv_tile(const int tid, const float* __restrict__ src, size_t ld, u16* __restrict__ dst, size_t ldd, int r0, int k0, CM colmap, char* smem) {
    float (*t)[65] = (float (*)[65])smem;
    {
        const int n = tid & 63; const int col = colmap(r0 + n);
#pragma unroll 4
        for (int i = 0; i < 16; ++i) {
            const int k = (tid >> 6) + 4 * i;
            t[k][n] = (col >= 0) ? src[(size_t)(k0 + k) * ld + col] : 0.f;
        }
    }
    __syncthreads();
    {
        const int k2 = (tid & 31) * 2;
#pragma unroll 4
        for (int i = 0; i < 8; ++i) {
            const int n = (tid >> 5) + 8 * i;
            *(uint32_t*)(dst + (size_t)(r0 + n) * ldd + k0 + k2) = pack2(t[k2][n], t[k2 + 1][n]);
        }
    }
    __syncthreads();
}

DEVI void phase_prep(const Params& p, char* smem) {
    char* ws = p.ws;
    constexpr int J_WIN = 54 * 16;
    constexpr int J_WCK1 = 4 * 32;
    constexpr int J_WC2 = 2 * 4;
    constexpr int J_WO = 16 * 16;
    constexpr int J_WGU = 32 * 32 * 16;
    constexpr int J_WDN = 32 * 16 * 16;
    constexpr int J_XB = 16384;
    constexpr int J_ROPE = 1024;
    constexpr int J0 = 0, J1 = J0 + J_WIN, J2 = J1 + 2 * J_WCK1, J3 = J2 + 2 * J_WC2, J4 = J3 + J_WO, J5 = J4 + J_WGU,
                  J6 = J5 + J_WDN, J7 = J6 + J_XB, J8 = J7 + J_ROPE, J9 = J8 + 1;
    for (int job = VBID; job < J9; job += VGRID) {
        const int tid = VTID;
        if (job < J1) {
            const int j = job - J0, rt = j / 16, kt = j % 16;
            auto cm = [](int r) { return r < 1280 ? r : (r < 3328 ? r + 24 : (r < 3352 ? 1280 + (r - 3328) : -1)); };
            tconv_tile(tid, p.w_in, 3352, (u16*)(ws + OFF_WIN), 1024, rt * 64, kt * 64, cm, smem);
        } else if (job < J2) {
            int j = job - J1; const int which = j / J_WCK1; j %= J_WCK1; const int rt = j / 32, kt = j % 32;
            auto cm = [](int r) { return r; };
            tconv_tile(tid, which ? p.w_cv1 : p.w_ck1, 256, (u16*)(ws + (which ? OFF_WCV1 : OFF_WCK1)), 2048, rt * 64, kt * 64, cm, smem);
        } else if (job < J3) {
            int j = job - J2; const int which = j / J_WC2; j %= J_WC2; const int rt = j / 4, kt = j % 4;
            auto cm = [](int r) { return r < 64 ? r : -1; };
            tconv_tile(tid, which ? p.w_cv2 : p.w_ck2, 64, (u16*)(ws + (which ? OFF_WCV2 : OFF_WCK2)), 256, rt * 64, kt * 64, cm, smem);
        } else if (job < J4) {
            const int j = job - J3, rt = j / 16, kt = j % 16;
            auto cm = [](int r) { return r; };
            tconv_tile(tid, p.w_o, 1024, (u16*)(ws + OFF_WO), 1024, rt * 64, kt * 64, cm, smem);
        } else if (job < J5) {
            int j = job - J4; const int e = j / 512; j %= 512; const int rt = j / 16, kt = j % 16;
            auto cm = [](int r) { const int pn = r >> 8, bj = (r >> 7) & 1, wc = (r >> 5) & 3, n = (r >> 4) & 1, i = r & 15; return (n ? 1024 : 0) + pn * 128 + (bj * 4 + wc) * 16 + i; };
            tconv_tile(tid, p.w_gu + (size_t)e * 1024 * 2048, 2048, (u16*)(ws + OFF_WGU) + (size_t)e * 2048 * 1024, 1024, rt * 64, kt * 64, cm, smem);
        } else if (job < J6) {
            int j = job - J5; const int e = j / 256; j %= 256; const int rt = j / 16, kt = j % 16;
            auto cm = [](int r) { return r; };
            tconv_tile(tid, p.w_dn + (size_t)e * 1024 * 1024, 1024, (u16*)(ws + OFF_WDN) + (size_t)e * 1024 * 1024, 1024, rt * 64, kt * 64, cm, smem);
        } else if (job < J7) {
            const size_t base = (size_t)(job - J6) * 2048 + (size_t)tid * 8;
            const float4 a = *(const float4*)(p.x + base), b = *(const float4*)(p.x + base + 4);
            uint4 o; o.x = pack2(a.x, a.y); o.y = pack2(a.z, a.w); o.z = pack2(b.x, b.y); o.w = pack2(b.z, b.w);
            *(uint4*)((u16*)(ws + OFF_XB) + base) = o;
        } else if (job < J8) {
            const int idx = (job - J7) * 256 + tid;
            const int n = idx >> 3, i = idx & 7;
            const float inv = powf(500000.f, -(float)i / 8.f);
            const float ang = (float)p.pos[n] * inv;
            float s, c; sincosf(ang, &s, &c);
            float* ct = (float*)(ws + OFF_ROPE);
            ct[idx] = c; ct[NTOK * 8 + idx] = s;
        } else {
            float* misc = (float*)(ws + OFF_MISC);
            float sk = 0.f, sv = 0.f;
            for (int i = 0; i < 2048; ++i) { const float pe = p.pe[i]; sk += pe * p.w_ck1[(size_t)i * 256 + tid]; sv += pe * p.w_cv1[(size_t)i * 256 + tid]; }
            misc[tid] = sk; misc[256 + tid] = sv;
            for (int i = tid; i < 512; i += 256) { const float a0 = p.hg_lb[i], a1 = p.hg_lb[512 + i]; misc[512 + i] = 1.f / (1.f + expf(a1 - a0)); }
            if (tid < 32) ((int*)(misc + 1024))[tid] = 0;
        }
    }
}

DEVI f32x4 rope4(f32x4 v, int fr, const float* __restrict__ cs, int i0, int i1, int i2, int i3) {
    const int i = fr & 7; const float sg = (fr & 8) ? 1.f : -1.f;
    const int idx[4] = {i0, i1, i2, i3};
    f32x4 o;
#pragma unroll
    for (int j = 0; j < 4; ++j) {
        const float partner = __shfl_xor(v[j], 8);
        const float c = cs[(size_t)idx[j] * 8 + i], s = cs[(size_t)NTOK * 8 + (size_t)idx[j] * 8 + i];
        o[j] = v[j] * c + sg * partner * s;
    }
    return o;
}

DEVI void phase_proj(const Params& p, char* smem) {
    char* ws = p.ws;
    const u16* XB = (const u16*)(ws + OFF_XB); const u16* WIN = (const u16*)(ws + OFF_WIN);
    const float* cs = (const float*)(ws + OFF_ROPE); const float* lb = (const float*)(ws + OFF_MISC) + 512;
    const int tid = VTID, lane = tid & 63, wid = tid >> 6, wr = wid >> 1, wc = wid & 1, fr = lane & 15, fq = lane >> 4;
    for (int tile = VBID; tile < 256 * 27; tile += VGRID) {
        const int rt = tile / 27, ct = tile % 27;
        auto arow = [&](int r) { return XB + (size_t)(rt * 128 + r) * 1024; };
        f32x4 acc[4][4];
        gemm128(tid, arow, WIN + (size_t)ct * 128 * 1024, 1024, 1024, smem, acc);
#pragma unroll
        for (int m = 0; m < 4; ++m) {
            const int tok = rt * 128 + wr * 64 + m * 16 + fq * 4;
            const int b = tok >> 13, s = tok & 8191;
#pragma unroll
            for (int n = 0; n < 4; ++n) {
                const int cc = wc * 64 + n * 16 + fr; const int d = n * 16 + fr;
                f32x4 v = acc[m][n];
                if (ct < 4) {
                    if (n == 0) v = rope4(v, fr, cs, tok, tok + 1, tok + 2, tok + 3);
                    u16* Q = (u16*)(ws + OFF_Q);
#pragma unroll
                    for (int j = 0; j < 4; ++j) Q[(size_t)(tok + j) * 512 + ct * 128 + cc] = f2bf(v[j] * 0.125f);
                } else if (ct == 4 || ct == 5) {
                    u16* dst = (u16*)(ws + (ct == 4 ? OFF_KCR : OFF_VCR));
#pragma unroll
                    for (int j = 0; j < 4; ++j) dst[((size_t)(b * 2 + wc) * SP + s + j) * 64 + d] = f2bf(v[j]);
                } else if (ct == 6 || ct == 8) {
                    if (n == 0) v = rope4(v, fr, cs, tok, tok + 1, tok + 2, tok + 3);
                    u16* dst = (u16*)(ws + (ct == 6 ? OFF_KS : OFF_KW));
#pragma unroll
                    for (int j = 0; j < 4; ++j) dst[((size_t)(b * 2 + wc) * 8192 + s + j) * 64 + d] = f2bf(v[j]);
                } else if (ct == 7 || ct == 9) {
                    u16* dst = (u16*)(ws + (ct == 7 ? OFF_VST : OFF_VWT));
                    *(uint2*)(dst + (((size_t)(b * 2 + wc) * 128 + (s >> 6)) * 64 + d) * 64 + (s & 63)) = pack4(v);
                } else if (ct < 14) {
                    u16* dst = (u16*)(ws + OFF_QH);
#pragma unroll
                    for (int j = 0; j < 4; ++j) dst[(size_t)(tok + j) * 512 + (ct - 10) * 128 + cc] = f2bf(v[j]);
                } else if (ct < 18) {
                    const int hk = (ct - 14) * 128 + cc; const float lbv = lb[hk];
                    float* dst = (float*)(ws + OFF_LOGF);
#pragma unroll
                    for (int j = 0; j < 4; ++j) {
                        const float fh = 1.f / (1.f + expf(-v[j]));
                        dst[(size_t)(tok + j) * 512 + hk] = logf(lbv + (1.f - lbv) * fh);
                    }
                } else if (ct < 22) {
                    u16* dst = (u16*)(ws + OFF_VTH);
                    *(uint2*)(dst + (((size_t)(b * 4 + (ct - 18)) * 128 + (s >> 6)) * 128 + cc) * 64 + (s & 63)) = pack4(v);
                } else if (ct < 26) {
                    u16* dst = (u16*)(ws + OFF_GH);
#pragma unroll
                    for (int j = 0; j < 4; ++j) dst[(size_t)(tok + j) * 512 + (ct - 22) * 128 + cc] = f2bf(v[j] / (1.f + expf(-v[j])));
                } else {
                    if (cc < 24) {
                        float* dst = (float*)(ws + OFF_GATES);
#pragma unroll
                        for (int j = 0; j < 4; ++j) dst[(size_t)(tok + j) * 24 + cc] = 1.f / (1.f + expf(-v[j]));
                    }
                }
            }
        }
    }
}

DEVI void hgrn_local_tile(const Params& p, char* smem, int tile) {
    char* ws = p.ws;
    const int bh = tile >> 7, chunk = tile & 127, b = bh >> 2, h = bh & 3;
    const int tid = VTID, lane = tid & 63, w = tid >> 6, fr = lane & 15, fq = lane >> 4;
    const size_t n0 = (size_t)b * 8192 + chunk * 64;
    const float* lfp = (const float*)(ws + OFF_LOGF) + n0 * 512 + h * 128;
    u16* khT = (u16*)(smem + 1024);
    float blast;
    float* totp = (float*)smem;
    {
        const int k = tid & 127, half = tid >> 7;
        float run = 0.f;
#pragma unroll 8
        for (int i = 0; i < 32; ++i) run += lfp[(size_t)(32 * half + i) * 512 + k];
        totp[half * 128 + k] = run;
        __syncthreads();
        const float t0 = totp[k], t1 = totp[128 + k];
        blast = t0 + t1;
        float bcur = half ? t0 : 0.f;
#pragma unroll 4
        for (int i = 0; i < 32; ++i) {
            const float lf = lfp[(size_t)(32 * half + i) * 512 + k];
            bcur += lf;
            const float kh = (1.f - expf(lf)) * expf(blast - bcur);
            khT[k * 72 + 32 * half + i] = f2bf(kh);
        }
        if (half == 0) ((float*)(ws + OFF_DG))[(size_t)tile * 128 + k] = expf(blast);
    }
    __syncthreads();
    const u16* vT = (const u16*)(ws + OFF_VTH) + (size_t)tile * 128 * 64;
    f32x4 acc[2][8];
#pragma unroll
    for (int m = 0; m < 2; ++m)
#pragma unroll
        for (int n = 0; n < 8; ++n) acc[m][n] = f32x4{0.f, 0.f, 0.f, 0.f};
#pragma unroll
    for (int ks = 0; ks < 2; ++ks) {
        bf16x8 a[2];
#pragma unroll
        for (int m = 0; m < 2; ++m) a[m] = ld8(khT + (32 * w + 16 * m + fr) * 72 + 32 * ks + 8 * fq);
#pragma unroll
        for (int n = 0; n < 8; ++n) {
            const bf16x8 bv = ld8(vT + (size_t)(16 * n + fr) * 64 + 32 * ks + 8 * fq);
#pragma unroll
            for (int m = 0; m < 2; ++m) acc[m][n] = mfma16(a[m], bv, acc[m][n]);
        }
    }
    u16* L = (u16*)(ws + OFF_LBUF) + (size_t)tile * 128 * 128;
#pragma unroll
    for (int m = 0; m < 2; ++m)
#pragma unroll
        for (int n = 0; n < 8; ++n) *(uint2*)(L + (size_t)(16 * n + fr) * 128 + 32 * w + 16 * m + 4 * fq) = pack4(acc[m][n]);
    __syncthreads();
}

DEVI void hgrn_scan_task(const Params& p, int task) {
    char* ws = p.ws;
    const int gid = task * 256 + VTID;
    const int bh = gid >> 13, v = (gid >> 6) & 127, kp = gid & 63;
    uint32_t* L = (uint32_t*)(ws + OFF_LBUF) + ((size_t)bh * 128 * 128 * 128 + (size_t)v * 128) / 2 + kp;
    const float2* Dg = (const float2*)(ws + OFF_DG) + (size_t)bh * 128 * 64 + kp;
    float s0 = 0.f, s1 = 0.f;
#pragma unroll 8
    for (int c = 0; c < 128; ++c) {
        const uint32_t l = L[(size_t)c * 8192];
        const float2 d = Dg[(size_t)c * 64];
        L[(size_t)c * 8192] = pack2(s0, s1);
        s0 = d.x * s0 + __uint_as_float(l << 16);
        s1 = d.y * s1 + __uint_as_float(l & 0xffff0000u);
    }
}

DEVI void hgrn_out_tile(const Params& p, char* smem, int tile) {
    char* ws = p.ws;
    const int bh = tile >> 7, chunk = tile & 127, b = bh >> 2, h = bh & 3;
    const int tid = VTID, lane = tid & 63, w = tid >> 6, fr = lane & 15, fq = lane >> 4;
    const size_t n0 = (size_t)b * 8192 + chunk * 64;
    const float* lfp = (const float*)(ws + OFF_LOGF) + n0 * 512 + h * 128;
    const u16* qh = (const u16*)(ws + OFF_QH) + n0 * 512 + h * 128;
    float* totp = (float*)smem;
    u16* qt = (u16*)(smem + 1024);
    u16* kt = qt + 64 * 136;
    {
        const int k = tid & 127, half = tid >> 7;
        float run = 0.f;
#pragma unroll 8
        for (int i = 0; i < 32; ++i) run += lfp[(size_t)(32 * half + i) * 512 + k];
        totp[half * 128 + k] = run;
        __syncthreads();
        float bcur = half ? totp[k] : 0.f;
#pragma unroll 4
        for (int i = 0; i < 32; ++i) {
            const int t = 32 * half + i;
            const float lf = lfp[(size_t)t * 512 + k];
            bcur += lf;
            const float q = bf2f(qh[(size_t)t * 512 + k]);
            qt[t * 136 + k] = f2bf(q * expf(bcur));
            kt[t * 136 + k] = f2bf((1.f - expf(lf)) * expf(-bcur));
        }
    }
    __syncthreads();
    bf16x8 qb[4];
#pragma unroll
    for (int ks = 0; ks < 4; ++ks) qb[ks] = ld8(qt + (16 * w + fr) * 136 + 32 * ks + 8 * fq);
    f32x4 at[4];
#pragma unroll
    for (int sf = 0; sf < 4; ++sf) {
        const int srow = 32 * (sf >> 1) + 8 * (fr >> 2) + 4 * (sf & 1) + (fr & 3);
        f32x4 a = f32x4{0.f, 0.f, 0.f, 0.f};
#pragma unroll
        for (int ks = 0; ks < 4; ++ks) a = mfma16(ld8(kt + srow * 136 + 32 * ks + 8 * fq), qb[ks], a);
        const int tcol = 16 * w + fr;
#pragma unroll
        for (int r = 0; r < 4; ++r) { const int s = 32 * (sf >> 1) + 8 * fq + 4 * (sf & 1) + r; if (s > tcol) a[r] = 0.f; }
        at[sf] = a;
    }
    const u16* vT = (const u16*)(ws + OFF_VTH) + (size_t)tile * 128 * 64;
    const u16* ST = (const u16*)(ws + OFF_LBUF) + (size_t)tile * 128 * 128;
    f32x4 o[8];
#pragma unroll
    for (int mf = 0; mf < 8; ++mf) o[mf] = f32x4{0.f, 0.f, 0.f, 0.f};
#pragma unroll
    for (int sc = 0; sc < 2; ++sc) {
        const bf16x8 pb = pack8(at[2 * sc], at[2 * sc + 1]);
#pragma unroll
        for (int mf = 0; mf < 8; ++mf) o[mf] = mfma16(ld8(vT + (size_t)(16 * mf + fr) * 64 + 32 * sc + 8 * fq), pb, o[mf]);
    }
#pragma unroll
    for (int ks = 0; ks < 4; ++ks)
#pragma unroll
        for (int mf = 0; mf < 8; ++mf) o[mf] = mfma16(ld8(ST + (size_t)(16 * mf + fr) * 128 + 32 * ks + 8 * fq), qb[ks], o[mf]);
    float ss = 0.f;
#pragma unroll
    for (int mf = 0; mf < 8; ++mf)
#pragma unroll
        for (int r = 0; r < 4; ++r) ss += o[mf][r] * o[mf][r];
    ss = xor16_sum(ss);
    const float rn = rsqrtf(ss * (1.f / 128.f) + 1e-6f);
    const size_t tok = n0 + 16 * w + fr;
    const u16* gh = (const u16*)(ws + OFF_GH) + tok * 512 + h * 128;
    u16* mix = (u16*)(ws + OFF_MIX) + tok * 1024 + 512 + h * 128;
#pragma unroll
    for (int mf = 0; mf < 8; ++mf) {
        const int v0 = 16 * mf + 4 * fq;
        const uint2 g2 = *(const uint2*)(gh + v0);
        const float4 ng = *(const float4*)(p.hg_ng + v0);
        f32x4 r;
        r[0] = o[mf][0] * rn * ng.x * __uint_as_float(g2.x << 16);
        r[1] = o[mf][1] * rn * ng.y * __uint_as_float(g2.x & 0xffff0000u);
        r[2] = o[mf][2] * rn * ng.z * __uint_as_float(g2.y << 16);
        r[3] = o[mf][3] * rn * ng.w * __uint_as_float(g2.y & 0xffff0000u);
        *(uint2*)(mix + v0) = pack4(r);
    }
    __syncthreads();
}

DEVI float gelu_tanh(float x) { const float u = 0.7978845608028654f * (x + 0.044715f * x * x * x); return 0.5f * x * (1.f + tanhf(u)); }

DEVI void cmp1_tile(const Params& p, char* smem, int tile) {
    char* ws = p.ws;
    const int which = tile >> 6, rt = (tile >> 1) & 31, ct = tile & 1;
    const int tid = VTID, lane = tid & 63, wid = tid >> 6, wr = wid >> 1, wc = wid & 1, fr = lane & 15, fq = lane >> 4;
    const u16* src = (const u16*)(ws + (which ? OFF_VCR : OFF_KCR));
    auto arow = [&](int r) { const int m = rt * 128 + r; return src + ((size_t)(m >> 9) * SP + 16 * (m & 511)) * 64; };
    const u16* Bt = (const u16*)(ws + (which ? OFF_WCV1 : OFF_WCK1)) + (size_t)ct * 128 * 2048;
    f32x4 acc[4][4];
    gemm128(tid, arow, Bt, 2048, 2048, smem, acc);
    const float* bias = (const float*)(ws + OFF_MISC) + which * 256;
    u16* hid = (u16*)(ws + OFF_HID) + (size_t)which * 4096 * 256;
#pragma unroll
    for (int m = 0; m < 4; ++m)
#pragma unroll
        for (int n = 0; n < 4; ++n) {
            const int row = rt * 128 + wr * 64 + m * 16 + fq * 4, col = ct * 128 + wc * 64 + n * 16 + fr;
            const float bv = bias[col];
#pragma unroll
            for (int j = 0; j < 4; ++j) hid[(size_t)(row + j) * 256 + col] = f2bf(gelu_tanh(acc[m][n][j] + bv));
        }
}

DEVI void cmp2_tile(const Params& p, char* smem, int tile) {
    char* ws = p.ws;
    const int which = tile >> 5, rt = tile & 31;
    const int tid = VTID, lane = tid & 63, wid = tid >> 6, wr = wid >> 1, wc = wid & 1, fr = lane & 15, fq = lane >> 4;
    const u16* hid = (const u16*)(ws + OFF_HID) + (size_t)which * 4096 * 256;
    auto arow = [&](int r) { return hid + (size_t)(rt * 128 + r) * 256; };
    const u16* Bt = (const u16*)(ws + (which ? OFF_WCV2 : OFF_WCK2));
    f32x4 acc[4][4];
    gemm128(tid, arow, Bt, 256, 256, smem, acc);
    if (wc == 0) {
        const float* cs = (const float*)(ws + OFF_ROPE);
#pragma unroll
        for (int m = 0; m < 4; ++m) {
            const int row = rt * 128 + wr * 64 + m * 16 + fq * 4;
            const int bg = row >> 9, c = row & 511, b = bg >> 1;
#pragma unroll
            for (int n = 0; n < 4; ++n) {
                const int d = n * 16 + fr;
                f32x4 v = acc[m][n];
                if (which == 0) {
                    if (n == 0) {
                        int ix[4];
#pragma unroll
                        for (int j = 0; j < 4; ++j) { int sp = 16 * (c + j) + 31; sp = sp > 8191 ? 8191 : sp; ix[j] = b * 8192 + sp; }
                        v = rope4(v, fr, cs, ix[0], ix[1], ix[2], ix[3]);
                    }
                    u16* kc = (u16*)(ws + OFF_KC);
#pragma unroll
                    for (int j = 0; j < 4; ++j) kc[((size_t)bg * 512 + c + j) * 64 + d] = f2bf(v[j]);
                } else {
                    u16* vct = (u16*)(ws + OFF_VCT);
                    *(uint2*)(vct + (((size_t)bg * 8 + (c >> 6)) * 64 + d) * 64 + (c & 63)) = pack4(v);
                }
            }
        }
    }
}

DEVI uint64_t lowest_bits(uint64_t mask, int n) {
    uint64_t out = 0;
    while (n > 0 && mask) { const uint64_t b = mask & (~mask + 1); out |= b; mask ^= b; --n; }
    return out;
}

constexpr int NSA_NW = 4;
constexpr int NSA_NTT = NSA_NW / 2;
constexpr int NSA_TB = 16 * NSA_NTT;
constexpr int NSA_TILES = 8 * (SEQ / NSA_TB);
constexpr int NSA_STG = 18432;
constexpr int NSA_OFF_IMP = 2 * NSA_STG;
constexpr int NSA_OFF_SEL = NSA_OFF_IMP + NSA_NTT * 8192;

DEVI void nsa_tile(const Params& p, char* smem, int tile) {
    char* ws = p.ws;
    const int bg = tile & 7, tbi = (SEQ / NSA_TB - 1) - (tile >> 3), b = bg >> 1, g = bg & 1;
    const int tid = VTID, lane = tid & 63, w = tid >> 6, fr = lane & 15, fq = lane >> 4;
    const int tt = w >> 1, hp = w & 1;
    const int tbase = tbi * NSA_TB;
    const int t0 = tbase + tt * 16;
    const int cur = t0 >> 6;
    const int curmax = (tbase + NSA_TB - 1) >> 6;
    const size_t n0 = (size_t)b * 8192 + t0;
    const int tok = t0 + fr;
    const u16* Qb = (const u16*)(ws + OFF_Q);
    const u16* Kc = (const u16*)(ws + OFF_KC) + (size_t)bg * 512 * 64;
    const u16* Vct = (const u16*)(ws + OFF_VCT) + (size_t)bg * 8 * 64 * 64;
    const u16* Ks = (const u16*)(ws + OFF_KS) + (size_t)bg * 8192 * 64;
    const u16* Kw = (const u16*)(ws + OFF_KW) + (size_t)bg * 8192 * 64;
    const u16* Vst = (const u16*)(ws + OFF_VST) + (size_t)bg * 128 * 64 * 64;
    const u16* Vwt = (const u16*)(ws + OFF_VWT) + (size_t)bg * 128 * 64 * 64;
    const float* gp = (const float*)(ws + OFF_GATES) + (n0 + fr) * 24 + (g * 4 + 2 * hp) * 3;
    float* imp = (float*)(smem + NSA_OFF_IMP) + tt * 2048;
    unsigned long long* selm = (unsigned long long*)(smem + NSA_OFF_SEL) + tt * 32;

    for (int i = tid; i < NSA_NTT * 2048; i += 256) ((float*)(smem + NSA_OFF_IMP))[i] = 0.f;
    __syncthreads();

    bf16x8 qf[2][2];
#pragma unroll
    for (int hh = 0; hh < 2; ++hh)
#pragma unroll
        for (int ks = 0; ks < 2; ++ks) qf[hh][ks] = ld8(Qb + (n0 + fr) * 512 + (g * 4 + 2 * hp + hh) * 64 + 32 * ks + 8 * fq);
    f32x4 ot[2][4];
#pragma unroll
    for (int hh = 0; hh < 2; ++hh)
#pragma unroll
        for (int mf = 0; mf < 4; ++mf) ot[hh][mf] = f32x4{0.f, 0.f, 0.f, 0.f};

    {
        const int nc = t0 >> 4;
        const int nchunk = (nc + 31) >> 5;
        float mC[2], lC[2];
#pragma unroll
        for (int hh = 0; hh < 2; ++hh) { mC[hh] = -1e30f; lC[hh] = 0.f; }
        for (int ch = 0; ch < nchunk; ++ch) {
            f32x4 s[2][2];
#pragma unroll
            for (int u = 0; u < 2; ++u) {
                const int crow = 32 * ch + 8 * (fr >> 2) + 4 * u + (fr & 3);
                const u16* kp = Kc + (size_t)crow * 64 + 8 * fq;
                const bf16x8 k0 = ld8(kp), k1 = ld8(kp + 32);
#pragma unroll
                for (int hh = 0; hh < 2; ++hh) {
                    f32x4 a = f32x4{0.f, 0.f, 0.f, 0.f};
                    a = mfma16(k0, qf[hh][0], a); a = mfma16(k1, qf[hh][1], a);
                    s[hh][u] = a;
                }
            }
#pragma unroll
            for (int hh = 0; hh < 2; ++hh) {
                float mx = -1e30f;
#pragma unroll
                for (int u = 0; u < 2; ++u)
#pragma unroll
                    for (int r = 0; r < 4; ++r) {
                        const int c = 32 * ch + 8 * fq + 4 * u + r;
                        const float v = (16 * c + 31 <= tok) ? s[hh][u][r] : -1e30f;
                        s[hh][u][r] = v; mx = fmaxf(mx, v);
                    }
                mx = xor16_max(mx);
                const float mn = fmaxf(mC[hh], mx);
                float sum = 0.f;
#pragma unroll
                for (int u = 0; u < 2; ++u)
#pragma unroll
                    for (int r = 0; r < 4; ++r) sum += (s[hh][u][r] > -1e29f) ? __expf(s[hh][u][r] - mn) : 0.f;
                lC[hh] = lC[hh] * __expf(mC[hh] - mn) + sum; mC[hh] = mn;
            }
        }
        float ilC[2];
#pragma unroll
        for (int hh = 0; hh < 2; ++hh) { const float l = xor16_sum(lC[hh]); ilC[hh] = l > 0.f ? 1.f / l : 0.f; }
        f32x4 oc[2][4];
#pragma unroll
        for (int hh = 0; hh < 2; ++hh)
#pragma unroll
            for (int mf = 0; mf < 4; ++mf) oc[hh][mf] = f32x4{0.f, 0.f, 0.f, 0.f};
        for (int ch = 0; ch < nchunk; ++ch) {
            f32x4 s[2][2];
#pragma unroll
            for (int u = 0; u < 2; ++u) {
                const int crow = 32 * ch + 8 * (fr >> 2) + 4 * u + (fr & 3);
                const u16* kp = Kc + (size_t)crow * 64 + 8 * fq;
                const bf16x8 k0 = ld8(kp), k1 = ld8(kp + 32);
#pragma unroll
                for (int hh = 0; hh < 2; ++hh) {
                    f32x4 a = f32x4{0.f, 0.f, 0.f, 0.f};
                    a = mfma16(k0, qf[hh][0], a); a = mfma16(k1, qf[hh][1], a);
                    s[hh][u] = a;
                }
            }
            float qs[2] = {0.f, 0.f}, p3[2] = {0.f, 0.f};
            bf16x8 pb[2];
#pragma unroll
            for (int hh = 0; hh < 2; ++hh) {
#pragma unroll
                for (int u = 0; u < 2; ++u)
#pragma unroll
                    for (int r = 0; r < 4; ++r) {
                        const int c = 32 * ch + 8 * fq + 4 * u + r;
                        const float pv = (16 * c + 31 <= tok) ? __expf(s[hh][u][r] - mC[hh]) * ilC[hh] : 0.f;
                        s[hh][u][r] = pv; qs[u] += pv; if (r == 3) p3[u] += pv;
                    }
                pb[hh] = pack8(s[hh][0], s[hh][1]);
            }
#pragma unroll
            for (int u = 0; u < 2; ++u) {
                const int j = 8 * ch + 2 * fq + u;
                atomicAdd(&imp[fr * 128 + j], qs[u]);
                if (j + 1 < 128) atomicAdd(&imp[fr * 128 + j + 1], p3[u]);
            }
#pragma unroll
            for (int mf = 0; mf < 4; ++mf) {
                const bf16x8 va = ld8(Vct + ((size_t)(ch >> 1) * 64 + 16 * mf + fr) * 64 + 32 * (ch & 1) + 8 * fq);
#pragma unroll
                for (int hh = 0; hh < 2; ++hh) oc[hh][mf] = mfma16(va, pb[hh], oc[hh][mf]);
            }
        }
#pragma unroll
        for (int hh = 0; hh < 2; ++hh) {
            const float gc = gp[hh * 3 + 0];
#pragma unroll
            for (int mf = 0; mf < 4; ++mf) ot[hh][mf] += oc[hh][mf] * gc;
        }
    }
    __syncthreads();
    if (hp == 0) {
        if (cur < 16) {
            if (lane < 16) { selm[lane * 2] = (2ull << cur) - 1ull; selm[lane * 2 + 1] = 0ull; }
        } else {
            for (int tau = 0; tau < 16; ++tau) {
                const int j0 = lane, j1 = lane + 64;
                const bool in0 = (j0 >= 1) && (j0 <= cur - 2), in1 = (j1 <= cur - 2);
                const float v0 = in0 ? imp[tau * 128 + j0] : 0.f;
                const float v1 = in1 ? imp[tau * 128 + j1] : 0.f;
                const uint32_t u0 = __float_as_uint(v0), u1 = __float_as_uint(v1);
                uint32_t res = 0;
                for (int bit = 30; bit >= 0; --bit) {
                    const uint32_t cand = res | (1u << bit);
                    const int cnt = __popcll(__ballot(in0 && u0 >= cand)) + __popcll(__ballot(in1 && u1 >= cand));
                    if (cnt >= 13) res = cand;
                }
                const uint64_t g0 = __ballot(in0 && u0 > res), g1 = __ballot(in1 && u1 > res);
                const uint64_t e0 = __ballot(in0 && u0 == res), e1 = __ballot(in1 && u1 == res);
                int need = 13 - (__popcll(g0) + __popcll(g1));
                const int ne0 = __popcll(e0);
                uint64_t sa = g0 | lowest_bits(e0, need);
                need -= (need < ne0 ? need : ne0);
                uint64_t sb = g1 | lowest_bits(e1, need);
                sa |= 1ull;
                if (cur - 1 < 64) sa |= 1ull << (cur - 1); else sb |= 1ull << (cur - 1 - 64);
                if (cur < 64) sa |= 1ull << cur; else sb |= 1ull << (cur - 64);
                if (lane == 0) { selm[tau * 2] = sa; selm[tau * 2 + 1] = sb; }
            }
        }
    }
    {
        int kbeg = t0 - 511; kbeg = kbeg < 0 ? 0 : kbeg; kbeg &= ~31;
        const int nch = (t0 + 16 - kbeg + 31) >> 5;
        float mW[2], lW[2];
        f32x4 ow[2][4];
#pragma unroll
        for (int hh = 0; hh < 2; ++hh) {
            mW[hh] = -1e30f; lW[hh] = 0.f;
#pragma unroll
            for (int mf = 0; mf < 4; ++mf) ow[hh][mf] = f32x4{0.f, 0.f, 0.f, 0.f};
        }
        for (int ch = 0; ch < nch; ++ch) {
            const int kb = kbeg + 32 * ch;
            f32x4 s[2][2];
#pragma unroll
            for (int u = 0; u < 2; ++u) {
                const int krow = kb + 8 * (fr >> 2) + 4 * u + (fr & 3);
                const u16* kp = Kw + (size_t)krow * 64 + 8 * fq;
                const bf16x8 k0 = ld8(kp), k1 = ld8(kp + 32);
#pragma unroll
                for (int hh = 0; hh < 2; ++hh) {
                    f32x4 a = f32x4{0.f, 0.f, 0.f, 0.f};
                    a = mfma16(k0, qf[hh][0], a); a = mfma16(k1, qf[hh][1], a);
                    s[hh][u] = a;
                }
            }
            bf16x8 pb[2];
#pragma unroll
            for (int hh = 0; hh < 2; ++hh) {
                float mx = -1e30f;
#pragma unroll
                for (int u = 0; u < 2; ++u)
#pragma unroll
                    for (int r = 0; r < 4; ++r) {
                        const int key = kb + 8 * fq + 4 * u + r;
                        const float v = (key <= tok && key > tok - 512) ? s[hh][u][r] : -1e30f;
                        s[hh][u][r] = v; mx = fmaxf(mx, v);
                    }
                mx = xor16_max(mx);
                const float mn = fmaxf(mW[hh], mx);
                const float sc = __expf(mW[hh] - mn);
                float sum = 0.f;
#pragma unroll
                for (int u = 0; u < 2; ++u)
#pragma unroll
                    for (int r = 0; r < 4; ++r) { const float pv = (s[hh][u][r] > -1e29f) ? __expf(s[hh][u][r] - mn) : 0.f; s[hh][u][r] = pv; sum += pv; }
                lW[hh] = lW[hh] * sc + sum; mW[hh] = mn;
#pragma unroll
                for (int mf = 0; mf < 4; ++mf) { ow[hh][mf][0] *= sc; ow[hh][mf][1] *= sc; ow[hh][mf][2] *= sc; ow[hh][mf][3] *= sc; }
                pb[hh] = pack8(s[hh][0], s[hh][1]);
            }
#pragma unroll
            for (int mf = 0; mf < 4; ++mf) {
                const bf16x8 va = ld8(Vwt + ((size_t)(kb >> 6) * 64 + 16 * mf + fr) * 64 + (kb & 63) + 8 * fq);
#pragma unroll
                for (int hh = 0; hh < 2; ++hh) ow[hh][mf] = mfma16(va, pb[hh], ow[hh][mf]);
            }
        }
#pragma unroll
        for (int hh = 0; hh < 2; ++hh) {
            const float l = xor16_sum(lW[hh]);
            const float gw = gp[hh * 3 + 2] * (l > 0.f ? 1.f / l : 0.f);
#pragma unroll
            for (int mf = 0; mf < 4; ++mf) ot[hh][mf] += ow[hh][mf] * gw;
        }
    }
    __syncthreads();
    {
        const unsigned long long mA = selm[fr * 2], mB = selm[fr * 2 + 1];
        uint4 kr0, kr1, vr0, vr1;
        const int srow0 = tid >> 3, srow1 = srow0 + 32, sc8 = (tid & 7) * 8;
        const int rho0 = (srow0 & 32) | ((srow0 & 4) << 2) | ((srow0 & 24) >> 1) | (srow0 & 3);
        const int rho1 = (srow1 & 32) | ((srow1 & 4) << 2) | ((srow1 & 24) >> 1) | (srow1 & 3);
#define gload(JB) do { const int jb_ = (JB); \
            kr0 = *(const uint4*)(Ks + ((size_t)(64 * jb_ + srow0)) * 64 + sc8); kr1 = *(const uint4*)(Ks + ((size_t)(64 * jb_ + srow1)) * 64 + sc8); \
            vr0 = *(const uint4*)(Vst + ((size_t)jb_ * 64 + srow0) * 64 + sc8); vr1 = *(const uint4*)(Vst + ((size_t)jb_ * 64 + srow1) * 64 + sc8); } while (0)
#define lstore(BUF) do { char* sb_ = smem + (BUF) * NSA_STG; \
            *(uint4*)(sb_ + (rho0 * 72 + sc8) * 2) = kr0; *(uint4*)(sb_ + (rho1 * 72 + sc8) * 2) = kr1; \
            *(uint4*)(sb_ + 9216 + (srow0 * 72 + sc8) * 2) = vr0; *(uint4*)(sb_ + 9216 + (srow1 * 72 + sc8) * 2) = vr1; } while (0)
        gload(0); lstore(0);
        if (curmax >= 1) gload(1);
        __syncthreads();
        float mS[2], lS[2];
        f32x4 os[2][4];
#pragma unroll
        for (int hh = 0; hh < 2; ++hh) {
            mS[hh] = -1e30f; lS[hh] = 0.f;
#pragma unroll
            for (int mf = 0; mf < 4; ++mf) os[hh][mf] = f32x4{0.f, 0.f, 0.f, 0.f};
        }
        for (int jb = 0; jb <= curmax; ++jb) {
            const int buf = jb & 1;
            const u16* Kl = (const u16*)(smem + buf * NSA_STG);
            const u16* Vl = Kl + 4608;
            const bool on = ((jb < 64 ? (mA >> jb) : (mB >> (jb - 64))) & 1ull) != 0ull;
            if (__ballot(on)) {
#pragma unroll 1
                for (int sc = 0; sc < 2; ++sc) {
                    f32x4 s[2][2];
#pragma unroll
                    for (int u = 0; u < 2; ++u) {
                        const u16* kp = Kl + (32 * sc + 16 * u + fr) * 72 + 8 * fq;
                        const bf16x8 k0 = ld8(kp), k1 = ld8(kp + 32);
#pragma unroll
                        for (int hh = 0; hh < 2; ++hh) {
                            f32x4 a = f32x4{0.f, 0.f, 0.f, 0.f};
                            a = mfma16(k0, qf[hh][0], a); a = mfma16(k1, qf[hh][1], a);
                            s[hh][u] = a;
                        }
                    }
                    bf16x8 pb[2];
#pragma unroll
                    for (int hh = 0; hh < 2; ++hh) {
                        float mx = -1e30f;
#pragma unroll
                        for (int u = 0; u < 2; ++u)
#pragma unroll
                            for (int r = 0; r < 4; ++r) {
                                const int key = 64 * jb + 32 * sc + 8 * fq + 4 * u + r;
                                const float v = (on && key <= tok) ? s[hh][u][r] : -1e30f;
                                s[hh][u][r] = v; mx = fmaxf(mx, v);
                            }
                        mx = xor16_max(mx);
                        const float mn = fmaxf(mS[hh], mx);
                        const float scl = __expf(mS[hh] - mn);
                        float sum = 0.f;
#pragma unroll
                        for (int u = 0; u < 2; ++u)
#pragma unroll
                            for (int r = 0; r < 4; ++r) { const float pv = (s[hh][u][r] > -1e29f) ? __expf(s[hh][u][r] - mn) : 0.f; s[hh][u][r] = pv; sum += pv; }
                        lS[hh] = lS[hh] * scl + sum; mS[hh] = mn;
#pragma unroll
                        for (int mf = 0; mf < 4; ++mf) { os[hh][mf][0] *= scl; os[hh][mf][1] *= scl; os[hh][mf][2] *= scl; os[hh][mf][3] *= scl; }
                        pb[hh] = pack8(s[hh][0], s[hh][1]);
                    }
#pragma unroll
                    for (int mf = 0; mf < 4; ++mf) {
                        const bf16x8 va = ld8(Vl + (16 * mf + fr) * 72 + 32 * sc + 8 * fq);
#pragma unroll
                        for (int hh = 0; hh < 2; ++hh) os[hh][mf] = mfma16(va, pb[hh], os[hh][mf]);
                    }
                }
            }
            if (jb + 1 <= curmax) lstore(buf ^ 1);
            if (jb + 2 <= curmax) gload(jb + 2);
            __syncthreads();
        }
#undef gload
#undef lstore
#pragma unroll
        for (int hh = 0; hh < 2; ++hh) {
            const float l = xor16_sum(lS[hh]);
            const float gs = gp[hh * 3 + 1] * (l > 0.f ? 1.f / l : 0.f);
#pragma unroll
            for (int mf = 0; mf < 4; ++mf) ot[hh][mf] += os[hh][mf] * gs;
        }
    }
    {
        u16* mix = (u16*)(ws + OFF_MIX) + (n0 + fr) * 1024 + (g * 4 + 2 * hp) * 64;
#pragma unroll
        for (int hh = 0; hh < 2; ++hh)
#pragma unroll
            for (int mf = 0; mf < 4; ++mf) *(uint2*)(mix + hh * 64 + 16 * mf + 4 * fq) = pack4(ot[hh][mf]);
    }
    __syncthreads();
}

#define LAS3 __attribute__((address_space(3)))
namespace g8 {
constexpr int BM = 256, BK = 64, HALF = 128, HTB = HALF * BK * 2, KK = 1024, NT = KK / BK;
DEVI int lds_byte(int r, int c) { const int st = (r >> 4) * 2 + (c >> 5), rr = r & 15, cc = c & 31, ob = rr * 64 + cc * 2; return st * 1024 + (ob ^ (((ob >> 9) & 1) << 5)); }
DEVI void stage_rc(int b, int& R, int& C) { const int st = b / 1024, sb = b % 1024, swz = sb ^ (((sb >> 9) & 1) << 5); R = (st >> 1) * 16 + swz / 64; C = (st & 1) * 32 + (swz % 64) / 2; }
DEVI int perm32(int rho) { const int n = rho >> 4, i = rho & 15; return 8 * (i >> 2) + 4 * n + (i & 3); }

template <bool TRANS, bool PERM, class Src, class Epi>
DEVI void gemm_phase(int tid, LAS3 unsigned char* lds, const char* Abase, const Src& S, const Epi& E) {
    asm volatile("" : "+v"(tid));
    const int wid = __builtin_amdgcn_readfirstlane(tid >> 6), lane = tid & 63, wr = wid >> 2, wc = wid & 3, fr = lane & 15, fq = lane >> 4;
    int R0, C0, R1, C1;
    stage_rc(tid * 16, R0, C0); stage_rc(tid * 16 + 8192, R1, C1);
    unsigned voffB[2];
    voffB[0] = (unsigned)((PERM ? ((R0 & ~31) + perm32(R0 & 31)) : R0) * KK + C0) * 2u;
    voffB[1] = (unsigned)((PERM ? ((R1 & ~31) + perm32(R1 & 31)) : R1) * KK + C1) * 2u;
    constexpr size_t kstep = (size_t)(BK * 2);
    constexpr size_t hstepB = (size_t)HALF * KK * 2;
    const unsigned ldsw = (unsigned)wid * 1024u;
    const int aoff = lds_byte(wr * 64 + fr, fq * 8), boff = lds_byte(wc * 32 + fr, fq * 8);
#define G8_SA(b, h) (((b) * 2 + (h)) * HTB)
#define G8_SB(b, h) ((4 + (b) * 2 + (h)) * HTB)
#define G8_STAGE_A(bufoff, kbyte, v0, v1) do { \
        __builtin_amdgcn_global_load_lds((const unsigned*)(Abase + (kbyte) + (v0)), (LAS3 unsigned*)(lds + (bufoff) + ldsw), 16, 0, 0); \
        __builtin_amdgcn_global_load_lds((const unsigned*)(Abase + (kbyte) + (v1)), (LAS3 unsigned*)(lds + (bufoff) + ldsw + 8192), 16, 0, 0); } while (0)
#define G8_STAGE_B(bufoff, gptr) do { \
        __builtin_amdgcn_global_load_lds((const unsigned*)((gptr) + voffB[0]), (LAS3 unsigned*)(lds + (bufoff) + ldsw), 16, 0, 0); \
        __builtin_amdgcn_global_load_lds((const unsigned*)((gptr) + voffB[1]), (LAS3 unsigned*)(lds + (bufoff) + ldsw + 8192), 16, 0, 0); } while (0)
#define G8_LDA(dst, b, h) do { _Pragma("unroll") for (int m = 0; m < 4; ++m) _Pragma("unroll") for (int k = 0; k < 2; ++k) dst[m][k] = *(const LAS3 bf16x8*)(lds + G8_SA(b, h) + aoff + m * 2048 + k * 1024); } while (0)
#define G8_LDB(dst, b, h) do { _Pragma("unroll") for (int n = 0; n < 2; ++n) _Pragma("unroll") for (int k = 0; k < 2; ++k) dst[n][k] = *(const LAS3 bf16x8*)(lds + G8_SB(b, h) + boff + n * 2048 + k * 1024); } while (0)
#define G8_MMA(ai, bj, At, Bt) do { __builtin_amdgcn_s_setprio(1); _Pragma("unroll") for (int m = 0; m < 4; ++m) _Pragma("unroll") for (int n = 0; n < 2; ++n) _Pragma("unroll") for (int k = 0; k < 2; ++k) \
        acc[ai][bj][m][n] = TRANS ? __builtin_amdgcn_mfma_f32_16x16x32_bf16(Bt[n][k], At[m][k], acc[ai][bj][m][n], 0, 0, 0) \
                                  : __builtin_amdgcn_mfma_f32_16x16x32_bf16(At[m][k], Bt[n][k], acc[ai][bj][m][n], 0, 0, 0); __builtin_amdgcn_s_setprio(0); } while (0)
#define G8_WAIT_V(n) asm volatile("s_waitcnt vmcnt(" #n ")" ::: "memory")
#define G8_WAIT_L(n) asm volatile("s_waitcnt lgkmcnt(" #n ")" ::: "memory")
#define G8_BAR __builtin_amdgcn_s_barrier()
#define G8_SCHED __builtin_amdgcn_sched_barrier(0)
    typename Src::U cur, nxt; int ui = 0;
    if (!S.next(0, cur)) return;
    f32x4 acc[2][2][4][2];
#pragma unroll
    for (int a = 0; a < 2; ++a)
#pragma unroll
        for (int b = 0; b < 2; ++b)
#pragma unroll
            for (int m = 0; m < 4; ++m)
#pragma unroll
                for (int n = 0; n < 2; ++n) acc[a][b][m][n] = (f32x4){0.f, 0.f, 0.f, 0.f};
    bf16x8 At[4][2], B0[2][2], B1[2][2];
    unsigned cA00 = S.aoff(cur, R0) + C0 * 2u, cA01 = S.aoff(cur, R1) + C1 * 2u, cA10 = S.aoff(cur, HALF + R0) + C0 * 2u, cA11 = S.aoff(cur, HALF + R1) + C1 * 2u;
    const char* cB = S.bbase(cur);
    G8_STAGE_B(G8_SB(0, 0), cB); G8_STAGE_A(G8_SA(0, 0), 0, cA00, cA01); G8_STAGE_B(G8_SB(0, 1), cB + hstepB); G8_STAGE_A(G8_SA(0, 1), 0, cA10, cA11);
    if (wr == 1) G8_BAR;
    G8_WAIT_V(4); G8_BAR;
    G8_STAGE_B(G8_SB(1, 0), cB + kstep); G8_STAGE_A(G8_SA(1, 0), kstep, cA00, cA01); G8_STAGE_B(G8_SB(1, 1), cB + hstepB + kstep);
    G8_WAIT_V(6); G8_BAR;
    for (;;) {
        const bool has_next = S.next(ui + 1, nxt);
        unsigned nA00 = cA00, nA01 = cA01, nA10 = cA10, nA11 = cA11;
        const char* nB = cB;
        if (has_next) {
            nA00 = S.aoff(nxt, R0) + C0 * 2u; nA01 = S.aoff(nxt, R1) + C1 * 2u; nA10 = S.aoff(nxt, HALF + R0) + C0 * 2u; nA11 = S.aoff(nxt, HALF + R1) + C1 * 2u;
            nB = S.bbase(nxt);
        }
#pragma unroll 1
        for (int t = 0; t < NT; t += 2) {
            const bool last = (t == NT - 2);
            const size_t k1 = (size_t)(t + 1) * kstep;
            const size_t k2 = last ? (size_t)0 : (size_t)(t + 2) * kstep, k3 = k2 + kstep;
            const unsigned x00 = last ? nA00 : cA00, x01 = last ? nA01 : cA01, x10 = last ? nA10 : cA10, x11 = last ? nA11 : cA11;
            const char* b2 = (last ? nB : cB) + k2; const char* b3 = b2 + kstep;
            G8_LDB(B0, 0, 0); G8_SCHED; G8_LDA(At, 0, 0); G8_STAGE_A(G8_SA(1, 1), k1, cA10, cA11);
            G8_WAIT_L(8); G8_BAR; G8_WAIT_L(0); G8_MMA(0, 0, At, B0); G8_BAR; G8_SCHED;
            G8_LDB(B1, 0, 1); G8_STAGE_B(G8_SB(0, 0), b2);
            G8_BAR; G8_WAIT_L(0); G8_MMA(0, 1, At, B1); G8_BAR;
            G8_LDA(At, 0, 1); G8_STAGE_A(G8_SA(0, 0), k2, x00, x01);
            G8_BAR; G8_WAIT_L(0); G8_MMA(1, 0, At, B0); G8_BAR; G8_SCHED;
            G8_STAGE_B(G8_SB(0, 1), b2 + hstepB);
            G8_WAIT_V(6); G8_BAR; G8_MMA(1, 1, At, B1); G8_BAR;
            G8_LDB(B0, 1, 0); G8_SCHED; G8_LDA(At, 1, 0); G8_STAGE_A(G8_SA(0, 1), k2, x10, x11);
            G8_WAIT_L(8); G8_BAR; G8_WAIT_L(0); G8_MMA(0, 0, At, B0); G8_BAR; G8_SCHED;
            G8_LDB(B1, 1, 1); G8_STAGE_B(G8_SB(1, 0), b3);
            G8_BAR; G8_WAIT_L(0); G8_MMA(0, 1, At, B1); G8_BAR;
            G8_LDA(At, 1, 1); G8_STAGE_A(G8_SA(1, 0), k3, x00, x01);
            G8_BAR; G8_WAIT_L(0); G8_MMA(1, 0, At, B0); G8_BAR; G8_SCHED;
            G8_STAGE_B(G8_SB(1, 1), b3 + hstepB);
            G8_WAIT_V(6); G8_BAR; G8_MMA(1, 1, At, B1); G8_BAR;
        }
        E(acc, cur, wr, wc, fr, fq);
        if (!has_next) break;
#pragma unroll
        for (int a = 0; a < 2; ++a)
#pragma unroll
            for (int b = 0; b < 2; ++b)
#pragma unroll
                for (int m = 0; m < 4; ++m)
#pragma unroll
                    for (int n = 0; n < 2; ++n) acc[a][b][m][n] = (f32x4){0.f, 0.f, 0.f, 0.f};
        cur = nxt; cA00 = nA00; cA01 = nA01; cA10 = nA10; cA11 = nA11; cB = nB; ++ui;
    }
    G8_WAIT_V(0);
    if (wr == 0) G8_BAR;
    G8_BAR;
#undef G8_SA
#undef G8_SB
#undef G8_STAGE_A
#undef G8_STAGE_B
#undef G8_LDA
#undef G8_LDB
#undef G8_MMA
#undef G8_WAIT_V
#undef G8_WAIT_L
#undef G8_BAR
#undef G8_SCHED
}

struct DenseSrc {
    struct U { int pm, pn; };
    const char* Bt; int nM, nN, nwg, G, c;
    DEVI void init(const void* Bt_, int M, int N, int G_, int c_) { Bt = (const char*)Bt_; nM = M / BM; nN = N / BM; nwg = nM * nN; G = G_; c = c_; }
    DEVI bool next(int i, U& u) const {
        const int L = i * G + c; if (L >= nwg) return false;
        int wgid = L; { const int q = nwg / 8, r = nwg % 8, xcd = wgid % 8, off = wgid / 8; wgid = (xcd < r ? xcd * (q + 1) : r * (q + 1) + (xcd - r) * q) + off; }
        const int nig = 8 * nN, gid = wgid / nig, fm = gid * 8, gsz = (nM - fm) < 8 ? (nM - fm) : 8;
        u.pm = fm + ((wgid % nig) % gsz); u.pn = (wgid % nig) / gsz; return true;
    }
    DEVI unsigned aoff(const U& u, int row) const { return (unsigned)(u.pm * BM + row) * (unsigned)(KK * 2); }
    DEVI const char* bbase(const U& u) const { return Bt + (size_t)u.pn * BM * KK * 2; }
};
}


struct EpiWo {
    u16* o;
    DEVI void operator()(const f32x4 (&acc)[2][2][4][2], const g8::DenseSrc::U& u, int wr, int wc, int fr, int fq) const {
#pragma unroll
        for (int ai = 0; ai < 2; ++ai)
#pragma unroll
            for (int m = 0; m < 4; ++m) {
                const size_t row = (size_t)u.pm * 256 + ai * 128 + wr * 64 + m * 16 + fr;
#pragma unroll
                for (int bj = 0; bj < 2; ++bj) {
                    uint4 v; v.x = pack2(acc[ai][bj][m][0][0], acc[ai][bj][m][0][1]); v.y = pack2(acc[ai][bj][m][0][2], acc[ai][bj][m][0][3]);
                    v.z = pack2(acc[ai][bj][m][1][0], acc[ai][bj][m][1][1]); v.w = pack2(acc[ai][bj][m][1][2], acc[ai][bj][m][1][3]);
                    *(uint4*)(o + row * 1024 + u.pn * 256 + bj * 128 + wc * 32 + fq * 8) = v;
                }
            }
    }
};
DEVI void phase_wo8(const Params& p, char* smem_all) {
    g8::DenseSrc S; S.init(p.ws + OFF_WO, NTOK, 1024, gridDim.x, blockIdx.x);
    EpiWo E; E.o = (u16*)(p.ws + OFF_PRE);
    g8::gemm_phase<true, true>(TIDX, (LAS3 unsigned char*)smem_all, p.ws + OFF_MIX, S, E);
}

DEVI void wo_tile(const Params& p, char* smem, int tile) {
    char* ws = p.ws;
    const int rt = tile >> 3, ct = tile & 7;
    const int tid = VTID, lane = tid & 63, wid = tid >> 6, wr = wid >> 1, wc = wid & 1, fr = lane & 15, fq = lane >> 4;
    const u16* MIX = (const u16*)(ws + OFF_MIX);
    auto arow = [&](int r) { return MIX + (size_t)(rt * 128 + r) * 1024; };
    f32x4 acc[4][4];
    gemm128(tid, arow, (const u16*)(ws + OFF_WO) + (size_t)ct * 128 * 1024, 1024, 1024, smem, acc);
    float* pre = (float*)(ws + OFF_PRE);
#pragma unroll
    for (int m = 0; m < 4; ++m)
#pragma unroll
        for (int n = 0; n < 4; ++n) {
            const int row = rt * 128 + wr * 64 + m * 16 + fq * 4, col = ct * 128 + wc * 64 + n * 16 + fr;
#pragma unroll
            for (int j = 0; j < 4; ++j) {
                const size_t ix = (size_t)(row + j) * 1024 + col;
                pre[ix] = DN_ALPHA * p.x[ix] + acc[m][n][j];
            }
        }
}

DEVI void ln1_router_tile(const Params& p, char* smem, int tile) {
    char* ws = p.ws;
    const int tid = VTID, lane = tid & 63, w = tid >> 6;
    const int tok0 = tile * 32;
    const u16* mixo = (const u16*)(ws + OFF_PRE);
    float* H1 = (float*)(ws + OFF_H1); u16* H1B = (u16*)(ws + OFF_H1B);
    for (int i = 0; i < 8; ++i) {
        const size_t row = (size_t)tok0 + w * 8 + i;
        float4 v[4];
        float s = 0.f;
#pragma unroll
        for (int q = 0; q < 4; ++q) {
            const float4 xv = *(const float4*)(p.x + row * 1024 + q * 256 + lane * 4);
            const uint2 mv = *(const uint2*)(mixo + row * 1024 + q * 256 + lane * 4);
            v[q].x = DN_ALPHA * xv.x + __uint_as_float(mv.x << 16); v[q].y = DN_ALPHA * xv.y + __uint_as_float(mv.x & 0xffff0000u);
            v[q].z = DN_ALPHA * xv.z + __uint_as_float(mv.y << 16); v[q].w = DN_ALPHA * xv.w + __uint_as_float(mv.y & 0xffff0000u);
            s += v[q].x + v[q].y + v[q].z + v[q].w;
        }
        const float mu = wave_sum(s) * (1.f / 1024.f);
        float ss = 0.f;
#pragma unroll
        for (int q = 0; q < 4; ++q) { v[q].x -= mu; v[q].y -= mu; v[q].z -= mu; v[q].w -= mu; ss += v[q].x * v[q].x + v[q].y * v[q].y + v[q].z * v[q].z + v[q].w * v[q].w; }
        const float rs = rsqrtf(wave_sum(ss) * (1.f / 1024.f) + 1e-5f);
#pragma unroll
        for (int q = 0; q < 4; ++q) {
            const int c = q * 256 + lane * 4;
            const float4 gq = *(const float4*)(p.ln1g + c), bq = *(const float4*)(p.ln1b + c);
            float4 o; o.x = v[q].x * rs * gq.x + bq.x; o.y = v[q].y * rs * gq.y + bq.y; o.z = v[q].z * rs * gq.z + bq.z; o.w = v[q].w * rs * gq.w + bq.w;
            *(float4*)(H1 + row * 1024 + c) = o;
            uint2 ob; ob.x = pack2(o.x, o.y); ob.y = pack2(o.z, o.w);
            *(uint2*)(H1B + row * 1024 + c) = ob;
        }
    }
    __threadfence();
    __syncthreads();
    float* part = (float*)smem;
    int* lcnt = (int*)(smem + 4 * 32 * 33 * 4);
    {
        f32x16 acc;
#pragma unroll
        for (int i = 0; i < 16; ++i) acc[i] = 0.f;
        const int i32 = lane & 31, hh = lane >> 5;
        const float* ap = H1 + ((size_t)tok0 + i32) * 1024 + 256 * w + 4 * hh;
        const float* bp = p.w_r + (size_t)(256 * w + 4 * hh) * 32 + i32;
#pragma unroll 2
        for (int m = 0; m < 32; ++m) {
            const float4 a = *(const float4*)(ap + 8 * m);
            const float b0 = bp[(size_t)(8 * m + 0) * 32], b1 = bp[(size_t)(8 * m + 1) * 32], b2 = bp[(size_t)(8 * m + 2) * 32], b3 = bp[(size_t)(8 * m + 3) * 32];
            acc = __builtin_amdgcn_mfma_f32_32x32x2f32(a.x, b0, acc, 0, 0, 0);
            acc = __builtin_amdgcn_mfma_f32_32x32x2f32(a.y, b1, acc, 0, 0, 0);
            acc = __builtin_amdgcn_mfma_f32_32x32x2f32(a.z, b2, acc, 0, 0, 0);
            acc = __builtin_amdgcn_mfma_f32_32x32x2f32(a.w, b3, acc, 0, 0, 0);
        }
#pragma unroll
        for (int r = 0; r < 16; ++r) {
            const int row = (r & 3) + 8 * (r >> 2) + 4 * hh;
            part[(w * 32 + row) * 33 + i32] = acc[r];
        }
    }
    if (tid < 32) lcnt[tid] = 0;
    __syncthreads();
    int e_sel[4]; float w_sel[4]; int rank[4];
    if (tid < 32) {
        float bestv[4]; int besti[4];
        uint32_t used = 0;
#pragma unroll
        for (int k = 0; k < 4; ++k) {
            float bv = -3.0e38f; int bi = 0;
            for (int j = 0; j < 32; ++j) {
                const float lg = part[(0 * 32 + tid) * 33 + j] + part[(1 * 32 + tid) * 33 + j] + part[(2 * 32 + tid) * 33 + j] + part[(3 * 32 + tid) * 33 + j] + p.b_r[j];
                if (!((used >> j) & 1u) && lg > bv) { bv = lg; bi = j; }
            }
            used |= 1u << bi; bestv[k] = bv; besti[k] = bi;
        }
        float den = 0.f;
#pragma unroll
        for (int k = 0; k < 4; ++k) { w_sel[k] = expf(bestv[k] - bestv[0]); den += w_sel[k]; }
#pragma unroll
        for (int k = 0; k < 4; ++k) { w_sel[k] /= den; e_sel[k] = besti[k]; rank[k] = atomicAdd(&lcnt[besti[k]], 1); }
    }
    __syncthreads();
    if (tid < 32) {
        const int c = lcnt[tid];
        int* counts = (int*)((float*)(ws + OFF_MISC) + 1024);
        lcnt[32 + tid] = c ? atomicAdd(&counts[tid], c) : 0;
    }
    __syncthreads();
    if (tid < 32) {
        int* la = (int*)(ws + OFF_LISTA); float* lw = (float*)(ws + OFF_LISTW);
#pragma unroll
        for (int k = 0; k < 4; ++k) {
            const size_t pos = (size_t)e_sel[k] * NTOK + lcnt[32 + e_sel[k]] + rank[k];
            la[pos] = (tok0 + tid) * 4 + k; lw[pos] = w_sel[k];
        }
    }
    __syncthreads();
}

struct MoeMap { int e, rt, ct, cnt, pbase; };
DEVI void moe_setup(const Params& p, int* sm  , int ctn) {
    const int tid = VTID;
    if (tid == 0) {
        const int* counts = (const int*)((const float*)(p.ws + OFF_MISC) + 1024);
        int tp = 0, cp = 0;
        for (int e = 0; e < 32; ++e) {
            const int c = counts[e];
            sm[e] = tp; sm[32 + e] = cp; sm[64 + e] = c;
            tp += ((c + 127) >> 7) * ctn; cp += c;
        }
        sm[96] = tp;
    }
    __syncthreads();
}
DEVI MoeMap moe_map(const int* sm, int tile, int ctn) {
    int e = 0;
#pragma unroll 1
    for (int i = 1; i < 32; ++i) if (sm[i] <= tile) e = i;
    MoeMap m; m.e = e; m.cnt = sm[64 + e]; m.pbase = sm[32 + e];
    const int tl = tile - sm[e], nrt = (m.cnt + 127) >> 7;
    m.ct = tl / nrt; m.rt = tl % nrt;
    return m;
}

DEVI void moe1_tile(const Params& p, char* smem, const MoeMap& mm) {
    char* ws = p.ws;
    const int tid = VTID, lane = tid & 63, wid = tid >> 6, wr = wid >> 1, wc = wid & 1, fr = lane & 15, fq = lane >> 4;
    const int* la = (const int*)(ws + OFF_LISTA) + (size_t)mm.e * NTOK;
    const u16* H1B = (const u16*)(ws + OFF_H1B);
    auto arow = [&](int r) { const int idx = mm.rt * 128 + r; const int tokn = idx < mm.cnt ? (la[idx] >> 2) : 0; return H1B + (size_t)tokn * 1024; };
    const u16* Bt = (const u16*)(ws + OFF_WGU) + ((size_t)mm.e * 2048 + (size_t)mm.ct * 128) * 1024;
    f32x4 acc[4][4];
    gemm128(tid, arow, Bt, 1024, 1024, smem, acc);
    u16* act = (u16*)(ws + OFF_ACT);
    const float* bgu = p.b_gu + (size_t)mm.e * 2048;
#pragma unroll
    for (int m = 0; m < 4; ++m) {
        const int idx0 = mm.rt * 128 + wr * 64 + m * 16 + fq * 4;
#pragma unroll
        for (int i = 0; i < 2; ++i) {
            const int col = 64 * mm.ct + 32 * wc + 16 * i + fr;
            const float bg_ = bgu[col], bu_ = bgu[1024 + col];
#pragma unroll
            for (int j = 0; j < 4; ++j) {
                if (idx0 + j < mm.cnt) {
                    float gt = acc[m][2 * i][j] + bg_; gt = fminf(gt, 7.f);
                    float up = acc[m][2 * i + 1][j] + bu_; up = fminf(fmaxf(up, -7.f), 7.f);
                    const float a = gt * (1.f / (1.f + __expf(-1.702f * gt))) * (up + 1.f);
                    act[(size_t)(mm.pbase + idx0 + j) * 1024 + col] = f2bf(a);
                }
            }
        }
    }
}

DEVI void moe2_tile(const Params& p, char* smem, const MoeMap& mm) {
    char* ws = p.ws;
    const int tid = VTID, lane = tid & 63, wid = tid >> 6, wr = wid >> 1, wc = wid & 1, fr = lane & 15, fq = lane >> 4;
    const u16* act = (const u16*)(ws + OFF_ACT);
    auto arow = [&](int r) { return act + (size_t)(mm.pbase + mm.rt * 128 + r) * 1024; };
    const u16* Bt = (const u16*)(ws + OFF_WDN) + ((size_t)mm.e * 1024 + (size_t)mm.ct * 128) * 1024;
    f32x4 acc[4][4];
    gemm128(tid, arow, Bt, 1024, 1024, smem, acc);
    const int* la = (const int*)(ws + OFF_LISTA) + (size_t)mm.e * NTOK;
    const float* lw = (const float*)(ws + OFF_LISTW) + (size_t)mm.e * NTOK;
    u16* Y = (u16*)(ws + OFF_Y);
    const float* bdn = p.b_dn + (size_t)mm.e * 1024;
#pragma unroll
    for (int m = 0; m < 4; ++m) {
        const int idx0 = mm.rt * 128 + wr * 64 + m * 16 + fq * 4;
#pragma unroll
        for (int j = 0; j < 4; ++j) {
            if (idx0 + j < mm.cnt) {
                const int a = la[idx0 + j]; const float wgt = lw[idx0 + j];
#pragma unroll
                for (int n = 0; n < 4; ++n) {
                    const int col = mm.ct * 128 + wc * 64 + n * 16 + fr;
                    Y[(size_t)a * 1024 + col] = f2bf((acc[m][n][j] + bdn[col]) * wgt);
                }
            }
        }
    }
}

constexpr int MOE_TAB_OFF = 131072;
DEVI void moe_setup8(const Params& p, char* smem_all, int ctn) {
    int* sm = (int*)(smem_all + MOE_TAB_OFF);
    if (TIDX == 0) {
        const int* counts = (const int*)((const float*)(p.ws + OFF_MISC) + 1024);
        int tp = 0, cp = 0;
        for (int e = 0; e < 32; ++e) {
            const int c = counts[e];
            sm[e] = tp; sm[33 + e] = cp; sm[65 + e] = c;
            tp += ((c + 255) >> 8) * ctn; cp += c;
        }
        sm[32] = tp;
    }
    __syncthreads();
}
template <bool GATHER>
struct MoeSrc {
    struct U { int e, rt, pn, cnt, pbase; };
    const LAS3 int* tab; const char* Bt; const int* la; int nrowsB, G, c;
    DEVI bool next(int i, U& u) const {
        const int L = i * G + c; if (L >= tab[32]) return false;
        int e = 0;
#pragma unroll 1
        for (int k = 1; k < 32; ++k) e = (tab[k] <= L) ? k : e;
        u.e = e; u.cnt = tab[65 + e]; u.pbase = tab[33 + e];
        const int tl = L - tab[e], nrt = (u.cnt + 255) >> 8;
        u.pn = tl / nrt; u.rt = tl - u.pn * nrt;
        return true;
    }
    DEVI unsigned aoff(const U& u, int row) const {
        const int idx = u.rt * 256 + row;
        if (GATHER) { const int tokn = idx < u.cnt ? (la[(size_t)u.e * NTOK + idx] >> 2) : 0; return (unsigned)tokn * 2048u; }
        return (unsigned)(u.pbase + idx) * 2048u;
    }
    DEVI const char* bbase(const U& u) const { return Bt + ((size_t)u.e * nrowsB + (size_t)u.pn * 256) * 2048; }
};
struct EpiMoe1 {
    const float* b_gu; u16* act;
    DEVI void operator()(const f32x4 (&acc)[2][2][4][2], const MoeSrc<true>::U& u, int wr, int wc, int fr, int fq) const {
        const float* bg = b_gu + (size_t)u.e * 2048;
        float4 bgate[2], bup[2];
#pragma unroll
        for (int bj = 0; bj < 2; ++bj) {
            const int col = u.pn * 128 + (bj * 4 + wc) * 16 + 4 * fq;
            bgate[bj] = *(const float4*)(bg + col); bup[bj] = *(const float4*)(bg + 1024 + col);
        }
#pragma unroll
        for (int ai = 0; ai < 2; ++ai)
#pragma unroll
            for (int m = 0; m < 4; ++m) {
                const int idx = u.rt * 256 + ai * 128 + wr * 64 + m * 16 + fr;
                if (idx < u.cnt) {
#pragma unroll
                    for (int bj = 0; bj < 2; ++bj) {
                        const int col = u.pn * 128 + (bj * 4 + wc) * 16 + 4 * fq;
                        const float bgv[4] = {bgate[bj].x, bgate[bj].y, bgate[bj].z, bgate[bj].w};
                        const float buv[4] = {bup[bj].x, bup[bj].y, bup[bj].z, bup[bj].w};
                        f32x4 a;
#pragma unroll
                        for (int j = 0; j < 4; ++j) {
                            float gt = acc[ai][bj][m][0][j] + bgv[j]; gt = fminf(gt, 7.f);
                            float up = acc[ai][bj][m][1][j] + buv[j]; up = fminf(fmaxf(up, -7.f), 7.f);
                            a[j] = gt * (1.f / (1.f + __expf(-1.702f * gt))) * (up + 1.f);
                        }
                        *(uint2*)(act + (size_t)(u.pbase + idx) * 1024 + col) = pack4(a);
                    }
                }
            }
    }
};
struct EpiMoe2 {
    const float* b_dn; const int* la; const float* lw; u16* Y;
    DEVI void operator()(const f32x4 (&acc)[2][2][4][2], const MoeSrc<false>::U& u, int wr, int wc, int fr, int fq) const {
        const float* bd = b_dn + (size_t)u.e * 1024;
#pragma unroll
        for (int ai = 0; ai < 2; ++ai) {
            int av[4]; float wv[4];
#pragma unroll
            for (int m = 0; m < 4; ++m) {
                const int idx = u.rt * 256 + ai * 128 + wr * 64 + m * 16 + fr;
                const bool ok = idx < u.cnt;
                av[m] = ok ? la[(size_t)u.e * NTOK + idx] : -1;
                wv[m] = ok ? lw[(size_t)u.e * NTOK + idx] : 0.f;
            }
#pragma unroll
            for (int bj = 0; bj < 2; ++bj) {
                const int col = u.pn * 256 + bj * 128 + wc * 32 + fq * 8;
                const float4 b0 = *(const float4*)(bd + col), b1 = *(const float4*)(bd + col + 4);
#pragma unroll
                for (int m = 0; m < 4; ++m) {
                    if (av[m] >= 0) {
                        const float wgt = wv[m];
                        uint4 v;
                        v.x = pack2((acc[ai][bj][m][0][0] + b0.x) * wgt, (acc[ai][bj][m][0][1] + b0.y) * wgt);
                        v.y = pack2((acc[ai][bj][m][0][2] + b0.z) * wgt, (acc[ai][bj][m][0][3] + b0.w) * wgt);
                        v.z = pack2((acc[ai][bj][m][1][0] + b1.x) * wgt, (acc[ai][bj][m][1][1] + b1.y) * wgt);
                        v.w = pack2((acc[ai][bj][m][1][2] + b1.z) * wgt, (acc[ai][bj][m][1][3] + b1.w) * wgt);
                        *(uint4*)(Y + (size_t)av[m] * 1024 + col) = v;
                    }
                }
            }
        }
    }
};
DEVI void phase_moe1_8(const Params& p, char* smem_all) {
    moe_setup8(p, smem_all, 8);
    MoeSrc<true> S; S.tab = (const LAS3 int*)(smem_all + MOE_TAB_OFF); S.Bt = p.ws + OFF_WGU; S.la = (const int*)(p.ws + OFF_LISTA); S.nrowsB = 2048; S.G = gridDim.x; S.c = blockIdx.x;
    EpiMoe1 E; E.b_gu = p.b_gu; E.act = (u16*)(p.ws + OFF_ACT);
    g8::gemm_phase<true, false>(TIDX, (LAS3 unsigned char*)smem_all, p.ws + OFF_H1B, S, E);
}
DEVI void phase_moe2_8(const Params& p, char* smem_all) {
    moe_setup8(p, smem_all, 4);
    MoeSrc<false> S; S.tab = (const LAS3 int*)(smem_all + MOE_TAB_OFF); S.Bt = p.ws + OFF_WDN; S.la = nullptr; S.nrowsB = 1024; S.G = gridDim.x; S.c = blockIdx.x;
    EpiMoe2 E; E.b_dn = p.b_dn; E.la = (const int*)(p.ws + OFF_LISTA); E.lw = (const float*)(p.ws + OFF_LISTW); E.Y = (u16*)(p.ws + OFF_Y);
    g8::gemm_phase<true, true>(TIDX, (LAS3 unsigned char*)smem_all, p.ws + OFF_ACT, S, E);
}

DEVI void final_rows(const Params& p, int task) {
    char* ws = p.ws;
    const int tid = VTID, lane = tid & 63, w = tid >> 6;
    const float* H1 = (const float*)(ws + OFF_H1); const u16* Y = (const u16*)(ws + OFF_Y);
    for (int i = 0; i < 8; ++i) {
        const size_t row = (size_t)task * 32 + w * 8 + i;
        float4 v[4];
        float s = 0.f;
#pragma unroll
        for (int q = 0; q < 4; ++q) {
            const int c = q * 256 + lane * 4;
            float4 a = *(const float4*)(H1 + row * 1024 + c);
            a.x *= DN_ALPHA; a.y *= DN_ALPHA; a.z *= DN_ALPHA; a.w *= DN_ALPHA;
#pragma unroll
            for (int k = 0; k < 4; ++k) {
                const uint2 y = *(const uint2*)(Y + (row * 4 + k) * 1024 + c);
                a.x += __uint_as_float(y.x << 16); a.y += __uint_as_float(y.x & 0xffff0000u);
                a.z += __uint_as_float(y.y << 16); a.w += __uint_as_float(y.y & 0xffff0000u);
            }
            v[q] = a; s += a.x + a.y + a.z + a.w;
        }
        const float mu = wave_sum(s) * (1.f / 1024.f);
        float ss = 0.f;
#pragma unroll
        for (int q = 0; q < 4; ++q) { v[q].x -= mu; v[q].y -= mu; v[q].z -= mu; v[q].w -= mu; ss += v[q].x * v[q].x + v[q].y * v[q].y + v[q].z * v[q].z + v[q].w * v[q].w; }
        const float rs = rsqrtf(wave_sum(ss) * (1.f / 1024.f) + 1e-5f);
#pragma unroll
        for (int q = 0; q < 4; ++q) {
            const int c = q * 256 + lane * 4;
            const float4 gq = *(const float4*)(p.ln2g + c), bq = *(const float4*)(p.ln2b + c);
            float4 o; o.x = v[q].x * rs * gq.x + bq.x; o.y = v[q].y * rs * gq.y + bq.y; o.z = v[q].z * rs * gq.z + bq.z; o.w = v[q].w * rs * gq.w + bq.w;
            *(float4*)(p.out + row * 1024 + c) = o;
        }
    }
}

DEVI void run_phase(const Params& p, char* smem, char* smem_all, int ph) {
    const int G = VGRID, B0 = VBID;
#ifdef ONLY_PHASE
    if (ph != ONLY_PHASE) return;
#endif
    switch (ph) {
    case 0: phase_prep(p, smem); break;
    case 1: phase_proj(p, smem); break;
    case 2:
        for (int t = B0; t < 128; t += G) cmp1_tile(p, smem, t);
        for (int t = B0; t < 2048; t += G) hgrn_local_tile(p, smem, t);
        break;
    case 3:
        for (int t = B0; t < 64; t += G) cmp2_tile(p, smem, t);
        for (int t = G - 1 - B0; t < 512; t += G) hgrn_scan_task(p, t);
        break;
    case 4:
#ifndef NO_NSA
        for (int t = B0; t < NSA_TILES; t += G) nsa_tile(p, smem, t);
#endif
#ifndef NO_HG3
        for (int t = G - 1 - B0; t < 2048; t += G) hgrn_out_tile(p, smem, t);
#endif
        break;
    case 5:
        phase_wo8(p, smem_all);
        break;
    case 6:
        for (int t = B0; t < 1024; t += G) ln1_router_tile(p, smem, t);
        break;
    case 7: phase_moe1_8(p, smem_all); break;
    case 8: phase_moe2_8(p, smem_all); break;
    case 9:
        for (int t = B0; t < 1024; t += G) final_rows(p, t);
        break;
    }
}

#if N_LAUNCH_MODE == 1
__global__ void __launch_bounds__(512, 2) fwd_kernel(Params p_in) {
    extern __shared__ __attribute__((aligned(16))) char smem_all[];
    Params p = p_in;
    p.ph_lo = __builtin_amdgcn_readfirstlane((int)(threadIdx.x >> 6));
    char* smem = smem_all + (p.ph_lo >> 2) * 65536;
    cg::grid_group grid = cg::this_grid();
#ifndef PROBE_REP
#define PROBE_REP -1
#endif
#define RP(k) run_phase(p, smem, smem_all, k); grid.sync(); if (PROBE_REP == k) { run_phase(p, smem, smem_all, k); grid.sync(); }
    RP(0) RP(1) RP(2)
    run_phase(p, smem, smem_all, 3); grid.sync();
    if (PROBE_REP == 23) { run_phase(p, smem, smem_all, 2); grid.sync(); run_phase(p, smem, smem_all, 3); grid.sync(); }
    RP(4) RP(5)
    run_phase(p, smem, smem_all, 6); grid.sync();
    if (PROBE_REP == 6) {
        if (blockIdx.x == 0 && TIDX < 32) ((int*)((float*)(p.ws + OFF_MISC) + 1024))[TIDX] = 0;
        grid.sync(); run_phase(p, smem, smem_all, 6); grid.sync();
    }
    RP(7) RP(8)
    run_phase(p, smem, smem_all, 9);
    if (PROBE_REP == 9) { grid.sync(); run_phase(p, smem, smem_all, 9); }
#undef RP
}
#define KFN fwd_kernel
#else
template <int PH>
__global__ void __launch_bounds__(256, 2) phase_kernel(Params p) {
    extern __shared__ __attribute__((aligned(16))) char smem[];
    run_phase(p, smem, PH);
}
#define KFN phase_kernel<4>
#endif

extern "C" void kernel_launch(void* const* d_in, const int* in_sizes, int n_in, void* d_out, int out_size, void* d_ws, size_t ws_size,
                              hipStream_t stream) {
    static int grid = 0;
    if (grid == 0) {
        if (ws_size < WS_NEED) { fprintf(stderr, "kernel_launch: workspace too small: %zu < %zu\n", ws_size, (size_t)WS_NEED); grid = -1; return; }
        int dev = 0, cus = 0, per_cu = 0;
        (void)hipGetDevice(&dev);
        (void)hipDeviceGetAttribute(&cus, hipDeviceAttributeMultiprocessorCount, dev);
#if N_LAUNCH_MODE == 1
        (void)hipFuncSetAttribute((const void*)KFN, hipFuncAttributeMaxDynamicSharedMemorySize, SMEM_BYTES);
#else
#define SA_(PH) (void)hipFuncSetAttribute((const void*)phase_kernel<PH>, hipFuncAttributeMaxDynamicSharedMemorySize, SMEM_BYTES);
        SA_(0) SA_(1) SA_(2) SA_(3) SA_(4) SA_(5) SA_(6) SA_(7) SA_(8) SA_(9)
#undef SA_
#endif
        (void)hipOccupancyMaxActiveBlocksPerMultiprocessor(&per_cu, (const void*)KFN, 512, SMEM_BYTES);
        if (per_cu < 1) per_cu = 1;
        if (per_cu > 1) per_cu = 1;
        grid = cus * per_cu;
    }
    if (grid < 0) return;
    Params p{};
    p.x = (const float*)d_in[0]; p.pos = (const int*)d_in[1]; p.w_in = (const float*)d_in[2]; p.pe = (const float*)d_in[3];
    p.w_ck1 = (const float*)d_in[4]; p.w_ck2 = (const float*)d_in[5]; p.w_cv1 = (const float*)d_in[6]; p.w_cv2 = (const float*)d_in[7];
    p.hg_lb = (const float*)d_in[8]; p.hg_ng = (const float*)d_in[9]; p.w_o = (const float*)d_in[10]; p.ln1g = (const float*)d_in[11];
    p.ln1b = (const float*)d_in[12]; p.w_r = (const float*)d_in[13]; p.b_r = (const float*)d_in[14]; p.w_gu = (const float*)d_in[15];
    p.b_gu = (const float*)d_in[16]; p.w_dn = (const float*)d_in[17]; p.b_dn = (const float*)d_in[18]; p.ln2g = (const float*)d_in[19];
    p.ln2b = (const float*)d_in[20];
    p.out = (float*)d_out; p.ws = (char*)d_ws;
#if N_LAUNCH_MODE == 1
    p.ph_lo = 0; p.ph_hi = NPHASE;
    void* args[] = {&p};
    hipError_t e = hipLaunchCooperativeKernel((const void*)fwd_kernel, dim3(grid), dim3(512), args, SMEM_BYTES, stream);
    if (e != hipSuccess) fprintf(stderr, "cooperative launch failed: %s (grid %d)\n", hipGetErrorString(e), grid);
#else
    p.ph_lo = 0; p.ph_hi = NPHASE;
#define LP(PH) hipLaunchKernelGGL(phase_kernel<PH>, dim3(grid), dim3(256), SMEM_BYTES, stream, p);
    LP(0) LP(1) LP(2) LP(3) LP(4) LP(5) LP(6) LP(7) LP(8) LP(9)
#undef LP
#endif
}
```

```cpp
#include <hip/hip_runtime.h>
#include <hip/hip_cooperative_groups.h>
#include <stdint.h>
#include <stdio.h>
namespace cg = cooperative_groups;

typedef unsigned short u16;
typedef __attribute__((ext_vector_type(8))) short bf16x8;
typedef __attribute__((ext_vector_type(4))) float f32x4;
typedef __attribute__((ext_vector_type(16))) float f32x16;
#define DEVI __device__ __forceinline__
static __device__ __forceinline__ int laneid_() { int r; asm volatile("v_mbcnt_lo_u32_b32 %0, -1, 0\n\tv_mbcnt_hi_u32_b32 %0, -1, %0" : "=v"(r)); return r; }
#define LANEID (laneid_())
#define TIDX (p.ph_lo * 64 + LANEID)
#define VTID ((p.ph_lo & 3) * 64 + LANEID)
#define VBID ((int)(blockIdx.x * 2 + (p.ph_lo >> 2)))
#define VGRID ((int)(gridDim.x * 2))

#ifndef N_LAUNCH_MODE
#define N_LAUNCH_MODE 1
#endif

constexpr int NTOK = 32768, SEQ = 8192, NB = 4;
constexpr int SP = 8224;
constexpr int NPHASE = 10;
constexpr int SMEM_BYTES = 131072 + 1024;
constexpr float DN_ALPHA = 1.189207115002721f;

constexpr size_t MB = 1ull << 20;
constexpr size_t OFF_WIN = 0;
constexpr size_t OFF_WCK1 = 7 * MB;
constexpr size_t OFF_WCV1 = 8 * MB;
constexpr size_t OFF_WCK2 = 9 * MB;
constexpr size_t OFF_WCV2 = 9 * MB + 65536;
constexpr size_t OFF_WO = 10 * MB;
constexpr size_t OFF_ROPE = 12 * MB;
constexpr size_t OFF_GATES = 14 * MB;
constexpr size_t OFF_MISC = 17 * MB;
constexpr size_t OFF_LISTA = 18 * MB;
constexpr size_t OFF_LISTW = 22 * MB;
constexpr size_t OFF_HID = 26 * MB;
constexpr size_t OFF_KC = 30 * MB;
constexpr size_t OFF_VCT = 30 * MB + 524288;
constexpr size_t OFF_DG = 31 * MB;
constexpr size_t OFF_WGU = 32 * MB;
constexpr size_t OFF_WDN = 160 * MB;
constexpr size_t OFF_H1 = 224 * MB;
constexpr size_t OFF_H1B = 352 * MB;
constexpr size_t OFF_X = 416 * MB;
constexpr size_t OFF_XB = OFF_X;
constexpr size_t OFF_Q = OFF_X + 64 * MB;
constexpr size_t OFF_KCR = OFF_X + 96 * MB;
constexpr size_t OFF_VCR = OFF_X + 105 * MB;
constexpr size_t OFF_KS = OFF_X + 114 * MB;
constexpr size_t OFF_KW = OFF_X + 123 * MB;
constexpr size_t OFF_VST = OFF_X + 132 * MB;
constexpr size_t OFF_VWT = OFF_X + 141 * MB;
constexpr size_t OFF_QH = OFF_X + 150 * MB;
constexpr size_t OFF_LOGF = OFF_X + 182 * MB;
constexpr size_t OFF_VTH = OFF_X + 246 * MB;
constexpr size_t OFF_GH = OFF_X + 278 * MB;
constexpr size_t OFF_LBUF = OFF_X + 310 * MB;
constexpr size_t OFF_MIX = OFF_X + 374 * MB;
constexpr size_t OFF_PRE = OFF_X;
constexpr size_t OFF_ACT = OFF_X;
constexpr size_t OFF_Y = OFF_X + 256 * MB;
constexpr size_t WS_NEED = OFF_Y + 256 * MB;

struct Params {
    const float* x; const int* pos; const float* w_in; const float* pe;
    const float* w_ck1; const float* w_ck2; const float* w_cv1; const float* w_cv2;
    const float* hg_lb; const float* hg_ng; const float* w_o; const float* ln1g; const float* ln1b;
    const float* w_r; const float* b_r; const float* w_gu; const float* b_gu; const float* w_dn; const float* b_dn;
    const float* ln2g; const float* ln2b;
    float* out; char* ws;
    int ph_lo, ph_hi;
};

DEVI u16 f2bf(float f) { uint32_t u = __float_as_uint(f); u += 0x7fffu + ((u >> 16) & 1u); return (u16)(u >> 16); }
DEVI float bf2f(u16 h) { return __uint_as_float(((uint32_t)h) << 16); }
typedef float f32x2_t __attribute__((ext_vector_type(2)));
typedef __bf16 bf16x2_t __attribute__((ext_vector_type(2)));
DEVI uint32_t pack2(float a, float b) { f32x2_t v = {a, b}; bf16x2_t r = __builtin_convertvector(v, bf16x2_t); return __builtin_bit_cast(uint32_t, r); }
DEVI bf16x8 pack8(f32x4 a, f32x4 b) {
    union { bf16x8 v; uint32_t u[4]; } r;
    r.u[0] = pack2(a[0], a[1]); r.u[1] = pack2(a[2], a[3]); r.u[2] = pack2(b[0], b[1]); r.u[3] = pack2(b[2], b[3]);
    return r.v;
}
DEVI uint2 pack4(f32x4 a) { uint2 r; r.x = pack2(a[0], a[1]); r.y = pack2(a[2], a[3]); return r; }
DEVI f32x4 mfma16(bf16x8 a, bf16x8 b, f32x4 c) { return __builtin_amdgcn_mfma_f32_16x16x32_bf16(a, b, c, 0, 0, 0); }
DEVI bf16x8 ld8(const u16* p) { return *reinterpret_cast<const bf16x8*>(p); }
DEVI bf16x8 zero8() { bf16x8 z = {0, 0, 0, 0, 0, 0, 0, 0}; return z; }
DEVI float sigmoidf_(float v) { return 1.f / (1.f + __expf(-v)); }
DEVI float xor16_max(float v) { v = fmaxf(v, __shfl_xor(v, 16)); v = fmaxf(v, __shfl_xor(v, 32)); return v; }
DEVI float xor16_sum(float v) { v += __shfl_xor(v, 16); v += __shfl_xor(v, 32); return v; }
DEVI float wave_sum(float v) {
#pragma unroll
    for (int o = 32; o > 0; o >>= 1) v += __shfl_xor(v, o);
    return v;
}
DEVI void glds16(const u16* g, u16* l) {
    __builtin_amdgcn_global_load_lds((const unsigned*)g, (__attribute__((address_space(3))) unsigned*)l, 16, 0, 0);
}

template <class AFn>
DEVI void gemm128(const int tid, AFn arow, const u16* __restrict__ Bt, size_t ldb, int K, char* smem, f32x4 (&acc)[4][4]) {
    const int lane = tid & 63, wid = tid >> 6, wr = wid >> 1, wc = wid & 1, fr = lane & 15, fq = lane >> 4;
    u16* SA = (u16*)smem; u16* SB = (u16*)(smem + 8192);
    const int r0 = tid >> 2, c0 = (tid & 3) * 8;
    const u16* a0 = arow(r0) + c0; const u16* a1 = arow(r0 + 64) + c0;
    const u16* b0 = Bt + (size_t)r0 * ldb + c0; const u16* b1 = Bt + (size_t)(r0 + 64) * ldb + c0;
#pragma unroll
    for (int m = 0; m < 4; ++m)
#pragma unroll
        for (int n = 0; n < 4; ++n) acc[m][n] = f32x4{0.f, 0.f, 0.f, 0.f};
    for (int kt = 0; kt < K; kt += 32) {
        glds16(a0 + kt, SA + tid * 8); glds16(a1 + kt, SA + 2048 + tid * 8);
        glds16(b0 + kt, SB + tid * 8); glds16(b1 + kt, SB + 2048 + tid * 8);
        asm volatile("s_waitcnt vmcnt(0)" ::: "memory");
        __syncthreads();
        bf16x8 af[4], bfr[4];
#pragma unroll
        for (int m = 0; m < 4; ++m) af[m] = ld8(SA + (wr * 64 + m * 16 + fr) * 32 + fq * 8);
#pragma unroll
        for (int n = 0; n < 4; ++n) bfr[n] = ld8(SB + (wc * 64 + n * 16 + fr) * 32 + fq * 8);
#pragma unroll
        for (int m = 0; m < 4; ++m)
#pragma unroll
            for (int n = 0; n < 4; ++n) acc[m][n] = mfma16(af[m], bfr[n], acc[m][n]);
        __syncthreads();
    }
}

template <class CM>
DEVI void tconv_tile(const int tid, const float* __restrict__ src, size_t ld, u16* __restrict__ dst, size_t ldd, int r0, int k0, CM colmap, char* smem) {
    float (*t)[65] = (float (*)[65])smem;
    {
        const int n = tid & 63; const int col = colmap(r0 + n);
#pragma unroll 4
        for (int i = 0; i < 16; ++i) {
            const int k = (tid >> 6) + 4 * i;
            t[k][n] = (col >= 0) ? src[(size_t)(k0 + k) * ld + col] : 0.f;
        }
    }
    __syncthreads();
    {
        const int k2 = (tid & 31) * 2;
#pragma unroll 4
        for (int i = 0; i < 8; ++i) {
            const int n = (tid >> 5) + 8 * i;
            *(uint32_t*)(dst + (size_t)(r0 + n) * ldd + k0 + k2) = pack2(t[k2][n], t[k2 + 1][n]);
        }
    }
    __syncthreads();
}

DEVI void phase_prep(const Params& p, char* smem) {
    char* ws = p.ws;
    constexpr int J_WIN = 54 * 16;
    constexpr int J_WCK1 = 4 * 32;
    constexpr int J_WC2 = 2 * 4;
    constexpr int J_WO = 16 * 16;
    constexpr int J_WGU = 32 * 32 * 16;
    constexpr int J_WDN = 32 * 16 * 16;
    constexpr int J_XB = 16384;
    constexpr int J_ROPE = 1024;
    constexpr int J0 = 0, J1 = J0 + J_WIN, J2 = J1 + 2 * J_WCK1, J3 = J2 + 2 * J_WC2, J4 = J3 + J_WO, J5 = J4 + J_WGU,
                  J6 = J5 + J_WDN, J7 = J6 + J_XB, J8 = J7 + J_ROPE, J9 = J8 + 1;
    for (int job = VBID; job < J9; job += VGRID) {
        const int tid = VTID;
        if (job < J1) {
            const int j = job - J0, rt = j / 16, kt = j % 16;
            auto cm = [](int r) {
                if (r < 768) return r;
                if (r < 1024) { const int rr = r - 768; return rr < 128 ? 768 + rr : 1024 + (rr - 128); }
                if (r < 1536) return 1304 + (r - 1024);
                if (r < 2048) return 1816 + (r - 1536);
                if (r < 2560) return 2840 + (r - 2048);
                if (r < 2816) { const int rr = r - 2560; return rr < 128 ? 896 + rr : 1152 + (rr - 128); }
                if (r < 3328) return 2328 + (r - 2816);
                if (r < 3352) return 1280 + (r - 3328);
                return -1; };
            tconv_tile(tid, p.w_in, 3352, (u16*)(ws + OFF_WIN), 1024, rt * 64, kt * 64, cm, smem);
        } else if (job < J2) {
            int j = job - J1; const int which = j / J_WCK1; j %= J_WCK1; const int rt = j / 32, kt = j % 32;
            auto cm = [](int r) { return r; };
            tconv_tile(tid, which ? p.w_cv1 : p.w_ck1, 256, (u16*)(ws + (which ? OFF_WCV1 : OFF_WCK1)), 2048, rt * 64, kt * 64, cm, smem);
        } else if (job < J3) {
            int j = job - J2; const int which = j / J_WC2; j %= J_WC2; const int rt = j / 4, kt = j % 4;
            auto cm = [](int r) { return r < 64 ? r : -1; };
            tconv_tile(tid, which ? p.w_cv2 : p.w_ck2, 64, (u16*)(ws + (which ? OFF_WCV2 : OFF_WCK2)), 256, rt * 64, kt * 64, cm, smem);
        } else if (job < J4) {
            const int j = job - J3, rt = j / 16, kt = j % 16;
            auto cm = [](int r) { return r; };
            tconv_tile(tid, p.w_o, 1024, (u16*)(ws + OFF_WO), 1024, rt * 64, kt * 64, cm, smem);
        } else if (job < J5) {
            int j = job - J4; const int e = j / 512; j %= 512; const int rt = j / 16, kt = j % 16;
            auto cm = [](int r) { const int pn = r >> 8, bj = (r >> 7) & 1, wc = (r >> 5) & 3, n = (r >> 4) & 1, i = r & 15; return (n ? 1024 : 0) + pn * 128 + (bj * 4 + wc) * 16 + i; };
            tconv_tile(tid, p.w_gu + (size_t)e * 1024 * 2048, 2048, (u16*)(ws + OFF_WGU) + (size_t)e * 2048 * 1024, 1024, rt * 64, kt * 64, cm, smem);
        } else if (job < J6) {
            int j = job - J5; const int e = j / 256; j %= 256; const int rt = j / 16, kt = j % 16;
            auto cm = [](int r) { return r; };
            tconv_tile(tid, p.w_dn + (size_t)e * 1024 * 1024, 1024, (u16*)(ws + OFF_WDN) + (size_t)e * 1024 * 1024, 1024, rt * 64, kt * 64, cm, smem);
        } else if (job < J7) {
            const size_t base = (size_t)(job - J6) * 2048 + (size_t)tid * 8;
            const float4 a = *(const float4*)(p.x + base), b = *(const float4*)(p.x + base + 4);
            uint4 o; o.x = pack2(a.x, a.y); o.y = pack2(a.z, a.w); o.z = pack2(b.x, b.y); o.w = pack2(b.z, b.w);
            *(uint4*)((u16*)(ws + OFF_XB) + base) = o;
        } else if (job < J8) {
            const int idx = (job - J7) * 256 + tid;
            const int n = idx >> 3, i = idx & 7;
            const float inv = powf(500000.f, -(float)i / 8.f);
            const float ang = (float)p.pos[n] * inv;
            float s, c; sincosf(ang, &s, &c);
            float* ct = (float*)(ws + OFF_ROPE);
            ct[idx] = c; ct[NTOK * 8 + idx] = s;
        } else {
            float* misc = (float*)(ws + OFF_MISC);
            float sk = 0.f, sv = 0.f;
            for (int i = 0; i < 2048; ++i) { const float pe = p.pe[i]; sk += pe * p.w_ck1[(size_t)i * 256 + tid]; sv += pe * p.w_cv1[(size_t)i * 256 + tid]; }
            misc[tid] = sk; misc[256 + tid] = sv;
            for (int i = tid; i < 512; i += 256) { const float a0 = p.hg_lb[i], a1 = p.hg_lb[512 + i]; misc[512 + i] = 1.f / (1.f + expf(a1 - a0)); }
            if (tid < 32) ((int*)(misc + 1024))[tid] = 0;
        }
    }
}

DEVI f32x4 rope4(f32x4 v, int fr, const float* __restrict__ cs, int i0, int i1, int i2, int i3) {
    const int i = fr & 7; const float sg = (fr & 8) ? 1.f : -1.f;
    const int idx[4] = {i0, i1, i2, i3};
    f32x4 o;
#pragma unroll
    for (int j = 0; j < 4; ++j) {
        const float partner = __shfl_xor(v[j], 8);
        const float c = cs[(size_t)idx[j] * 8 + i], s = cs[(size_t)NTOK * 8 + (size_t)idx[j] * 8 + i];
        o[j] = v[j] * c + sg * partner * s;
    }
    return o;
}

DEVI void hgrn_local_tile(const Params& p, char* smem, int tile) {
    char* ws = p.ws;
    const int bh = tile >> 7, chunk = tile & 127, b = bh >> 2, h = bh & 3;
    const int tid = VTID, lane = tid & 63, w = tid >> 6, fr = lane & 15, fq = lane >> 4;
    const size_t n0 = (size_t)b * 8192 + chunk * 64;
    const float* lfp = (const float*)(ws + OFF_LOGF) + n0 * 512 + h * 128;
    u16* khT = (u16*)(smem + 1024);
    float blast;
    float* totp = (float*)smem;
    {
        const int k = tid & 127, half = tid >> 7;
        float run = 0.f;
#pragma unroll 8
        for (int i = 0; i < 32; ++i) run += lfp[(size_t)(32 * half + i) * 512 + k];
        totp[half * 128 + k] = run;
        __syncthreads();
        const float t0 = totp[k], t1 = totp[128 + k];
        blast = t0 + t1;
        float bcur = half ? t0 : 0.f;
#pragma unroll 4
        for (int i = 0; i < 32; ++i) {
            const float lf = lfp[(size_t)(32 * half + i) * 512 + k];
            bcur += lf;
            const float kh = (1.f - expf(lf)) * expf(blast - bcur);
            khT[k * 72 + 32 * half + i] = f2bf(kh);
        }
        if (half == 0) ((float*)(ws + OFF_DG))[(size_t)tile * 128 + k] = expf(blast);
    }
    __syncthreads();
    const u16* vT = (const u16*)(ws + OFF_VTH) + (size_t)tile * 128 * 64;
    f32x4 acc[2][8];
#pragma unroll
    for (int m = 0; m < 2; ++m)
#pragma unroll
        for (int n = 0; n < 8; ++n) acc[m][n] = f32x4{0.f, 0.f, 0.f, 0.f};
#pragma unroll
    for (int ks = 0; ks < 2; ++ks) {
        bf16x8 a[2];
#pragma unroll
        for (int m = 0; m < 2; ++m) a[m] = ld8(khT + (32 * w + 16 * m + fr) * 72 + 32 * ks + 8 * fq);
#pragma unroll
        for (int n = 0; n < 8; ++n) {
            const bf16x8 bv = ld8(vT + (size_t)(16 * n + fr) * 64 + 32 * ks + 8 * fq);
#pragma unroll
            for (int m = 0; m < 2; ++m) acc[m][n] = mfma16(a[m], bv, acc[m][n]);
        }
    }
    u16* L = (u16*)(ws + OFF_LBUF) + (size_t)tile * 128 * 128;
#pragma unroll
    for (int m = 0; m < 2; ++m)
#pragma unroll
        for (int n = 0; n < 8; ++n) *(uint2*)(L + (size_t)(16 * n + fr) * 128 + 32 * w + 16 * m + 4 * fq) = pack4(acc[m][n]);
    __syncthreads();
}

DEVI void hgrn_scan_task(const Params& p, int task) {
    char* ws = p.ws;
    const int gid = task * 256 + VTID;
    const int bh = gid >> 13, v = (gid >> 6) & 127, kp = gid & 63;
    uint32_t* L = (uint32_t*)(ws + OFF_LBUF) + ((size_t)bh * 128 * 128 * 128 + (size_t)v * 128) / 2 + kp;
    const float2* Dg = (const float2*)(ws + OFF_DG) + (size_t)bh * 128 * 64 + kp;
    float s0 = 0.f, s1 = 0.f;
#pragma unroll 8
    for (int c = 0; c < 128; ++c) {
        const uint32_t l = L[(size_t)c * 8192];
        const float2 d = Dg[(size_t)c * 64];
        L[(size_t)c * 8192] = pack2(s0, s1);
        s0 = d.x * s0 + __uint_as_float(l << 16);
        s1 = d.y * s1 + __uint_as_float(l & 0xffff0000u);
    }
}

DEVI void hgrn_out_tile(const Params& p, char* smem, int tile) {
    char* ws = p.ws;
    const int bh = tile >> 7, chunk = tile & 127, b = bh >> 2, h = bh & 3;
    const int tid = VTID, lane = tid & 63, w = tid >> 6, fr = lane & 15, fq = lane >> 4;
    const size_t n0 = (size_t)b * 8192 + chunk * 64;
    const float* lfp = (const float*)(ws + OFF_LOGF) + n0 * 512 + h * 128;
    const u16* qh = (const u16*)(ws + OFF_QH) + n0 * 512 + h * 128;
    float* totp = (float*)smem;
    u16* qt = (u16*)(smem + 1024);
    u16* kt = qt + 64 * 136;
    {
        const int k = tid & 127, half = tid >> 7;
        float run = 0.f;
#pragma unroll 8
        for (int i = 0; i < 32; ++i) run += lfp[(size_t)(32 * half + i) * 512 + k];
        totp[half * 128 + k] = run;
        __syncthreads();
        float bcur = half ? totp[k] : 0.f;
#pragma unroll 4
        for (int i = 0; i < 32; ++i) {
            const int t = 32 * half + i;
            const float lf = lfp[(size_t)t * 512 + k];
            bcur += lf;
            const float q = bf2f(qh[(size_t)t * 512 + k]);
            qt[t * 136 + k] = f2bf(q * expf(bcur));
            kt[t * 136 + k] = f2bf((1.f - expf(lf)) * expf(-bcur));
        }
    }
    __syncthreads();
    bf16x8 qb[4];
#pragma unroll
    for (int ks = 0; ks < 4; ++ks) qb[ks] = ld8(qt + (16 * w + fr) * 136 + 32 * ks + 8 * fq);
    f32x4 at[4];
#pragma unroll
    for (int sf = 0; sf < 4; ++sf) {
        const int srow = 32 * (sf >> 1) + 8 * (fr >> 2) + 4 * (sf & 1) + (fr & 3);
        f32x4 a = f32x4{0.f, 0.f, 0.f, 0.f};
#pragma unroll
        for (int ks = 0; ks < 4; ++ks) a = mfma16(ld8(kt + srow * 136 + 32 * ks + 8 * fq), qb[ks], a);
        const int tcol = 16 * w + fr;
#pragma unroll
        for (int r = 0; r < 4; ++r) { const int s = 32 * (sf >> 1) + 8 * fq + 4 * (sf & 1) + r; if (s > tcol) a[r] = 0.f; }
        at[sf] = a;
    }
    const u16* vT = (const u16*)(ws + OFF_VTH) + (size_t)tile * 128 * 64;
    const u16* ST = (const u16*)(ws + OFF_LBUF) + (size_t)tile * 128 * 128;
    f32x4 o[8];
#pragma unroll
    for (int mf = 0; mf < 8; ++mf) o[mf] = f32x4{0.f, 0.f, 0.f, 0.f};
#pragma unroll
    for (int sc = 0; sc < 2; ++sc) {
        const bf16x8 pb = pack8(at[2 * sc], at[2 * sc + 1]);
#pragma unroll
        for (int mf = 0; mf < 8; ++mf) o[mf] = mfma16(ld8(vT + (size_t)(16 * mf + fr) * 64 + 32 * sc + 8 * fq), pb, o[mf]);
    }
#pragma unroll
    for (int ks = 0; ks < 4; ++ks)
#pragma unroll
        for (int mf = 0; mf < 8; ++mf) o[mf] = mfma16(ld8(ST + (size_t)(16 * mf + fr) * 128 + 32 * ks + 8 * fq), qb[ks], o[mf]);
    float ss = 0.f;
#pragma unroll
    for (int mf = 0; mf < 8; ++mf)
#pragma unroll
        for (int r = 0; r < 4; ++r) ss += o[mf][r] * o[mf][r];
    ss = xor16_sum(ss);
    const float rn = rsqrtf(ss * (1.f / 128.f) + 1e-6f);
    const size_t tok = n0 + 16 * w + fr;
    const u16* gh = (const u16*)(ws + OFF_GH) + tok * 512 + h * 128;
    u16* mix = (u16*)(ws + OFF_MIX) + tok * 1024 + 512 + h * 128;
#pragma unroll
    for (int mf = 0; mf < 8; ++mf) {
        const int v0 = 16 * mf + 4 * fq;
        const uint2 g2 = *(const uint2*)(gh + v0);
        const float4 ng = *(const float4*)(p.hg_ng + v0);
        f32x4 r;
        r[0] = o[mf][0] * rn * ng.x * __uint_as_float(g2.x << 16);
        r[1] = o[mf][1] * rn * ng.y * __uint_as_float(g2.x & 0xffff0000u);
        r[2] = o[mf][2] * rn * ng.z * __uint_as_float(g2.y << 16);
        r[3] = o[mf][3] * rn * ng.w * __uint_as_float(g2.y & 0xffff0000u);
        *(uint2*)(mix + v0) = pack4(r);
    }
    __syncthreads();
}

DEVI float gelu_tanh(float x) { const float u = 0.7978845608028654f * (x + 0.044715f * x * x * x); return 0.5f * x * (1.f + tanhf(u)); }

DEVI void cmp1_tile(const Params& p, char* smem, int tile) {
    char* ws = p.ws;
    const int which = tile >> 6, rt = (tile >> 1) & 31, ct = tile & 1;
    const int tid = VTID, lane = tid & 63, wid = tid >> 6, wr = wid >> 1, wc = wid & 1, fr = lane & 15, fq = lane >> 4;
    const u16* src = (const u16*)(ws + (which ? OFF_VCR : OFF_KCR));
    auto arow = [&](int r) { const int m = rt * 128 + r; return src + ((size_t)(m >> 9) * SP + 16 * (m & 511)) * 64; };
    const u16* Bt = (const u16*)(ws + (which ? OFF_WCV1 : OFF_WCK1)) + (size_t)ct * 128 * 2048;
    f32x4 acc[4][4];
    gemm128(tid, arow, Bt, 2048, 2048, smem, acc);
    const float* bias = (const float*)(ws + OFF_MISC) + which * 256;
    u16* hid = (u16*)(ws + OFF_HID) + (size_t)which * 4096 * 256;
#pragma unroll
    for (int m = 0; m < 4; ++m)
#pragma unroll
        for (int n = 0; n < 4; ++n) {
            const int row = rt * 128 + wr * 64 + m * 16 + fq * 4, col = ct * 128 + wc * 64 + n * 16 + fr;
            const float bv = bias[col];
#pragma unroll
            for (int j = 0; j < 4; ++j) hid[(size_t)(row + j) * 256 + col] = f2bf(gelu_tanh(acc[m][n][j] + bv));
        }
}

DEVI void cmp2_tile(const Params& p, char* smem, int tile) {
    char* ws = p.ws;
    const int which = tile >> 5, rt = tile & 31;
    const int tid = VTID, lane = tid & 63, wid = tid >> 6, wr = wid >> 1, wc = wid & 1, fr = lane & 15, fq = lane >> 4;
    const u16* hid = (const u16*)(ws + OFF_HID) + (size_t)which * 4096 * 256;
    auto arow = [&](int r) { return hid + (size_t)(rt * 128 + r) * 256; };
    const u16* Bt = (const u16*)(ws + (which ? OFF_WCV2 : OFF_WCK2));
    f32x4 acc[4][4];
    gemm128(tid, arow, Bt, 256, 256, smem, acc);
    if (wc == 0) {
        const float* cs = (const float*)(ws + OFF_ROPE);
#pragma unroll
        for (int m = 0; m < 4; ++m) {
            const int row = rt * 128 + wr * 64 + m * 16 + fq * 4;
            const int bg = row >> 9, c = row & 511, b = bg >> 1;
#pragma unroll
            for (int n = 0; n < 4; ++n) {
                const int d = n * 16 + fr;
                f32x4 v = acc[m][n];
                if (which == 0) {
                    if (n == 0) {
                        int ix[4];
#pragma unroll
                        for (int j = 0; j < 4; ++j) { int sp = 16 * (c + j) + 31; sp = sp > 8191 ? 8191 : sp; ix[j] = b * 8192 + sp; }
                        v = rope4(v, fr, cs, ix[0], ix[1], ix[2], ix[3]);
                    }
                    u16* kc = (u16*)(ws + OFF_KC);
#pragma unroll
                    for (int j = 0; j < 4; ++j) kc[((size_t)bg * 512 + c + j) * 64 + d] = f2bf(v[j]);
                } else {
                    u16* vct = (u16*)(ws + OFF_VCT);
                    *(uint2*)(vct + (((size_t)bg * 8 + (c >> 6)) * 64 + d) * 64 + (c & 63)) = pack4(v);
                }
            }
        }
    }
}

DEVI uint64_t lowest_bits(uint64_t mask, int n) {
    uint64_t out = 0;
    while (n > 0 && mask) { const uint64_t b = mask & (~mask + 1); out |= b; mask ^= b; --n; }
    return out;
}

constexpr int NSA_TILES = 8 * 128;
constexpr int NSA_STG = 18432;
constexpr int NSA_OFF_IMP = 2 * NSA_STG;
constexpr int NSA_OFF_SEL = NSA_OFF_IMP + 4 * 8192;
constexpr float NSA_NEG = -3.0e30f;

DEVI float ex2(float x) { return __builtin_amdgcn_exp2f(x); }
DEVI void sm_update(f32x4 (&s)[2][2], const bool on, float (&R)[2], float (&l)[2], f32x4 (&os)[2][4], bf16x8 (&pb)[2]) {
    float lm[2];
#pragma unroll
    for (int hh = 0; hh < 2; ++hh) {
        float a = fmaxf(fmaxf(s[hh][0][0], s[hh][0][1]), fmaxf(s[hh][0][2], s[hh][0][3]));
        float b = fmaxf(fmaxf(s[hh][1][0], s[hh][1][1]), fmaxf(s[hh][1][2], s[hh][1][3]));
        a = fmaxf(a, b);
        lm[hh] = on ? a : NSA_NEG;
    }
    const bool trig = (lm[0] > R[0] + 8.f) || (lm[1] > R[1] + 8.f);
    if (__ballot(trig)) {
#pragma unroll
        for (int hh = 0; hh < 2; ++hh) {
            const float cm = xor16_max(lm[hh]);
            const float nr = fmaxf(R[hh], cm);
            const float sc = ex2(R[hh] - nr);
            l[hh] *= sc;
#pragma unroll
            for (int mf = 0; mf < 4; ++mf) { os[hh][mf][0] *= sc; os[hh][mf][1] *= sc; os[hh][mf][2] *= sc; os[hh][mf][3] *= sc; }
            R[hh] = nr;
        }
    }
#pragma unroll
    for (int hh = 0; hh < 2; ++hh) {
        const float ref = on ? R[hh] : 3.0e30f;
        float sum = 0.f;
#pragma unroll
        for (int u = 0; u < 2; ++u)
#pragma unroll
            for (int r = 0; r < 4; ++r) { const float pv = ex2(s[hh][u][r] - ref); s[hh][u][r] = pv; sum += pv; }
        l[hh] += sum;
        pb[hh] = pack8(s[hh][0], s[hh][1]);
    }
}

DEVI void nsa_tile(const Params& p, char* smem, int tile) {
    char* ws = p.ws;
    const int bg = tile & 7, cur = 127 - (tile >> 3), b = bg >> 1, g = bg & 1;
    const int tid = TIDX, lane = tid & 63, w = tid >> 6, fr = lane & 15, fq = lane >> 4;
    const int tt = w >> 1, hp = w & 1;
    const int t0 = cur * 64 + tt * 16;
    const size_t n0 = (size_t)b * 8192 + t0;
    const int tok = t0 + fr;
    const u16* Qb = (const u16*)(ws + OFF_Q);
    const u16* Kc = (const u16*)(ws + OFF_KC) + (size_t)bg * 512 * 64;
    const u16* Vct = (const u16*)(ws + OFF_VCT) + (size_t)bg * 8 * 64 * 64;
    const u16* Ks = (const u16*)(ws + OFF_KS) + (size_t)bg * 8192 * 64;
    const u16* Kw = (const u16*)(ws + OFF_KW) + (size_t)bg * 8192 * 64;
    const u16* Vst = (const u16*)(ws + OFF_VST) + (size_t)bg * 128 * 64 * 64;
    const u16* Vwt = (const u16*)(ws + OFF_VWT) + (size_t)bg * 128 * 64 * 64;
    const float* gp = (const float*)(ws + OFF_GATES) + (n0 + fr) * 24 + (g * 4 + 2 * hp) * 3;
    float* imp = (float*)(smem + NSA_OFF_IMP) + tt * 2048;
    unsigned long long* selm = (unsigned long long*)(smem + NSA_OFF_SEL) + tt * 32;

    for (int i = tid; i < 4 * 2048; i += 512) ((float*)(smem + NSA_OFF_IMP))[i] = 0.f;
    __syncthreads();

    bf16x8 qf[2][2];
#pragma unroll
    for (int hh = 0; hh < 2; ++hh)
#pragma unroll
        for (int ks = 0; ks < 2; ++ks) qf[hh][ks] = ld8(Qb + (n0 + fr) * 512 + (g * 4 + 2 * hp + hh) * 64 + 32 * ks + 8 * fq);
    f32x4 ot[2][4];
#pragma unroll
    for (int hh = 0; hh < 2; ++hh)
#pragma unroll
        for (int mf = 0; mf < 4; ++mf) ot[hh][mf] = f32x4{0.f, 0.f, 0.f, 0.f};

#define NSA_QK(KPTR, S) do { \
        const bf16x8 k0_ = ld8(KPTR), k1_ = ld8((KPTR) + 32); \
        _Pragma("unroll") for (int hh = 0; hh < 2; ++hh) { f32x4 a_ = f32x4{0.f, 0.f, 0.f, 0.f}; a_ = mfma16(k0_, qf[hh][0], a_); a_ = mfma16(k1_, qf[hh][1], a_); S[hh] = a_; } } while (0)

    {
        const int nc = t0 >> 4;
        const int nchunk = (nc + 31) >> 5;
        float RC[2] = {-1e30f, -1e30f}, lC[2] = {0.f, 0.f};
        f32x4 oc[2][4];
#pragma unroll
        for (int hh = 0; hh < 2; ++hh)
#pragma unroll
            for (int mf = 0; mf < 4; ++mf) oc[hh][mf] = f32x4{0.f, 0.f, 0.f, 0.f};
        for (int ch = 0; ch < nchunk; ++ch) {
            f32x4 s[2][2];
#pragma unroll
            for (int u = 0; u < 2; ++u) {
                f32x4 su[2];
                NSA_QK(Kc + (size_t)(32 * ch + 8 * (fr >> 2) + 4 * u + (fr & 3)) * 64 + 8 * fq, su);
                s[0][u] = su[0]; s[1][u] = su[1];
            }
            if (512 * ch + 527 > t0) {
#pragma unroll
                for (int hh = 0; hh < 2; ++hh)
#pragma unroll
                    for (int u = 0; u < 2; ++u)
#pragma unroll
                        for (int r = 0; r < 4; ++r) { const int c = 32 * ch + 8 * fq + 4 * u + r; if (16 * c + 31 > tok) s[hh][u][r] = NSA_NEG; }
            }
            bf16x8 pb[2];
            sm_update(s, true, RC, lC, oc, pb);
        }
        float ilC[2];
#pragma unroll
        for (int hh = 0; hh < 2; ++hh) { const float l = xor16_sum(lC[hh]); ilC[hh] = l > 0.f ? 1.f / l : 0.f; }
        for (int ch = 0; ch < nchunk; ++ch) {
            f32x4 s[2][2];
#pragma unroll
            for (int u = 0; u < 2; ++u) {
                f32x4 su[2];
                NSA_QK(Kc + (size_t)(32 * ch + 8 * (fr >> 2) + 4 * u + (fr & 3)) * 64 + 8 * fq, su);
                s[0][u] = su[0]; s[1][u] = su[1];
            }
            float qs[2] = {0.f, 0.f}, p3[2] = {0.f, 0.f};
            bf16x8 pb[2];
#pragma unroll
            for (int hh = 0; hh < 2; ++hh) {
#pragma unroll
                for (int u = 0; u < 2; ++u)
#pragma unroll
                    for (int r = 0; r < 4; ++r) {
                        const int c = 32 * ch + 8 * fq + 4 * u + r;
                        const float pv = (16 * c + 31 <= tok) ? ex2(s[hh][u][r] - RC[hh]) * ilC[hh] : 0.f;
                        s[hh][u][r] = pv; qs[u] += pv; if (r == 3) p3[u] += pv;
                    }
                pb[hh] = pack8(s[hh][0], s[hh][1]);
            }
#pragma unroll
            for (int u = 0; u < 2; ++u) {
                const int j = 8 * ch + 2 * fq + u;
                atomicAdd(&imp[fr * 128 + j], qs[u]);
                if (j + 1 < 128) atomicAdd(&imp[fr * 128 + j + 1], p3[u]);
            }
#pragma unroll
            for (int mf = 0; mf < 4; ++mf) {
                const bf16x8 va = ld8(Vct + ((size_t)(ch >> 1) * 64 + 16 * mf + fr) * 64 + 32 * (ch & 1) + 8 * fq);
#pragma unroll
                for (int hh = 0; hh < 2; ++hh) oc[hh][mf] = mfma16(va, pb[hh], oc[hh][mf]);
            }
        }
#pragma unroll
        for (int hh = 0; hh < 2; ++hh) {
            const float gc = gp[hh * 3 + 0];
#pragma unroll
            for (int mf = 0; mf < 4; ++mf) ot[hh][mf] += oc[hh][mf] * gc;
        }
    }
    __syncthreads();
    if (hp == 0) {
        if (cur < 16) {
            if (lane < 16) { selm[lane * 2] = (2ull << cur) - 1ull; selm[lane * 2 + 1] = 0ull; }
        } else {
            for (int tau = 0; tau < 16; ++tau) {
                const int j0 = lane, j1 = lane + 64;
                const bool in0 = (j0 >= 1) && (j0 <= cur - 2), in1 = (j1 <= cur - 2);
                const float v0 = in0 ? imp[tau * 128 + j0] : 0.f;
                const float v1 = in1 ? imp[tau * 128 + j1] : 0.f;
                const uint32_t u0 = __float_as_uint(v0), u1 = __float_as_uint(v1);
                uint32_t res = 0;
                for (int bit = 30; bit >= 0; --bit) {
                    const uint32_t cand = res | (1u << bit);
                    const int cnt = __popcll(__ballot(in0 && u0 >= cand)) + __popcll(__ballot(in1 && u1 >= cand));
                    if (cnt >= 13) res = cand;
                }
                const uint64_t g0 = __ballot(in0 && u0 > res), g1 = __ballot(in1 && u1 > res);
                const uint64_t e0 = __ballot(in0 && u0 == res), e1 = __ballot(in1 && u1 == res);
                int need = 13 - (__popcll(g0) + __popcll(g1));
                const int ne0 = __popcll(e0);
                uint64_t sa = g0 | lowest_bits(e0, need);
                need -= (need < ne0 ? need : ne0);
                uint64_t sb = g1 | lowest_bits(e1, need);
                sa |= 1ull;
                if (cur - 1 < 64) sa |= 1ull << (cur - 1); else sb |= 1ull << (cur - 1 - 64);
                if (cur < 64) sa |= 1ull << cur; else sb |= 1ull << (cur - 64);
                if (lane == 0) { selm[tau * 2] = sa; selm[tau * 2 + 1] = sb; }
            }
        }
    }
    {
        int kbeg = t0 - 511; kbeg = kbeg < 0 ? 0 : kbeg; kbeg &= ~31;
        const int nch = (t0 + 16 - kbeg + 31) >> 5;
        float RW[2] = {-1e30f, -1e30f}, lW[2] = {0.f, 0.f};
        f32x4 ow[2][4];
#pragma unroll
        for (int hh = 0; hh < 2; ++hh)
#pragma unroll
            for (int mf = 0; mf < 4; ++mf) ow[hh][mf] = f32x4{0.f, 0.f, 0.f, 0.f};
        for (int ch = 0; ch < nch; ++ch) {
            const int kb = kbeg + 32 * ch;
            f32x4 s[2][2];
#pragma unroll
            for (int u = 0; u < 2; ++u) {
                f32x4 su[2];
                NSA_QK(Kw + (size_t)(kb + 8 * (fr >> 2) + 4 * u + (fr & 3)) * 64 + 8 * fq, su);
                s[0][u] = su[0]; s[1][u] = su[1];
            }
            if (kb + 31 > t0 || kb <= t0 + 15 - 512) {
#pragma unroll
                for (int hh = 0; hh < 2; ++hh)
#pragma unroll
                    for (int u = 0; u < 2; ++u)
#pragma unroll
                        for (int r = 0; r < 4; ++r) { const int key = kb + 8 * fq + 4 * u + r; if (key > tok || key <= tok - 512) s[hh][u][r] = NSA_NEG; }
            }
            bf16x8 pb[2];
            sm_update(s, true, RW, lW, ow, pb);
#pragma unroll
            for (int mf = 0; mf < 4; ++mf) {
                const bf16x8 va = ld8(Vwt + ((size_t)(kb >> 6) * 64 + 16 * mf + fr) * 64 + (kb & 63) + 8 * fq);
#pragma unroll
                for (int hh = 0; hh < 2; ++hh) ow[hh][mf] = mfma16(va, pb[hh], ow[hh][mf]);
            }
        }
#pragma unroll
        for (int hh = 0; hh < 2; ++hh) {
            const float l = xor16_sum(lW[hh]);
            const float gw = gp[hh * 3 + 2] * (l > 0.f ? 1.f / l : 0.f);
#pragma unroll
            for (int mf = 0; mf < 4; ++mf) ot[hh][mf] += ow[hh][mf] * gw;
        }
    }
    __syncthreads();
    {
        const unsigned long long mA = selm[fr * 2], mB = selm[fr * 2 + 1];
        uint4 kr0, vr0;
        const int srow = tid >> 3, sc8 = (tid & 7) * 8;
        const int rho = (srow & 32) | ((srow & 4) << 2) | ((srow & 24) >> 1) | (srow & 3);
#define gload(JB) do { const int jb_ = (JB); \
            kr0 = *(const uint4*)(Ks + ((size_t)(64 * jb_ + srow)) * 64 + sc8); vr0 = *(const uint4*)(Vst + ((size_t)jb_ * 64 + srow) * 64 + sc8); } while (0)
#define lstore(BUF) do { char* sb_ = smem + (BUF) * NSA_STG; \
            *(uint4*)(sb_ + (rho * 72 + sc8) * 2) = kr0; *(uint4*)(sb_ + 9216 + (srow * 72 + sc8) * 2) = vr0; } while (0)
        gload(0); lstore(0);
        if (cur >= 1) gload(1);
        __syncthreads();
        float RS[2] = {-1e30f, -1e30f}, lS[2] = {0.f, 0.f};
        f32x4 os[2][4];
#pragma unroll
        for (int hh = 0; hh < 2; ++hh)
#pragma unroll
            for (int mf = 0; mf < 4; ++mf) os[hh][mf] = f32x4{0.f, 0.f, 0.f, 0.f};
        for (int jb = 0; jb <= cur; ++jb) {
            const int buf = jb & 1;
            const u16* Kl = (const u16*)(smem + buf * NSA_STG);
            const u16* Vl = Kl + 4608;
            const bool on = ((jb < 64 ? (mA >> jb) : (mB >> (jb - 64))) & 1ull) != 0ull;
            if (__ballot(on)) {
#pragma unroll 1
                for (int sc = 0; sc < 2; ++sc) {
                    f32x4 s[2][2];
#pragma unroll
                    for (int u = 0; u < 2; ++u) {
                        f32x4 su[2];
                        NSA_QK(Kl + (32 * sc + 16 * u + fr) * 72 + 8 * fq, su);
                        s[0][u] = su[0]; s[1][u] = su[1];
                    }
                    if (jb == cur) {
#pragma unroll
                        for (int hh = 0; hh < 2; ++hh)
#pragma unroll
                            for (int u = 0; u < 2; ++u)
#pragma unroll
                                for (int r = 0; r < 4; ++r) { const int key = 64 * jb + 32 * sc + 8 * fq + 4 * u + r; if (key > tok) s[hh][u][r] = NSA_NEG; }
                    }
                    bf16x8 pb[2];
                    sm_update(s, on, RS, lS, os, pb);
#pragma unroll
                    for (int mf = 0; mf < 4; ++mf) {
                        const bf16x8 va = ld8(Vl + (16 * mf + fr) * 72 + 32 * sc + 8 * fq);
#pragma unroll
                        for (int hh = 0; hh < 2; ++hh) os[hh][mf] = mfma16(va, pb[hh], os[hh][mf]);
                    }
                }
            }
            if (jb + 1 <= cur) lstore(buf ^ 1);
            if (jb + 2 <= cur) gload(jb + 2);
            __syncthreads();
        }
#undef gload
#undef lstore
#pragma unroll
        for (int hh = 0; hh < 2; ++hh) {
            const float l = xor16_sum(lS[hh]);
            const float gs = gp[hh * 3 + 1] * (l > 0.f ? 1.f / l : 0.f);
#pragma unroll
            for (int mf = 0; mf < 4; ++mf) ot[hh][mf] += os[hh][mf] * gs;
        }
    }
#undef NSA_QK
    {
        u16* mix = (u16*)(ws + OFF_MIX) + (n0 + fr) * 1024 + (g * 4 + 2 * hp) * 64;
#pragma unroll
        for (int hh = 0; hh < 2; ++hh)
#pragma unroll
            for (int mf = 0; mf < 4; ++mf) *(uint2*)(mix + hh * 64 + 16 * mf + 4 * fq) = pack4(ot[hh][mf]);
    }
    __syncthreads();
}

#define LAS3 __attribute__((address_space(3)))
namespace g8 {
constexpr int BM = 256, BK = 64, HALF = 128, HTB = HALF * BK * 2, KK = 1024, NT = KK / BK;
DEVI int lds_byte(int r, int c) { const int st = (r >> 4) * 2 + (c >> 5), rr = r & 15, cc = c & 31, ob = rr * 64 + cc * 2; return st * 1024 + (ob ^ (((ob >> 9) & 1) << 5)); }
DEVI void stage_rc(int b, int& R, int& C) { const int st = b / 1024, sb = b % 1024, swz = sb ^ (((sb >> 9) & 1) << 5); R = (st >> 1) * 16 + swz / 64; C = (st & 1) * 32 + (swz % 64) / 2; }
DEVI int perm32(int rho) { const int n = rho >> 4, i = rho & 15; return 8 * (i >> 2) + 4 * n + (i & 3); }

template <bool TRANS, bool PERM, class Src, class Epi>
DEVI void gemm_phase(int tid, LAS3 unsigned char* lds, const char* Abase, const Src& S, const Epi& E) {
    asm volatile("" : "+v"(tid));
    const int wid = __builtin_amdgcn_readfirstlane(tid >> 6), lane = tid & 63, wr = wid >> 2, wc = wid & 3, fr = lane & 15, fq = lane >> 4;
    int R0, C0, R1, C1;
    stage_rc(tid * 16, R0, C0); stage_rc(tid * 16 + 8192, R1, C1);
    unsigned voffB[2];
    voffB[0] = (unsigned)((PERM ? ((R0 & ~31) + perm32(R0 & 31)) : R0) * KK + C0) * 2u;
    voffB[1] = (unsigned)((PERM ? ((R1 & ~31) + perm32(R1 & 31)) : R1) * KK + C1) * 2u;
    constexpr size_t kstep = (size_t)(BK * 2);
    constexpr size_t hstepB = (size_t)HALF * KK * 2;
    const unsigned ldsw = (unsigned)wid * 1024u;
    const int aoff = lds_byte(wr * 64 + fr, fq * 8), boff = lds_byte(wc * 32 + fr, fq * 8);
#define G8_SA(b, h) (((b) * 2 + (h)) * HTB)
#define G8_SB(b, h) ((4 + (b) * 2 + (h)) * HTB)
#define G8_STAGE_A(bufoff, kbyte, v0, v1) do { \
        __builtin_amdgcn_global_load_lds((const unsigned*)(Abase + (kbyte) + (v0)), (LAS3 unsigned*)(lds + (bufoff) + ldsw), 16, 0, 0); \
        __builtin_amdgcn_global_load_lds((const unsigned*)(Abase + (kbyte) + (v1)), (LAS3 unsigned*)(lds + (bufoff) + ldsw + 8192), 16, 0, 0); } while (0)
#define G8_STAGE_B(bufoff, gptr) do { \
        __builtin_amdgcn_global_load_lds((const unsigned*)((gptr) + voffB[0]), (LAS3 unsigned*)(lds + (bufoff) + ldsw), 16, 0, 0); \
        __builtin_amdgcn_global_load_lds((const unsigned*)((gptr) + voffB[1]), (LAS3 unsigned*)(lds + (bufoff) + ldsw + 8192), 16, 0, 0); } while (0)
#define G8_LDA(dst, b, h) do { _Pragma("unroll") for (int m = 0; m < 4; ++m) _Pragma("unroll") for (int k = 0; k < 2; ++k) dst[m][k] = *(const LAS3 bf16x8*)(lds + G8_SA(b, h) + aoff + m * 2048 + k * 1024); } while (0)
#define G8_LDB(dst, b, h) do { _Pragma("unroll") for (int n = 0; n < 2; ++n) _Pragma("unroll") for (int k = 0; k < 2; ++k) dst[n][k] = *(const LAS3 bf16x8*)(lds + G8_SB(b, h) + boff + n * 2048 + k * 1024); } while (0)
#define G8_MMA(ai, bj, At, Bt) do { __builtin_amdgcn_s_setprio(1); _Pragma("unroll") for (int m = 0; m < 4; ++m) _Pragma("unroll") for (int n = 0; n < 2; ++n) _Pragma("unroll") for (int k = 0; k < 2; ++k) \
        acc[ai][bj][m][n] = TRANS ? __builtin_amdgcn_mfma_f32_16x16x32_bf16(Bt[n][k], At[m][k], acc[ai][bj][m][n], 0, 0, 0) \
                                  : __builtin_amdgcn_mfma_f32_16x16x32_bf16(At[m][k], Bt[n][k], acc[ai][bj][m][n], 0, 0, 0); __builtin_amdgcn_s_setprio(0); } while (0)
#define G8_WAIT_V(n) asm volatile("s_waitcnt vmcnt(" #n ")" ::: "memory")
#define G8_WAIT_L(n) asm volatile("s_waitcnt lgkmcnt(" #n ")" ::: "memory")
#define G8_BAR __builtin_amdgcn_s_barrier()
#define G8_SCHED __builtin_amdgcn_sched_barrier(0)
    typename Src::U cur, nxt; int ui = 0;
    if (!S.next(0, cur)) return;
    f32x4 acc[2][2][4][2];
#pragma unroll
    for (int a = 0; a < 2; ++a)
#pragma unroll
        for (int b = 0; b < 2; ++b)
#pragma unroll
            for (int m = 0; m < 4; ++m)
#pragma unroll
                for (int n = 0; n < 2; ++n) acc[a][b][m][n] = (f32x4){0.f, 0.f, 0.f, 0.f};
    bf16x8 At[4][2], B0[2][2], B1[2][2];
    unsigned cA00 = S.aoff(cur, R0) + C0 * 2u, cA01 = S.aoff(cur, R1) + C1 * 2u, cA10 = S.aoff(cur, HALF + R0) + C0 * 2u, cA11 = S.aoff(cur, HALF + R1) + C1 * 2u;
    const char* cB = S.bbase(cur);
    G8_STAGE_B(G8_SB(0, 0), cB); G8_STAGE_A(G8_SA(0, 0), 0, cA00, cA01); G8_STAGE_B(G8_SB(0, 1), cB + hstepB); G8_STAGE_A(G8_SA(0, 1), 0, cA10, cA11);
    if (wr == 1) G8_BAR;
    G8_WAIT_V(4); G8_BAR;
    G8_STAGE_B(G8_SB(1, 0), cB + kstep); G8_STAGE_A(G8_SA(1, 0), kstep, cA00, cA01); G8_STAGE_B(G8_SB(1, 1), cB + hstepB + kstep);
    G8_WAIT_V(6); G8_BAR;
    for (;;) {
        const bool has_next = S.next(ui + 1, nxt);
        unsigned nA00 = cA00, nA01 = cA01, nA10 = cA10, nA11 = cA11;
        const char* nB = cB;
        if (has_next) {
            nA00 = S.aoff(nxt, R0) + C0 * 2u; nA01 = S.aoff(nxt, R1) + C1 * 2u; nA10 = S.aoff(nxt, HALF + R0) + C0 * 2u; nA11 = S.aoff(nxt, HALF + R1) + C1 * 2u;
            nB = S.bbase(nxt);
        }
#pragma unroll 1
        for (int t = 0; t < NT; t += 2) {
            const bool last = (t == NT - 2);
            const size_t k1 = (size_t)(t + 1) * kstep;
            const size_t k2 = last ? (size_t)0 : (size_t)(t + 2) * kstep, k3 = k2 + kstep;
            const unsigned x00 = last ? nA00 : cA00, x01 = last ? nA01 : cA01, x10 = last ? nA10 : cA10, x11 = last ? nA11 : cA11;
            const char* b2 = (last ? nB : cB) + k2; const char* b3 = b2 + kstep;
            G8_LDB(B0, 0, 0); G8_SCHED; G8_LDA(At, 0, 0); G8_STAGE_A(G8_SA(1, 1), k1, cA10, cA11);
            G8_WAIT_L(8); G8_BAR; G8_WAIT_L(0); G8_MMA(0, 0, At, B0); G8_BAR; G8_SCHED;
            G8_LDB(B1, 0, 1); G8_STAGE_B(G8_SB(0, 0), b2);
            G8_BAR; G8_WAIT_L(0); G8_MMA(0, 1, At, B1); G8_BAR;
            G8_LDA(At, 0, 1); G8_STAGE_A(G8_SA(0, 0), k2, x00, x01);
            G8_BAR; G8_WAIT_L(0); G8_MMA(1, 0, At, B0); G8_BAR; G8_SCHED;
            G8_STAGE_B(G8_SB(0, 1), b2 + hstepB);
            G8_WAIT_V(6); G8_BAR; G8_MMA(1, 1, At, B1); G8_BAR;
            G8_LDB(B0, 1, 0); G8_SCHED; G8_LDA(At, 1, 0); G8_STAGE_A(G8_SA(0, 1), k2, x10, x11);
            G8_WAIT_L(8); G8_BAR; G8_WAIT_L(0); G8_MMA(0, 0, At, B0); G8_BAR; G8_SCHED;
            G8_LDB(B1, 1, 1); G8_STAGE_B(G8_SB(1, 0), b3);
            G8_BAR; G8_WAIT_L(0); G8_MMA(0, 1, At, B1); G8_BAR;
            G8_LDA(At, 1, 1); G8_STAGE_A(G8_SA(1, 0), k3, x00, x01);
            G8_BAR; G8_WAIT_L(0); G8_MMA(1, 0, At, B0); G8_BAR; G8_SCHED;
            G8_STAGE_B(G8_SB(1, 1), b3 + hstepB);
            G8_WAIT_V(6); G8_BAR; G8_MMA(1, 1, At, B1); G8_BAR;
        }
        E(acc, cur, wr, wc, fr, fq);
        if (!has_next) break;
#pragma unroll
        for (int a = 0; a < 2; ++a)
#pragma unroll
            for (int b = 0; b < 2; ++b)
#pragma unroll
                for (int m = 0; m < 4; ++m)
#pragma unroll
                    for (int n = 0; n < 2; ++n) acc[a][b][m][n] = (f32x4){0.f, 0.f, 0.f, 0.f};
        cur = nxt; cA00 = nA00; cA01 = nA01; cA10 = nA10; cA11 = nA11; cB = nB; ++ui;
    }
    G8_WAIT_V(0);
    if (wr == 0) G8_BAR;
    G8_BAR;
#undef G8_SA
#undef G8_SB
#undef G8_STAGE_A
#undef G8_STAGE_B
#undef G8_LDA
#undef G8_LDB
#undef G8_MMA
#undef G8_WAIT_V
#undef G8_WAIT_L
#undef G8_BAR
#undef G8_SCHED
}

struct DenseSrc {
    struct U { int pm, pn; };
    const char* Bt; int nM, nN, nwg, G, c;
    DEVI void init(const void* Bt_, int M, int N, int G_, int c_) { Bt = (const char*)Bt_; nM = M / BM; nN = N / BM; nwg = nM * nN; G = G_; c = c_; }
    DEVI bool next(int i, U& u) const {
        const int L = i * G + c; if (L >= nwg) return false;
        int wgid = L; { const int q = nwg / 8, r = nwg % 8, xcd = wgid % 8, off = wgid / 8; wgid = (xcd < r ? xcd * (q + 1) : r * (q + 1) + (xcd - r) * q) + off; }
        const int nig = 8 * nN, gid = wgid / nig, fm = gid * 8, gsz = (nM - fm) < 8 ? (nM - fm) : 8;
        u.pm = fm + ((wgid % nig) % gsz); u.pn = (wgid % nig) / gsz; return true;
    }
    DEVI unsigned aoff(const U& u, int row) const { return (unsigned)(u.pm * BM + row) * (unsigned)(KK * 2); }
    DEVI const char* bbase(const U& u) const { return Bt + (size_t)u.pn * BM * KK * 2; }
};
}


struct EpiWo {
    u16* o;
    DEVI void operator()(const f32x4 (&acc)[2][2][4][2], const g8::DenseSrc::U& u, int wr, int wc, int fr, int fq) const {
#pragma unroll
        for (int ai = 0; ai < 2; ++ai)
#pragma unroll
            for (int m = 0; m < 4; ++m) {
                const size_t row = (size_t)u.pm * 256 + ai * 128 + wr * 64 + m * 16 + fr;
#pragma unroll
                for (int bj = 0; bj < 2; ++bj) {
                    uint4 v; v.x = pack2(acc[ai][bj][m][0][0], acc[ai][bj][m][0][1]); v.y = pack2(acc[ai][bj][m][0][2], acc[ai][bj][m][0][3]);
                    v.z = pack2(acc[ai][bj][m][1][0], acc[ai][bj][m][1][1]); v.w = pack2(acc[ai][bj][m][1][2], acc[ai][bj][m][1][3]);
                    *(uint4*)(o + row * 1024 + u.pn * 256 + bj * 128 + wc * 32 + fq * 8) = v;
                }
            }
    }
};
DEVI void phase_wo8(const Params& p, char* smem_all) {
    g8::DenseSrc S; S.init(p.ws + OFF_WO, NTOK, 1024, gridDim.x, blockIdx.x);
    EpiWo E; E.o = (u16*)(p.ws + OFF_PRE);
    g8::gemm_phase<true, true>(TIDX, (LAS3 unsigned char*)smem_all, p.ws + OFF_MIX, S, E);
}

DEVI void wo_tile(const Params& p, char* smem, int tile) {
    char* ws = p.ws;
    const int rt = tile >> 3, ct = tile & 7;
    const int tid = VTID, lane = tid & 63, wid = tid >> 6, wr = wid >> 1, wc = wid & 1, fr = lane & 15, fq = lane >> 4;
    const u16* MIX = (const u16*)(ws + OFF_MIX);
    auto arow = [&](int r) { return MIX + (size_t)(rt * 128 + r) * 1024; };
    f32x4 acc[4][4];
    gemm128(tid, arow, (const u16*)(ws + OFF_WO) + (size_t)ct * 128 * 1024, 1024, 1024, smem, acc);
    float* pre = (float*)(ws + OFF_PRE);
#pragma unroll
    for (int m = 0; m < 4; ++m)
#pragma unroll
        for (int n = 0; n < 4; ++n) {
            const int row = rt * 128 + wr * 64 + m * 16 + fq * 4, col = ct * 128 + wc * 64 + n * 16 + fr;
#pragma unroll
            for (int j = 0; j < 4; ++j) {
                const size_t ix = (size_t)(row + j) * 1024 + col;
                pre[ix] = DN_ALPHA * p.x[ix] + acc[m][n][j];
            }
        }
}

DEVI void ln1_router_tile(const Params& p, char* smem, int tile) {
    char* ws = p.ws;
    const int tid = VTID, lane = tid & 63, w = tid >> 6;
    const int tok0 = tile * 32;
    const u16* mixo = (const u16*)(ws + OFF_PRE);
    float* H1 = (float*)(ws + OFF_H1); u16* H1B = (u16*)(ws + OFF_H1B);
    for (int i = 0; i < 8; ++i) {
        const size_t row = (size_t)tok0 + w * 8 + i;
        float4 v[4];
        float s = 0.f;
#pragma unroll
        for (int q = 0; q < 4; ++q) {
            const float4 xv = *(const float4*)(p.x + row * 1024 + q * 256 + lane * 4);
            const uint2 mv = *(const uint2*)(mixo + row * 1024 + q * 256 + lane * 4);
            v[q].x = DN_ALPHA * xv.x + __uint_as_float(mv.x << 16); v[q].y = DN_ALPHA * xv.y + __uint_as_float(mv.x & 0xffff0000u);
            v[q].z = DN_ALPHA * xv.z + __uint_as_float(mv.y << 16); v[q].w = DN_ALPHA * xv.w + __uint_as_float(mv.y & 0xffff0000u);
            s += v[q].x + v[q].y + v[q].z + v[q].w;
        }
        const float mu = wave_sum(s) * (1.f / 1024.f);
        float ss = 0.f;
#pragma unroll
        for (int q = 0; q < 4; ++q) { v[q].x -= mu; v[q].y -= mu; v[q].z -= mu; v[q].w -= mu; ss += v[q].x * v[q].x + v[q].y * v[q].y + v[q].z * v[q].z + v[q].w * v[q].w; }
        const float rs = rsqrtf(wave_sum(ss) * (1.f / 1024.f) + 1e-5f);
#pragma unroll
        for (int q = 0; q < 4; ++q) {
            const int c = q * 256 + lane * 4;
            const float4 gq = *(const float4*)(p.ln1g + c), bq = *(const float4*)(p.ln1b + c);
            float4 o; o.x = v[q].x * rs * gq.x + bq.x; o.y = v[q].y * rs * gq.y + bq.y; o.z = v[q].z * rs * gq.z + bq.z; o.w = v[q].w * rs * gq.w + bq.w;
            *(float4*)(H1 + row * 1024 + c) = o;
            uint2 ob; ob.x = pack2(o.x, o.y); ob.y = pack2(o.z, o.w);
            *(uint2*)(H1B + row * 1024 + c) = ob;
        }
    }
    __threadfence();
    __syncthreads();
    float* part = (float*)smem;
    int* lcnt = (int*)(smem + 4 * 32 * 33 * 4);
    {
        f32x16 acc;
#pragma unroll
        for (int i = 0; i < 16; ++i) acc[i] = 0.f;
        const int i32 = lane & 31, hh = lane >> 5;
        const float* ap = H1 + ((size_t)tok0 + i32) * 1024 + 256 * w + 4 * hh;
        const float* bp = p.w_r + (size_t)(256 * w + 4 * hh) * 32 + i32;
#pragma unroll 2
        for (int m = 0; m < 32; ++m) {
            const float4 a = *(const float4*)(ap + 8 * m);
            const float b0 = bp[(size_t)(8 * m + 0) * 32], b1 = bp[(size_t)(8 * m + 1) * 32], b2 = bp[(size_t)(8 * m + 2) * 32], b3 = bp[(size_t)(8 * m + 3) * 32];
            acc = __builtin_amdgcn_mfma_f32_32x32x2f32(a.x, b0, acc, 0, 0, 0);
            acc = __builtin_amdgcn_mfma_f32_32x32x2f32(a.y, b1, acc, 0, 0, 0);
            acc = __builtin_amdgcn_mfma_f32_32x32x2f32(a.z, b2, acc, 0, 0, 0);
            acc = __builtin_amdgcn_mfma_f32_32x32x2f32(a.w, b3, acc, 0, 0, 0);
        }
#pragma unroll
        for (int r = 0; r < 16; ++r) {
            const int row = (r & 3) + 8 * (r >> 2) + 4 * hh;
            part[(w * 32 + row) * 33 + i32] = acc[r];
        }
    }
    if (tid < 32) lcnt[tid] = 0;
    __syncthreads();
    int e_sel[4]; float w_sel[4]; int rank[4];
    if (tid < 32) {
        float bestv[4]; int besti[4];
        uint32_t used = 0;
#pragma unroll
        for (int k = 0; k < 4; ++k) {
            float bv = -3.0e38f; int bi = 0;
            for (int j = 0; j < 32; ++j) {
                const float lg = part[(0 * 32 + tid) * 33 + j] + part[(1 * 32 + tid) * 33 + j] + part[(2 * 32 + tid) * 33 + j] + part[(3 * 32 + tid) * 33 + j] + p.b_r[j];
                if (!((used >> j) & 1u) && lg > bv) { bv = lg; bi = j; }
            }
            used |= 1u << bi; bestv[k] = bv; besti[k] = bi;
        }
        float den = 0.f;
#pragma unroll
        for (int k = 0; k < 4; ++k) { w_sel[k] = expf(bestv[k] - bestv[0]); den += w_sel[k]; }
#pragma unroll
        for (int k = 0; k < 4; ++k) { w_sel[k] /= den; e_sel[k] = besti[k]; rank[k] = atomicAdd(&lcnt[besti[k]], 1); }
    }
    __syncthreads();
    if (tid < 32) {
        const int c = lcnt[tid];
        int* counts = (int*)((float*)(ws + OFF_MISC) + 1024);
        lcnt[32 + tid] = c ? atomicAdd(&counts[tid], c) : 0;
    }
    __syncthreads();
    if (tid < 32) {
        int* la = (int*)(ws + OFF_LISTA); float* lw = (float*)(ws + OFF_LISTW);
#pragma unroll
        for (int k = 0; k < 4; ++k) {
            const size_t pos = (size_t)e_sel[k] * NTOK + lcnt[32 + e_sel[k]] + rank[k];
            la[pos] = (tok0 + tid) * 4 + k; lw[pos] = w_sel[k];
        }
    }
    __syncthreads();
}

struct MoeMap { int e, rt, ct, cnt, pbase; };
DEVI void moe_setup(const Params& p, int* sm  , int ctn) {
    const int tid = VTID;
    if (tid == 0) {
        const int* counts = (const int*)((const float*)(p.ws + OFF_MISC) + 1024);
        int tp = 0, cp = 0;
        for (int e = 0; e < 32; ++e) {
            const int c = counts[e];
            sm[e] = tp; sm[32 + e] = cp; sm[64 + e] = c;
            tp += ((c + 127) >> 7) * ctn; cp += c;
        }
        sm[96] = tp;
    }
    __syncthreads();
}
DEVI MoeMap moe_map(const int* sm, int tile, int ctn) {
    int e = 0;
#pragma unroll 1
    for (int i = 1; i < 32; ++i) if (sm[i] <= tile) e = i;
    MoeMap m; m.e = e; m.cnt = sm[64 + e]; m.pbase = sm[32 + e];
    const int tl = tile - sm[e], nrt = (m.cnt + 127) >> 7;
    m.ct = tl / nrt; m.rt = tl % nrt;
    return m;
}

DEVI void moe1_tile(const Params& p, char* smem, const MoeMap& mm) {
    char* ws = p.ws;
    const int tid = VTID, lane = tid & 63, wid = tid >> 6, wr = wid >> 1, wc = wid & 1, fr = lane & 15, fq = lane >> 4;
    const int* la = (const int*)(ws + OFF_LISTA) + (size_t)mm.e * NTOK;
    const u16* H1B = (const u16*)(ws + OFF_H1B);
    auto arow = [&](int r) { const int idx = mm.rt * 128 + r; const int tokn = idx < mm.cnt ? (la[idx] >> 2) : 0; return H1B + (size_t)tokn * 1024; };
    const u16* Bt = (const u16*)(ws + OFF_WGU) + ((size_t)mm.e * 2048 + (size_t)mm.ct * 128) * 1024;
    f32x4 acc[4][4];
    gemm128(tid, arow, Bt, 1024, 1024, smem, acc);
    u16* act = (u16*)(ws + OFF_ACT);
    const float* bgu = p.b_gu + (size_t)mm.e * 2048;
#pragma unroll
    for (int m = 0; m < 4; ++m) {
        const int idx0 = mm.rt * 128 + wr * 64 + m * 16 + fq * 4;
#pragma unroll
        for (int i = 0; i < 2; ++i) {
            const int col = 64 * mm.ct + 32 * wc + 16 * i + fr;
            const float bg_ = bgu[col], bu_ = bgu[1024 + col];
#pragma unroll
            for (int j = 0; j < 4; ++j) {
                if (idx0 + j < mm.cnt) {
                    float gt = acc[m][2 * i][j] + bg_; gt = fminf(gt, 7.f);
                    float up = acc[m][2 * i + 1][j] + bu_; up = fminf(fmaxf(up, -7.f), 7.f);
                    const float a = gt * (1.f / (1.f + __expf(-1.702f * gt))) * (up + 1.f);
                    act[(size_t)(mm.pbase + idx0 + j) * 1024 + col] = f2bf(a);
                }
            }
        }
    }
}

DEVI void moe2_tile(const Params& p, char* smem, const MoeMap& mm) {
    char* ws = p.ws;
    const int tid = VTID, lane = tid & 63, wid = tid >> 6, wr = wid >> 1, wc = wid & 1, fr = lane & 15, fq = lane >> 4;
    const u16* act = (const u16*)(ws + OFF_ACT);
    auto arow = [&](int r) { return act + (size_t)(mm.pbase + mm.rt * 128 + r) * 1024; };
    const u16* Bt = (const u16*)(ws + OFF_WDN) + ((size_t)mm.e * 1024 + (size_t)mm.ct * 128) * 1024;
    f32x4 acc[4][4];
    gemm128(tid, arow, Bt, 1024, 1024, smem, acc);
    const int* la = (const int*)(ws + OFF_LISTA) + (size_t)mm.e * NTOK;
    const float* lw = (const float*)(ws + OFF_LISTW) + (size_t)mm.e * NTOK;
    u16* Y = (u16*)(ws + OFF_Y);
    const float* bdn = p.b_dn + (size_t)mm.e * 1024;
#pragma unroll
    for (int m = 0; m < 4; ++m) {
        const int idx0 = mm.rt * 128 + wr * 64 + m * 16 + fq * 4;
#pragma unroll
        for (int j = 0; j < 4; ++j) {
            if (idx0 + j < mm.cnt) {
                const int a = la[idx0 + j]; const float wgt = lw[idx0 + j];
#pragma unroll
                for (int n = 0; n < 4; ++n) {
                    const int col = mm.ct * 128 + wc * 64 + n * 16 + fr;
                    Y[(size_t)a * 1024 + col] = f2bf((acc[m][n][j] + bdn[col]) * wgt);
                }
            }
        }
    }
}

constexpr int MOE_TAB_OFF = 131072;
DEVI void moe_setup8(const Params& p, char* smem_all, int ctn) {
    int* sm = (int*)(smem_all + MOE_TAB_OFF);
    if (TIDX == 0) {
        const int* counts = (const int*)((const float*)(p.ws + OFF_MISC) + 1024);
        int tp = 0, cp = 0;
        for (int e = 0; e < 32; ++e) {
            const int c = counts[e];
            sm[e] = tp; sm[33 + e] = cp; sm[65 + e] = c;
            tp += ((c + 255) >> 8) * ctn; cp += c;
        }
        sm[32] = tp;
    }
    __syncthreads();
}
template <bool GATHER>
struct MoeSrc {
    struct U { int e, rt, pn, cnt, pbase; };
    const LAS3 int* tab; const char* Bt; const int* la; int nrowsB, G, c;
    DEVI bool next(int i, U& u) const {
        const int L = i * G + c; if (L >= tab[32]) return false;
        int e = 0;
#pragma unroll 1
        for (int k = 1; k < 32; ++k) e = (tab[k] <= L) ? k : e;
        u.e = e; u.cnt = tab[65 + e]; u.pbase = tab[33 + e];
        const int tl = L - tab[e], nrt = (u.cnt + 255) >> 8;
        u.pn = tl / nrt; u.rt = tl - u.pn * nrt;
        return true;
    }
    DEVI unsigned aoff(const U& u, int row) const {
        const int idx = u.rt * 256 + row;
        if (GATHER) { const int tokn = idx < u.cnt ? (la[(size_t)u.e * NTOK + idx] >> 2) : 0; return (unsigned)tokn * 2048u; }
        return (unsigned)(u.pbase + idx) * 2048u;
    }
    DEVI const char* bbase(const U& u) const { return Bt + ((size_t)u.e * nrowsB + (size_t)u.pn * 256) * 2048; }
};
struct EpiMoe1 {
    const float* b_gu; u16* act;
    DEVI void operator()(const f32x4 (&acc)[2][2][4][2], const MoeSrc<true>::U& u, int wr, int wc, int fr, int fq) const {
        const float* bg = b_gu + (size_t)u.e * 2048;
        float4 bgate[2], bup[2];
#pragma unroll
        for (int bj = 0; bj < 2; ++bj) {
            const int col = u.pn * 128 + (bj * 4 + wc) * 16 + 4 * fq;
            bgate[bj] = *(const float4*)(bg + col); bup[bj] = *(const float4*)(bg + 1024 + col);
        }
#pragma unroll
        for (int ai = 0; ai < 2; ++ai)
#pragma unroll
            for (int m = 0; m < 4; ++m) {
                const int idx = u.rt * 256 + ai * 128 + wr * 64 + m * 16 + fr;
                if (idx < u.cnt) {
#pragma unroll
                    for (int bj = 0; bj < 2; ++bj) {
                        const int col = u.pn * 128 + (bj * 4 + wc) * 16 + 4 * fq;
                        const float bgv[4] = {bgate[bj].x, bgate[bj].y, bgate[bj].z, bgate[bj].w};
                        const float buv[4] = {bup[bj].x, bup[bj].y, bup[bj].z, bup[bj].w};
                        f32x4 a;
#pragma unroll
                        for (int j = 0; j < 4; ++j) {
                            float gt = acc[ai][bj][m][0][j] + bgv[j]; gt = fminf(gt, 7.f);
                            float up = acc[ai][bj][m][1][j] + buv[j]; up = fminf(fmaxf(up, -7.f), 7.f);
                            a[j] = gt * (1.f / (1.f + __expf(-1.702f * gt))) * (up + 1.f);
                        }
                        *(uint2*)(act + (size_t)(u.pbase + idx) * 1024 + col) = pack4(a);
                    }
                }
            }
    }
};
struct EpiMoe2 {
    const float* b_dn; const int* la; const float* lw; u16* Y;
    DEVI void operator()(const f32x4 (&acc)[2][2][4][2], const MoeSrc<false>::U& u, int wr, int wc, int fr, int fq) const {
        const float* bd = b_dn + (size_t)u.e * 1024;
#pragma unroll
        for (int ai = 0; ai < 2; ++ai) {
            int av[4]; float wv[4];
#pragma unroll
            for (int m = 0; m < 4; ++m) {
                const int idx = u.rt * 256 + ai * 128 + wr * 64 + m * 16 + fr;
                const bool ok = idx < u.cnt;
                av[m] = ok ? la[(size_t)u.e * NTOK + idx] : -1;
                wv[m] = ok ? lw[(size_t)u.e * NTOK + idx] : 0.f;
            }
#pragma unroll
            for (int bj = 0; bj < 2; ++bj) {
                const int col = u.pn * 256 + bj * 128 + wc * 32 + fq * 8;
                const float4 b0 = *(const float4*)(bd + col), b1 = *(const float4*)(bd + col + 4);
#pragma unroll
                for (int m = 0; m < 4; ++m) {
                    if (av[m] >= 0) {
                        const float wgt = wv[m];
                        uint4 v;
                        v.x = pack2((acc[ai][bj][m][0][0] + b0.x) * wgt, (acc[ai][bj][m][0][1] + b0.y) * wgt);
                        v.y = pack2((acc[ai][bj][m][0][2] + b0.z) * wgt, (acc[ai][bj][m][0][3] + b0.w) * wgt);
                        v.z = pack2((acc[ai][bj][m][1][0] + b1.x) * wgt, (acc[ai][bj][m][1][1] + b1.y) * wgt);
                        v.w = pack2((acc[ai][bj][m][1][2] + b1.z) * wgt, (acc[ai][bj][m][1][3] + b1.w) * wgt);
                        *(uint4*)(Y + (size_t)av[m] * 1024 + col) = v;
                    }
                }
            }
        }
    }
};
DEVI void phase_moe1_8(const Params& p, char* smem_all) {
    moe_setup8(p, smem_all, 8);
    MoeSrc<true> S; S.tab = (const LAS3 int*)(smem_all + MOE_TAB_OFF); S.Bt = p.ws + OFF_WGU; S.la = (const int*)(p.ws + OFF_LISTA); S.nrowsB = 2048; S.G = gridDim.x; S.c = blockIdx.x;
    EpiMoe1 E; E.b_gu = p.b_gu; E.act = (u16*)(p.ws + OFF_ACT);
    g8::gemm_phase<true, false>(TIDX, (LAS3 unsigned char*)smem_all, p.ws + OFF_H1B, S, E);
}
DEVI void phase_moe2_8(const Params& p, char* smem_all) {
    moe_setup8(p, smem_all, 4);
    MoeSrc<false> S; S.tab = (const LAS3 int*)(smem_all + MOE_TAB_OFF); S.Bt = p.ws + OFF_WDN; S.la = nullptr; S.nrowsB = 1024; S.G = gridDim.x; S.c = blockIdx.x;
    EpiMoe2 E; E.b_dn = p.b_dn; E.la = (const int*)(p.ws + OFF_LISTA); E.lw = (const float*)(p.ws + OFF_LISTW); E.Y = (u16*)(p.ws + OFF_Y);
    g8::gemm_phase<true, true>(TIDX, (LAS3 unsigned char*)smem_all, p.ws + OFF_ACT, S, E);
}

struct EpiProjT {
    char* ws; const float* lb;
    DEVI void operator()(const f32x4 (&acc)[2][2][4][2], const g8::DenseSrc::U& u, int wr, int wc, int fr, int fq) const {
        const int mt = u.pn;
        float4 lb0[2], lb1[2];
        if (mt == 6 || mt == 7) {
#pragma unroll
            for (int bj = 0; bj < 2; ++bj) { const int hk = (mt - 6) * 256 + bj * 128 + wc * 32 + fq * 8; lb0[bj] = *(const float4*)(lb + hk); lb1[bj] = *(const float4*)(lb + hk + 4); }
        }
#pragma unroll
        for (int ai = 0; ai < 2; ++ai)
#pragma unroll
            for (int m = 0; m < 4; ++m) {
                const int tok = u.pm * 256 + ai * 128 + wr * 64 + m * 16 + fr;
                const int b = tok >> 13, s = tok & 8191;
#pragma unroll
                for (int bj = 0; bj < 2; ++bj) {
                    const int c8 = bj * 128 + wc * 32 + fq * 8;
                    const f32x4 v0 = acc[ai][bj][m][0], v1 = acc[ai][bj][m][1];
                    if (mt < 2) {
                        uint4 o; const float qs_ = 0.125f * 1.4426950408889634f;
                        o.x = pack2(v0[0] * qs_, v0[1] * qs_); o.y = pack2(v0[2] * qs_, v0[3] * qs_);
                        o.z = pack2(v1[0] * qs_, v1[1] * qs_); o.w = pack2(v1[2] * qs_, v1[3] * qs_);
                        *(uint4*)((u16*)(ws + OFF_Q) + (size_t)tok * 512 + mt * 256 + c8) = o;
                    } else if (mt < 4) {
                        const int g = wc >> 1, d0 = (wc & 1) * 32 + fq * 8;
                        uint4 o; o.x = pack2(v0[0], v0[1]); o.y = pack2(v0[2], v0[3]); o.z = pack2(v1[0], v1[1]); o.w = pack2(v1[2], v1[3]);
                        u16* dst;
                        if (mt == 2) dst = (u16*)(ws + (bj ? OFF_VCR : OFF_KCR)) + ((size_t)(b * 2 + g) * SP + s) * 64 + d0;
                        else dst = (u16*)(ws + (bj ? OFF_KW : OFF_KS)) + ((size_t)(b * 2 + g) * 8192 + s) * 64 + d0;
                        *(uint4*)dst = o;
                    } else if (mt < 6) {
                        uint4 o; o.x = pack2(v0[0], v0[1]); o.y = pack2(v0[2], v0[3]); o.z = pack2(v1[0], v1[1]); o.w = pack2(v1[2], v1[3]);
                        *(uint4*)((u16*)(ws + OFF_QH) + (size_t)tok * 512 + (mt - 4) * 256 + c8) = o;
                    } else if (mt < 8) {
                        const float lv[8] = {lb0[bj].x, lb0[bj].y, lb0[bj].z, lb0[bj].w, lb1[bj].x, lb1[bj].y, lb1[bj].z, lb1[bj].w};
                        float r[8];
#pragma unroll
                        for (int j = 0; j < 8; ++j) {
                            const float z = j < 4 ? v0[j & 3] : v1[j & 3];
                            const float fh = 1.f / (1.f + expf(-z));
                            r[j] = logf(lv[j] + (1.f - lv[j]) * fh);
                        }
                        float* dst = (float*)(ws + OFF_LOGF) + (size_t)tok * 512 + (mt - 6) * 256 + c8;
                        *(float4*)dst = make_float4(r[0], r[1], r[2], r[3]); *(float4*)(dst + 4) = make_float4(r[4], r[5], r[6], r[7]);
                    } else {
                        float r[8];
#pragma unroll
                        for (int j = 0; j < 8; ++j) { const float z = j < 4 ? v0[j & 3] : v1[j & 3]; r[j] = z / (1.f + __expf(-z)); }
                        uint4 o; o.x = pack2(r[0], r[1]); o.y = pack2(r[2], r[3]); o.z = pack2(r[4], r[5]); o.w = pack2(r[6], r[7]);
                        *(uint4*)((u16*)(ws + OFF_GH) + (size_t)tok * 512 + (mt - 8) * 256 + c8) = o;
                    }
                }
            }
    }
};
struct EpiProjN {
    char* ws;
    DEVI void operator()(const f32x4 (&acc)[2][2][4][2], const g8::DenseSrc::U& u, int wr, int wc, int fr, int fq) const {
        const int mt = u.pn;
#pragma unroll
        for (int ai = 0; ai < 2; ++ai)
#pragma unroll
            for (int m = 0; m < 4; ++m) {
                const int tok = u.pm * 256 + ai * 128 + wr * 64 + m * 16 + fq * 4;
                const int b = tok >> 13, s = tok & 8191;
#pragma unroll
                for (int bj = 0; bj < 2; ++bj)
#pragma unroll
                    for (int n = 0; n < 2; ++n) {
                        const int c = bj * 128 + wc * 32 + n * 16 + fr;
                        u16* dst;
                        if (mt == 0) {
                            const int g = wc >> 1, d = (wc & 1) * 32 + n * 16 + fr;
                            dst = (u16*)(ws + (bj ? OFF_VWT : OFF_VST)) + (((size_t)(b * 2 + g) * 128 + (s >> 6)) * 64 + d) * 64 + (s & 63);
                        } else {
                            const int hv = (mt - 1) * 256 + c;
                            dst = (u16*)(ws + OFF_VTH) + (((size_t)(b * 4 + (hv >> 7)) * 128 + (s >> 6)) * 128 + (hv & 127)) * 64 + (s & 63);
                        }
                        *(uint2*)dst = pack4(acc[ai][bj][m][n]);
                    }
            }
    }
};
DEVI void phase_proj8(const Params& p, char* smem_all) {
    {
        g8::DenseSrc S; S.init(p.ws + OFF_WIN, NTOK, 2560, gridDim.x, blockIdx.x);
        EpiProjT E; E.ws = p.ws; E.lb = (const float*)(p.ws + OFF_MISC) + 512;
        g8::gemm_phase<true, true>(TIDX, (LAS3 unsigned char*)smem_all, p.ws + OFF_XB, S, E);
    }
    {
        g8::DenseSrc S; S.init(p.ws + OFF_WIN + (size_t)2560 * 2048, NTOK, 768, gridDim.x, blockIdx.x);
        EpiProjN E; E.ws = p.ws;
        g8::gemm_phase<false, false>(TIDX, (LAS3 unsigned char*)smem_all, p.ws + OFF_XB, S, E);
    }
}
DEVI void gates_tile(const Params& p, char* smem, int rt) {
    char* ws = p.ws;
    const int tid = VTID, lane = tid & 63, wid = tid >> 6, wr = wid >> 1, wc = wid & 1, fr = lane & 15, fq = lane >> 4;
    const u16* XB = (const u16*)(ws + OFF_XB);
    auto arow = [&](int r) { return XB + (size_t)(rt * 128 + r) * 1024; };
    f32x4 acc[4][4];
    gemm128(tid, arow, (const u16*)(ws + OFF_WIN) + (size_t)3328 * 1024, 1024, 1024, smem, acc);
    if (wc == 0) {
        float* dst = (float*)(ws + OFF_GATES);
#pragma unroll
        for (int m = 0; m < 4; ++m)
#pragma unroll
            for (int n = 0; n < 2; ++n) {
                const int cc = n * 16 + fr, tok = rt * 128 + wr * 64 + m * 16 + fq * 4;
                if (cc < 24) {
#pragma unroll
                    for (int j = 0; j < 4; ++j) dst[(size_t)(tok + j) * 24 + cc] = 1.f / (1.f + expf(-acc[m][n][j]));
                }
            }
    }
}
DEVI void rope_task(const Params& p, int task) {
    char* ws = p.ws;
    const int gid = task * 256 + VTID;
    const int tok = gid / 12, vec = gid - tok * 12;
    const int b = tok >> 13, s = tok & 8191;
    u16* ptr;
    if (vec < 8) ptr = (u16*)(ws + OFF_Q) + (size_t)tok * 512 + vec * 64;
    else { const int g = vec & 1; ptr = (u16*)(ws + (vec < 10 ? OFF_KS : OFF_KW)) + ((size_t)(b * 2 + g) * 8192 + s) * 64; }
    const float* cs = (const float*)(ws + OFF_ROPE) + (size_t)tok * 8;
    const float4 c0 = *(const float4*)cs, c1 = *(const float4*)(cs + 4), s0 = *(const float4*)(cs + (size_t)NTOK * 8), s1 = *(const float4*)(cs + (size_t)NTOK * 8 + 4);
    const uint4 a = *(const uint4*)ptr, bq = *(const uint4*)(ptr + 8);
    const float cv[8] = {c0.x, c0.y, c0.z, c0.w, c1.x, c1.y, c1.z, c1.w}, sv[8] = {s0.x, s0.y, s0.z, s0.w, s1.x, s1.y, s1.z, s1.w};
    const uint32_t aw[4] = {a.x, a.y, a.z, a.w}, bw[4] = {bq.x, bq.y, bq.z, bq.w};
    float o1[8], o2[8];
#pragma unroll
    for (int i = 0; i < 8; ++i) {
        const float x1 = (i & 1) ? __uint_as_float(aw[i >> 1] & 0xffff0000u) : __uint_as_float(aw[i >> 1] << 16);
        const float x2 = (i & 1) ? __uint_as_float(bw[i >> 1] & 0xffff0000u) : __uint_as_float(bw[i >> 1] << 16);
        o1[i] = x1 * cv[i] - x2 * sv[i]; o2[i] = x2 * cv[i] + x1 * sv[i];
    }
    uint4 oa, ob;
    oa.x = pack2(o1[0], o1[1]); oa.y = pack2(o1[2], o1[3]); oa.z = pack2(o1[4], o1[5]); oa.w = pack2(o1[6], o1[7]);
    ob.x = pack2(o2[0], o2[1]); ob.y = pack2(o2[2], o2[3]); ob.z = pack2(o2[4], o2[5]); ob.w = pack2(o2[6], o2[7]);
    *(uint4*)ptr = oa; *(uint4*)(ptr + 8) = ob;
}

DEVI void final_rows(const Params& p, int task) {
    char* ws = p.ws;
    const int tid = VTID, lane = tid & 63, w = tid >> 6;
    const float* H1 = (const float*)(ws + OFF_H1); const u16* Y = (const u16*)(ws + OFF_Y);
    for (int i = 0; i < 8; ++i) {
        const size_t row = (size_t)task * 32 + w * 8 + i;
        float4 v[4];
        float s = 0.f;
#pragma unroll
        for (int q = 0; q < 4; ++q) {
            const int c = q * 256 + lane * 4;
            float4 a = *(const float4*)(H1 + row * 1024 + c);
            a.x *= DN_ALPHA; a.y *= DN_ALPHA; a.z *= DN_ALPHA; a.w *= DN_ALPHA;
#pragma unroll
            for (int k = 0; k < 4; ++k) {
                const uint2 y = *(const uint2*)(Y + (row * 4 + k) * 1024 + c);
                a.x += __uint_as_float(y.x << 16); a.y += __uint_as_float(y.x & 0xffff0000u);
                a.z += __uint_as_float(y.y << 16); a.w += __uint_as_float(y.y & 0xffff0000u);
            }
            v[q] = a; s += a.x + a.y + a.z + a.w;
        }
        const float mu = wave_sum(s) * (1.f / 1024.f);
        float ss = 0.f;
#pragma unroll
        for (int q = 0; q < 4; ++q) { v[q].x -= mu; v[q].y -= mu; v[q].z -= mu; v[q].w -= mu; ss += v[q].x * v[q].x + v[q].y * v[q].y + v[q].z * v[q].z + v[q].w * v[q].w; }
        const float rs = rsqrtf(wave_sum(ss) * (1.f / 1024.f) + 1e-5f);
#pragma unroll
        for (int q = 0; q < 4; ++q) {
            const int c = q * 256 + lane * 4;
            const float4 gq = *(const float4*)(p.ln2g + c), bq = *(const float4*)(p.ln2b + c);
            float4 o; o.x = v[q].x * rs * gq.x + bq.x; o.y = v[q].y * rs * gq.y + bq.y; o.z = v[q].z * rs * gq.z + bq.z; o.w = v[q].w * rs * gq.w + bq.w;
            *(float4*)(p.out + row * 1024 + c) = o;
        }
    }
}

DEVI void run_phase(const Params& p, char* smem, char* smem_all, int ph) {
    const int G = VGRID, B0 = VBID;
#ifdef ONLY_PHASE
    if (ph != ONLY_PHASE) return;
#endif
    switch (ph) {
    case 0: phase_prep(p, smem); break;
    case 1: phase_proj8(p, smem_all); break;
    case 2:
        for (int t = B0; t < 128; t += G) cmp1_tile(p, smem, t);
        for (int t = B0; t < 256; t += G) gates_tile(p, smem, t);
        for (int t = B0; t < 1536; t += G) rope_task(p, t);
        for (int t = B0; t < 2048; t += G) hgrn_local_tile(p, smem, t);
        break;
    case 3:
        for (int t = B0; t < 64; t += G) cmp2_tile(p, smem, t);
        for (int t = G - 1 - B0; t < 512; t += G) hgrn_scan_task(p, t);
        break;
    case 4:
#ifndef NO_NSA
        for (int t = blockIdx.x; t < NSA_TILES; t += gridDim.x) nsa_tile(p, smem_all, t);
#endif
#ifndef NO_HG3
        for (int t = G - 1 - B0; t < 2048; t += G) hgrn_out_tile(p, smem, t);
#endif
        break;
    case 5:
        phase_wo8(p, smem_all);
        break;
    case 6:
        for (int t = B0; t < 1024; t += G) ln1_router_tile(p, smem, t);
        break;
    case 7: phase_moe1_8(p, smem_all); break;
    case 8: phase_moe2_8(p, smem_all); break;
    case 9:
        for (int t = B0; t < 1024; t += G) final_rows(p, t);
        break;
    }
}

#if N_LAUNCH_MODE == 1
__global__ void __launch_bounds__(512, 2) fwd_kernel(Params p_in) {
    extern __shared__ __attribute__((aligned(16))) char smem_all[];
    Params p = p_in;
    p.ph_lo = __builtin_amdgcn_readfirstlane((int)(threadIdx.x >> 6));
    char* smem = smem_all + (p.ph_lo >> 2) * 65536;
    cg::grid_group grid = cg::this_grid();
#ifndef PROBE_REP
#define PROBE_REP -1
#endif
#define RP(k) run_phase(p, smem, smem_all, k); grid.sync(); if (PROBE_REP == k) { run_phase(p, smem, smem_all, k); grid.sync(); }
    RP(0) RP(1) RP(2)
    run_phase(p, smem, smem_all, 3); grid.sync();
    if (PROBE_REP == 23) { run_phase(p, smem, smem_all, 2); grid.sync(); run_phase(p, smem, smem_all, 3); grid.sync(); }
    RP(4) RP(5)
    run_phase(p, smem, smem_all, 6); grid.sync();
    if (PROBE_REP == 6) {
        if (blockIdx.x == 0 && TIDX < 32) ((int*)((float*)(p.ws + OFF_MISC) + 1024))[TIDX] = 0;
        grid.sync(); run_phase(p, smem, smem_all, 6); grid.sync();
    }
    RP(7) RP(8)
    run_phase(p, smem, smem_all, 9);
    if (PROBE_REP == 9) { grid.sync(); run_phase(p, smem, smem_all, 9); }
#undef RP
}
#define KFN fwd_kernel
#else
template <int PH>
__global__ void __launch_bounds__(256, 2) phase_kernel(Params p) {
    extern __shared__ __attribute__((aligned(16))) char smem[];
    run_phase(p, smem, PH);
}
#define KFN phase_kernel<4>
#endif

extern "C" void kernel_launch(void* const* d_in, const int* in_sizes, int n_in, void* d_out, int out_size, void* d_ws, size_t ws_size,
                              hipStream_t stream) {
    static int grid = 0;
    if (grid == 0) {
        if (ws_size < WS_NEED) { fprintf(stderr, "kernel_launch: workspace too small: %zu < %zu\n", ws_size, (size_t)WS_NEED); grid = -1; return; }
        int dev = 0, cus = 0, per_cu = 0;
        (void)hipGetDevice(&dev);
        (void)hipDeviceGetAttribute(&cus, hipDeviceAttributeMultiprocessorCount, dev);
#if N_LAUNCH_MODE == 1
        (void)hipFuncSetAttribute((const void*)KFN, hipFuncAttributeMaxDynamicSharedMemorySize, SMEM_BYTES);
#else
#define SA_(PH) (void)hipFuncSetAttribute((const void*)phase_kernel<PH>, hipFuncAttributeMaxDynamicSharedMemorySize, SMEM_BYTES);
        SA_(0) SA_(1) SA_(2) SA_(3) SA_(4) SA_(5) SA_(6) SA_(7) SA_(8) SA_(9)
#undef SA_
#endif
        (void)hipOccupancyMaxActiveBlocksPerMultiprocessor(&per_cu, (const void*)KFN, 512, SMEM_BYTES);
        if (per_cu < 1) per_cu = 1;
        if (per_cu > 1) per_cu = 1;
        grid = cus * per_cu;
    }
    if (grid < 0) return;
    Params p{};
    p.x = (const float*)d_in[0]; p.pos = (const int*)d_in[1]; p.w_in = (const float*)d_in[2]; p.pe = (const float*)d_in[3];
    p.w_ck1 = (const float*)d_in[4]; p.w_ck2 = (const float*)d_in[5]; p.w_cv1 = (const float*)d_in[6]; p.w_cv2 = (const float*)d_in[7];
    p.hg_lb = (const float*)d_in[8]; p.hg_ng = (const float*)d_in[9]; p.w_o = (const float*)d_in[10]; p.ln1g = (const float*)d_in[11];
    p.ln1b = (const float*)d_in[12]; p.w_r = (const float*)d_in[13]; p.b_r = (const float*)d_in[14]; p.w_gu = (const float*)d_in[15];
    p.b_gu = (const float*)d_in[16]; p.w_dn = (const float*)d_in[17]; p.b_dn = (const float*)d_in[18]; p.ln2g = (const float*)d_in[19];
    p.ln2b = (const float*)d_in[20];
    p.out = (float*)d_out; p.ws = (char*)d_ws;
#if N_LAUNCH_MODE == 1
    p.ph_lo = 0; p.ph_hi = NPHASE;
    void* args[] = {&p};
    hipError_t e = hipLaunchCooperativeKernel((const void*)fwd_kernel, dim3(grid), dim3(512), args, SMEM_BYTES, stream);
    if (e != hipSuccess) fprintf(stderr, "cooperative launch failed: %s (grid %d)\n", hipGetErrorString(e), grid);
#else
    p.ph_lo = 0; p.ph_hi = NPHASE;
#define LP(PH) hipLaunchKernelGGL(phase_kernel<PH>, dim3(grid), dim3(256), SMEM_BYTES, stream, p);
    LP(0) LP(1) LP(2) LP(3) LP(4) LP(5) LP(6) LP(7) LP(8) LP(9)
#undef LP
#endif
}
```

```cpp
#include <hip/hip_runtime.h>
#include <hip/hip_cooperative_groups.h>
#include <stdint.h>
#include <stdio.h>
namespace cg = cooperative_groups;

typedef unsigned short u16;
typedef __attribute__((ext_vector_type(8))) short bf16x8;
typedef __attribute__((ext_vector_type(4))) float f32x4;
typedef __attribute__((ext_vector_type(16))) float f32x16;
#define DEVI __device__ __forceinline__
static __device__ __forceinline__ int laneid_() { int r; asm volatile("v_mbcnt_lo_u32_b32 %0, -1, 0\n\tv_mbcnt_hi_u32_b32 %0, -1, %0" : "=v"(r)); return r; }
#define LANEID (laneid_())
#define TIDX (p.ph_lo * 64 + LANEID)
#define VTID ((p.ph_lo & 3) * 64 + LANEID)
#define VBID ((int)(blockIdx.x * 2 + (p.ph_lo >> 2)))
#define VGRID ((int)(gridDim.x * 2))

#ifndef N_LAUNCH_MODE
#define N_LAUNCH_MODE 1
#endif

constexpr int NTOK = 32768, SEQ = 8192, NB = 4;
constexpr int SP = 8224;
constexpr int NPHASE = 10;
constexpr int XCD_BAR_WORDS_ = 3456;
constexpr int SMEM_BYTES = 131072 + 1024;
constexpr float DN_ALPHA = 1.189207115002721f;

constexpr size_t MB = 1ull << 20;
constexpr size_t OFF_WIN = 0;
constexpr size_t OFF_WCK1 = 7 * MB;
constexpr size_t OFF_WCV1 = 8 * MB;
constexpr size_t OFF_WCK2 = 9 * MB;
constexpr size_t OFF_WCV2 = 9 * MB + 65536;
constexpr size_t OFF_WO = 10 * MB;
constexpr size_t OFF_ROPE = 12 * MB;
constexpr size_t OFF_GATES = 14 * MB;
constexpr size_t OFF_MISC = 17 * MB;
constexpr size_t OFF_BAR = 17 * MB + 32768;
constexpr size_t OFF_LISTA = 18 * MB;
constexpr size_t OFF_LISTW = 22 * MB;
constexpr size_t OFF_HID = 26 * MB;
constexpr size_t OFF_KC = 30 * MB;
constexpr size_t OFF_VCT = 30 * MB + 524288;
constexpr size_t OFF_DG = 31 * MB;
constexpr size_t OFF_WGU = 32 * MB;
constexpr size_t OFF_WDN = 160 * MB;
constexpr size_t OFF_H1 = 224 * MB;
constexpr size_t OFF_H1B = 352 * MB;
constexpr size_t OFF_X = 416 * MB;
constexpr size_t OFF_XB = OFF_X;
constexpr size_t OFF_Q = OFF_X + 64 * MB;
constexpr size_t OFF_KCR = OFF_X + 96 * MB;
constexpr size_t OFF_VCR = OFF_X + 105 * MB;
constexpr size_t OFF_KS = OFF_X + 114 * MB;
constexpr size_t OFF_KW = OFF_X + 123 * MB;
constexpr size_t OFF_VST = OFF_X + 132 * MB;
constexpr size_t OFF_VWT = OFF_X + 141 * MB;
constexpr size_t OFF_QH = OFF_X + 150 * MB;
constexpr size_t OFF_LOGF = OFF_X + 182 * MB;
constexpr size_t OFF_VTH = OFF_X + 246 * MB;
constexpr size_t OFF_GH = OFF_X + 278 * MB;
constexpr size_t OFF_LBUF = OFF_X + 310 * MB;
constexpr size_t OFF_MIX = OFF_X + 374 * MB;
constexpr size_t OFF_PRE = OFF_X;
constexpr size_t OFF_ACT = OFF_X;
constexpr size_t OFF_Y = OFF_X + 256 * MB;
constexpr size_t WS_NEED = OFF_Y + 256 * MB;

struct Params {
    const float* x; const int* pos; const float* w_in; const float* pe;
    const float* w_ck1; const float* w_ck2; const float* w_cv1; const float* w_cv2;
    const float* hg_lb; const float* hg_ng; const float* w_o; const float* ln1g; const float* ln1b;
    const float* w_r; const float* b_r; const float* w_gu; const float* b_gu; const float* w_dn; const float* b_dn;
    const float* ln2g; const float* ln2b;
    float* out; char* ws;
    int ph_lo, ph_hi;
};

DEVI u16 f2bf(float f) { uint32_t u = __float_as_uint(f); u += 0x7fffu + ((u >> 16) & 1u); return (u16)(u >> 16); }
DEVI float bf2f(u16 h) { return __uint_as_float(((uint32_t)h) << 16); }
typedef float f32x2_t __attribute__((ext_vector_type(2)));
typedef __bf16 bf16x2_t __attribute__((ext_vector_type(2)));
DEVI uint32_t pack2(float a, float b) { f32x2_t v = {a, b}; bf16x2_t r = __builtin_convertvector(v, bf16x2_t); return __builtin_bit_cast(uint32_t, r); }
DEVI bf16x8 pack8(f32x4 a, f32x4 b) {
    union { bf16x8 v; uint32_t u[4]; } r;
    r.u[0] = pack2(a[0], a[1]); r.u[1] = pack2(a[2], a[3]); r.u[2] = pack2(b[0], b[1]); r.u[3] = pack2(b[2], b[3]);
    return r.v;
}
DEVI uint2 pack4(f32x4 a) { uint2 r; r.x = pack2(a[0], a[1]); r.y = pack2(a[2], a[3]); return r; }
DEVI f32x4 mfma16(bf16x8 a, bf16x8 b, f32x4 c) { return __builtin_amdgcn_mfma_f32_16x16x32_bf16(a, b, c, 0, 0, 0); }
DEVI bf16x8 ld8(const u16* p) { return *reinterpret_cast<const bf16x8*>(p); }
DEVI bf16x8 zero8() { bf16x8 z = {0, 0, 0, 0, 0, 0, 0, 0}; return z; }
DEVI float sigmoidf_(float v) { return 1.f / (1.f + __expf(-v)); }
DEVI float xor16_max(float v) { v = fmaxf(v, __shfl_xor(v, 16)); v = fmaxf(v, __shfl_xor(v, 32)); return v; }
DEVI float xor16_sum(float v) { v += __shfl_xor(v, 16); v += __shfl_xor(v, 32); return v; }
DEVI float wave_sum(float v) {
#pragma unroll
    for (int o = 32; o > 0; o >>= 1) v += __shfl_xor(v, o);
    return v;
}
DEVI void glds16(const u16* g, u16* l) {
    __builtin_amdgcn_global_load_lds((const unsigned*)g, (__attribute__((address_space(3))) unsigned*)l, 16, 0, 0);
}

template <class AFn>
DEVI void gemm128(const int tid, AFn arow, const u16* __restrict__ Bt, size_t ldb, int K, char* smem, f32x4 (&acc)[4][4]) {
    const int lane = tid & 63, wid = tid >> 6, wr = wid >> 1, wc = wid & 1, fr = lane & 15, fq = lane >> 4;
    u16* SA = (u16*)smem; u16* SB = (u16*)(smem + 8192);
    const int r0 = tid >> 2, c0 = (tid & 3) * 8;
    const u16* a0 = arow(r0) + c0; const u16* a1 = arow(r0 + 64) + c0;
    const u16* b0 = Bt + (size_t)r0 * ldb + c0; const u16* b1 = Bt + (size_t)(r0 + 64) * ldb + c0;
#pragma unroll
    for (int m = 0; m < 4; ++m)
#pragma unroll
        for (int n = 0; n < 4; ++n) acc[m][n] = f32x4{0.f, 0.f, 0.f, 0.f};
    for (int kt = 0; kt < K; kt += 32) {
        glds16(a0 + kt, SA + tid * 8); glds16(a1 + kt, SA + 2048 + tid * 8);
        glds16(b0 + kt, SB + tid * 8); glds16(b1 + kt, SB + 2048 + tid * 8);
        asm volatile("s_waitcnt vmcnt(0)" ::: "memory");
        __syncthreads();
        bf16x8 af[4], bfr[4];
#pragma unroll
        for (int m = 0; m < 4; ++m) af[m] = ld8(SA + (wr * 64 + m * 16 + fr) * 32 + fq * 8);
#pragma unroll
        for (int n = 0; n < 4; ++n) bfr[n] = ld8(SB + (wc * 64 + n * 16 + fr) * 32 + fq * 8);
#pragma unroll
        for (int m = 0; m < 4; ++m)
#pragma unroll
            for (int n = 0; n < 4; ++n) acc[m][n] = mfma16(af[m], bfr[n], acc[m][n]);
        __syncthreads();
    }
}

template <class CM>
DEVI void tconv_tile(const int tid, const float* __restrict__ src, size_t ld, u16* __restrict__ dst, size_t ldd, int r0, int k0, CM colmap, char* smem) {
    float (*t)[65] = (float (*)[65])smem;
    {
        const int n = tid & 63; const int col = colmap(r0 + n);
#pragma unroll 4
        for (int i = 0; i < 16; ++i) {
            const int k = (tid >> 6) + 4 * i;
            t[k][n] = (col >= 0) ? src[(size_t)(k0 + k) * ld + col] : 0.f;
        }
    }
    __syncthreads();
    {
        const int k2 = (tid & 31) * 2;
#pragma unroll 4
        for (int i = 0; i < 8; ++i) {
            const int n = (tid >> 5) + 8 * i;
            *(uint32_t*)(dst + (size_t)(r0 + n) * ldd + k0 + k2) = pack2(t[k2][n], t[k2 + 1][n]);
        }
    }
    __syncthreads();
}

DEVI void phase_prep(const Params& p, char* smem) {
    char* ws = p.ws;
    constexpr int J_WIN = 54 * 16;
    constexpr int J_WCK1 = 4 * 32;
    constexpr int J_WC2 = 2 * 4;
    constexpr int J_WO = 16 * 16;
    constexpr int J_WGU = 32 * 32 * 16;
    constexpr int J_WDN = 32 * 16 * 16;
    constexpr int J_XB = 16384;
    constexpr int J_ROPE = 1024;
    constexpr int J0 = 0, J1 = J0 + J_WIN, J2 = J1 + 2 * J_WCK1, J3 = J2 + 2 * J_WC2, J4 = J3 + J_WO, J5 = J4 + J_WGU,
                  J6 = J5 + J_WDN, J7 = J6 + J_XB, J8 = J7 + J_ROPE, J9 = J8 + 1;
    for (int job = VBID; job < J9; job += VGRID) {
        const int tid = VTID;
        if (job < J1) {
            const int j = job - J0, rt = j / 16, kt = j % 16;
            auto cm = [](int r) {
                if (r < 768) return r;
                if (r < 1024) { const int rr = r - 768; return rr < 128 ? 768 + rr : 1024 + (rr - 128); }
                if (r < 1536) return 1304 + (r - 1024);
                if (r < 2048) return 1816 + (r - 1536);
                if (r < 2560) return 2840 + (r - 2048);
                if (r < 2816) { const int rr = r - 2560; return rr < 128 ? 896 + rr : 1152 + (rr - 128); }
                if (r < 3328) return 2328 + (r - 2816);
                if (r < 3352) return 1280 + (r - 3328);
                return -1; };
            tconv_tile(tid, p.w_in, 3352, (u16*)(ws + OFF_WIN), 1024, rt * 64, kt * 64, cm, smem);
        } else if (job < J2) {
            int j = job - J1; const int which = j / J_WCK1; j %= J_WCK1; const int rt = j / 32, kt = j % 32;
            auto cm = [](int r) { return r; };
            tconv_tile(tid, which ? p.w_cv1 : p.w_ck1, 256, (u16*)(ws + (which ? OFF_WCV1 : OFF_WCK1)), 2048, rt * 64, kt * 64, cm, smem);
        } else if (job < J3) {
            int j = job - J2; const int which = j / J_WC2; j %= J_WC2; const int rt = j / 4, kt = j % 4;
            auto cm = [](int r) { return r < 64 ? r : -1; };
            tconv_tile(tid, which ? p.w_cv2 : p.w_ck2, 64, (u16*)(ws + (which ? OFF_WCV2 : OFF_WCK2)), 256, rt * 64, kt * 64, cm, smem);
        } else if (job < J4) {
            const int j = job - J3, rt = j / 16, kt = j % 16;
            auto cm = [](int r) { return r; };
            tconv_tile(tid, p.w_o, 1024, (u16*)(ws + OFF_WO), 1024, rt * 64, kt * 64, cm, smem);
        } else if (job < J5) {
            int j = job - J4; const int e = j / 512; j %= 512; const int rt = j / 16, kt = j % 16;
            auto cm = [](int r) { const int pn = r >> 8, bj = (r >> 7) & 1, wc = (r >> 5) & 3, n = (r >> 4) & 1, i = r & 15; return (n ? 1024 : 0) + pn * 128 + (bj * 4 + wc) * 16 + i; };
            tconv_tile(tid, p.w_gu + (size_t)e * 1024 * 2048, 2048, (u16*)(ws + OFF_WGU) + (size_t)e * 2048 * 1024, 1024, rt * 64, kt * 64, cm, smem);
        } else if (job < J6) {
            int j = job - J5; const int e = j / 256; j %= 256; const int rt = j / 16, kt = j % 16;
            auto cm = [](int r) { return r; };
            tconv_tile(tid, p.w_dn + (size_t)e * 1024 * 1024, 1024, (u16*)(ws + OFF_WDN) + (size_t)e * 1024 * 1024, 1024, rt * 64, kt * 64, cm, smem);
        } else if (job < J7) {
            const size_t base = (size_t)(job - J6) * 2048 + (size_t)tid * 8;
            const float4 a = *(const float4*)(p.x + base), b = *(const float4*)(p.x + base + 4);
            uint4 o; o.x = pack2(a.x, a.y); o.y = pack2(a.z, a.w); o.z = pack2(b.x, b.y); o.w = pack2(b.z, b.w);
            *(uint4*)((u16*)(ws + OFF_XB) + base) = o;
        } else if (job < J8) {
            const int idx = (job - J7) * 256 + tid;
            const int n = idx >> 3, i = idx & 7;
            const float inv = powf(500000.f, -(float)i / 8.f);
            const float ang = (float)p.pos[n] * inv;
            float s, c; sincosf(ang, &s, &c);
            float* ct = (float*)(ws + OFF_ROPE);
            ct[idx] = c; ct[NTOK * 8 + idx] = s;
        } else {
            float* misc = (float*)(ws + OFF_MISC);
            float sk = 0.f, sv = 0.f;
            for (int i = 0; i < 2048; ++i) { const float pe = p.pe[i]; sk += pe * p.w_ck1[(size_t)i * 256 + tid]; sv += pe * p.w_cv1[(size_t)i * 256 + tid]; }
            misc[tid] = sk; misc[256 + tid] = sv;
            for (int i = tid; i < 512; i += 256) { const float a0 = p.hg_lb[i], a1 = p.hg_lb[512 + i]; misc[512 + i] = 1.f / (1.f + expf(a1 - a0)); }
            if (tid < 64) ((int*)(misc + 1024))[tid] = 0;
            for (int i = tid; i < XCD_BAR_WORDS_; i += 256) ((unsigned*)(ws + OFF_BAR))[i] = 0u;
        }
    }
}

DEVI f32x4 rope4(f32x4 v, int fr, const float* __restrict__ cs, int i0, int i1, int i2, int i3) {
    const int i = fr & 7; const float sg = (fr & 8) ? 1.f : -1.f;
    const int idx[4] = {i0, i1, i2, i3};
    f32x4 o;
#pragma unroll
    for (int j = 0; j < 4; ++j) {
        const float partner = __shfl_xor(v[j], 8);
        const float c = cs[(size_t)idx[j] * 8 + i], s = cs[(size_t)NTOK * 8 + (size_t)idx[j] * 8 + i];
        o[j] = v[j] * c + sg * partner * s;
    }
    return o;
}

DEVI void hgrn_local_tile(const Params& p, char* smem, int tile) {
    char* ws = p.ws;
    const int bh = tile >> 7, chunk = tile & 127, b = bh >> 2, h = bh & 3;
    const int tid = VTID, lane = tid & 63, w = tid >> 6, fr = lane & 15, fq = lane >> 4;
    const size_t n0 = (size_t)b * 8192 + chunk * 64;
    const float* lfp = (const float*)(ws + OFF_LOGF) + n0 * 512 + h * 128;
    u16* khT = (u16*)(smem + 1024);
    float blast;
    float* totp = (float*)smem;
    {
        const int k = tid & 127, half = tid >> 7;
        float run = 0.f;
#pragma unroll 8
        for (int i = 0; i < 32; ++i) run += lfp[(size_t)(32 * half + i) * 512 + k];
        totp[half * 128 + k] = run;
        __syncthreads();
        const float t0 = totp[k], t1 = totp[128 + k];
        blast = t0 + t1;
        float bcur = half ? t0 : 0.f;
#pragma unroll 4
        for (int i = 0; i < 32; ++i) {
            const float lf = lfp[(size_t)(32 * half + i) * 512 + k];
            bcur += lf;
            const float kh = (1.f - expf(lf)) * expf(blast - bcur);
            khT[k * 72 + 32 * half + i] = f2bf(kh);
        }
        if (half == 0) ((float*)(ws + OFF_DG))[(size_t)tile * 128 + k] = expf(blast);
    }
    __syncthreads();
    const u16* vT = (const u16*)(ws + OFF_VTH) + (size_t)tile * 128 * 64;
    f32x4 acc[2][8];
#pragma unroll
    for (int m = 0; m < 2; ++m)
#pragma unroll
        for (int n = 0; n < 8; ++n) acc[m][n] = f32x4{0.f, 0.f, 0.f, 0.f};
#pragma unroll
    for (int ks = 0; ks < 2; ++ks) {
        bf16x8 a[2];
#pragma unroll
        for (int m = 0; m < 2; ++m) a[m] = ld8(khT + (32 * w + 16 * m + fr) * 72 + 32 * ks + 8 * fq);
#pragma unroll
        for (int n = 0; n < 8; ++n) {
            const bf16x8 bv = ld8(vT + (size_t)(16 * n + fr) * 64 + 32 * ks + 8 * fq);
#pragma unroll
            for (int m = 0; m < 2; ++m) acc[m][n] = mfma16(a[m], bv, acc[m][n]);
        }
    }
    u16* L = (u16*)(ws + OFF_LBUF) + (size_t)tile * 128 * 128;
#pragma unroll
    for (int m = 0; m < 2; ++m)
#pragma unroll
        for (int n = 0; n < 8; ++n) *(uint2*)(L + (size_t)(16 * n + fr) * 128 + 32 * w + 16 * m + 4 * fq) = pack4(acc[m][n]);
    __syncthreads();
}

DEVI void hgrn_scan_task(const Params& p, int task) {
    char* ws = p.ws;
    const int gid = task * 256 + VTID;
    const int bh = gid >> 13, v = (gid >> 6) & 127, kp = gid & 63;
    uint32_t* L = (uint32_t*)(ws + OFF_LBUF) + ((size_t)bh * 128 * 128 * 128 + (size_t)v * 128) / 2 + kp;
    const float2* Dg = (const float2*)(ws + OFF_DG) + (size_t)bh * 128 * 64 + kp;
    float s0 = 0.f, s1 = 0.f;
#pragma unroll 8
    for (int c = 0; c < 128; ++c) {
        const uint32_t l = L[(size_t)c * 8192];
        const float2 d = Dg[(size_t)c * 64];
        L[(size_t)c * 8192] = pack2(s0, s1);
        s0 = d.x * s0 + __uint_as_float(l << 16);
        s1 = d.y * s1 + __uint_as_float(l & 0xffff0000u);
    }
}

DEVI void hgrn_out_tile(const Params& p, char* smem, int tile) {
    char* ws = p.ws;
    const int bh = tile >> 7, chunk = tile & 127, b = bh >> 2, h = bh & 3;
    const int tid = VTID, lane = tid & 63, w = tid >> 6, fr = lane & 15, fq = lane >> 4;
    const size_t n0 = (size_t)b * 8192 + chunk * 64;
    const float* lfp = (const float*)(ws + OFF_LOGF) + n0 * 512 + h * 128;
    const u16* qh = (const u16*)(ws + OFF_QH) + n0 * 512 + h * 128;
    float* totp = (float*)smem;
    u16* qt = (u16*)(smem + 1024);
    u16* kt = qt + 64 * 136;
    {
        const int k = tid & 127, half = tid >> 7;
        float run = 0.f;
#pragma unroll 8
        for (int i = 0; i < 32; ++i) run += lfp[(size_t)(32 * half + i) * 512 + k];
        totp[half * 128 + k] = run;
        __syncthreads();
        float bcur = half ? totp[k] : 0.f;
#pragma unroll 4
        for (int i = 0; i < 32; ++i) {
            const int t = 32 * half + i;
            const float lf = lfp[(size_t)t * 512 + k];
            bcur += lf;
            const float q = bf2f(qh[(size_t)t * 512 + k]);
            qt[t * 136 + k] = f2bf(q * expf(bcur));
            kt[t * 136 + k] = f2bf((1.f - expf(lf)) * expf(-bcur));
        }
    }
    __syncthreads();
    bf16x8 qb[4];
#pragma unroll
    for (int ks = 0; ks < 4; ++ks) qb[ks] = ld8(qt + (16 * w + fr) * 136 + 32 * ks + 8 * fq);
    f32x4 at[4];
#pragma unroll
    for (int sf = 0; sf < 4; ++sf) {
        const int srow = 32 * (sf >> 1) + 8 * (fr >> 2) + 4 * (sf & 1) + (fr & 3);
        f32x4 a = f32x4{0.f, 0.f, 0.f, 0.f};
#pragma unroll
        for (int ks = 0; ks < 4; ++ks) a = mfma16(ld8(kt + srow * 136 + 32 * ks + 8 * fq), qb[ks], a);
        const int tcol = 16 * w + fr;
#pragma unroll
        for (int r = 0; r < 4; ++r) { const int s = 32 * (sf >> 1) + 8 * fq + 4 * (sf & 1) + r; if (s > tcol) a[r] = 0.f; }
        at[sf] = a;
    }
    const u16* vT = (const u16*)(ws + OFF_VTH) + (size_t)tile * 128 * 64;
    const u16* ST = (const u16*)(ws + OFF_LBUF) + (size_t)tile * 128 * 128;
    f32x4 o[8];
#pragma unroll
    for (int mf = 0; mf < 8; ++mf) o[mf] = f32x4{0.f, 0.f, 0.f, 0.f};
#pragma unroll
    for (int sc = 0; sc < 2; ++sc) {
        const bf16x8 pb = pack8(at[2 * sc], at[2 * sc + 1]);
#pragma unroll
        for (int mf = 0; mf < 8; ++mf) o[mf] = mfma16(ld8(vT + (size_t)(16 * mf + fr) * 64 + 32 * sc + 8 * fq), pb, o[mf]);
    }
#pragma unroll
    for (int ks = 0; ks < 4; ++ks)
#pragma unroll
        for (int mf = 0; mf < 8; ++mf) o[mf] = mfma16(ld8(ST + (size_t)(16 * mf + fr) * 128 + 32 * ks + 8 * fq), qb[ks], o[mf]);
    float ss = 0.f;
#pragma unroll
    for (int mf = 0; mf < 8; ++mf)
#pragma unroll
        for (int r = 0; r < 4; ++r) ss += o[mf][r] * o[mf][r];
    ss = xor16_sum(ss);
    const float rn = rsqrtf(ss * (1.f / 128.f) + 1e-6f);
    const size_t tok = n0 + 16 * w + fr;
    const u16* gh = (const u16*)(ws + OFF_GH) + tok * 512 + h * 128;
    u16* mix = (u16*)(ws + OFF_MIX) + tok * 1024 + 512 + h * 128;
#pragma unroll
    for (int mf = 0; mf < 8; ++mf) {
        const int v0 = 16 * mf + 4 * fq;
        const uint2 g2 = *(const uint2*)(gh + v0);
        const float4 ng = *(const float4*)(p.hg_ng + v0);
        f32x4 r;
        r[0] = o[mf][0] * rn * ng.x * __uint_as_float(g2.x << 16);
        r[1] = o[mf][1] * rn * ng.y * __uint_as_float(g2.x & 0xffff0000u);
        r[2] = o[mf][2] * rn * ng.z * __uint_as_float(g2.y << 16);
        r[3] = o[mf][3] * rn * ng.w * __uint_as_float(g2.y & 0xffff0000u);
        *(uint2*)(mix + v0) = pack4(r);
    }
    __syncthreads();
}

DEVI float gelu_tanh(float x) { const float u = 0.7978845608028654f * (x + 0.044715f * x * x * x); return 0.5f * x * (1.f + tanhf(u)); }

DEVI void cmp1_tile(const Params& p, char* smem, int tile) {
    char* ws = p.ws;
    const int which = tile >> 6, rt = (tile >> 1) & 31, ct = tile & 1;
    const int tid = VTID, lane = tid & 63, wid = tid >> 6, wr = wid >> 1, wc = wid & 1, fr = lane & 15, fq = lane >> 4;
    const u16* src = (const u16*)(ws + (which ? OFF_VCR : OFF_KCR));
    auto arow = [&](int r) { const int m = rt * 128 + r; return src + ((size_t)(m >> 9) * SP + 16 * (m & 511)) * 64; };
    const u16* Bt = (const u16*)(ws + (which ? OFF_WCV1 : OFF_WCK1)) + (size_t)ct * 128 * 2048;
    f32x4 acc[4][4];
    gemm128(tid, arow, Bt, 2048, 2048, smem, acc);
    const float* bias = (const float*)(ws + OFF_MISC) + which * 256;
    u16* hid = (u16*)(ws + OFF_HID) + (size_t)which * 4096 * 256;
#pragma unroll
    for (int m = 0; m < 4; ++m)
#pragma unroll
        for (int n = 0; n < 4; ++n) {
            const int row = rt * 128 + wr * 64 + m * 16 + fq * 4, col = ct * 128 + wc * 64 + n * 16 + fr;
            const float bv = bias[col];
#pragma unroll
            for (int j = 0; j < 4; ++j) hid[(size_t)(row + j) * 256 + col] = f2bf(gelu_tanh(acc[m][n][j] + bv));
        }
}

DEVI void cmp2_tile(const Params& p, char* smem, int tile) {
    char* ws = p.ws;
    const int which = tile >> 5, rt = tile & 31;
    const int tid = VTID, lane = tid & 63, wid = tid >> 6, wr = wid >> 1, wc = wid & 1, fr = lane & 15, fq = lane >> 4;
    const u16* hid = (const u16*)(ws + OFF_HID) + (size_t)which * 4096 * 256;
    auto arow = [&](int r) { return hid + (size_t)(rt * 128 + r) * 256; };
    const u16* Bt = (const u16*)(ws + (which ? OFF_WCV2 : OFF_WCK2));
    f32x4 acc[4][4];
    gemm128(tid, arow, Bt, 256, 256, smem, acc);
    if (wc == 0) {
        const float* cs = (const float*)(ws + OFF_ROPE);
#pragma unroll
        for (int m = 0; m < 4; ++m) {
            const int row = rt * 128 + wr * 64 + m * 16 + fq * 4;
            const int bg = row >> 9, c = row & 511, b = bg >> 1;
#pragma unroll
            for (int n = 0; n < 4; ++n) {
                const int d = n * 16 + fr;
                f32x4 v = acc[m][n];
                if (which == 0) {
                    if (n == 0) {
                        int ix[4];
#pragma unroll
                        for (int j = 0; j < 4; ++j) { int sp = 16 * (c + j) + 31; sp = sp > 8191 ? 8191 : sp; ix[j] = b * 8192 + sp; }
                        v = rope4(v, fr, cs, ix[0], ix[1], ix[2], ix[3]);
                    }
                    u16* kc = (u16*)(ws + OFF_KC);
#pragma unroll
                    for (int j = 0; j < 4; ++j) kc[((size_t)bg * 512 + c + j) * 64 + d] = f2bf(v[j]);
                } else {
                    u16* vct = (u16*)(ws + OFF_VCT);
                    *(uint2*)(vct + (((size_t)bg * 8 + (c >> 6)) * 64 + d) * 64 + (c & 63)) = pack4(v);
                }
            }
        }
    }
}

DEVI uint64_t lowest_bits(uint64_t mask, int n) {
    uint64_t out = 0;
    while (n > 0 && mask) { const uint64_t b = mask & (~mask + 1); out |= b; mask ^= b; --n; }
    return out;
}

constexpr int NSA_TILES = 8 * 128;
constexpr int NSA_STG = 18432;
constexpr int NSA_OFF_IMP = 2 * NSA_STG;
constexpr int NSA_OFF_SEL = NSA_OFF_IMP + 4 * 8192;
constexpr float NSA_NEG = -3.0e30f;

DEVI float ex2(float x) { return __builtin_amdgcn_exp2f(x); }
DEVI void sm_update(f32x4 (&s)[2][2], const bool on, float (&R)[2], float (&l)[2], f32x4 (&os)[2][4], bf16x8 (&pb)[2]) {
    float lm[2];
#pragma unroll
    for (int hh = 0; hh < 2; ++hh) {
        float a = fmaxf(fmaxf(s[hh][0][0], s[hh][0][1]), fmaxf(s[hh][0][2], s[hh][0][3]));
        float b = fmaxf(fmaxf(s[hh][1][0], s[hh][1][1]), fmaxf(s[hh][1][2], s[hh][1][3]));
        a = fmaxf(a, b);
        lm[hh] = on ? a : NSA_NEG;
    }
    const bool trig = (lm[0] > R[0] + 8.f) || (lm[1] > R[1] + 8.f);
    if (__ballot(trig)) {
#pragma unroll
        for (int hh = 0; hh < 2; ++hh) {
            const float cm = xor16_max(lm[hh]);
            const float nr = fmaxf(R[hh], cm);
            const float sc = ex2(R[hh] - nr);
            l[hh] *= sc;
#pragma unroll
            for (int mf = 0; mf < 4; ++mf) { os[hh][mf][0] *= sc; os[hh][mf][1] *= sc; os[hh][mf][2] *= sc; os[hh][mf][3] *= sc; }
            R[hh] = nr;
        }
    }
#pragma unroll
    for (int hh = 0; hh < 2; ++hh) {
        const float ref = on ? R[hh] : 3.0e30f;
        float sum = 0.f;
#pragma unroll
        for (int u = 0; u < 2; ++u)
#pragma unroll
            for (int r = 0; r < 4; ++r) { const float pv = ex2(s[hh][u][r] - ref); s[hh][u][r] = pv; sum += pv; }
        l[hh] += sum;
        pb[hh] = pack8(s[hh][0], s[hh][1]);
    }
}

DEVI void nsa_tile(const Params& p, char* smem, int tile) {
    char* ws = p.ws;
    const int bg = tile & 7, cur = 127 - (tile >> 3), b = bg >> 1, g = bg & 1;
    const int tid = TIDX, lane = tid & 63, w = tid >> 6, fr = lane & 15, fq = lane >> 4;
    const int tt = w >> 1, hp = w & 1;
    const int t0 = cur * 64 + tt * 16;
    const size_t n0 = (size_t)b * 8192 + t0;
    const int tok = t0 + fr;
    const u16* Qb = (const u16*)(ws + OFF_Q);
    const u16* Kc = (const u16*)(ws + OFF_KC) + (size_t)bg * 512 * 64;
    const u16* Vct = (const u16*)(ws + OFF_VCT) + (size_t)bg * 8 * 64 * 64;
    const u16* Ks = (const u16*)(ws + OFF_KS) + (size_t)bg * 8192 * 64;
    const u16* Kw = (const u16*)(ws + OFF_KW) + (size_t)bg * 8192 * 64;
    const u16* Vst = (const u16*)(ws + OFF_VST) + (size_t)bg * 128 * 64 * 64;
    const u16* Vwt = (const u16*)(ws + OFF_VWT) + (size_t)bg * 128 * 64 * 64;
    const float* gp = (const float*)(ws + OFF_GATES) + (n0 + fr) * 24 + (g * 4 + 2 * hp) * 3;
    float* imp = (float*)(smem + NSA_OFF_IMP) + tt * 2048;
    unsigned long long* selm = (unsigned long long*)(smem + NSA_OFF_SEL) + tt * 32;

    for (int i = tid; i < 4 * 2048; i += 512) ((float*)(smem + NSA_OFF_IMP))[i] = 0.f;
    __syncthreads();

    bf16x8 qf[2][2];
#pragma unroll
    for (int hh = 0; hh < 2; ++hh)
#pragma unroll
        for (int ks = 0; ks < 2; ++ks) qf[hh][ks] = ld8(Qb + (n0 + fr) * 512 + (g * 4 + 2 * hp + hh) * 64 + 32 * ks + 8 * fq);
    f32x4 ot[2][4];
#pragma unroll
    for (int hh = 0; hh < 2; ++hh)
#pragma unroll
        for (int mf = 0; mf < 4; ++mf) ot[hh][mf] = f32x4{0.f, 0.f, 0.f, 0.f};

#define NSA_QK(KPTR, S) do { \
        const bf16x8 k0_ = ld8(KPTR), k1_ = ld8((KPTR) + 32); \
        _Pragma("unroll") for (int hh = 0; hh < 2; ++hh) { f32x4 a_ = f32x4{0.f, 0.f, 0.f, 0.f}; a_ = mfma16(k0_, qf[hh][0], a_); a_ = mfma16(k1_, qf[hh][1], a_); S[hh] = a_; } } while (0)

    {
        const int nc = t0 >> 4;
        const int nchunk = (nc + 31) >> 5;
        float RC[2] = {-1e30f, -1e30f}, lC[2] = {0.f, 0.f};
        f32x4 oc[2][4];
#pragma unroll
        for (int hh = 0; hh < 2; ++hh)
#pragma unroll
            for (int mf = 0; mf < 4; ++mf) oc[hh][mf] = f32x4{0.f, 0.f, 0.f, 0.f};
        for (int ch = 0; ch < nchunk; ++ch) {
            f32x4 s[2][2];
#pragma unroll
            for (int u = 0; u < 2; ++u) {
                f32x4 su[2];
                NSA_QK(Kc + (size_t)(32 * ch + 8 * (fr >> 2) + 4 * u + (fr & 3)) * 64 + 8 * fq, su);
                s[0][u] = su[0]; s[1][u] = su[1];
            }
            if (512 * ch + 527 > t0) {
#pragma unroll
                for (int hh = 0; hh < 2; ++hh)
#pragma unroll
                    for (int u = 0; u < 2; ++u)
#pragma unroll
                        for (int r = 0; r < 4; ++r) { const int c = 32 * ch + 8 * fq + 4 * u + r; if (16 * c + 31 > tok) s[hh][u][r] = NSA_NEG; }
            }
            bf16x8 pb[2];
            sm_update(s, true, RC, lC, oc, pb);
        }
        float ilC[2];
#pragma unroll
        for (int hh = 0; hh < 2; ++hh) { const float l = xor16_sum(lC[hh]); ilC[hh] = l > 0.f ? 1.f / l : 0.f; }
        for (int ch = 0; ch < nchunk; ++ch) {
            f32x4 s[2][2];
#pragma unroll
            for (int u = 0; u < 2; ++u) {
                f32x4 su[2];
                NSA_QK(Kc + (size_t)(32 * ch + 8 * (fr >> 2) + 4 * u + (fr & 3)) * 64 + 8 * fq, su);
                s[0][u] = su[0]; s[1][u] = su[1];
            }
            float qs[2] = {0.f, 0.f}, p3[2] = {0.f, 0.f};
            bf16x8 pb[2];
#pragma unroll
            for (int hh = 0; hh < 2; ++hh) {
#pragma unroll
                for (int u = 0; u < 2; ++u)
#pragma unroll
                    for (int r = 0; r < 4; ++r) {
                        const int c = 32 * ch + 8 * fq + 4 * u + r;
                        const float pv = (16 * c + 31 <= tok) ? ex2(s[hh][u][r] - RC[hh]) * ilC[hh] : 0.f;
                        s[hh][u][r] = pv; qs[u] += pv; if (r == 3) p3[u] += pv;
                    }
                pb[hh] = pack8(s[hh][0], s[hh][1]);
            }
#pragma unroll
            for (int u = 0; u < 2; ++u) {
                const int j = 8 * ch + 2 * fq + u;
                atomicAdd(&imp[fr * 128 + j], qs[u]);
                if (j + 1 < 128) atomicAdd(&imp[fr * 128 + j + 1], p3[u]);
            }
#pragma unroll
            for (int mf = 0; mf < 4; ++mf) {
                const bf16x8 va = ld8(Vct + ((size_t)(ch >> 1) * 64 + 16 * mf + fr) * 64 + 32 * (ch & 1) + 8 * fq);
#pragma unroll
                for (int hh = 0; hh < 2; ++hh) oc[hh][mf] = mfma16(va, pb[hh], oc[hh][mf]);
            }
        }
#pragma unroll
        for (int hh = 0; hh < 2; ++hh) {
            const float gc = gp[hh * 3 + 0];
#pragma unroll
            for (int mf = 0; mf < 4; ++mf) ot[hh][mf] += oc[hh][mf] * gc;
        }
    }
    __syncthreads();
    if (hp == 0) {
        if (cur < 16) {
            if (lane < 16) { selm[lane * 2] = (2ull << cur) - 1ull; selm[lane * 2 + 1] = 0ull; }
        } else {
            for (int tau = 0; tau < 16; ++tau) {
                const int j0 = lane, j1 = lane + 64;
                const bool in0 = (j0 >= 1) && (j0 <= cur - 2), in1 = (j1 <= cur - 2);
                const float v0 = in0 ? imp[tau * 128 + j0] : 0.f;
                const float v1 = in1 ? imp[tau * 128 + j1] : 0.f;
                const uint32_t u0 = __float_as_uint(v0), u1 = __float_as_uint(v1);
                uint32_t res = 0;
                for (int bit = 30; bit >= 0; --bit) {
                    const uint32_t cand = res | (1u << bit);
                    const int cnt = __popcll(__ballot(in0 && u0 >= cand)) + __popcll(__ballot(in1 && u1 >= cand));
                    if (cnt >= 13) res = cand;
                }
                const uint64_t g0 = __ballot(in0 && u0 > res), g1 = __ballot(in1 && u1 > res);
                const uint64_t e0 = __ballot(in0 && u0 == res), e1 = __ballot(in1 && u1 == res);
                int need = 13 - (__popcll(g0) + __popcll(g1));
                const int ne0 = __popcll(e0);
                uint64_t sa = g0 | lowest_bits(e0, need);
                need -= (need < ne0 ? need : ne0);
                uint64_t sb = g1 | lowest_bits(e1, need);
                sa |= 1ull;
                if (cur - 1 < 64) sa |= 1ull << (cur - 1); else sb |= 1ull << (cur - 1 - 64);
                if (cur < 64) sa |= 1ull << cur; else sb |= 1ull << (cur - 64);
                if (lane == 0) { selm[tau * 2] = sa; selm[tau * 2 + 1] = sb; }
            }
        }
    }
    {
        int kbeg = t0 - 511; kbeg = kbeg < 0 ? 0 : kbeg; kbeg &= ~31;
        const int nch = (t0 + 16 - kbeg + 31) >> 5;
        float RW[2] = {-1e30f, -1e30f}, lW[2] = {0.f, 0.f};
        f32x4 ow[2][4];
#pragma unroll
        for (int hh = 0; hh < 2; ++hh)
#pragma unroll
            for (int mf = 0; mf < 4; ++mf) ow[hh][mf] = f32x4{0.f, 0.f, 0.f, 0.f};
        for (int ch = 0; ch < nch; ++ch) {
            const int kb = kbeg + 32 * ch;
            f32x4 s[2][2];
#pragma unroll
            for (int u = 0; u < 2; ++u) {
                f32x4 su[2];
                NSA_QK(Kw + (size_t)(kb + 8 * (fr >> 2) + 4 * u + (fr & 3)) * 64 + 8 * fq, su);
                s[0][u] = su[0]; s[1][u] = su[1];
            }
            if (kb + 31 > t0 || kb <= t0 + 15 - 512) {
#pragma unroll
                for (int hh = 0; hh < 2; ++hh)
#pragma unroll
                    for (int u = 0; u < 2; ++u)
#pragma unroll
                        for (int r = 0; r < 4; ++r) { const int key = kb + 8 * fq + 4 * u + r; if (key > tok || key <= tok - 512) s[hh][u][r] = NSA_NEG; }
            }
            bf16x8 pb[2];
            sm_update(s, true, RW, lW, ow, pb);
#pragma unroll
            for (int mf = 0; mf < 4; ++mf) {
                const bf16x8 va = ld8(Vwt + ((size_t)(kb >> 6) * 64 + 16 * mf + fr) * 64 + (kb & 63) + 8 * fq);
#pragma unroll
                for (int hh = 0; hh < 2; ++hh) ow[hh][mf] = mfma16(va, pb[hh], ow[hh][mf]);
            }
        }
#pragma unroll
        for (int hh = 0; hh < 2; ++hh) {
            const float l = xor16_sum(lW[hh]);
            const float gw = gp[hh * 3 + 2] * (l > 0.f ? 1.f / l : 0.f);
#pragma unroll
            for (int mf = 0; mf < 4; ++mf) ot[hh][mf] += ow[hh][mf] * gw;
        }
    }
    __syncthreads();
    {
        const unsigned long long mA = selm[fr * 2], mB = selm[fr * 2 + 1];
        uint4 kr0, vr0;
        const int srow = tid >> 3, sc8 = (tid & 7) * 8;
        const int rho = (srow & 32) | ((srow & 4) << 2) | ((srow & 24) >> 1) | (srow & 3);
#define gload(JB) do { const int jb_ = (JB); \
            kr0 = *(const uint4*)(Ks + ((size_t)(64 * jb_ + srow)) * 64 + sc8); vr0 = *(const uint4*)(Vst + ((size_t)jb_ * 64 + srow) * 64 + sc8); } while (0)
#define lstore(BUF) do { char* sb_ = smem + (BUF) * NSA_STG; \
            *(uint4*)(sb_ + (rho * 72 + sc8) * 2) = kr0; *(uint4*)(sb_ + 9216 + (srow * 72 + sc8) * 2) = vr0; } while (0)
        gload(0); lstore(0);
        if (cur >= 1) gload(1);
        __syncthreads();
        float RS[2] = {-1e30f, -1e30f}, lS[2] = {0.f, 0.f};
        f32x4 os[2][4];
#pragma unroll
        for (int hh = 0; hh < 2; ++hh)
#pragma unroll
            for (int mf = 0; mf < 4; ++mf) os[hh][mf] = f32x4{0.f, 0.f, 0.f, 0.f};
        for (int jb = 0; jb <= cur; ++jb) {
            const int buf = jb & 1;
            const u16* Kl = (const u16*)(smem + buf * NSA_STG);
            const u16* Vl = Kl + 4608;
            const bool on = ((jb < 64 ? (mA >> jb) : (mB >> (jb - 64))) & 1ull) != 0ull;
            if (__ballot(on)) {
#pragma unroll 1
                for (int sc = 0; sc < 2; ++sc) {
                    f32x4 s[2][2];
#pragma unroll
                    for (int u = 0; u < 2; ++u) {
                        f32x4 su[2];
                        NSA_QK(Kl + (32 * sc + 16 * u + fr) * 72 + 8 * fq, su);
                        s[0][u] = su[0]; s[1][u] = su[1];
                    }
                    if (jb == cur) {
#pragma unroll
                        for (int hh = 0; hh < 2; ++hh)
#pragma unroll
                            for (int u = 0; u < 2; ++u)
#pragma unroll
                                for (int r = 0; r < 4; ++r) { const int key = 64 * jb + 32 * sc + 8 * fq + 4 * u + r; if (key > tok) s[hh][u][r] = NSA_NEG; }
                    }
                    bf16x8 pb[2];
                    sm_update(s, on, RS, lS, os, pb);
#pragma unroll
                    for (int mf = 0; mf < 4; ++mf) {
                        const bf16x8 va = ld8(Vl + (16 * mf + fr) * 72 + 32 * sc + 8 * fq);
#pragma unroll
                        for (int hh = 0; hh < 2; ++hh) os[hh][mf] = mfma16(va, pb[hh], os[hh][mf]);
                    }
                }
            }
            if (jb + 1 <= cur) lstore(buf ^ 1);
            if (jb + 2 <= cur) gload(jb + 2);
            __syncthreads();
        }
#undef gload
#undef lstore
#pragma unroll
        for (int hh = 0; hh < 2; ++hh) {
            const float l = xor16_sum(lS[hh]);
            const float gs = gp[hh * 3 + 1] * (l > 0.f ? 1.f / l : 0.f);
#pragma unroll
            for (int mf = 0; mf < 4; ++mf) ot[hh][mf] += os[hh][mf] * gs;
        }
    }
#undef NSA_QK
    {
        u16* mix = (u16*)(ws + OFF_MIX) + (n0 + fr) * 1024 + (g * 4 + 2 * hp) * 64;
#pragma unroll
        for (int hh = 0; hh < 2; ++hh)
#pragma unroll
            for (int mf = 0; mf < 4; ++mf) *(uint2*)(mix + hh * 64 + 16 * mf + 4 * fq) = pack4(ot[hh][mf]);
    }
    __syncthreads();
}

#define LAS3 __attribute__((address_space(3)))
namespace g8 {
constexpr int BM = 256, BK = 64, HALF = 128, HTB = HALF * BK * 2, KK = 1024, NT = KK / BK;
DEVI int lds_byte(int r, int c) { const int st = (r >> 4) * 2 + (c >> 5), rr = r & 15, cc = c & 31, ob = rr * 64 + cc * 2; return st * 1024 + (ob ^ (((ob >> 9) & 1) << 5)); }
DEVI void stage_rc(int b, int& R, int& C) { const int st = b / 1024, sb = b % 1024, swz = sb ^ (((sb >> 9) & 1) << 5); R = (st >> 1) * 16 + swz / 64; C = (st & 1) * 32 + (swz % 64) / 2; }
DEVI int perm32(int rho) { const int n = rho >> 4, i = rho & 15; return 8 * (i >> 2) + 4 * n + (i & 3); }

template <bool TRANS, bool PERM, class Src, class Epi>
DEVI void gemm_phase(int tid, LAS3 unsigned char* lds, const char* Abase, const Src& S, const Epi& E) {
    asm volatile("" : "+v"(tid));
    const int wid = __builtin_amdgcn_readfirstlane(tid >> 6), lane = tid & 63, wr = wid >> 2, wc = wid & 3, fr = lane & 15, fq = lane >> 4;
    int R0, C0, R1, C1;
    stage_rc(tid * 16, R0, C0); stage_rc(tid * 16 + 8192, R1, C1);
    unsigned voffB[2];
    voffB[0] = (unsigned)((PERM ? ((R0 & ~31) + perm32(R0 & 31)) : R0) * KK + C0) * 2u;
    voffB[1] = (unsigned)((PERM ? ((R1 & ~31) + perm32(R1 & 31)) : R1) * KK + C1) * 2u;
    constexpr size_t kstep = (size_t)(BK * 2);
    constexpr size_t hstepB = (size_t)HALF * KK * 2;
    const unsigned ldsw = (unsigned)wid * 1024u;
    const int aoff = lds_byte(wr * 64 + fr, fq * 8), boff = lds_byte(wc * 32 + fr, fq * 8);
#define G8_SA(b, h) (((b) * 2 + (h)) * HTB)
#define G8_SB(b, h) ((4 + (b) * 2 + (h)) * HTB)
#define G8_STAGE_A(bufoff, kbyte, v0, v1) do { \
        __builtin_amdgcn_global_load_lds((const unsigned*)(Abase + (kbyte) + (v0)), (LAS3 unsigned*)(lds + (bufoff) + ldsw), 16, 0, 0); \
        __builtin_amdgcn_global_load_lds((const unsigned*)(Abase + (kbyte) + (v1)), (LAS3 unsigned*)(lds + (bufoff) + ldsw + 8192), 16, 0, 0); } while (0)
#define G8_STAGE_B(bufoff, gptr) do { \
        __builtin_amdgcn_global_load_lds((const unsigned*)((gptr) + voffB[0]), (LAS3 unsigned*)(lds + (bufoff) + ldsw), 16, 0, 0); \
        __builtin_amdgcn_global_load_lds((const unsigned*)((gptr) + voffB[1]), (LAS3 unsigned*)(lds + (bufoff) + ldsw + 8192), 16, 0, 0); } while (0)
#define G8_LDA(dst, b, h) do { _Pragma("unroll") for (int m = 0; m < 4; ++m) _Pragma("unroll") for (int k = 0; k < 2; ++k) dst[m][k] = *(const LAS3 bf16x8*)(lds + G8_SA(b, h) + aoff + m * 2048 + k * 1024); } while (0)
#define G8_LDB(dst, b, h) do { _Pragma("unroll") for (int n = 0; n < 2; ++n) _Pragma("unroll") for (int k = 0; k < 2; ++k) dst[n][k] = *(const LAS3 bf16x8*)(lds + G8_SB(b, h) + boff + n * 2048 + k * 1024); } while (0)
#define G8_MMA(ai, bj, At, Bt) do { __builtin_amdgcn_s_setprio(1); _Pragma("unroll") for (int m = 0; m < 4; ++m) _Pragma("unroll") for (int n = 0; n < 2; ++n) _Pragma("unroll") for (int k = 0; k < 2; ++k) \
        acc[ai][bj][m][n] = TRANS ? __builtin_amdgcn_mfma_f32_16x16x32_bf16(Bt[n][k], At[m][k], acc[ai][bj][m][n], 0, 0, 0) \
                                  : __builtin_amdgcn_mfma_f32_16x16x32_bf16(At[m][k], Bt[n][k], acc[ai][bj][m][n], 0, 0, 0); __builtin_amdgcn_s_setprio(0); } while (0)
#define G8_WAIT_V(n) asm volatile("s_waitcnt vmcnt(" #n ")" ::: "memory")
#define G8_WAIT_L(n) asm volatile("s_waitcnt lgkmcnt(" #n ")" ::: "memory")
#define G8_BAR __builtin_amdgcn_s_barrier()
#define G8_SCHED __builtin_amdgcn_sched_barrier(0)
    typename Src::U cur, nxt; int ui = 0;
    if (!S.next(0, cur)) return;
    f32x4 acc[2][2][4][2];
#pragma unroll
    for (int a = 0; a < 2; ++a)
#pragma unroll
        for (int b = 0; b < 2; ++b)
#pragma unroll
            for (int m = 0; m < 4; ++m)
#pragma unroll
                for (int n = 0; n < 2; ++n) acc[a][b][m][n] = (f32x4){0.f, 0.f, 0.f, 0.f};
    bf16x8 At[4][2], B0[2][2], B1[2][2];
    unsigned cA00 = S.aoff(cur, R0) + C0 * 2u, cA01 = S.aoff(cur, R1) + C1 * 2u, cA10 = S.aoff(cur, HALF + R0) + C0 * 2u, cA11 = S.aoff(cur, HALF + R1) + C1 * 2u;
    const char* cB = S.bbase(cur);
    G8_STAGE_B(G8_SB(0, 0), cB); G8_STAGE_A(G8_SA(0, 0), 0, cA00, cA01); G8_STAGE_B(G8_SB(0, 1), cB + hstepB); G8_STAGE_A(G8_SA(0, 1), 0, cA10, cA11);
    if (wr == 1) G8_BAR;
    G8_WAIT_V(4); G8_BAR;
    G8_STAGE_B(G8_SB(1, 0), cB + kstep); G8_STAGE_A(G8_SA(1, 0), kstep, cA00, cA01); G8_STAGE_B(G8_SB(1, 1), cB + hstepB + kstep);
    G8_WAIT_V(6); G8_BAR;
    for (;;) {
        const bool has_next = S.next(ui + 1, nxt);
        unsigned nA00 = cA00, nA01 = cA01, nA10 = cA10, nA11 = cA11;
        const char* nB = cB;
        if (has_next) {
            nA00 = S.aoff(nxt, R0) + C0 * 2u; nA01 = S.aoff(nxt, R1) + C1 * 2u; nA10 = S.aoff(nxt, HALF + R0) + C0 * 2u; nA11 = S.aoff(nxt, HALF + R1) + C1 * 2u;
            nB = S.bbase(nxt);
        }
#pragma unroll 1
        for (int t = 0; t < NT; t += 2) {
            const bool last = (t == NT - 2);
            const size_t k1 = (size_t)(t + 1) * kstep;
            const size_t k2 = last ? (size_t)0 : (size_t)(t + 2) * kstep, k3 = k2 + kstep;
            const unsigned x00 = last ? nA00 : cA00, x01 = last ? nA01 : cA01, x10 = last ? nA10 : cA10, x11 = last ? nA11 : cA11;
            const char* b2 = (last ? nB : cB) + k2; const char* b3 = b2 + kstep;
            G8_LDB(B0, 0, 0); G8_SCHED; G8_LDA(At, 0, 0); G8_STAGE_A(G8_SA(1, 1), k1, cA10, cA11);
            G8_WAIT_L(8); G8_BAR; G8_WAIT_L(0); G8_MMA(0, 0, At, B0); G8_BAR; G8_SCHED;
            G8_LDB(B1, 0, 1); G8_STAGE_B(G8_SB(0, 0), b2);
            G8_BAR; G8_WAIT_L(0); G8_MMA(0, 1, At, B1); G8_BAR;
            G8_LDA(At, 0, 1); G8_STAGE_A(G8_SA(0, 0), k2, x00, x01);
            G8_BAR; G8_WAIT_L(0); G8_MMA(1, 0, At, B0); G8_BAR; G8_SCHED;
            G8_STAGE_B(G8_SB(0, 1), b2 + hstepB);
            G8_WAIT_V(6); G8_BAR; G8_MMA(1, 1, At, B1); G8_BAR;
            G8_LDB(B0, 1, 0); G8_SCHED; G8_LDA(At, 1, 0); G8_STAGE_A(G8_SA(0, 1), k2, x10, x11);
            G8_WAIT_L(8); G8_BAR; G8_WAIT_L(0); G8_MMA(0, 0, At, B0); G8_BAR; G8_SCHED;
            G8_LDB(B1, 1, 1); G8_STAGE_B(G8_SB(1, 0), b3);
            G8_BAR; G8_WAIT_L(0); G8_MMA(0, 1, At, B1); G8_BAR;
            G8_LDA(At, 1, 1); G8_STAGE_A(G8_SA(1, 0), k3, x00, x01);
            G8_BAR; G8_WAIT_L(0); G8_MMA(1, 0, At, B0); G8_BAR; G8_SCHED;
            G8_STAGE_B(G8_SB(1, 1), b3 + hstepB);
            G8_WAIT_V(6); G8_BAR; G8_MMA(1, 1, At, B1); G8_BAR;
        }
        E(acc, cur, wr, wc, fr, fq);
        if (!has_next) break;
#pragma unroll
        for (int a = 0; a < 2; ++a)
#pragma unroll
            for (int b = 0; b < 2; ++b)
#pragma unroll
                for (int m = 0; m < 4; ++m)
#pragma unroll
                    for (int n = 0; n < 2; ++n) acc[a][b][m][n] = (f32x4){0.f, 0.f, 0.f, 0.f};
        cur = nxt; cA00 = nA00; cA01 = nA01; cA10 = nA10; cA11 = nA11; cB = nB; ++ui;
    }
    G8_WAIT_V(0);
    if (wr == 0) G8_BAR;
    G8_BAR;
#undef G8_SA
#undef G8_SB
#undef G8_STAGE_A
#undef G8_STAGE_B
#undef G8_LDA
#undef G8_LDB
#undef G8_MMA
#undef G8_WAIT_V
#undef G8_WAIT_L
#undef G8_BAR
#undef G8_SCHED
}

struct DenseSrc {
    struct U { int pm, pn; };
    const char* Bt; int nM, nN, nwg, G, c;
    DEVI void init(const void* Bt_, int M, int N, int G_, int c_) { Bt = (const char*)Bt_; nM = M / BM; nN = N / BM; nwg = nM * nN; G = G_; c = c_; }
    DEVI bool next(int i, U& u) const {
        const int L = i * G + c; if (L >= nwg) return false;
        int wgid = L; { const int q = nwg / 8, r = nwg % 8, xcd = wgid % 8, off = wgid / 8; wgid = (xcd < r ? xcd * (q + 1) : r * (q + 1) + (xcd - r) * q) + off; }
        const int nig = 8 * nN, gid = wgid / nig, fm = gid * 8, gsz = (nM - fm) < 8 ? (nM - fm) : 8;
        u.pm = fm + ((wgid % nig) % gsz); u.pn = (wgid % nig) / gsz; return true;
    }
    DEVI unsigned aoff(const U& u, int row) const { return (unsigned)(u.pm * BM + row) * (unsigned)(KK * 2); }
    DEVI const char* bbase(const U& u) const { return Bt + (size_t)u.pn * BM * KK * 2; }
};
}


struct EpiWo {
    u16* o;
    DEVI void operator()(const f32x4 (&acc)[2][2][4][2], const g8::DenseSrc::U& u, int wr, int wc, int fr, int fq) const {
#pragma unroll
        for (int ai = 0; ai < 2; ++ai)
#pragma unroll
            for (int m = 0; m < 4; ++m) {
                const size_t row = (size_t)u.pm * 256 + ai * 128 + wr * 64 + m * 16 + fr;
#pragma unroll
                for (int bj = 0; bj < 2; ++bj) {
                    uint4 v; v.x = pack2(acc[ai][bj][m][0][0], acc[ai][bj][m][0][1]); v.y = pack2(acc[ai][bj][m][0][2], acc[ai][bj][m][0][3]);
                    v.z = pack2(acc[ai][bj][m][1][0], acc[ai][bj][m][1][1]); v.w = pack2(acc[ai][bj][m][1][2], acc[ai][bj][m][1][3]);
                    *(uint4*)(o + row * 1024 + u.pn * 256 + bj * 128 + wc * 32 + fq * 8) = v;
                }
            }
    }
};
DEVI void phase_wo8(const Params& p, char* smem_all) {
    g8::DenseSrc S; S.init(p.ws + OFF_WO, NTOK, 1024, gridDim.x, blockIdx.x);
    EpiWo E; E.o = (u16*)(p.ws + OFF_PRE);
    g8::gemm_phase<true, true>(TIDX, (LAS3 unsigned char*)smem_all, p.ws + OFF_MIX, S, E);
}

DEVI void wo_tile(const Params& p, char* smem, int tile) {
    char* ws = p.ws;
    const int rt = tile >> 3, ct = tile & 7;
    const int tid = VTID, lane = tid & 63, wid = tid >> 6, wr = wid >> 1, wc = wid & 1, fr = lane & 15, fq = lane >> 4;
    const u16* MIX = (const u16*)(ws + OFF_MIX);
    auto arow = [&](int r) { return MIX + (size_t)(rt * 128 + r) * 1024; };
    f32x4 acc[4][4];
    gemm128(tid, arow, (const u16*)(ws + OFF_WO) + (size_t)ct * 128 * 1024, 1024, 1024, smem, acc);
    float* pre = (float*)(ws + OFF_PRE);
#pragma unroll
    for (int m = 0; m < 4; ++m)
#pragma unroll
        for (int n = 0; n < 4; ++n) {
            const int row = rt * 128 + wr * 64 + m * 16 + fq * 4, col = ct * 128 + wc * 64 + n * 16 + fr;
#pragma unroll
            for (int j = 0; j < 4; ++j) {
                const size_t ix = (size_t)(row + j) * 1024 + col;
                pre[ix] = DN_ALPHA * p.x[ix] + acc[m][n][j];
            }
        }
}

DEVI void ln1_router_tile(const Params& p, char* smem, int tile) {
    char* ws = p.ws;
    const int tid = VTID, lane = tid & 63, w = tid >> 6;
    const int tok0 = tile * 32;
    const u16* mixo = (const u16*)(ws + OFF_PRE);
    float* H1 = (float*)(ws + OFF_H1); u16* H1B = (u16*)(ws + OFF_H1B);
    for (int i = 0; i < 8; ++i) {
        const size_t row = (size_t)tok0 + w * 8 + i;
        float4 v[4];
        float s = 0.f;
#pragma unroll
        for (int q = 0; q < 4; ++q) {
            const float4 xv = *(const float4*)(p.x + row * 1024 + q * 256 + lane * 4);
            const uint2 mv = *(const uint2*)(mixo + row * 1024 + q * 256 + lane * 4);
            v[q].x = DN_ALPHA * xv.x + __uint_as_float(mv.x << 16); v[q].y = DN_ALPHA * xv.y + __uint_as_float(mv.x & 0xffff0000u);
            v[q].z = DN_ALPHA * xv.z + __uint_as_float(mv.y << 16); v[q].w = DN_ALPHA * xv.w + __uint_as_float(mv.y & 0xffff0000u);
            s += v[q].x + v[q].y + v[q].z + v[q].w;
        }
        const float mu = wave_sum(s) * (1.f / 1024.f);
        float ss = 0.f;
#pragma unroll
        for (int q = 0; q < 4; ++q) { v[q].x -= mu; v[q].y -= mu; v[q].z -= mu; v[q].w -= mu; ss += v[q].x * v[q].x + v[q].y * v[q].y + v[q].z * v[q].z + v[q].w * v[q].w; }
        const float rs = rsqrtf(wave_sum(ss) * (1.f / 1024.f) + 1e-5f);
#pragma unroll
        for (int q = 0; q < 4; ++q) {
            const int c = q * 256 + lane * 4;
            const float4 gq = *(const float4*)(p.ln1g + c), bq = *(const float4*)(p.ln1b + c);
            float4 o; o.x = v[q].x * rs * gq.x + bq.x; o.y = v[q].y * rs * gq.y + bq.y; o.z = v[q].z * rs * gq.z + bq.z; o.w = v[q].w * rs * gq.w + bq.w;
            *(float4*)(H1 + row * 1024 + c) = o;
            uint2 ob; ob.x = pack2(o.x, o.y); ob.y = pack2(o.z, o.w);
            *(uint2*)(H1B + row * 1024 + c) = ob;
        }
    }
    __builtin_amdgcn_fence(__ATOMIC_RELEASE, "workgroup");
    __syncthreads();
    float* part = (float*)smem;
    int* lcnt = (int*)(smem + 4 * 32 * 33 * 4);
    {
        f32x16 acc;
#pragma unroll
        for (int i = 0; i < 16; ++i) acc[i] = 0.f;
        const int i32 = lane & 31, hh = lane >> 5;
        const float* ap = H1 + ((size_t)tok0 + i32) * 1024 + 256 * w + 4 * hh;
        const float* bp = p.w_r + (size_t)(256 * w + 4 * hh) * 32 + i32;
#pragma unroll 2
        for (int m = 0; m < 32; ++m) {
            const float4 a = *(const float4*)(ap + 8 * m);
            const float b0 = bp[(size_t)(8 * m + 0) * 32], b1 = bp[(size_t)(8 * m + 1) * 32], b2 = bp[(size_t)(8 * m + 2) * 32], b3 = bp[(size_t)(8 * m + 3) * 32];
            acc = __builtin_amdgcn_mfma_f32_32x32x2f32(a.x, b0, acc, 0, 0, 0);
            acc = __builtin_amdgcn_mfma_f32_32x32x2f32(a.y, b1, acc, 0, 0, 0);
            acc = __builtin_amdgcn_mfma_f32_32x32x2f32(a.z, b2, acc, 0, 0, 0);
            acc = __builtin_amdgcn_mfma_f32_32x32x2f32(a.w, b3, acc, 0, 0, 0);
        }
#pragma unroll
        for (int r = 0; r < 16; ++r) {
            const int row = (r & 3) + 8 * (r >> 2) + 4 * hh;
            part[(w * 32 + row) * 33 + i32] = acc[r];
        }
    }
    if (tid < 32) lcnt[tid] = 0;
    __syncthreads();
    float* lgt = (float*)(smem + 24576);
    for (int i = tid; i < 1024; i += 256) {
        const int t = i >> 5, j = i & 31;
        lgt[t * 33 + j] = part[(0 * 32 + t) * 33 + j] + part[(1 * 32 + t) * 33 + j] + part[(2 * 32 + t) * 33 + j] + part[(3 * 32 + t) * 33 + j] + p.b_r[j];
    }
    __syncthreads();
    int e_sel[4]; float w_sel[4]; int rank[4];
    if (tid < 32) {
        float v0 = -3.0e38f, v1 = -3.0e38f, v2 = -3.0e38f, v3 = -3.0e38f; int i0 = 0, i1 = 0, i2 = 0, i3 = 0;
#pragma unroll 8
        for (int j = 0; j < 32; ++j) {
            const float lg = lgt[tid * 33 + j];
            if (lg > v3) {
                if (lg > v0) { v3 = v2; i3 = i2; v2 = v1; i2 = i1; v1 = v0; i1 = i0; v0 = lg; i0 = j; }
                else if (lg > v1) { v3 = v2; i3 = i2; v2 = v1; i2 = i1; v1 = lg; i1 = j; }
                else if (lg > v2) { v3 = v2; i3 = i2; v2 = lg; i2 = j; }
                else { v3 = lg; i3 = j; }
            }
        }
        const float bestv[4] = {v0, v1, v2, v3}; const int besti[4] = {i0, i1, i2, i3};
        float den = 0.f;
#pragma unroll
        for (int k = 0; k < 4; ++k) { w_sel[k] = expf(bestv[k] - bestv[0]); den += w_sel[k]; }
#pragma unroll
        for (int k = 0; k < 4; ++k) { w_sel[k] /= den; e_sel[k] = besti[k]; rank[k] = atomicAdd(&lcnt[besti[k]], 1); }
    }
    __syncthreads();
    if (tid < 32) {
        const int c = lcnt[tid];
        int* counts = (int*)((float*)(ws + OFF_MISC) + 1024);
        lcnt[32 + tid] = c ? atomicAdd(&counts[tid], c) : 0;
    }
    __syncthreads();
    if (tid < 32) {
        int* la = (int*)(ws + OFF_LISTA); float* lw = (float*)(ws + OFF_LISTW);
#pragma unroll
        for (int k = 0; k < 4; ++k) {
            const size_t pos = (size_t)e_sel[k] * NTOK + lcnt[32 + e_sel[k]] + rank[k];
            la[pos] = (tok0 + tid) * 4 + k; lw[pos] = w_sel[k];
        }
    }
    __syncthreads();
}

struct MoeMap { int e, rt, ct, cnt, pbase; };
DEVI void moe_setup(const Params& p, int* sm  , int ctn) {
    const int tid = VTID;
    if (tid == 0) {
        const int* counts = (const int*)((const float*)(p.ws + OFF_MISC) + 1024);
        int tp = 0, cp = 0;
        for (int e = 0; e < 32; ++e) {
            const int c = counts[e];
            sm[e] = tp; sm[32 + e] = cp; sm[64 + e] = c;
            tp += ((c + 127) >> 7) * ctn; cp += c;
        }
        sm[96] = tp;
    }
    __syncthreads();
}
DEVI MoeMap moe_map(const int* sm, int tile, int ctn) {
    int e = 0;
#pragma unroll 1
    for (int i = 1; i < 32; ++i) if (sm[i] <= tile) e = i;
    MoeMap m; m.e = e; m.cnt = sm[64 + e]; m.pbase = sm[32 + e];
    const int tl = tile - sm[e], nrt = (m.cnt + 127) >> 7;
    m.ct = tl / nrt; m.rt = tl % nrt;
    return m;
}

DEVI void moe1_tile(const Params& p, char* smem, const MoeMap& mm) {
    char* ws = p.ws;
    const int tid = VTID, lane = tid & 63, wid = tid >> 6, wr = wid >> 1, wc = wid & 1, fr = lane & 15, fq = lane >> 4;
    const int* la = (const int*)(ws + OFF_LISTA) + (size_t)mm.e * NTOK;
    const u16* H1B = (const u16*)(ws + OFF_H1B);
    auto arow = [&](int r) { const int idx = mm.rt * 128 + r; const int tokn = idx < mm.cnt ? (la[idx] >> 2) : 0; return H1B + (size_t)tokn * 1024; };
    const u16* Bt = (const u16*)(ws + OFF_WGU) + ((size_t)mm.e * 2048 + (size_t)mm.ct * 128) * 1024;
    f32x4 acc[4][4];
    gemm128(tid, arow, Bt, 1024, 1024, smem, acc);
    u16* act = (u16*)(ws + OFF_ACT);
    const float* bgu = p.b_gu + (size_t)mm.e * 2048;
#pragma unroll
    for (int m = 0; m < 4; ++m) {
        const int idx0 = mm.rt * 128 + wr * 64 + m * 16 + fq * 4;
#pragma unroll
        for (int i = 0; i < 2; ++i) {
            const int col = 64 * mm.ct + 32 * wc + 16 * i + fr;
            const float bg_ = bgu[col], bu_ = bgu[1024 + col];
#pragma unroll
            for (int j = 0; j < 4; ++j) {
                if (idx0 + j < mm.cnt) {
                    float gt = acc[m][2 * i][j] + bg_; gt = fminf(gt, 7.f);
                    float up = acc[m][2 * i + 1][j] + bu_; up = fminf(fmaxf(up, -7.f), 7.f);
                    const float a = gt * (1.f / (1.f + __expf(-1.702f * gt))) * (up + 1.f);
                    act[(size_t)(mm.pbase + idx0 + j) * 1024 + col] = f2bf(a);
                }
            }
        }
    }
}

DEVI void moe2_tile(const Params& p, char* smem, const MoeMap& mm) {
    char* ws = p.ws;
    const int tid = VTID, lane = tid & 63, wid = tid >> 6, wr = wid >> 1, wc = wid & 1, fr = lane & 15, fq = lane >> 4;
    const u16* act = (const u16*)(ws + OFF_ACT);
    auto arow = [&](int r) { return act + (size_t)(mm.pbase + mm.rt * 128 + r) * 1024; };
    const u16* Bt = (const u16*)(ws + OFF_WDN) + ((size_t)mm.e * 1024 + (size_t)mm.ct * 128) * 1024;
    f32x4 acc[4][4];
    gemm128(tid, arow, Bt, 1024, 1024, smem, acc);
    const int* la = (const int*)(ws + OFF_LISTA) + (size_t)mm.e * NTOK;
    const float* lw = (const float*)(ws + OFF_LISTW) + (size_t)mm.e * NTOK;
    u16* Y = (u16*)(ws + OFF_Y);
    const float* bdn = p.b_dn + (size_t)mm.e * 1024;
#pragma unroll
    for (int m = 0; m < 4; ++m) {
        const int idx0 = mm.rt * 128 + wr * 64 + m * 16 + fq * 4;
#pragma unroll
        for (int j = 0; j < 4; ++j) {
            if (idx0 + j < mm.cnt) {
                const int a = la[idx0 + j]; const float wgt = lw[idx0 + j];
#pragma unroll
                for (int n = 0; n < 4; ++n) {
                    const int col = mm.ct * 128 + wc * 64 + n * 16 + fr;
                    Y[(size_t)a * 1024 + col] = f2bf((acc[m][n][j] + bdn[col]) * wgt);
                }
            }
        }
    }
}

constexpr int MOE_TAB_OFF = 131072;
DEVI void moe_setup8(const Params& p, char* smem_all, int ctn) {
    int* sm = (int*)(smem_all + MOE_TAB_OFF);
    if (TIDX == 0) {
        const int* counts = (const int*)((const float*)(p.ws + OFF_MISC) + 1024);
        int tp = 0, cp = 0;
        for (int e = 0; e < 32; ++e) {
            const int c = counts[e];
            sm[e] = tp; sm[33 + e] = cp; sm[65 + e] = c;
            tp += ((c + 255) >> 8) * ctn; cp += c;
        }
        sm[32] = tp;
    }
    __syncthreads();
}
template <bool GATHER>
struct MoeSrc {
    struct U { int e, rt, pn, cnt, pbase; };
    const LAS3 int* tab; const char* Bt; const int* la; int nrowsB, G, c;
    DEVI bool next(int i, U& u) const {
        const int L = i * G + c; if (L >= tab[32]) return false;
        int e = 0;
#pragma unroll 1
        for (int k = 1; k < 32; ++k) e = (tab[k] <= L) ? k : e;
        u.e = e; u.cnt = tab[65 + e]; u.pbase = tab[33 + e];
        const int tl = L - tab[e], nrt = (u.cnt + 255) >> 8;
        u.pn = tl / nrt; u.rt = tl - u.pn * nrt;
        return true;
    }
    DEVI unsigned aoff(const U& u, int row) const {
        const int idx = u.rt * 256 + row;
        if (GATHER) { const int tokn = idx < u.cnt ? (la[(size_t)u.e * NTOK + idx] >> 2) : 0; return (unsigned)tokn * 2048u; }
        return (unsigned)(u.pbase + idx) * 2048u;
    }
    DEVI const char* bbase(const U& u) const { return Bt + ((size_t)u.e * nrowsB + (size_t)u.pn * 256) * 2048; }
};
struct EpiMoe1 {
    const float* b_gu; u16* act;
    DEVI void operator()(const f32x4 (&acc)[2][2][4][2], const MoeSrc<true>::U& u, int wr, int wc, int fr, int fq) const {
        const float* bg = b_gu + (size_t)u.e * 2048;
        float4 bgate[2], bup[2];
#pragma unroll
        for (int bj = 0; bj < 2; ++bj) {
            const int col = u.pn * 128 + (bj * 4 + wc) * 16 + 4 * fq;
            bgate[bj] = *(const float4*)(bg + col); bup[bj] = *(const float4*)(bg + 1024 + col);
        }
#pragma unroll
        for (int ai = 0; ai < 2; ++ai)
#pragma unroll
            for (int m = 0; m < 4; ++m) {
                const int idx = u.rt * 256 + ai * 128 + wr * 64 + m * 16 + fr;
                if (idx < u.cnt) {
#pragma unroll
                    for (int bj = 0; bj < 2; ++bj) {
                        const int col = u.pn * 128 + (bj * 4 + wc) * 16 + 4 * fq;
                        const float bgv[4] = {bgate[bj].x, bgate[bj].y, bgate[bj].z, bgate[bj].w};
                        const float buv[4] = {bup[bj].x, bup[bj].y, bup[bj].z, bup[bj].w};
                        f32x4 a;
#pragma unroll
                        for (int j = 0; j < 4; ++j) {
                            float gt = acc[ai][bj][m][0][j] + bgv[j]; gt = fminf(gt, 7.f);
                            float up = acc[ai][bj][m][1][j] + buv[j]; up = fminf(fmaxf(up, -7.f), 7.f);
                            a[j] = gt * (1.f / (1.f + __expf(-1.702f * gt))) * (up + 1.f);
                        }
                        *(uint2*)(act + (size_t)(u.pbase + idx) * 1024 + col) = pack4(a);
                    }
                }
            }
    }
};
struct EpiMoe2 {
    const float* b_dn; const int* la; const float* lw; u16* Y;
    DEVI void operator()(const f32x4 (&acc)[2][2][4][2], const MoeSrc<false>::U& u, int wr, int wc, int fr, int fq) const {
        const float* bd = b_dn + (size_t)u.e * 1024;
#pragma unroll
        for (int ai = 0; ai < 2; ++ai) {
            int av[4]; float wv[4];
#pragma unroll
            for (int m = 0; m < 4; ++m) {
                const int idx = u.rt * 256 + ai * 128 + wr * 64 + m * 16 + fr;
                const bool ok = idx < u.cnt;
                av[m] = ok ? la[(size_t)u.e * NTOK + idx] : -1;
                wv[m] = ok ? lw[(size_t)u.e * NTOK + idx] : 0.f;
            }
#pragma unroll
            for (int bj = 0; bj < 2; ++bj) {
                const int col = u.pn * 256 + bj * 128 + wc * 32 + fq * 8;
                const float4 b0 = *(const float4*)(bd + col), b1 = *(const float4*)(bd + col + 4);
#pragma unroll
                for (int m = 0; m < 4; ++m) {
                    if (av[m] >= 0) {
                        const float wgt = wv[m];
                        uint4 v;
                        v.x = pack2((acc[ai][bj][m][0][0] + b0.x) * wgt, (acc[ai][bj][m][0][1] + b0.y) * wgt);
                        v.y = pack2((acc[ai][bj][m][0][2] + b0.z) * wgt, (acc[ai][bj][m][0][3] + b0.w) * wgt);
                        v.z = pack2((acc[ai][bj][m][1][0] + b1.x) * wgt, (acc[ai][bj][m][1][1] + b1.y) * wgt);
                        v.w = pack2((acc[ai][bj][m][1][2] + b1.z) * wgt, (acc[ai][bj][m][1][3] + b1.w) * wgt);
                        *(uint4*)(Y + (size_t)av[m] * 1024 + col) = v;
                    }
                }
            }
        }
    }
};
DEVI void phase_moe1_8(const Params& p, char* smem_all) {
    moe_setup8(p, smem_all, 8);
    MoeSrc<true> S; S.tab = (const LAS3 int*)(smem_all + MOE_TAB_OFF); S.Bt = p.ws + OFF_WGU; S.la = (const int*)(p.ws + OFF_LISTA); S.nrowsB = 2048; S.G = gridDim.x; S.c = blockIdx.x;
    EpiMoe1 E; E.b_gu = p.b_gu; E.act = (u16*)(p.ws + OFF_ACT);
    g8::gemm_phase<true, false>(TIDX, (LAS3 unsigned char*)smem_all, p.ws + OFF_H1B, S, E);
}
DEVI void phase_moe2_8(const Params& p, char* smem_all) {
    moe_setup8(p, smem_all, 4);
    MoeSrc<false> S; S.tab = (const LAS3 int*)(smem_all + MOE_TAB_OFF); S.Bt = p.ws + OFF_WDN; S.la = nullptr; S.nrowsB = 1024; S.G = gridDim.x; S.c = blockIdx.x;
    EpiMoe2 E; E.b_dn = p.b_dn; E.la = (const int*)(p.ws + OFF_LISTA); E.lw = (const float*)(p.ws + OFF_LISTW); E.Y = (u16*)(p.ws + OFF_Y);
    g8::gemm_phase<true, true>(TIDX, (LAS3 unsigned char*)smem_all, p.ws + OFF_ACT, S, E);
}

struct EpiProjT {
    char* ws; const float* lb;
    DEVI void operator()(const f32x4 (&acc)[2][2][4][2], const g8::DenseSrc::U& u, int wr, int wc, int fr, int fq) const {
        const int mt = u.pn;
        float4 lb0[2], lb1[2];
        if (mt == 6 || mt == 7) {
#pragma unroll
            for (int bj = 0; bj < 2; ++bj) { const int hk = (mt - 6) * 256 + bj * 128 + wc * 32 + fq * 8; lb0[bj] = *(const float4*)(lb + hk); lb1[bj] = *(const float4*)(lb + hk + 4); }
        }
#pragma unroll
        for (int ai = 0; ai < 2; ++ai)
#pragma unroll
            for (int m = 0; m < 4; ++m) {
                const int tok = u.pm * 256 + ai * 128 + wr * 64 + m * 16 + fr;
                const int b = tok >> 13, s = tok & 8191;
#pragma unroll
                for (int bj = 0; bj < 2; ++bj) {
                    const int c8 = bj * 128 + wc * 32 + fq * 8;
                    const f32x4 v0 = acc[ai][bj][m][0], v1 = acc[ai][bj][m][1];
                    if (mt < 2) {
                        uint4 o; const float qs_ = 0.125f * 1.4426950408889634f;
                        o.x = pack2(v0[0] * qs_, v0[1] * qs_); o.y = pack2(v0[2] * qs_, v0[3] * qs_);
                        o.z = pack2(v1[0] * qs_, v1[1] * qs_); o.w = pack2(v1[2] * qs_, v1[3] * qs_);
                        *(uint4*)((u16*)(ws + OFF_Q) + (size_t)tok * 512 + mt * 256 + c8) = o;
                    } else if (mt < 4) {
                        const int g = wc >> 1, d0 = (wc & 1) * 32 + fq * 8;
                        uint4 o; o.x = pack2(v0[0], v0[1]); o.y = pack2(v0[2], v0[3]); o.z = pack2(v1[0], v1[1]); o.w = pack2(v1[2], v1[3]);
                        u16* dst;
                        if (mt == 2) dst = (u16*)(ws + (bj ? OFF_VCR : OFF_KCR)) + ((size_t)(b * 2 + g) * SP + s) * 64 + d0;
                        else dst = (u16*)(ws + (bj ? OFF_KW : OFF_KS)) + ((size_t)(b * 2 + g) * 8192 + s) * 64 + d0;
                        *(uint4*)dst = o;
                    } else if (mt < 6) {
                        uint4 o; o.x = pack2(v0[0], v0[1]); o.y = pack2(v0[2], v0[3]); o.z = pack2(v1[0], v1[1]); o.w = pack2(v1[2], v1[3]);
                        *(uint4*)((u16*)(ws + OFF_QH) + (size_t)tok * 512 + (mt - 4) * 256 + c8) = o;
                    } else if (mt < 8) {
                        const float lv[8] = {lb0[bj].x, lb0[bj].y, lb0[bj].z, lb0[bj].w, lb1[bj].x, lb1[bj].y, lb1[bj].z, lb1[bj].w};
                        float r[8];
#pragma unroll
                        for (int j = 0; j < 8; ++j) {
                            const float z = j < 4 ? v0[j & 3] : v1[j & 3];
                            const float fh = 1.f / (1.f + expf(-z));
                            r[j] = logf(lv[j] + (1.f - lv[j]) * fh);
                        }
                        float* dst = (float*)(ws + OFF_LOGF) + (size_t)tok * 512 + (mt - 6) * 256 + c8;
                        *(float4*)dst = make_float4(r[0], r[1], r[2], r[3]); *(float4*)(dst + 4) = make_float4(r[4], r[5], r[6], r[7]);
                    } else {
                        float r[8];
#pragma unroll
                        for (int j = 0; j < 8; ++j) { const float z = j < 4 ? v0[j & 3] : v1[j & 3]; r[j] = z / (1.f + __expf(-z)); }
                        uint4 o; o.x = pack2(r[0], r[1]); o.y = pack2(r[2], r[3]); o.z = pack2(r[4], r[5]); o.w = pack2(r[6], r[7]);
                        *(uint4*)((u16*)(ws + OFF_GH) + (size_t)tok * 512 + (mt - 8) * 256 + c8) = o;
                    }
                }
            }
    }
};
struct EpiProjN {
    char* ws;
    DEVI void operator()(const f32x4 (&acc)[2][2][4][2], const g8::DenseSrc::U& u, int wr, int wc, int fr, int fq) const {
        const int mt = u.pn;
#pragma unroll
        for (int ai = 0; ai < 2; ++ai)
#pragma unroll
            for (int m = 0; m < 4; ++m) {
                const int tok = u.pm * 256 + ai * 128 + wr * 64 + m * 16 + fq * 4;
                const int b = tok >> 13, s = tok & 8191;
#pragma unroll
                for (int bj = 0; bj < 2; ++bj)
#pragma unroll
                    for (int n = 0; n < 2; ++n) {
                        const int c = bj * 128 + wc * 32 + n * 16 + fr;
                        u16* dst;
                        if (mt == 0) {
                            const int g = wc >> 1, d = (wc & 1) * 32 + n * 16 + fr;
                            dst = (u16*)(ws + (bj ? OFF_VWT : OFF_VST)) + (((size_t)(b * 2 + g) * 128 + (s >> 6)) * 64 + d) * 64 + (s & 63);
                        } else {
                            const int hv = (mt - 1) * 256 + c;
                            dst = (u16*)(ws + OFF_VTH) + (((size_t)(b * 4 + (hv >> 7)) * 128 + (s >> 6)) * 128 + (hv & 127)) * 64 + (s & 63);
                        }
                        *(uint2*)dst = pack4(acc[ai][bj][m][n]);
                    }
            }
    }
};
DEVI void phase_proj8(const Params& p, char* smem_all) {
    {
        g8::DenseSrc S; S.init(p.ws + OFF_WIN, NTOK, 2560, gridDim.x, blockIdx.x);
        EpiProjT E; E.ws = p.ws; E.lb = (const float*)(p.ws + OFF_MISC) + 512;
        g8::gemm_phase<true, true>(TIDX, (LAS3 unsigned char*)smem_all, p.ws + OFF_XB, S, E);
    }
    {
        g8::DenseSrc S; S.init(p.ws + OFF_WIN + (size_t)2560 * 2048, NTOK, 768, gridDim.x, blockIdx.x);
        EpiProjN E; E.ws = p.ws;
        g8::gemm_phase<false, false>(TIDX, (LAS3 unsigned char*)smem_all, p.ws + OFF_XB, S, E);
    }
}
DEVI void gates_tile(const Params& p, char* smem, int rt) {
    char* ws = p.ws;
    const int tid = VTID, lane = tid & 63, wid = tid >> 6, wr = wid >> 1, wc = wid & 1, fr = lane & 15, fq = lane >> 4;
    const u16* XB = (const u16*)(ws + OFF_XB);
    auto arow = [&](int r) { return XB + (size_t)(rt * 128 + r) * 1024; };
    f32x4 acc[4][4];
    gemm128(tid, arow, (const u16*)(ws + OFF_WIN) + (size_t)3328 * 1024, 1024, 1024, smem, acc);
    if (wc == 0) {
        float* dst = (float*)(ws + OFF_GATES);
#pragma unroll
        for (int m = 0; m < 4; ++m)
#pragma unroll
            for (int n = 0; n < 2; ++n) {
                const int cc = n * 16 + fr, tok = rt * 128 + wr * 64 + m * 16 + fq * 4;
                if (cc < 24) {
#pragma unroll
                    for (int j = 0; j < 4; ++j) dst[(size_t)(tok + j) * 24 + cc] = 1.f / (1.f + expf(-acc[m][n][j]));
                }
            }
    }
}
DEVI void rope_task(const Params& p, int task) {
    char* ws = p.ws;
    const int gid = task * 256 + VTID;
    const int tok = gid / 12, vec = gid - tok * 12;
    const int b = tok >> 13, s = tok & 8191;
    u16* ptr;
    if (vec < 8) ptr = (u16*)(ws + OFF_Q) + (size_t)tok * 512 + vec * 64;
    else { const int g = vec & 1; ptr = (u16*)(ws + (vec < 10 ? OFF_KS : OFF_KW)) + ((size_t)(b * 2 + g) * 8192 + s) * 64; }
    const float* cs = (const float*)(ws + OFF_ROPE) + (size_t)tok * 8;
    const float4 c0 = *(const float4*)cs, c1 = *(const float4*)(cs + 4), s0 = *(const float4*)(cs + (size_t)NTOK * 8), s1 = *(const float4*)(cs + (size_t)NTOK * 8 + 4);
    const uint4 a = *(const uint4*)ptr, bq = *(const uint4*)(ptr + 8);
    const float cv[8] = {c0.x, c0.y, c0.z, c0.w, c1.x, c1.y, c1.z, c1.w}, sv[8] = {s0.x, s0.y, s0.z, s0.w, s1.x, s1.y, s1.z, s1.w};
    const uint32_t aw[4] = {a.x, a.y, a.z, a.w}, bw[4] = {bq.x, bq.y, bq.z, bq.w};
    float o1[8], o2[8];
#pragma unroll
    for (int i = 0; i < 8; ++i) {
        const float x1 = (i & 1) ? __uint_as_float(aw[i >> 1] & 0xffff0000u) : __uint_as_float(aw[i >> 1] << 16);
        const float x2 = (i & 1) ? __uint_as_float(bw[i >> 1] & 0xffff0000u) : __uint_as_float(bw[i >> 1] << 16);
        o1[i] = x1 * cv[i] - x2 * sv[i]; o2[i] = x2 * cv[i] + x1 * sv[i];
    }
    uint4 oa, ob;
    oa.x = pack2(o1[0], o1[1]); oa.y = pack2(o1[2], o1[3]); oa.z = pack2(o1[4], o1[5]); oa.w = pack2(o1[6], o1[7]);
    ob.x = pack2(o2[0], o2[1]); ob.y = pack2(o2[2], o2[3]); ob.z = pack2(o2[4], o2[5]); ob.w = pack2(o2[6], o2[7]);
    *(uint4*)ptr = oa; *(uint4*)(ptr + 8) = ob;
}

DEVI void final_rows(const Params& p, int task) {
    char* ws = p.ws;
    const int tid = VTID, lane = tid & 63, w = tid >> 6;
    const float* H1 = (const float*)(ws + OFF_H1); const u16* Y = (const u16*)(ws + OFF_Y);
    for (int i = 0; i < 8; ++i) {
        const size_t row = (size_t)task * 32 + w * 8 + i;
        float4 v[4];
        float s = 0.f;
#pragma unroll
        for (int q = 0; q < 4; ++q) {
            const int c = q * 256 + lane * 4;
            float4 a = *(const float4*)(H1 + row * 1024 + c);
            a.x *= DN_ALPHA; a.y *= DN_ALPHA; a.z *= DN_ALPHA; a.w *= DN_ALPHA;
#pragma unroll
            for (int k = 0; k < 4; ++k) {
                const uint2 y = *(const uint2*)(Y + (row * 4 + k) * 1024 + c);
                a.x += __uint_as_float(y.x << 16); a.y += __uint_as_float(y.x & 0xffff0000u);
                a.z += __uint_as_float(y.y << 16); a.w += __uint_as_float(y.y & 0xffff0000u);
            }
            v[q] = a; s += a.x + a.y + a.z + a.w;
        }
        const float mu = wave_sum(s) * (1.f / 1024.f);
        float ss = 0.f;
#pragma unroll
        for (int q = 0; q < 4; ++q) { v[q].x -= mu; v[q].y -= mu; v[q].z -= mu; v[q].w -= mu; ss += v[q].x * v[q].x + v[q].y * v[q].y + v[q].z * v[q].z + v[q].w * v[q].w; }
        const float rs = rsqrtf(wave_sum(ss) * (1.f / 1024.f) + 1e-5f);
#pragma unroll
        for (int q = 0; q < 4; ++q) {
            const int c = q * 256 + lane * 4;
            const float4 gq = *(const float4*)(p.ln2g + c), bq = *(const float4*)(p.ln2b + c);
            float4 o; o.x = v[q].x * rs * gq.x + bq.x; o.y = v[q].y * rs * gq.y + bq.y; o.z = v[q].z * rs * gq.z + bq.z; o.w = v[q].w * rs * gq.w + bq.w;
            *(float4*)(p.out + row * 1024 + c) = o;
        }
    }
}

DEVI void run_phase(const Params& p, char* smem, char* smem_all, int ph) {
    const int G = VGRID, B0 = VBID;
#ifdef ONLY_PHASE
    if (ph != ONLY_PHASE) return;
#endif
    switch (ph) {
    case 0: phase_prep(p, smem); break;
    case 1: phase_proj8(p, smem_all); break;
    case 2:
        for (int t = B0; t < 128; t += G) cmp1_tile(p, smem, t);
        for (int t = B0; t < 256; t += G) gates_tile(p, smem, t);
        for (int t = B0; t < 1536; t += G) rope_task(p, t);
        for (int t = B0; t < 2048; t += G) hgrn_local_tile(p, smem, t);
        break;
    case 3:
        for (int t = B0; t < 64; t += G) cmp2_tile(p, smem, t);
        for (int t = G - 1 - B0; t < 512; t += G) hgrn_scan_task(p, t);
        break;
    case 4: {
        int* qctr = (int*)((float*)(p.ws + OFF_MISC) + 1024) + 32;
        int* sh = (int*)(smem_all + 131072);
        for (;;) {
            __syncthreads();
            if (TIDX == 0) sh[0] = atomicAdd(qctr, 1);
            __syncthreads();
            const int item = sh[0];
            if (item >= NSA_TILES + 1024) break;
            if (item < NSA_TILES) nsa_tile(p, smem_all, item);
            else hgrn_out_tile(p, smem, (item - NSA_TILES) * 2 + (p.ph_lo >> 2));
        }
    } break;
    case 5:
        phase_wo8(p, smem_all);
        break;
    case 6:
        for (int t = B0; t < 1024; t += G) ln1_router_tile(p, smem, t);
        break;
    case 7: phase_moe1_8(p, smem_all); break;
    case 8: phase_moe2_8(p, smem_all); break;
    case 9:
        for (int t = B0; t < 1024; t += G) final_rows(p, t);
        break;
    }
}

#define XB_TMO      128
#define XB_XCNT(j)  (256  + 64 * (j))
#define XB_XSUB(j)  (1280 + 64 * (j))
#define XB_XGEN(j)  (2304 + 64 * (j))
#define XB_TOP      3328
#define XB_TOPGEN   3392
#define XCD_BAR_WORDS 3456
#define XB_SPIN_CAP (1u << 18)
#define LAS LAS3

__device__ __forceinline__ unsigned xb_ld(unsigned* p)              { return __hip_atomic_load(p, __ATOMIC_RELAXED, __HIP_MEMORY_SCOPE_AGENT); }
__device__ __forceinline__ unsigned xb_add(unsigned* p, unsigned v) { return __hip_atomic_fetch_add(p, v, __ATOMIC_RELAXED, __HIP_MEMORY_SCOPE_AGENT); }
__device__ __forceinline__ unsigned xb_xcc_id() { return (unsigned)__builtin_amdgcn_s_getreg((3 << 11) | 20) & 0xFu; }
#define XB_SPIN(cond, bar) do { unsigned _sp = 0; while (cond) { __builtin_amdgcn_s_sleep(1); \
    if ((++_sp & 255u) == 0u) { if (xb_ld(&(bar)[XB_TMO])) break; if (_sp > XB_SPIN_CAP) { atomicAdd(&(bar)[XB_TMO], 1u); break; } } } } while (0)

struct XcdBarrier {
    unsigned* bar; unsigned x;
    volatile LAS unsigned* st;
};

__device__ __forceinline__ XcdBarrier xcd_barrier_post(unsigned* bar, volatile LAS unsigned* st, const bool lead) {
    XcdBarrier b; b.bar = bar; b.x = xb_xcc_id(); b.st = st;
    if (lead) (void)xb_add(&bar[XB_XCNT(b.x)], 1u);
    return b;
}
__device__ __forceinline__ void xcd_barrier_complete(unsigned* bar, unsigned x, unsigned& nloc, unsigned& nx) {
    const unsigned G = gridDim.x * gridDim.y * gridDim.z;
    unsigned sum, cnt, mine, sp = 0u;
    for (;;) {
        sum = 0u; cnt = 0u; mine = 0u;
#pragma unroll
        for (unsigned j = 0; j < 16; ++j) { const unsigned c = xb_ld(&bar[XB_XCNT(j)]); sum += c; cnt += (c > 0u) ? 1u : 0u; mine = (j == x) ? c : mine; }
        if (sum == G) break;
        __builtin_amdgcn_s_sleep(1);
        if ((++sp & 255u) == 0u) { if (xb_ld(&bar[XB_TMO])) break; if (sp > XB_SPIN_CAP) { atomicAdd(&bar[XB_TMO], 1u); break; } }
    }
    nloc = mine > 0u ? mine : 1u; nx = cnt > 0u ? cnt : 1u;
}

__device__ __forceinline__ void xcd_barrier(const XcdBarrier& b, const bool lead) {
    asm volatile("s_waitcnt vmcnt(0)" ::: "memory");
    __syncthreads();
    if (lead) {
        unsigned* bar = b.bar;
        __builtin_amdgcn_s_waitcnt(0);
        unsigned nloc = b.st[0], nx = b.st[1];
        if (nloc == 0u) { xcd_barrier_complete(bar, b.x, nloc, nx); b.st[0] = nloc; b.st[1] = nx; }
        const unsigned old = xb_add(&bar[XB_XSUB(b.x)], 1u);
        const unsigned gen = old / nloc;
        if (old + 1u == (gen + 1u) * nloc) {
            __builtin_amdgcn_fence(__ATOMIC_RELEASE, "agent");
            asm volatile("s_waitcnt vmcnt(0)" ::: "memory");
            const unsigned og = xb_add(&bar[XB_TOP], 1u);
            const unsigned tg = og / nx;
            if (og + 1u == (tg + 1u) * nx) xb_add(&bar[XB_TOPGEN], 1u);
            else XB_SPIN(xb_ld(&bar[XB_TOPGEN]) == tg, bar);
            __builtin_amdgcn_fence(__ATOMIC_ACQUIRE, "agent");
            xb_add(&bar[XB_XGEN(b.x)], 1u);
            asm volatile("s_waitcnt vmcnt(0)" ::: "memory");
        } else {
            XB_SPIN(xb_ld(&bar[XB_XGEN(b.x)]) == gen, bar);
            __builtin_amdgcn_fence(__ATOMIC_ACQUIRE, "agent");
            asm volatile("s_waitcnt vmcnt(0)" ::: "memory");
        }
    }
    __syncthreads();
}


#if N_LAUNCH_MODE == 1
__global__ void __launch_bounds__(512, 2) fwd_kernel(Params p_in) {
    extern __shared__ __attribute__((aligned(16))) char smem_all[];
    Params p = p_in;
    p.ph_lo = __builtin_amdgcn_readfirstlane((int)(threadIdx.x >> 6));
    char* smem = smem_all + (p.ph_lo >> 2) * 65536;
    cg::grid_group grid = cg::this_grid();
#ifndef PROBE_REP
#define PROBE_REP -1
#endif
    run_phase(p, smem, smem_all, 0);
    grid.sync();
    volatile LAS3 unsigned* xst = (volatile LAS3 unsigned*)(smem_all + 131072 + 512);
    if (TIDX == 0) { xst[0] = 0u; xst[1] = 0u; }
    __syncthreads();
    const XcdBarrier xb = xcd_barrier_post((unsigned*)(p.ws + OFF_BAR), xst, TIDX == 0);
#define GSYNC() xcd_barrier(xb, TIDX == 0)
#define RP(k) run_phase(p, smem, smem_all, k); GSYNC(); if (PROBE_REP == k) { run_phase(p, smem, smem_all, k); GSYNC(); }
    RP(1) RP(2)
    run_phase(p, smem, smem_all, 3); GSYNC();
    run_phase(p, smem, smem_all, 4); GSYNC();
    RP(5)
    run_phase(p, smem, smem_all, 6); GSYNC();
    RP(7) RP(8)
    run_phase(p, smem, smem_all, 9);
    if (PROBE_REP == 9) { GSYNC(); run_phase(p, smem, smem_all, 9); }
#undef RP
}
#define KFN fwd_kernel
#else
template <int PH>
__global__ void __launch_bounds__(256, 2) phase_kernel(Params p) {
    extern __shared__ __attribute__((aligned(16))) char smem[];
    run_phase(p, smem, PH);
}
#define KFN phase_kernel<4>
#endif

extern "C" void kernel_launch(void* const* d_in, const int* in_sizes, int n_in, void* d_out, int out_size, void* d_ws, size_t ws_size,
                              hipStream_t stream) {
    static int grid = 0;
    if (grid == 0) {
        if (ws_size < WS_NEED) { fprintf(stderr, "kernel_launch: workspace too small: %zu < %zu\n", ws_size, (size_t)WS_NEED); grid = -1; return; }
        int dev = 0, cus = 0, per_cu = 0;
        (void)hipGetDevice(&dev);
        (void)hipDeviceGetAttribute(&cus, hipDeviceAttributeMultiprocessorCount, dev);
#if N_LAUNCH_MODE == 1
        (void)hipFuncSetAttribute((const void*)KFN, hipFuncAttributeMaxDynamicSharedMemorySize, SMEM_BYTES);
#else
#define SA_(PH) (void)hipFuncSetAttribute((const void*)phase_kernel<PH>, hipFuncAttributeMaxDynamicSharedMemorySize, SMEM_BYTES);
        SA_(0) SA_(1) SA_(2) SA_(3) SA_(4) SA_(5) SA_(6) SA_(7) SA_(8) SA_(9)
#undef SA_
#endif
        (void)hipOccupancyMaxActiveBlocksPerMultiprocessor(&per_cu, (const void*)KFN, 512, SMEM_BYTES);
        if (per_cu < 1) per_cu = 1;
        if (per_cu > 1) per_cu = 1;
        grid = cus * per_cu;
    }
    if (grid < 0) return;
    Params p{};
    p.x = (const float*)d_in[0]; p.pos = (const int*)d_in[1]; p.w_in = (const float*)d_in[2]; p.pe = (const float*)d_in[3];
    p.w_ck1 = (const float*)d_in[4]; p.w_ck2 = (const float*)d_in[5]; p.w_cv1 = (const float*)d_in[6]; p.w_cv2 = (const float*)d_in[7];
    p.hg_lb = (const float*)d_in[8]; p.hg_ng = (const float*)d_in[9]; p.w_o = (const float*)d_in[10]; p.ln1g = (const float*)d_in[11];
    p.ln1b = (const float*)d_in[12]; p.w_r = (const float*)d_in[13]; p.b_r = (const float*)d_in[14]; p.w_gu = (const float*)d_in[15];
    p.b_gu = (const float*)d_in[16]; p.w_dn = (const float*)d_in[17]; p.b_dn = (const float*)d_in[18]; p.ln2g = (const float*)d_in[19];
    p.ln2b = (const float*)d_in[20];
    p.out = (float*)d_out; p.ws = (char*)d_ws;
#if N_LAUNCH_MODE == 1
    p.ph_lo = 0; p.ph_hi = NPHASE;
    void* args[] = {&p};
    hipError_t e = hipLaunchCooperativeKernel((const void*)fwd_kernel, dim3(grid), dim3(512), args, SMEM_BYTES, stream);
    if (e != hipSuccess) fprintf(stderr, "cooperative launch failed: %s (grid %d)\n", hipGetErrorString(e), grid);
#else
    p.ph_lo = 0; p.ph_hi = NPHASE;
#define LP(PH) hipLaunchKernelGGL(phase_kernel<PH>, dim3(grid), dim3(256), SMEM_BYTES, stream, p);
    LP(0) LP(1) LP(2) LP(3) LP(4) LP(5) LP(6) LP(7) LP(8) LP(9)
#undef LP
#endif
}
```

```cpp
#include <hip/hip_runtime.h>
#include <hip/hip_cooperative_groups.h>
#include <stdint.h>
#include <stdio.h>
namespace cg = cooperative_groups;

typedef unsigned short u16;
typedef __attribute__((ext_vector_type(8))) short bf16x8;
typedef __attribute__((ext_vector_type(4))) float f32x4;
typedef __attribute__((ext_vector_type(16))) float f32x16;
#define DEVI __device__ __forceinline__
static __device__ __forceinline__ int laneid_() { int r; asm volatile("v_mbcnt_lo_u32_b32 %0, -1, 0\n\tv_mbcnt_hi_u32_b32 %0, -1, %0" : "=v"(r)); return r; }
#define LANEID (laneid_())
#define TIDX (p.ph_lo * 64 + LANEID)
#define VTID ((p.ph_lo & 3) * 64 + LANEID)
#define VBID ((int)(blockIdx.x * 2 + (p.ph_lo >> 2)))
#define VGRID ((int)(gridDim.x * 2))

#ifndef N_LAUNCH_MODE
#define N_LAUNCH_MODE 1
#endif

constexpr int NTOK = 32768, SEQ = 8192, NB = 4;
constexpr int SP = 8224;
constexpr int NPHASE = 10;
constexpr int XCD_BAR_WORDS_ = 3456;
constexpr int SMEM_BYTES = 131072 + 1024;
constexpr float DN_ALPHA = 1.189207115002721f;

constexpr size_t MB = 1ull << 20;
constexpr size_t OFF_WIN = 0;
constexpr size_t OFF_WCK1 = 7 * MB;
constexpr size_t OFF_WCV1 = 8 * MB;
constexpr size_t OFF_WCK2 = 9 * MB;
constexpr size_t OFF_WCV2 = 9 * MB + 65536;
constexpr size_t OFF_WO = 10 * MB;
constexpr size_t OFF_ROPE = 12 * MB;
constexpr size_t OFF_GATES = 14 * MB;
constexpr size_t OFF_MISC = 17 * MB;
constexpr size_t OFF_BAR = 17 * MB + 32768;
constexpr size_t OFF_LISTA = 18 * MB;
constexpr size_t OFF_LISTW = 22 * MB;
constexpr size_t OFF_HID = 26 * MB;
constexpr size_t OFF_KC = 30 * MB;
constexpr size_t OFF_VCT = 30 * MB + 524288;
constexpr size_t OFF_DG = 31 * MB;
constexpr size_t OFF_WGU = 32 * MB;
constexpr size_t OFF_WDN = 160 * MB;
constexpr size_t OFF_H1 = 224 * MB;
constexpr size_t OFF_H1B = 352 * MB;
constexpr size_t OFF_X = 416 * MB;
constexpr size_t OFF_XB = OFF_X;
constexpr size_t OFF_Q = OFF_X + 64 * MB;
constexpr size_t OFF_KCR = OFF_X + 96 * MB;
constexpr size_t OFF_VCR = OFF_X + 105 * MB;
constexpr size_t OFF_KS = OFF_X + 114 * MB;
constexpr size_t OFF_KW = OFF_X + 123 * MB;
constexpr size_t OFF_VST = OFF_X + 132 * MB;
constexpr size_t OFF_VWT = OFF_X + 141 * MB;
constexpr size_t OFF_QH = OFF_X + 150 * MB;
constexpr size_t OFF_LOGF = OFF_X + 182 * MB;
constexpr size_t OFF_VTH = OFF_X + 246 * MB;
constexpr size_t OFF_GH = OFF_X + 278 * MB;
constexpr size_t OFF_LBUF = OFF_X + 310 * MB;
constexpr size_t OFF_MIX = OFF_X + 374 * MB;
constexpr size_t OFF_PRE = OFF_X;
constexpr size_t OFF_ACT = OFF_X;
constexpr size_t OFF_Y = OFF_X + 256 * MB;
constexpr size_t WS_NEED = OFF_Y + 256 * MB;

struct Params {
    const float* x; const int* pos; const float* w_in; const float* pe;
    const float* w_ck1; const float* w_ck2; const float* w_cv1; const float* w_cv2;
    const float* hg_lb; const float* hg_ng; const float* w_o; const float* ln1g; const float* ln1b;
    const float* w_r; const float* b_r; const float* w_gu; const float* b_gu; const float* w_dn; const float* b_dn;
    const float* ln2g; const float* ln2b;
    float* out; char* ws;
    int ph_lo, ph_hi;
};

DEVI u16 f2bf(float f) { uint32_t u = __float_as_uint(f); u += 0x7fffu + ((u >> 16) & 1u); return (u16)(u >> 16); }
DEVI float bf2f(u16 h) { return __uint_as_float(((uint32_t)h) << 16); }
typedef float f32x2_t __attribute__((ext_vector_type(2)));
typedef __bf16 bf16x2_t __attribute__((ext_vector_type(2)));
DEVI uint32_t pack2(float a, float b) { f32x2_t v = {a, b}; bf16x2_t r = __builtin_convertvector(v, bf16x2_t); return __builtin_bit_cast(uint32_t, r); }
DEVI bf16x8 pack8(f32x4 a, f32x4 b) {
    union { bf16x8 v; uint32_t u[4]; } r;
    r.u[0] = pack2(a[0], a[1]); r.u[1] = pack2(a[2], a[3]); r.u[2] = pack2(b[0], b[1]); r.u[3] = pack2(b[2], b[3]);
    return r.v;
}
DEVI uint2 pack4(f32x4 a) { uint2 r; r.x = pack2(a[0], a[1]); r.y = pack2(a[2], a[3]); return r; }
DEVI f32x4 mfma16(bf16x8 a, bf16x8 b, f32x4 c) { return __builtin_amdgcn_mfma_f32_16x16x32_bf16(a, b, c, 0, 0, 0); }
DEVI bf16x8 ld8(const u16* p) { return *reinterpret_cast<const bf16x8*>(p); }
DEVI bf16x8 zero8() { bf16x8 z = {0, 0, 0, 0, 0, 0, 0, 0}; return z; }
DEVI float sigmoidf_(float v) { return 1.f / (1.f + __expf(-v)); }
DEVI float xor16_max(float v) { v = fmaxf(v, __shfl_xor(v, 16)); v = fmaxf(v, __shfl_xor(v, 32)); return v; }
DEVI float xor16_sum(float v) { v += __shfl_xor(v, 16); v += __shfl_xor(v, 32); return v; }
DEVI float wave_sum(float v) {
#pragma unroll
    for (int o = 32; o > 0; o >>= 1) v += __shfl_xor(v, o);
    return v;
}
DEVI void glds16(const u16* g, u16* l) {
    __builtin_amdgcn_global_load_lds((const unsigned*)g, (__attribute__((address_space(3))) unsigned*)l, 16, 0, 0);
}

template <class AFn>
DEVI void gemm128(const int tid, AFn arow, const u16* __restrict__ Bt, size_t ldb, int K, char* smem, f32x4 (&acc)[4][4]) {
    const int lane = tid & 63, wid = tid >> 6, wr = wid >> 1, wc = wid & 1, fr = lane & 15, fq = lane >> 4;
    u16* SA = (u16*)smem; u16* SB = (u16*)(smem + 8192);
    const int r0 = tid >> 2, c0 = (tid & 3) * 8;
    const u16* a0 = arow(r0) + c0; const u16* a1 = arow(r0 + 64) + c0;
    const u16* b0 = Bt + (size_t)r0 * ldb + c0; const u16* b1 = Bt + (size_t)(r0 + 64) * ldb + c0;
#pragma unroll
    for (int m = 0; m < 4; ++m)
#pragma unroll
        for (int n = 0; n < 4; ++n) acc[m][n] = f32x4{0.f, 0.f, 0.f, 0.f};
    for (int kt = 0; kt < K; kt += 32) {
        glds16(a0 + kt, SA + tid * 8); glds16(a1 + kt, SA + 2048 + tid * 8);
        glds16(b0 + kt, SB + tid * 8); glds16(b1 + kt, SB + 2048 + tid * 8);
        asm volatile("s_waitcnt vmcnt(0)" ::: "memory");
        __syncthreads();
        bf16x8 af[4], bfr[4];
#pragma unroll
        for (int m = 0; m < 4; ++m) af[m] = ld8(SA + (wr * 64 + m * 16 + fr) * 32 + fq * 8);
#pragma unroll
        for (int n = 0; n < 4; ++n) bfr[n] = ld8(SB + (wc * 64 + n * 16 + fr) * 32 + fq * 8);
#pragma unroll
        for (int m = 0; m < 4; ++m)
#pragma unroll
            for (int n = 0; n < 4; ++n) acc[m][n] = mfma16(af[m], bfr[n], acc[m][n]);
        __syncthreads();
    }
}

template <class CM>
DEVI void tconv_tile(const int tid, const float* __restrict__ src, size_t ld, u16* __restrict__ dst, size_t ldd, int r0, int k0, CM colmap, char* smem) {
    float (*t)[65] = (float (*)[65])smem;
    {
        const int k = tid >> 2, nb = (tid & 3) * 16;
        const int col = colmap(r0 + nb);
        float4 v[4];
#pragma unroll
        for (int j = 0; j < 4; ++j) v[j] = (col >= 0) ? *(const float4*)(src + (size_t)(k0 + k) * ld + col + 4 * j) : make_float4(0.f, 0.f, 0.f, 0.f);
#pragma unroll
        for (int j = 0; j < 4; ++j) { t[nb + 4 * j + 0][k] = v[j].x; t[nb + 4 * j + 1][k] = v[j].y; t[nb + 4 * j + 2][k] = v[j].z; t[nb + 4 * j + 3][k] = v[j].w; }
    }
    __syncthreads();
    {
        const int n = tid >> 2, kb = (tid & 3) * 16;
        uint4 o0, o1;
        o0.x = pack2(t[n][kb + 0], t[n][kb + 1]); o0.y = pack2(t[n][kb + 2], t[n][kb + 3]); o0.z = pack2(t[n][kb + 4], t[n][kb + 5]); o0.w = pack2(t[n][kb + 6], t[n][kb + 7]);
        o1.x = pack2(t[n][kb + 8], t[n][kb + 9]); o1.y = pack2(t[n][kb + 10], t[n][kb + 11]); o1.z = pack2(t[n][kb + 12], t[n][kb + 13]); o1.w = pack2(t[n][kb + 14], t[n][kb + 15]);
        u16* d = dst + (size_t)(r0 + n) * ldd + k0 + kb;
        *(uint4*)d = o0; *(uint4*)(d + 8) = o1;
    }
    __syncthreads();
}

DEVI void phase_prep(const Params& p, char* smem) {
    char* ws = p.ws;
    constexpr int J_WIN = 54 * 16;
    constexpr int J_WCK1 = 4 * 32;
    constexpr int J_WC2 = 2 * 4;
    constexpr int J_WO = 16 * 16;
    constexpr int J_WGU = 32 * 32 * 16;
    constexpr int J_WDN = 32 * 16 * 16;
    constexpr int J_XB = 4096;
    constexpr int J_ROPE = 1024;
    constexpr int J0 = 0, J1 = J0 + J_WIN, J2 = J1 + 2 * J_WCK1, J3 = J2 + 2 * J_WC2, J4 = J3 + J_WO, J5 = J4 + J_WGU,
                  J6 = J5 + J_WDN, J7 = J6 + J_XB, J8 = J7 + J_ROPE, J9 = J8 + 1;
    for (int job = VBID; job < J9; job += VGRID) {
        const int tid = VTID;
        if (job < J1) {
            const int j = job - J0, rt = j / 16, kt = j % 16;
            auto cm = [](int r) {
                if (r < 768) return r;
                if (r < 1024) { const int rr = r - 768; return rr < 128 ? 768 + rr : 1024 + (rr - 128); }
                if (r < 1536) return 1304 + (r - 1024);
                if (r < 2048) return 1816 + (r - 1536);
                if (r < 2560) return 2840 + (r - 2048);
                if (r < 2816) { const int rr = r - 2560; return rr < 128 ? 896 + rr : 1152 + (rr - 128); }
                if (r < 3328) return 2328 + (r - 2816);
                if (r < 3352) return 1280 + (r - 3328);
                return -1; };
            tconv_tile(tid, p.w_in, 3352, (u16*)(ws + OFF_WIN), 1024, rt * 64, kt * 64, cm, smem);
        } else if (job < J2) {
            int j = job - J1; const int which = j / J_WCK1; j %= J_WCK1; const int rt = j / 32, kt = j % 32;
            auto cm = [](int r) { return r; };
            tconv_tile(tid, which ? p.w_cv1 : p.w_ck1, 256, (u16*)(ws + (which ? OFF_WCV1 : OFF_WCK1)), 2048, rt * 64, kt * 64, cm, smem);
        } else if (job < J3) {
            int j = job - J2; const int which = j / J_WC2; j %= J_WC2; const int rt = j / 4, kt = j % 4;
            auto cm = [](int r) { return r < 64 ? r : -1; };
            tconv_tile(tid, which ? p.w_cv2 : p.w_ck2, 64, (u16*)(ws + (which ? OFF_WCV2 : OFF_WCK2)), 256, rt * 64, kt * 64, cm, smem);
        } else if (job < J4) {
            const int j = job - J3, rt = j / 16, kt = j % 16;
            auto cm = [](int r) { return r; };
            tconv_tile(tid, p.w_o, 1024, (u16*)(ws + OFF_WO), 1024, rt * 64, kt * 64, cm, smem);
        } else if (job < J5) {
            int j = job - J4; const int e = j / 512; j %= 512; const int rt = j / 16, kt = j % 16;
            auto cm = [](int r) { const int pn = r >> 8, bj = (r >> 7) & 1, wc = (r >> 5) & 3, n = (r >> 4) & 1, i = r & 15; return (n ? 1024 : 0) + pn * 128 + (bj * 4 + wc) * 16 + i; };
            tconv_tile(tid, p.w_gu + (size_t)e * 1024 * 2048, 2048, (u16*)(ws + OFF_WGU) + (size_t)e * 2048 * 1024, 1024, rt * 64, kt * 64, cm, smem);
        } else if (job < J6) {
            int j = job - J5; const int e = j / 256; j %= 256; const int rt = j / 16, kt = j % 16;
            auto cm = [](int r) { return r; };
            tconv_tile(tid, p.w_dn + (size_t)e * 1024 * 1024, 1024, (u16*)(ws + OFF_WDN) + (size_t)e * 1024 * 1024, 1024, rt * 64, kt * 64, cm, smem);
        } else if (job < J7) {
            const size_t base = (size_t)(job - J6) * 8192 + (size_t)tid * 8;
            float4 a[4], b[4];
#pragma unroll
            for (int i = 0; i < 4; ++i) { a[i] = *(const float4*)(p.x + base + i * 2048); b[i] = *(const float4*)(p.x + base + i * 2048 + 4); }
#pragma unroll
            for (int i = 0; i < 4; ++i) {
                uint4 o; o.x = pack2(a[i].x, a[i].y); o.y = pack2(a[i].z, a[i].w); o.z = pack2(b[i].x, b[i].y); o.w = pack2(b[i].z, b[i].w);
                *(uint4*)((u16*)(ws + OFF_XB) + base + i * 2048) = o;
            }
        } else if (job < J8) {
            const int idx = (job - J7) * 256 + tid;
            const int n = idx >> 3, i = idx & 7;
            const float inv = powf(500000.f, -(float)i / 8.f);
            const float ang = (float)p.pos[n] * inv;
            float s, c; sincosf(ang, &s, &c);
            float* ct = (float*)(ws + OFF_ROPE);
            ct[idx] = c; ct[NTOK * 8 + idx] = s;
        } else {
            float* misc = (float*)(ws + OFF_MISC);
            float sk = 0.f, sv = 0.f;
            for (int i = 0; i < 2048; ++i) { const float pe = p.pe[i]; sk += pe * p.w_ck1[(size_t)i * 256 + tid]; sv += pe * p.w_cv1[(size_t)i * 256 + tid]; }
            misc[tid] = sk; misc[256 + tid] = sv;
            for (int i = tid; i < 512; i += 256) { const float a0 = p.hg_lb[i], a1 = p.hg_lb[512 + i]; misc[512 + i] = 1.f / (1.f + expf(a1 - a0)); }
            if (tid < 64) ((int*)(misc + 1024))[tid] = 0;
            for (int i = tid; i < XCD_BAR_WORDS_; i += 256) ((unsigned*)(ws + OFF_BAR))[i] = 0u;
        }
    }
}

DEVI f32x4 rope4(f32x4 v, int fr, const float* __restrict__ cs, int i0, int i1, int i2, int i3) {
    const int i = fr & 7; const float sg = (fr & 8) ? 1.f : -1.f;
    const int idx[4] = {i0, i1, i2, i3};
    f32x4 o;
#pragma unroll
    for (int j = 0; j < 4; ++j) {
        const float partner = __shfl_xor(v[j], 8);
        const float c = cs[(size_t)idx[j] * 8 + i], s = cs[(size_t)NTOK * 8 + (size_t)idx[j] * 8 + i];
        o[j] = v[j] * c + sg * partner * s;
    }
    return o;
}

DEVI void hgrn_local_tile(const Params& p, char* smem, int tile) {
    char* ws = p.ws;
    const int bh = tile >> 7, chunk = tile & 127, b = bh >> 2, h = bh & 3;
    const int tid = VTID, lane = tid & 63, w = tid >> 6, fr = lane & 15, fq = lane >> 4;
    const size_t n0 = (size_t)b * 8192 + chunk * 64;
    const float* lfp = (const float*)(ws + OFF_LOGF) + n0 * 512 + h * 128;
    u16* khT = (u16*)(smem + 1024);
    float blast;
    float* totp = (float*)smem;
    {
        const int k = tid & 127, half = tid >> 7;
        float run = 0.f;
#pragma unroll 8
        for (int i = 0; i < 32; ++i) run += lfp[(size_t)(32 * half + i) * 512 + k];
        totp[half * 128 + k] = run;
        __syncthreads();
        const float t0 = totp[k], t1 = totp[128 + k];
        blast = t0 + t1;
        float bcur = half ? t0 : 0.f;
#pragma unroll 4
        for (int i = 0; i < 32; ++i) {
            const float lf = lfp[(size_t)(32 * half + i) * 512 + k];
            bcur += lf;
            const float kh = (1.f - expf(lf)) * expf(blast - bcur);
            khT[k * 72 + 32 * half + i] = f2bf(kh);
        }
        if (half == 0) ((float*)(ws + OFF_DG))[(size_t)tile * 128 + k] = expf(blast);
    }
    __syncthreads();
    const u16* vT = (const u16*)(ws + OFF_VTH) + (size_t)tile * 128 * 64;
    f32x4 acc[2][8];
#pragma unroll
    for (int m = 0; m < 2; ++m)
#pragma unroll
        for (int n = 0; n < 8; ++n) acc[m][n] = f32x4{0.f, 0.f, 0.f, 0.f};
#pragma unroll
    for (int ks = 0; ks < 2; ++ks) {
        bf16x8 a[2];
#pragma unroll
        for (int m = 0; m < 2; ++m) a[m] = ld8(khT + (32 * w + 16 * m + fr) * 72 + 32 * ks + 8 * fq);
#pragma unroll
        for (int n = 0; n < 8; ++n) {
            const bf16x8 bv = ld8(vT + (size_t)(16 * n + fr) * 64 + 32 * ks + 8 * fq);
#pragma unroll
            for (int m = 0; m < 2; ++m) acc[m][n] = mfma16(a[m], bv, acc[m][n]);
        }
    }
    u16* L = (u16*)(ws + OFF_LBUF) + (size_t)tile * 128 * 128;
#pragma unroll
    for (int m = 0; m < 2; ++m)
#pragma unroll
        for (int n = 0; n < 8; ++n) *(uint2*)(L + (size_t)(16 * n + fr) * 128 + 32 * w + 16 * m + 4 * fq) = pack4(acc[m][n]);
    __syncthreads();
}

DEVI void hgrn_scan_task(const Params& p, int task) {
    char* ws = p.ws;
    const int gid = task * 256 + VTID;
    const int bh = gid >> 13, v = (gid >> 6) & 127, kp = gid & 63;
    uint32_t* L = (uint32_t*)(ws + OFF_LBUF) + ((size_t)bh * 128 * 128 * 128 + (size_t)v * 128) / 2 + kp;
    const float2* Dg = (const float2*)(ws + OFF_DG) + (size_t)bh * 128 * 64 + kp;
    float s0 = 0.f, s1 = 0.f;
#pragma unroll 8
    for (int c = 0; c < 128; ++c) {
        const uint32_t l = L[(size_t)c * 8192];
        const float2 d = Dg[(size_t)c * 64];
        L[(size_t)c * 8192] = pack2(s0, s1);
        s0 = d.x * s0 + __uint_as_float(l << 16);
        s1 = d.y * s1 + __uint_as_float(l & 0xffff0000u);
    }
}

DEVI void hgrn_out_tile(const Params& p, char* smem, int tile) {
    char* ws = p.ws;
    const int bh = tile >> 7, chunk = tile & 127, b = bh >> 2, h = bh & 3;
    const int tid = VTID, lane = tid & 63, w = tid >> 6, fr = lane & 15, fq = lane >> 4;
    const size_t n0 = (size_t)b * 8192 + chunk * 64;
    const float* lfp = (const float*)(ws + OFF_LOGF) + n0 * 512 + h * 128;
    const u16* qh = (const u16*)(ws + OFF_QH) + n0 * 512 + h * 128;
    float* totp = (float*)smem;
    u16* qt = (u16*)(smem + 1024);
    u16* kt = qt + 64 * 136;
    {
        const int k = tid & 127, half = tid >> 7;
        float run = 0.f;
#pragma unroll 8
        for (int i = 0; i < 32; ++i) run += lfp[(size_t)(32 * half + i) * 512 + k];
        totp[half * 128 + k] = run;
        __syncthreads();
        float bcur = half ? totp[k] : 0.f;
#pragma unroll 4
        for (int i = 0; i < 32; ++i) {
            const int t = 32 * half + i;
            const float lf = lfp[(size_t)t * 512 + k];
            bcur += lf;
            const float q = bf2f(qh[(size_t)t * 512 + k]);
            qt[t * 136 + k] = f2bf(q * expf(bcur));
            kt[t * 136 + k] = f2bf((1.f - expf(lf)) * expf(-bcur));
        }
    }
    __syncthreads();
    bf16x8 qb[4];
#pragma unroll
    for (int ks = 0; ks < 4; ++ks) qb[ks] = ld8(qt + (16 * w + fr) * 136 + 32 * ks + 8 * fq);
    f32x4 at[4];
#pragma unroll
    for (int sf = 0; sf < 4; ++sf) {
        const int srow = 32 * (sf >> 1) + 8 * (fr >> 2) + 4 * (sf & 1) + (fr & 3);
        f32x4 a = f32x4{0.f, 0.f, 0.f, 0.f};
#pragma unroll
        for (int ks = 0; ks < 4; ++ks) a = mfma16(ld8(kt + srow * 136 + 32 * ks + 8 * fq), qb[ks], a);
        const int tcol = 16 * w + fr;
#pragma unroll
        for (int r = 0; r < 4; ++r) { const int s = 32 * (sf >> 1) + 8 * fq + 4 * (sf & 1) + r; if (s > tcol) a[r] = 0.f; }
        at[sf] = a;
    }
    const u16* vT = (const u16*)(ws + OFF_VTH) + (size_t)tile * 128 * 64;
    const u16* ST = (const u16*)(ws + OFF_LBUF) + (size_t)tile * 128 * 128;
    f32x4 o[8];
#pragma unroll
    for (int mf = 0; mf < 8; ++mf) o[mf] = f32x4{0.f, 0.f, 0.f, 0.f};
#pragma unroll
    for (int sc = 0; sc < 2; ++sc) {
        const bf16x8 pb = pack8(at[2 * sc], at[2 * sc + 1]);
#pragma unroll
        for (int mf = 0; mf < 8; ++mf) o[mf] = mfma16(ld8(vT + (size_t)(16 * mf + fr) * 64 + 32 * sc + 8 * fq), pb, o[mf]);
    }
#pragma unroll
    for (int ks = 0; ks < 4; ++ks)
#pragma unroll
        for (int mf = 0; mf < 8; ++mf) o[mf] = mfma16(ld8(ST + (size_t)(16 * mf + fr) * 128 + 32 * ks + 8 * fq), qb[ks], o[mf]);
    float ss = 0.f;
#pragma unroll
    for (int mf = 0; mf < 8; ++mf)
#pragma unroll
        for (int r = 0; r < 4; ++r) ss += o[mf][r] * o[mf][r];
    ss = xor16_sum(ss);
    const float rn = rsqrtf(ss * (1.f / 128.f) + 1e-6f);
    const size_t tok = n0 + 16 * w + fr;
    const u16* gh = (const u16*)(ws + OFF_GH) + tok * 512 + h * 128;
    u16* mix = (u16*)(ws + OFF_MIX) + tok * 1024 + 512 + h * 128;
#pragma unroll
    for (int mf = 0; mf < 8; ++mf) {
        const int v0 = 16 * mf + 4 * fq;
        const uint2 g2 = *(const uint2*)(gh + v0);
        const float4 ng = *(const float4*)(p.hg_ng + v0);
        f32x4 r;
        r[0] = o[mf][0] * rn * ng.x * __uint_as_float(g2.x << 16);
        r[1] = o[mf][1] * rn * ng.y * __uint_as_float(g2.x & 0xffff0000u);
        r[2] = o[mf][2] * rn * ng.z * __uint_as_float(g2.y << 16);
        r[3] = o[mf][3] * rn * ng.w * __uint_as_float(g2.y & 0xffff0000u);
        *(uint2*)(mix + v0) = pack4(r);
    }
    __syncthreads();
}

DEVI float gelu_tanh(float x) { const float u = 0.7978845608028654f * (x + 0.044715f * x * x * x); return 0.5f * x * (1.f + tanhf(u)); }

DEVI void cmp1_tile(const Params& p, char* smem, int tile) {
    char* ws = p.ws;
    const int which = tile >> 6, rt = (tile >> 1) & 31, ct = tile & 1;
    const int tid = VTID, lane = tid & 63, wid = tid >> 6, wr = wid >> 1, wc = wid & 1, fr = lane & 15, fq = lane >> 4;
    const u16* src = (const u16*)(ws + (which ? OFF_VCR : OFF_KCR));
    auto arow = [&](int r) { const int m = rt * 128 + r; return src + ((size_t)(m >> 9) * SP + 16 * (m & 511)) * 64; };
    const u16* Bt = (const u16*)(ws + (which ? OFF_WCV1 : OFF_WCK1)) + (size_t)ct * 128 * 2048;
    f32x4 acc[4][4];
    gemm128(tid, arow, Bt, 2048, 2048, smem, acc);
    const float* bias = (const float*)(ws + OFF_MISC) + which * 256;
    u16* hid = (u16*)(ws + OFF_HID) + (size_t)which * 4096 * 256;
#pragma unroll
    for (int m = 0; m < 4; ++m)
#pragma unroll
        for (int n = 0; n < 4; ++n) {
            const int row = rt * 128 + wr * 64 + m * 16 + fq * 4, col = ct * 128 + wc * 64 + n * 16 + fr;
            const float bv = bias[col];
#pragma unroll
            for (int j = 0; j < 4; ++j) hid[(size_t)(row + j) * 256 + col] = f2bf(gelu_tanh(acc[m][n][j] + bv));
        }
}

DEVI void cmp2_tile(const Params& p, char* smem, int tile) {
    char* ws = p.ws;
    const int which = tile >> 5, rt = tile & 31;
    const int tid = VTID, lane = tid & 63, wid = tid >> 6, wr = wid >> 1, wc = wid & 1, fr = lane & 15, fq = lane >> 4;
    const u16* hid = (const u16*)(ws + OFF_HID) + (size_t)which * 4096 * 256;
    auto arow = [&](int r) { return hid + (size_t)(rt * 128 + r) * 256; };
    const u16* Bt = (const u16*)(ws + (which ? OFF_WCV2 : OFF_WCK2));
    f32x4 acc[4][4];
    gemm128(tid, arow, Bt, 256, 256, smem, acc);
    if (wc == 0) {
        const float* cs = (const float*)(ws + OFF_ROPE);
#pragma unroll
        for (int m = 0; m < 4; ++m) {
            const int row = rt * 128 + wr * 64 + m * 16 + fq * 4;
            const int bg = row >> 9, c = row & 511, b = bg >> 1;
#pragma unroll
            for (int n = 0; n < 4; ++n) {
                const int d = n * 16 + fr;
                f32x4 v = acc[m][n];
                if (which == 0) {
                    if (n == 0) {
                        int ix[4];
#pragma unroll
                        for (int j = 0; j < 4; ++j) { int sp = 16 * (c + j) + 31; sp = sp > 8191 ? 8191 : sp; ix[j] = b * 8192 + sp; }
                        v = rope4(v, fr, cs, ix[0], ix[1], ix[2], ix[3]);
                    }
                    u16* kc = (u16*)(ws + OFF_KC);
#pragma unroll
                    for (int j = 0; j < 4; ++j) kc[((size_t)bg * 512 + c + j) * 64 + d] = f2bf(v[j]);
                } else {
                    u16* vct = (u16*)(ws + OFF_VCT);
                    *(uint2*)(vct + (((size_t)bg * 8 + (c >> 6)) * 64 + d) * 64 + (c & 63)) = pack4(v);
                }
            }
        }
    }
}

DEVI uint64_t lowest_bits(uint64_t mask, int n) {
    uint64_t out = 0;
    while (n > 0 && mask) { const uint64_t b = mask & (~mask + 1); out |= b; mask ^= b; --n; }
    return out;
}

constexpr int NSA_TILES = 8 * 128;
constexpr int NSA_RING = 5;
constexpr int NSA_STG = 16384;
constexpr int NSA_OFF_IMP = NSA_RING * NSA_STG;
constexpr int NSA_OFF_SEL = NSA_OFF_IMP + 4 * 8192;
constexpr float NSA_NEG = -3.0e30f;

DEVI float ex2(float x) { return __builtin_amdgcn_exp2f(x); }
DEVI bf16x8 ones8() { bf16x8 o = {0x3F80, 0x3F80, 0x3F80, 0x3F80, 0x3F80, 0x3F80, 0x3F80, 0x3F80}; return o; }
DEVI int imax8(const f32x4& a, const f32x4& b) {
    const int x0 = __float_as_int(a[0]), x1 = __float_as_int(a[1]), x2 = __float_as_int(a[2]), x3 = __float_as_int(a[3]);
    const int y0 = __float_as_int(b[0]), y1 = __float_as_int(b[1]), y2 = __float_as_int(b[2]), y3 = __float_as_int(b[3]);
    return max(max(max(x0, x1), max(x2, x3)), max(max(y0, y1), max(y2, y3)));
}
template <bool WITH_O>
DEVI bool sm_update(f32x4 (&s)[2][2], float (&R)[2], f32x4 (&lacc)[2], f32x4 (&os)[2][4], bf16x8 (&pb)[2], const bool force, float (&dlt)[2]) {
    const int m0 = imax8(s[0][0], s[0][1]), m1 = imax8(s[1][0], s[1][1]);
    const bool trig = (m0 > 0x41000000) || (m1 > 0x41000000);
    bool moved = false;
    dlt[0] = 0.f; dlt[1] = 0.f;
    if (force || __ballot(trig)) {
        moved = true;
#pragma unroll
        for (int hh = 0; hh < 2; ++hh) {
            float a = fmaxf(fmaxf(s[hh][0][0], s[hh][0][1]), fmaxf(s[hh][0][2], s[hh][0][3]));
            float b = fmaxf(fmaxf(s[hh][1][0], s[hh][1][1]), fmaxf(s[hh][1][2], s[hh][1][3]));
            const float cm = xor16_max(fmaxf(a, b));
            const float dd = force ? ((cm > -1e29f) ? cm : 0.f) : fmaxf(cm, 0.f);
            dlt[hh] = dd; R[hh] += dd;
#pragma unroll
            for (int u = 0; u < 2; ++u) { s[hh][u][0] -= dd; s[hh][u][1] -= dd; s[hh][u][2] -= dd; s[hh][u][3] -= dd; }
            const float sc = ex2(-dd);
            lacc[hh][0] *= sc; lacc[hh][1] *= sc; lacc[hh][2] *= sc; lacc[hh][3] *= sc;
            if (WITH_O) {
#pragma unroll
                for (int mf = 0; mf < 4; ++mf) { os[hh][mf][0] *= sc; os[hh][mf][1] *= sc; os[hh][mf][2] *= sc; os[hh][mf][3] *= sc; }
            }
        }
    }
#pragma unroll
    for (int hh = 0; hh < 2; ++hh) {
#pragma unroll
        for (int u = 0; u < 2; ++u)
#pragma unroll
            for (int r = 0; r < 4; ++r) s[hh][u][r] = ex2(s[hh][u][r]);
        pb[hh] = pack8(s[hh][0], s[hh][1]);
        lacc[hh] = mfma16(ones8(), pb[hh], lacc[hh]);
    }
    return moved;
}

DEVI void nsa_tile(const Params& p, char* smem, int tile) {
    char* ws = p.ws;
    const int bg = tile & 7, cur = 127 - (tile >> 3), b = bg >> 1, g = bg & 1;
    const int tid = TIDX, lane = tid & 63, w = tid >> 6, fr = lane & 15, fq = lane >> 4;
    const int tt = w >> 1, hp = w & 1;
    const int t0 = cur * 64 + tt * 16;
    const size_t n0 = (size_t)b * 8192 + t0;
    const int tok = t0 + fr;
    const u16* Qb = (const u16*)(ws + OFF_Q);
    const u16* Kc = (const u16*)(ws + OFF_KC) + (size_t)bg * 512 * 64;
    const u16* Vct = (const u16*)(ws + OFF_VCT) + (size_t)bg * 8 * 64 * 64;
    const u16* Ks = (const u16*)(ws + OFF_KS) + (size_t)bg * 8192 * 64;
    const u16* Kw = (const u16*)(ws + OFF_KW) + (size_t)bg * 8192 * 64;
    const u16* Vst = (const u16*)(ws + OFF_VST) + (size_t)bg * 128 * 64 * 64;
    const u16* Vwt = (const u16*)(ws + OFF_VWT) + (size_t)bg * 128 * 64 * 64;
    const float* gp = (const float*)(ws + OFF_GATES) + (n0 + fr) * 24 + (g * 4 + 2 * hp) * 3;
    float* imp = (float*)(smem + NSA_OFF_IMP) + tt * 2048;
    unsigned long long* selm = (unsigned long long*)(smem + NSA_OFF_SEL) + tt * 32;

    for (int i = tid; i < 4 * 2048; i += 512) ((float*)(smem + NSA_OFF_IMP))[i] = 0.f;

    bf16x8 qf[2][2];
#pragma unroll
    for (int hh = 0; hh < 2; ++hh)
#pragma unroll
        for (int ks = 0; ks < 2; ++ks) qf[hh][ks] = ld8(Qb + (n0 + fr) * 512 + (g * 4 + 2 * hp + hh) * 64 + 32 * ks + 8 * fq);
    f32x4 ot[2][4];
#pragma unroll
    for (int hh = 0; hh < 2; ++hh)
#pragma unroll
        for (int mf = 0; mf < 4; ++mf) ot[hh][mf] = f32x4{0.f, 0.f, 0.f, 0.f};

    const int lrow = 8 * w + (lane >> 3), lpos = lane & 7, lch = lpos ^ ((lrow >> 1) & 7);
    const int lkey = (lrow & 32) | ((lrow & 16) >> 2) | ((lrow & 12) << 1) | (lrow & 3);
    const int koff = lkey * 64 + 8 * lch, voff = lrow * 64 + 8 * lch;
    const int ldsoff = w * 1024 + lane * 16;
#define RING_ISSUE_K(KB, BLK, SLOT) glds16((KB) + (size_t)(BLK) * 4096 + koff, (u16*)(smem + (SLOT) * NSA_STG + ldsoff))
#define RING_ISSUE_V(VB, BLK, SLOT) glds16((VB) + (size_t)(BLK) * 4096 + voff, (u16*)(smem + (SLOT) * NSA_STG + 8192 + ldsoff))
#define RING_BAR() __builtin_amdgcn_s_barrier()
#define WAITV(N) asm volatile("s_waitcnt vmcnt(" #N ")" ::: "memory")
    const int swz = fr >> 1;
#define NSA_QKC(KL, SC, S, NR) do { _Pragma("unroll") for (int u = 0; u < 2; ++u) { const u16* kp_ = (KL) + (32 * (SC) + 16 * u + fr) * 64; \
            const bf16x8 k0_ = ld8(kp_ + ((fq ^ swz) << 3)), k1_ = ld8(kp_ + (((4 + fq) ^ swz) << 3)); \
            _Pragma("unroll") for (int hh = 0; hh < 2; ++hh) { f32x4 a_ = f32x4{NR[hh], NR[hh], NR[hh], NR[hh]}; a_ = mfma16(k0_, qf[hh][0], a_); a_ = mfma16(k1_, qf[hh][1], a_); S[hh][u] = a_; } } } while (0)
#define NSA_PVC(VL, SC, PB, O) do { _Pragma("unroll") for (int mf = 0; mf < 4; ++mf) { const bf16x8 va_ = ld8((VL) + (16 * mf + fr) * 64 + (((4 * (SC) + fq) ^ swz) << 3)); \
            _Pragma("unroll") for (int hh = 0; hh < 2; ++hh) O[hh][mf] = mfma16(va_, PB[hh], O[hh][mf]); } } while (0)
#define NSA_ADJ(S, D) do { _Pragma("unroll") for (int hh = 0; hh < 2; ++hh) _Pragma("unroll") for (int u = 0; u < 2; ++u) { S[hh][u][0] -= D[hh]; S[hh][u][1] -= D[hh]; S[hh][u][2] -= D[hh]; S[hh][u][3] -= D[hh]; } } while (0)

    {
        const int ncmax = 4 * cur + 3;
        const int nb = (ncmax + 63) >> 6;
        float RC[2] = {0.f, 0.f};
        f32x4 lC[2] = {f32x4{0.f, 0.f, 0.f, 0.f}, f32x4{0.f, 0.f, 0.f, 0.f}};
        f32x4 oc[2][4];
#pragma unroll
        for (int hh = 0; hh < 2; ++hh)
#pragma unroll
            for (int mf = 0; mf < 4; ++mf) oc[hh][mf] = f32x4{0.f, 0.f, 0.f, 0.f};
        __syncthreads();
        for (int i = 0; i < 4 && i < nb; ++i) RING_ISSUE_K(Kc, i, i);
        if (nb >= 4) WAITV(2); else WAITV(0);
        RING_BAR();
        {
            bool first = true; int slot = 0;
            for (int i = 0; i < nb; ++i) {
                if (i + 4 < nb) RING_ISSUE_K(Kc, i + 4, slot == 0 ? 4 : slot - 1);
                const u16* Kl = (const u16*)(smem + slot * NSA_STG);
#pragma unroll 1
                for (int sc = 0; sc < 2; ++sc) {
                    const int c0 = 64 * i + 32 * sc;
                    if (16 * c0 + 31 <= t0 + 15) {
                        f32x4 s[2][2];
                        const float nr[2] = {-RC[0], -RC[1]};
                        NSA_QKC(Kl, sc, s, nr);
                        if (16 * (c0 + 31) + 31 > t0) {
#pragma unroll
                            for (int hh = 0; hh < 2; ++hh)
#pragma unroll
                                for (int u = 0; u < 2; ++u)
#pragma unroll
                                    for (int r = 0; r < 4; ++r) { const int c = c0 + 8 * fq + 4 * u + r; if (16 * c + 31 > tok) s[hh][u][r] = NSA_NEG; }
                        }
                        bf16x8 pb[2]; float dl[2];
                        sm_update<false>(s, RC, lC, oc, pb, first, dl);
                        first = false;
                    }
                }
                if (i + 4 < nb) WAITV(2); else WAITV(0);
                RING_BAR();
                slot = (slot == 4) ? 0 : slot + 1;
            }
        }
        float ilC[2];
#pragma unroll
        for (int hh = 0; hh < 2; ++hh) { const float l = lC[hh][0]; ilC[hh] = l > 0.f ? 1.f / l : 0.f; }
        const float nrC[2] = {-RC[0], -RC[1]};
        for (int i = 0; i < 4 && i < nb; ++i) { RING_ISSUE_K(Kc, i, i); RING_ISSUE_V(Vct, i, i); }
        if (nb >= 4) WAITV(4); else WAITV(0);
        RING_BAR();
        {
            int slot = 0;
            for (int i = 0; i < nb; ++i) {
                if (i + 4 < nb) { const int sl = slot == 0 ? 4 : slot - 1; RING_ISSUE_K(Kc, i + 4, sl); RING_ISSUE_V(Vct, i + 4, sl); }
                const u16* Kl = (const u16*)(smem + slot * NSA_STG);
                const u16* Vl = Kl + 4096;
#pragma unroll 1
                for (int sc = 0; sc < 2; ++sc) {
                    const int c0 = 64 * i + 32 * sc;
                    if (16 * c0 + 31 <= t0 + 15) {
                        f32x4 s[2][2];
                        NSA_QKC(Kl, sc, s, nrC);
                        float qs[2] = {0.f, 0.f}, p3[2] = {0.f, 0.f};
                        bf16x8 pb[2];
#pragma unroll
                        for (int hh = 0; hh < 2; ++hh) {
#pragma unroll
                            for (int u = 0; u < 2; ++u) {
                                float q4 = 0.f;
#pragma unroll
                                for (int r = 0; r < 4; ++r) {
                                    const int c = c0 + 8 * fq + 4 * u + r;
                                    const float pv = (16 * c + 31 <= tok) ? ex2(s[hh][u][r]) : 0.f;
                                    s[hh][u][r] = pv; q4 += pv;
                                }
                                qs[u] += q4 * ilC[hh]; p3[u] += s[hh][u][3] * ilC[hh];
                            }
                            pb[hh] = pack8(s[hh][0], s[hh][1]);
                        }
#pragma unroll
                        for (int u = 0; u < 2; ++u) {
                            const int j = (c0 >> 2) + 2 * fq + u;
                            atomicAdd(&imp[fr * 128 + j], qs[u]);
                            if (j + 1 < 128) atomicAdd(&imp[fr * 128 + j + 1], p3[u]);
                        }
                        NSA_PVC(Vl, sc, pb, oc);
                    }
                }
                if (i + 4 < nb) WAITV(4); else WAITV(0);
                RING_BAR();
                slot = (slot == 4) ? 0 : slot + 1;
            }
        }
#pragma unroll
        for (int hh = 0; hh < 2; ++hh) {
            const float gc = gp[hh * 3 + 0] * ilC[hh];
#pragma unroll
            for (int mf = 0; mf < 4; ++mf) ot[hh][mf] += oc[hh][mf] * gc;
        }
    }
    __syncthreads();
    {
        if (cur < 16) {
            if (hp == 0 && lane < 16) { selm[lane * 2] = (2ull << cur) - 1ull; selm[lane * 2 + 1] = 0ull; }
        } else {
            for (int tau = 8 * hp; tau < 8 * hp + 8; ++tau) {
                const int j0 = lane, j1 = lane + 64;
                const bool in0 = (j0 >= 1) && (j0 <= cur - 2), in1 = (j1 <= cur - 2);
                const float v0 = in0 ? imp[tau * 128 + j0] : 0.f;
                const float v1 = in1 ? imp[tau * 128 + j1] : 0.f;
                const uint32_t u0 = __float_as_uint(v0), u1 = __float_as_uint(v1);
                uint32_t res = 0;
                uint64_t sa = 0, sb = 0;
                bool found = false;
                for (int bit = 30; bit >= 0; --bit) {
                    const uint32_t cand = res | (1u << bit);
                    const uint64_t c0 = __ballot(in0 && u0 >= cand), c1 = __ballot(in1 && u1 >= cand);
                    const int cnt = __popcll(c0) + __popcll(c1);
                    if (cnt == 13) { sa = c0; sb = c1; found = true; break; }
                    if (cnt > 13) res = cand;
                }
                if (!found) {
                    const uint64_t g0 = __ballot(in0 && u0 > res), g1 = __ballot(in1 && u1 > res);
                    const uint64_t e0 = __ballot(in0 && u0 == res), e1 = __ballot(in1 && u1 == res);
                    int need = 13 - (__popcll(g0) + __popcll(g1));
                    const int ne0 = __popcll(e0);
                    sa = g0 | lowest_bits(e0, need);
                    need -= (need < ne0 ? need : ne0);
                    sb = g1 | lowest_bits(e1, need);
                }
                sa |= 1ull;
                if (cur - 1 < 64) sa |= 1ull << (cur - 1); else sb |= 1ull << (cur - 1 - 64);
                if (cur < 64) sa |= 1ull << cur; else sb |= 1ull << (cur - 64);
                if (lane == 0) { selm[tau * 2] = sa; selm[tau * 2 + 1] = sb; }
            }
        }
    }
    {
        const int wb0 = cur >= 8 ? cur - 8 : 0, nb = cur - wb0 + 1;
        float RW[2] = {0.f, 0.f};
        f32x4 lW[2] = {f32x4{0.f, 0.f, 0.f, 0.f}, f32x4{0.f, 0.f, 0.f, 0.f}};
        f32x4 ow[2][4];
#pragma unroll
        for (int hh = 0; hh < 2; ++hh)
#pragma unroll
            for (int mf = 0; mf < 4; ++mf) ow[hh][mf] = f32x4{0.f, 0.f, 0.f, 0.f};
        __syncthreads();
        for (int i = 0; i < 4 && i < nb; ++i) { RING_ISSUE_K(Kw, wb0 + i, i); RING_ISSUE_V(Vwt, wb0 + i, i); }
        if (nb >= 4) WAITV(4); else WAITV(0);
        RING_BAR();
        bool first = true; int slot = 0;
        for (int i = 0; i < nb; ++i) {
            if (i + 4 < nb) { const int sl = slot == 0 ? 4 : slot - 1; RING_ISSUE_K(Kw, wb0 + i + 4, sl); RING_ISSUE_V(Vwt, wb0 + i + 4, sl); }
            const u16* Kl = (const u16*)(smem + slot * NSA_STG);
            const u16* Vl = Kl + 4096;
#pragma unroll 1
            for (int sc = 0; sc < 2; ++sc) {
                const int kb = 64 * (wb0 + i) + 32 * sc;
                if (kb <= t0 + 15 && kb + 31 > t0 - 512) {
                    f32x4 s[2][2];
                    const float nr[2] = {-RW[0], -RW[1]};
                    NSA_QKC(Kl, sc, s, nr);
                    if (kb + 31 > t0 || kb <= t0 + 15 - 512) {
#pragma unroll
                        for (int hh = 0; hh < 2; ++hh)
#pragma unroll
                            for (int u = 0; u < 2; ++u)
#pragma unroll
                                for (int r = 0; r < 4; ++r) { const int key = kb + 8 * fq + 4 * u + r; if (key > tok || key <= tok - 512) s[hh][u][r] = NSA_NEG; }
                    }
                    bf16x8 pb[2]; float dl[2];
                    sm_update<true>(s, RW, lW, ow, pb, first, dl);
                    first = false;
                    NSA_PVC(Vl, sc, pb, ow);
                }
            }
            if (i + 4 < nb) WAITV(4); else WAITV(0);
            RING_BAR();
            slot = (slot == 4) ? 0 : slot + 1;
        }
#pragma unroll
        for (int hh = 0; hh < 2; ++hh) {
            const float l = lW[hh][0];
            const float gw = gp[hh * 3 + 2] * (l > 0.f ? 1.f / l : 0.f);
#pragma unroll
            for (int mf = 0; mf < 4; ++mf) ot[hh][mf] += ow[hh][mf] * gw;
        }
    }
    {
        __syncthreads();
        const unsigned long long mA = selm[fr * 2], mB = selm[fr * 2 + 1];
        const int nb = cur + 1;
        for (int i = 0; i < 4 && i < nb; ++i) { RING_ISSUE_K(Ks, i, i); RING_ISSUE_V(Vst, i, i); }
        if (nb >= 4) WAITV(4); else WAITV(0);
        RING_BAR();
        float RS[2] = {0.f, 0.f};
        f32x4 lS[2] = {f32x4{0.f, 0.f, 0.f, 0.f}, f32x4{0.f, 0.f, 0.f, 0.f}};
        f32x4 os[2][4];
#pragma unroll
        for (int hh = 0; hh < 2; ++hh)
#pragma unroll
            for (int mf = 0; mf < 4; ++mf) os[hh][mf] = f32x4{0.f, 0.f, 0.f, 0.f};
        f32x4 sn[2][2];
        {
            const float nr0[2] = {0.f, 0.f};
            NSA_QKC((const u16*)smem, 0, sn, nr0);
        }
        bool first = true;
        int slot = 0;
        for (int jb = 0; jb < cur; ++jb) {
            const int slot1 = (slot == 4) ? 0 : slot + 1;
            if (jb + 4 < nb) { const int sl = slot == 0 ? 4 : slot - 1; RING_ISSUE_K(Ks, jb + 4, sl); RING_ISSUE_V(Vst, jb + 4, sl); }
            const u16* Kl = (const u16*)(smem + slot * NSA_STG);
            const u16* Vl = Kl + 4096;
            const u16* Kn = (const u16*)(smem + slot1 * NSA_STG);
            const bool on = ((jb < 64 ? (mA >> jb) : (mB >> (jb - 64))) & 1ull) != 0ull;
            const bool onn = (((jb + 1) < 64 ? (mA >> (jb + 1)) : (mB >> (jb + 1 - 64))) & 1ull) != 0ull;
            const bool any = __ballot(on) != 0ull;
            f32x4 s[2][2];
            bf16x8 pb[2]; float dl[2];
#pragma unroll
            for (int hh = 0; hh < 2; ++hh) { s[hh][0] = sn[hh][0]; s[hh][1] = sn[hh][1]; }
            {
                const float nr[2] = {on ? -RS[0] : NSA_NEG, on ? -RS[1] : NSA_NEG};
                NSA_QKC(Kl, 1, sn, nr);
            }
            if (any) {
                if (sm_update<true>(s, RS, lS, os, pb, first, dl)) NSA_ADJ(sn, dl);
                first = false;
                NSA_PVC(Vl, 0, pb, os);
            }
#pragma unroll
            for (int hh = 0; hh < 2; ++hh) { s[hh][0] = sn[hh][0]; s[hh][1] = sn[hh][1]; }
            {
                const float nr[2] = {onn ? -RS[0] : NSA_NEG, onn ? -RS[1] : NSA_NEG};
                NSA_QKC(Kn, 0, sn, nr);
            }
            if (any) {
                if (sm_update<true>(s, RS, lS, os, pb, false, dl)) NSA_ADJ(sn, dl);
                NSA_PVC(Vl, 1, pb, os);
            }
            if (jb + 4 < nb) WAITV(4); else WAITV(0);
            RING_BAR();
            slot = slot1;
        }
        {
            const u16* Kl = (const u16*)(smem + slot * NSA_STG);
            const u16* Vl = Kl + 4096;
            f32x4 s[2][2];
            bf16x8 pb[2]; float dl[2];
#pragma unroll
            for (int sc = 0; sc < 2; ++sc) {
                if (sc == 0) {
#pragma unroll
                    for (int hh = 0; hh < 2; ++hh) { s[hh][0] = sn[hh][0]; s[hh][1] = sn[hh][1]; }
                } else {
                    const float nr[2] = {-RS[0], -RS[1]};
                    NSA_QKC(Kl, 1, s, nr);
                }
#pragma unroll
                for (int hh = 0; hh < 2; ++hh)
#pragma unroll
                    for (int u = 0; u < 2; ++u)
#pragma unroll
                        for (int r = 0; r < 4; ++r) { const int key = 64 * cur + 32 * sc + 8 * fq + 4 * u + r; if (key > tok) s[hh][u][r] = NSA_NEG; }
                sm_update<true>(s, RS, lS, os, pb, first, dl);
                first = false;
                NSA_PVC(Vl, sc, pb, os);
            }
        }
#pragma unroll
        for (int hh = 0; hh < 2; ++hh) {
            const float l = lS[hh][0];
            const float gs = gp[hh * 3 + 1] * (l > 0.f ? 1.f / l : 0.f);
#pragma unroll
            for (int mf = 0; mf < 4; ++mf) ot[hh][mf] += os[hh][mf] * gs;
        }
    }
#undef RING_ISSUE_K
#undef RING_ISSUE_V
#undef RING_BAR
#undef WAITV
#undef NSA_QKC
#undef NSA_PVC
#undef NSA_ADJ
    {
        u16* mix = (u16*)(ws + OFF_MIX) + (n0 + fr) * 1024 + (g * 4 + 2 * hp) * 64;
#pragma unroll
        for (int hh = 0; hh < 2; ++hh)
#pragma unroll
            for (int mf = 0; mf < 4; ++mf) *(uint2*)(mix + hh * 64 + 16 * mf + 4 * fq) = pack4(ot[hh][mf]);
    }
    __syncthreads();
}

#define LAS3 __attribute__((address_space(3)))
namespace g8 {
constexpr int BM = 256, BK = 64, HALF = 128, HTB = HALF * BK * 2, KK = 1024, NT = KK / BK;
DEVI int lds_byte(int r, int c) { const int st = (r >> 4) * 2 + (c >> 5), rr = r & 15, cc = c & 31, ob = rr * 64 + cc * 2; return st * 1024 + (ob ^ (((ob >> 9) & 1) << 5)); }
DEVI void stage_rc(int b, int& R, int& C) { const int st = b / 1024, sb = b % 1024, swz = sb ^ (((sb >> 9) & 1) << 5); R = (st >> 1) * 16 + swz / 64; C = (st & 1) * 32 + (swz % 64) / 2; }
DEVI int perm32(int rho) { const int n = rho >> 4, i = rho & 15; return 8 * (i >> 2) + 4 * n + (i & 3); }

template <bool TRANS, bool PERM, class Src, class Epi>
DEVI void gemm_phase(int tid, LAS3 unsigned char* lds, const char* Abase, const Src& S, const Epi& E) {
    asm volatile("" : "+v"(tid));
    const int wid = __builtin_amdgcn_readfirstlane(tid >> 6), lane = tid & 63, wr = wid >> 2, wc = wid & 3, fr = lane & 15, fq = lane >> 4;
    int R0, C0, R1, C1;
    stage_rc(tid * 16, R0, C0); stage_rc(tid * 16 + 8192, R1, C1);
    unsigned voffB[2];
    voffB[0] = (unsigned)((PERM ? ((R0 & ~31) + perm32(R0 & 31)) : R0) * KK + C0) * 2u;
    voffB[1] = (unsigned)((PERM ? ((R1 & ~31) + perm32(R1 & 31)) : R1) * KK + C1) * 2u;
    constexpr size_t kstep = (size_t)(BK * 2);
    constexpr size_t hstepB = (size_t)HALF * KK * 2;
    const unsigned ldsw = (unsigned)wid * 1024u;
    const int aoff = lds_byte(wr * 64 + fr, fq * 8), boff = lds_byte(wc * 32 + fr, fq * 8);
#define G8_SA(b, h) (((b) * 2 + (h)) * HTB)
#define G8_SB(b, h) ((4 + (b) * 2 + (h)) * HTB)
#define G8_STAGE_A(bufoff, kbyte, v0, v1) do { \
        __builtin_amdgcn_global_load_lds((const unsigned*)(Abase + (kbyte) + (v0)), (LAS3 unsigned*)(lds + (bufoff) + ldsw), 16, 0, 0); \
        __builtin_amdgcn_global_load_lds((const unsigned*)(Abase + (kbyte) + (v1)), (LAS3 unsigned*)(lds + (bufoff) + ldsw + 8192), 16, 0, 0); } while (0)
#define G8_STAGE_B(bufoff, gptr) do { \
        __builtin_amdgcn_global_load_lds((const unsigned*)((gptr) + voffB[0]), (LAS3 unsigned*)(lds + (bufoff) + ldsw), 16, 0, 0); \
        __builtin_amdgcn_global_load_lds((const unsigned*)((gptr) + voffB[1]), (LAS3 unsigned*)(lds + (bufoff) + ldsw + 8192), 16, 0, 0); } while (0)
#define G8_LDA(dst, b, h) do { _Pragma("unroll") for (int m = 0; m < 4; ++m) _Pragma("unroll") for (int k = 0; k < 2; ++k) dst[m][k] = *(const LAS3 bf16x8*)(lds + G8_SA(b, h) + aoff + m * 2048 + k * 1024); } while (0)
#define G8_LDB(dst, b, h) do { _Pragma("unroll") for (int n = 0; n < 2; ++n) _Pragma("unroll") for (int k = 0; k < 2; ++k) dst[n][k] = *(const LAS3 bf16x8*)(lds + G8_SB(b, h) + boff + n * 2048 + k * 1024); } while (0)
#define G8_MMA(ai, bj, At, Bt) do { __builtin_amdgcn_s_setprio(1); _Pragma("unroll") for (int m = 0; m < 4; ++m) _Pragma("unroll") for (int n = 0; n < 2; ++n) _Pragma("unroll") for (int k = 0; k < 2; ++k) \
        acc[ai][bj][m][n] = TRANS ? __builtin_amdgcn_mfma_f32_16x16x32_bf16(Bt[n][k], At[m][k], acc[ai][bj][m][n], 0, 0, 0) \
                                  : __builtin_amdgcn_mfma_f32_16x16x32_bf16(At[m][k], Bt[n][k], acc[ai][bj][m][n], 0, 0, 0); __builtin_amdgcn_s_setprio(0); } while (0)
#define G8_WAIT_V(n) asm volatile("s_waitcnt vmcnt(" #n ")" ::: "memory")
#define G8_WAIT_L(n) asm volatile("s_waitcnt lgkmcnt(" #n ")" ::: "memory")
#define G8_BAR __builtin_amdgcn_s_barrier()
#define G8_SCHED __builtin_amdgcn_sched_barrier(0)
    typename Src::U cur, nxt; int ui = 0;
    if (!S.next(0, cur)) return;
    f32x4 acc[2][2][4][2];
#pragma unroll
    for (int a = 0; a < 2; ++a)
#pragma unroll
        for (int b = 0; b < 2; ++b)
#pragma unroll
            for (int m = 0; m < 4; ++m)
#pragma unroll
                for (int n = 0; n < 2; ++n) acc[a][b][m][n] = (f32x4){0.f, 0.f, 0.f, 0.f};
    bf16x8 At[4][2], B0[2][2], B1[2][2];
    unsigned cA00, cA01, cA10, cA11;
    S.aoff4(cur, R0, R1, cA00, cA01, cA10, cA11);
    cA00 += C0 * 2u; cA01 += C1 * 2u; cA10 += C0 * 2u; cA11 += C1 * 2u;
    const char* cB = S.bbase(cur);
    G8_STAGE_B(G8_SB(0, 0), cB); G8_STAGE_A(G8_SA(0, 0), 0, cA00, cA01); G8_STAGE_B(G8_SB(0, 1), cB + hstepB); G8_STAGE_A(G8_SA(0, 1), 0, cA10, cA11);
    if (wr == 1) G8_BAR;
    G8_WAIT_V(4); G8_BAR;
    G8_STAGE_B(G8_SB(1, 0), cB + kstep); G8_STAGE_A(G8_SA(1, 0), kstep, cA00, cA01); G8_STAGE_B(G8_SB(1, 1), cB + hstepB + kstep);
    G8_WAIT_V(6); G8_BAR;
    for (;;) {
        const bool has_next = S.next(ui + 1, nxt);
        unsigned nA00 = cA00, nA01 = cA01, nA10 = cA10, nA11 = cA11;
        const char* nB = cB;
        if (has_next) {
            S.aoff4(nxt, R0, R1, nA00, nA01, nA10, nA11);
            nA00 += C0 * 2u; nA01 += C1 * 2u; nA10 += C0 * 2u; nA11 += C1 * 2u;
            nB = S.bbase(nxt);
        }
#pragma unroll 1
        for (int t = 0; t < NT; t += 2) {
            const bool last = (t == NT - 2);
            const size_t k1 = (size_t)(t + 1) * kstep;
            const size_t k2 = last ? (size_t)0 : (size_t)(t + 2) * kstep, k3 = k2 + kstep;
            const unsigned x00 = last ? nA00 : cA00, x01 = last ? nA01 : cA01, x10 = last ? nA10 : cA10, x11 = last ? nA11 : cA11;
            const char* b2 = (last ? nB : cB) + k2; const char* b3 = b2 + kstep;
            G8_LDB(B0, 0, 0); G8_SCHED; G8_LDA(At, 0, 0); G8_STAGE_A(G8_SA(1, 1), k1, cA10, cA11);
            G8_WAIT_L(8); G8_BAR; G8_WAIT_L(0); G8_MMA(0, 0, At, B0); G8_BAR; G8_SCHED;
            G8_LDB(B1, 0, 1); G8_STAGE_B(G8_SB(0, 0), b2);
            G8_BAR; G8_WAIT_L(0); G8_MMA(0, 1, At, B1); G8_BAR;
            G8_LDA(At, 0, 1); G8_STAGE_A(G8_SA(0, 0), k2, x00, x01);
            G8_BAR; G8_WAIT_L(0); G8_MMA(1, 0, At, B0); G8_BAR; G8_SCHED;
            G8_STAGE_B(G8_SB(0, 1), b2 + hstepB);
            G8_WAIT_V(6); G8_BAR; G8_MMA(1, 1, At, B1); G8_BAR;
            G8_LDB(B0, 1, 0); G8_SCHED; G8_LDA(At, 1, 0); G8_STAGE_A(G8_SA(0, 1), k2, x10, x11);
            G8_WAIT_L(8); G8_BAR; G8_WAIT_L(0); G8_MMA(0, 0, At, B0); G8_BAR; G8_SCHED;
            G8_LDB(B1, 1, 1); G8_STAGE_B(G8_SB(1, 0), b3);
            G8_BAR; G8_WAIT_L(0); G8_MMA(0, 1, At, B1); G8_BAR;
            G8_LDA(At, 1, 1); G8_STAGE_A(G8_SA(1, 0), k3, x00, x01);
            G8_BAR; G8_WAIT_L(0); G8_MMA(1, 0, At, B0); G8_BAR; G8_SCHED;
            G8_STAGE_B(G8_SB(1, 1), b3 + hstepB);
            G8_WAIT_V(6); G8_BAR; G8_MMA(1, 1, At, B1); G8_BAR;
        }
        E(acc, cur, wr, wc, fr, fq);
        if (!has_next) break;
#pragma unroll
        for (int a = 0; a < 2; ++a)
#pragma unroll
            for (int b = 0; b < 2; ++b)
#pragma unroll
                for (int m = 0; m < 4; ++m)
#pragma unroll
                    for (int n = 0; n < 2; ++n) acc[a][b][m][n] = (f32x4){0.f, 0.f, 0.f, 0.f};
        cur = nxt; cA00 = nA00; cA01 = nA01; cA10 = nA10; cA11 = nA11; cB = nB; ++ui;
    }
    G8_WAIT_V(0);
    if (wr == 0) G8_BAR;
    G8_BAR;
#undef G8_SA
#undef G8_SB
#undef G8_STAGE_A
#undef G8_STAGE_B
#undef G8_LDA
#undef G8_LDB
#undef G8_MMA
#undef G8_WAIT_V
#undef G8_WAIT_L
#undef G8_BAR
#undef G8_SCHED
}

struct DenseSrc {
    struct U { int pm, pn; };
    const char* Bt; int nM, nN, nwg, G, c;
    DEVI void init(const void* Bt_, int M, int N, int G_, int c_) { Bt = (const char*)Bt_; nM = M / BM; nN = N / BM; nwg = nM * nN; G = G_; c = c_; }
    DEVI bool next(int i, U& u) const {
        const int L = i * G + c; if (L >= nwg) return false;
        int wgid = L; { const int q = nwg / 8, r = nwg % 8, xcd = wgid % 8, off = wgid / 8; wgid = (xcd < r ? xcd * (q + 1) : r * (q + 1) + (xcd - r) * q) + off; }
        const int nig = 8 * nN, gid = wgid / nig, fm = gid * 8, gsz = (nM - fm) < 8 ? (nM - fm) : 8;
        u.pm = fm + ((wgid % nig) % gsz); u.pn = (wgid % nig) / gsz; return true;
    }
    DEVI unsigned aoff(const U& u, int row) const { return (unsigned)(u.pm * BM + row) * (unsigned)(KK * 2); }
    DEVI void aoff4(const U& u, int r0, int r1, unsigned& a00, unsigned& a01, unsigned& a10, unsigned& a11) const { a00 = aoff(u, r0); a01 = aoff(u, r1); a10 = aoff(u, HALF + r0); a11 = aoff(u, HALF + r1); }
    DEVI const char* bbase(const U& u) const { return Bt + (size_t)u.pn * BM * KK * 2; }
};
}


struct EpiWo {
    u16* o;
    DEVI void operator()(const f32x4 (&acc)[2][2][4][2], const g8::DenseSrc::U& u, int wr, int wc, int fr, int fq) const {
#pragma unroll
        for (int ai = 0; ai < 2; ++ai)
#pragma unroll
            for (int m = 0; m < 4; ++m) {
                const size_t row = (size_t)u.pm * 256 + ai * 128 + wr * 64 + m * 16 + fr;
#pragma unroll
                for (int bj = 0; bj < 2; ++bj) {
                    uint4 v; v.x = pack2(acc[ai][bj][m][0][0], acc[ai][bj][m][0][1]); v.y = pack2(acc[ai][bj][m][0][2], acc[ai][bj][m][0][3]);
                    v.z = pack2(acc[ai][bj][m][1][0], acc[ai][bj][m][1][1]); v.w = pack2(acc[ai][bj][m][1][2], acc[ai][bj][m][1][3]);
                    *(uint4*)(o + row * 1024 + u.pn * 256 + bj * 128 + wc * 32 + fq * 8) = v;
                }
            }
    }
};
DEVI void phase_wo8(const Params& p, char* smem_all) {
    g8::DenseSrc S; S.init(p.ws + OFF_WO, NTOK, 1024, gridDim.x, blockIdx.x);
    EpiWo E; E.o = (u16*)(p.ws + OFF_PRE);
    g8::gemm_phase<true, true>(TIDX, (LAS3 unsigned char*)smem_all, p.ws + OFF_MIX, S, E);
}

DEVI void wo_tile(const Params& p, char* smem, int tile) {
    char* ws = p.ws;
    const int rt = tile >> 3, ct = tile & 7;
    const int tid = VTID, lane = tid & 63, wid = tid >> 6, wr = wid >> 1, wc = wid & 1, fr = lane & 15, fq = lane >> 4;
    const u16* MIX = (const u16*)(ws + OFF_MIX);
    auto arow = [&](int r) { return MIX + (size_t)(rt * 128 + r) * 1024; };
    f32x4 acc[4][4];
    gemm128(tid, arow, (const u16*)(ws + OFF_WO) + (size_t)ct * 128 * 1024, 1024, 1024, smem, acc);
    float* pre = (float*)(ws + OFF_PRE);
#pragma unroll
    for (int m = 0; m < 4; ++m)
#pragma unroll
        for (int n = 0; n < 4; ++n) {
            const int row = rt * 128 + wr * 64 + m * 16 + fq * 4, col = ct * 128 + wc * 64 + n * 16 + fr;
#pragma unroll
            for (int j = 0; j < 4; ++j) {
                const size_t ix = (size_t)(row + j) * 1024 + col;
                pre[ix] = DN_ALPHA * p.x[ix] + acc[m][n][j];
            }
        }
}

DEVI void ln1_router_tile(const Params& p, char* smem, int tile) {
    char* ws = p.ws;
    const int tid = VTID, lane = tid & 63, w = tid >> 6;
    const int tok0 = tile * 32;
    const u16* mixo = (const u16*)(ws + OFF_PRE);
    u16* H1B = (u16*)(ws + OFF_H1B);
    for (int i = 0; i < 8; ++i) {
        const size_t row = (size_t)tok0 + w * 8 + i;
        float4 v[4];
        float s = 0.f;
#pragma unroll
        for (int q = 0; q < 4; ++q) {
            const float4 xv = *(const float4*)(p.x + row * 1024 + q * 256 + lane * 4);
            const uint2 mv = *(const uint2*)(mixo + row * 1024 + q * 256 + lane * 4);
            v[q].x = DN_ALPHA * xv.x + __uint_as_float(mv.x << 16); v[q].y = DN_ALPHA * xv.y + __uint_as_float(mv.x & 0xffff0000u);
            v[q].z = DN_ALPHA * xv.z + __uint_as_float(mv.y << 16); v[q].w = DN_ALPHA * xv.w + __uint_as_float(mv.y & 0xffff0000u);
            s += v[q].x + v[q].y + v[q].z + v[q].w;
        }
        const float mu = wave_sum(s) * (1.f / 1024.f);
        float ss = 0.f;
#pragma unroll
        for (int q = 0; q < 4; ++q) { v[q].x -= mu; v[q].y -= mu; v[q].z -= mu; v[q].w -= mu; ss += v[q].x * v[q].x + v[q].y * v[q].y + v[q].z * v[q].z + v[q].w * v[q].w; }
        const float rs = rsqrtf(wave_sum(ss) * (1.f / 1024.f) + 1e-5f);
#pragma unroll
        for (int q = 0; q < 4; ++q) {
            const int c = q * 256 + lane * 4;
            const float4 gq = *(const float4*)(p.ln1g + c), bq = *(const float4*)(p.ln1b + c);
            float4 o; o.x = v[q].x * rs * gq.x + bq.x; o.y = v[q].y * rs * gq.y + bq.y; o.z = v[q].z * rs * gq.z + bq.z; o.w = v[q].w * rs * gq.w + bq.w;
            uint2 ob; ob.x = pack2(o.x, o.y); ob.y = pack2(o.z, o.w);
            *(uint2*)(H1B + row * 1024 + c) = ob;
        }
    }
    __builtin_amdgcn_fence(__ATOMIC_RELEASE, "workgroup");
    __syncthreads();
    float* part = (float*)smem;
    int* lcnt = (int*)(smem + 4 * 32 * 33 * 4);
    {
        f32x16 acc;
#pragma unroll
        for (int i = 0; i < 16; ++i) acc[i] = 0.f;
        const int i32 = lane & 31, hh = lane >> 5;
        const u16* ap = H1B + ((size_t)tok0 + i32) * 1024 + 256 * w + 4 * hh;
        const float* bp = p.w_r + (size_t)(256 * w + 4 * hh) * 32 + i32;
#pragma unroll 2
        for (int m = 0; m < 32; ++m) {
            const uint2 ab = *(const uint2*)(ap + 8 * m);
            float4 a; a.x = __uint_as_float(ab.x << 16); a.y = __uint_as_float(ab.x & 0xffff0000u); a.z = __uint_as_float(ab.y << 16); a.w = __uint_as_float(ab.y & 0xffff0000u);
            const float b0 = bp[(size_t)(8 * m + 0) * 32], b1 = bp[(size_t)(8 * m + 1) * 32], b2 = bp[(size_t)(8 * m + 2) * 32], b3 = bp[(size_t)(8 * m + 3) * 32];
            acc = __builtin_amdgcn_mfma_f32_32x32x2f32(a.x, b0, acc, 0, 0, 0);
            acc = __builtin_amdgcn_mfma_f32_32x32x2f32(a.y, b1, acc, 0, 0, 0);
            acc = __builtin_amdgcn_mfma_f32_32x32x2f32(a.z, b2, acc, 0, 0, 0);
            acc = __builtin_amdgcn_mfma_f32_32x32x2f32(a.w, b3, acc, 0, 0, 0);
        }
#pragma unroll
        for (int r = 0; r < 16; ++r) {
            const int row = (r & 3) + 8 * (r >> 2) + 4 * hh;
            part[(w * 32 + row) * 33 + i32] = acc[r];
        }
    }
    if (tid < 32) lcnt[tid] = 0;
    __syncthreads();
    float* lgt = (float*)(smem + 24576);
    for (int i = tid; i < 1024; i += 256) {
        const int t = i >> 5, j = i & 31;
        lgt[t * 33 + j] = part[(0 * 32 + t) * 33 + j] + part[(1 * 32 + t) * 33 + j] + part[(2 * 32 + t) * 33 + j] + part[(3 * 32 + t) * 33 + j] + p.b_r[j];
    }
    __syncthreads();
    int e_sel[4]; float w_sel[4]; int rank[4];
    if (tid < 32) {
        float v0 = -3.0e38f, v1 = -3.0e38f, v2 = -3.0e38f, v3 = -3.0e38f; int i0 = 0, i1 = 0, i2 = 0, i3 = 0;
#pragma unroll 8
        for (int j = 0; j < 32; ++j) {
            const float lg = lgt[tid * 33 + j];
            if (lg > v3) {
                if (lg > v0) { v3 = v2; i3 = i2; v2 = v1; i2 = i1; v1 = v0; i1 = i0; v0 = lg; i0 = j; }
                else if (lg > v1) { v3 = v2; i3 = i2; v2 = v1; i2 = i1; v1 = lg; i1 = j; }
                else if (lg > v2) { v3 = v2; i3 = i2; v2 = lg; i2 = j; }
                else { v3 = lg; i3 = j; }
            }
        }
        const float bestv[4] = {v0, v1, v2, v3}; const int besti[4] = {i0, i1, i2, i3};
        float den = 0.f;
#pragma unroll
        for (int k = 0; k < 4; ++k) { w_sel[k] = expf(bestv[k] - bestv[0]); den += w_sel[k]; }
#pragma unroll
        for (int k = 0; k < 4; ++k) { w_sel[k] /= den; e_sel[k] = besti[k]; rank[k] = atomicAdd(&lcnt[besti[k]], 1); }
    }
    __syncthreads();
    if (tid < 32) {
        const int c = lcnt[tid];
        int* counts = (int*)((float*)(ws + OFF_MISC) + 1024);
        lcnt[32 + tid] = c ? atomicAdd(&counts[tid], c) : 0;
    }
    __syncthreads();
    if (tid < 32) {
        int* la = (int*)(ws + OFF_LISTA); float* lw = (float*)(ws + OFF_LISTW);
#pragma unroll
        for (int k = 0; k < 4; ++k) {
            const size_t pos = (size_t)e_sel[k] * NTOK + lcnt[32 + e_sel[k]] + rank[k];
            la[pos] = (tok0 + tid) * 4 + k; lw[pos] = w_sel[k];
        }
    }
    __syncthreads();
}

struct MoeMap { int e, rt, ct, cnt, pbase; };
DEVI void moe_setup(const Params& p, int* sm  , int ctn) {
    const int tid = VTID;
    if (tid == 0) {
        const int* counts = (const int*)((const float*)(p.ws + OFF_MISC) + 1024);
        int tp = 0, cp = 0;
        for (int e = 0; e < 32; ++e) {
            const int c = counts[e];
            sm[e] = tp; sm[32 + e] = cp; sm[64 + e] = c;
            tp += ((c + 127) >> 7) * ctn; cp += c;
        }
        sm[96] = tp;
    }
    __syncthreads();
}
DEVI MoeMap moe_map(const int* sm, int tile, int ctn) {
    int e = 0;
#pragma unroll 1
    for (int i = 1; i < 32; ++i) if (sm[i] <= tile) e = i;
    MoeMap m; m.e = e; m.cnt = sm[64 + e]; m.pbase = sm[32 + e];
    const int tl = tile - sm[e], nrt = (m.cnt + 127) >> 7;
    m.ct = tl / nrt; m.rt = tl % nrt;
    return m;
}

DEVI void moe1_tile(const Params& p, char* smem, const MoeMap& mm) {
    char* ws = p.ws;
    const int tid = VTID, lane = tid & 63, wid = tid >> 6, wr = wid >> 1, wc = wid & 1, fr = lane & 15, fq = lane >> 4;
    const int* la = (const int*)(ws + OFF_LISTA) + (size_t)mm.e * NTOK;
    const u16* H1B = (const u16*)(ws + OFF_H1B);
    auto arow = [&](int r) { const int idx = mm.rt * 128 + r; const int tokn = idx < mm.cnt ? (la[idx] >> 2) : 0; return H1B + (size_t)tokn * 1024; };
    const u16* Bt = (const u16*)(ws + OFF_WGU) + ((size_t)mm.e * 2048 + (size_t)mm.ct * 128) * 1024;
    f32x4 acc[4][4];
    gemm128(tid, arow, Bt, 1024, 1024, smem, acc);
    u16* act = (u16*)(ws + OFF_ACT);
    const float* bgu = p.b_gu + (size_t)mm.e * 2048;
#pragma unroll
    for (int m = 0; m < 4; ++m) {
        const int idx0 = mm.rt * 128 + wr * 64 + m * 16 + fq * 4;
#pragma unroll
        for (int i = 0; i < 2; ++i) {
            const int col = 64 * mm.ct + 32 * wc + 16 * i + fr;
            const float bg_ = bgu[col], bu_ = bgu[1024 + col];
#pragma unroll
            for (int j = 0; j < 4; ++j) {
                if (idx0 + j < mm.cnt) {
                    float gt = acc[m][2 * i][j] + bg_; gt = fminf(gt, 7.f);
                    float up = acc[m][2 * i + 1][j] + bu_; up = fminf(fmaxf(up, -7.f), 7.f);
                    const float a = gt * (1.f / (1.f + __expf(-1.702f * gt))) * (up + 1.f);
                    act[(size_t)(mm.pbase + idx0 + j) * 1024 + col] = f2bf(a);
                }
            }
        }
    }
}

DEVI void moe2_tile(const Params& p, char* smem, const MoeMap& mm) {
    char* ws = p.ws;
    const int tid = VTID, lane = tid & 63, wid = tid >> 6, wr = wid >> 1, wc = wid & 1, fr = lane & 15, fq = lane >> 4;
    const u16* act = (const u16*)(ws + OFF_ACT);
    auto arow = [&](int r) { return act + (size_t)(mm.pbase + mm.rt * 128 + r) * 1024; };
    const u16* Bt = (const u16*)(ws + OFF_WDN) + ((size_t)mm.e * 1024 + (size_t)mm.ct * 128) * 1024;
    f32x4 acc[4][4];
    gemm128(tid, arow, Bt, 1024, 1024, smem, acc);
    const int* la = (const int*)(ws + OFF_LISTA) + (size_t)mm.e * NTOK;
    const float* lw = (const float*)(ws + OFF_LISTW) + (size_t)mm.e * NTOK;
    u16* Y = (u16*)(ws + OFF_Y);
    const float* bdn = p.b_dn + (size_t)mm.e * 1024;
#pragma unroll
    for (int m = 0; m < 4; ++m) {
        const int idx0 = mm.rt * 128 + wr * 64 + m * 16 + fq * 4;
#pragma unroll
        for (int j = 0; j < 4; ++j) {
            if (idx0 + j < mm.cnt) {
                const int a = la[idx0 + j]; const float wgt = lw[idx0 + j];
#pragma unroll
                for (int n = 0; n < 4; ++n) {
                    const int col = mm.ct * 128 + wc * 64 + n * 16 + fr;
                    Y[(size_t)a * 1024 + col] = f2bf((acc[m][n][j] + bdn[col]) * wgt);
                }
            }
        }
    }
}

constexpr int MOE_TAB_OFF = 131072;
DEVI void moe_setup8(const Params& p, char* smem_all, int ctn) {
    int* sm = (int*)(smem_all + MOE_TAB_OFF);
    if (TIDX == 0) {
        const int* counts = (const int*)((const float*)(p.ws + OFF_MISC) + 1024);
        int tp = 0, cp = 0;
        for (int e = 0; e < 32; ++e) {
            const int c = counts[e];
            sm[e] = tp; sm[33 + e] = cp; sm[65 + e] = c;
            tp += ((c + 255) >> 8) * ctn; cp += c;
        }
        sm[32] = tp;
    }
    __syncthreads();
}
template <bool GATHER>
struct MoeSrc {
    struct U { int e, rt, pn, cnt, pbase; };
    const LAS3 int* tab; const char* Bt; const int* la; int nrowsB, G, c, ctn;
    DEVI bool next(int i, U& u) const {
        const int L = i * G + c, total = tab[32]; if (L >= total) return false;
        int wg; { const int q = total / 8, r = total % 8, xcd = L % 8, off = L / 8; wg = (xcd < r ? xcd * (q + 1) : r * (q + 1) + (xcd - r) * q) + off; }
        int e = 0;
#pragma unroll 1
        for (int k = 1; k < 32; ++k) e = (tab[k] <= wg) ? k : e;
        u.e = e; u.cnt = tab[65 + e]; u.pbase = tab[33 + e];
        const int tl = wg - tab[e], nrt = (u.cnt + 255) >> 8;
        const int nig = 8 * ctn, grp = tl / nig, fm = grp * 8, gsz = (nrt - fm) < 8 ? (nrt - fm) : 8, rem = tl - grp * nig;
        u.pn = rem / gsz; u.rt = fm + (rem - u.pn * gsz);
        return true;
    }
    DEVI unsigned aoff(const U& u, int row) const {
        const int idx = u.rt * 256 + row;
        if (GATHER) { const int tokn = idx < u.cnt ? (la[(size_t)u.e * NTOK + idx] >> 2) : 0; return (unsigned)tokn * 2048u; }
        return (unsigned)(u.pbase + idx) * 2048u;
    }
    DEVI void aoff4(const U& u, int r0, int r1, unsigned& a00, unsigned& a01, unsigned& a10, unsigned& a11) const {
        const int i0 = u.rt * 256 + r0, i1 = u.rt * 256 + r1, i2 = i0 + 128, i3 = i1 + 128;
        if (GATHER) {
            const int* lp = la + (size_t)u.e * NTOK; const int cm = u.cnt - 1;
            const int t0 = lp[i0 < cm ? i0 : cm], t1 = lp[i1 < cm ? i1 : cm], t2 = lp[i2 < cm ? i2 : cm], t3 = lp[i3 < cm ? i3 : cm];
            a00 = (unsigned)(t0 >> 2) * 2048u; a01 = (unsigned)(t1 >> 2) * 2048u; a10 = (unsigned)(t2 >> 2) * 2048u; a11 = (unsigned)(t3 >> 2) * 2048u;
        } else {
            a00 = (unsigned)(u.pbase + i0) * 2048u; a01 = (unsigned)(u.pbase + i1) * 2048u; a10 = (unsigned)(u.pbase + i2) * 2048u; a11 = (unsigned)(u.pbase + i3) * 2048u;
        }
    }
    DEVI const char* bbase(const U& u) const { return Bt + ((size_t)u.e * nrowsB + (size_t)u.pn * 256) * 2048; }
};
struct EpiMoe1 {
    const float* b_gu; u16* act;
    DEVI void operator()(const f32x4 (&acc)[2][2][4][2], const MoeSrc<true>::U& u, int wr, int wc, int fr, int fq) const {
        const float* bg = b_gu + (size_t)u.e * 2048;
        float4 bgate[2], bup[2];
#pragma unroll
        for (int bj = 0; bj < 2; ++bj) {
            const int col = u.pn * 128 + (bj * 4 + wc) * 16 + 4 * fq;
            bgate[bj] = *(const float4*)(bg + col); bup[bj] = *(const float4*)(bg + 1024 + col);
        }
        asm volatile("" :: "v"(bgate[0].x), "v"(bup[0].x), "v"(bgate[1].x), "v"(bup[1].x));
#pragma unroll
        for (int ai = 0; ai < 2; ++ai)
#pragma unroll
            for (int m = 0; m < 4; ++m) {
                const int idx = u.rt * 256 + ai * 128 + wr * 64 + m * 16 + fr;
                if (idx < u.cnt) {
#pragma unroll
                    for (int bj = 0; bj < 2; ++bj) {
                        const int col = u.pn * 128 + (bj * 4 + wc) * 16 + 4 * fq;
                        const float bgv[4] = {bgate[bj].x, bgate[bj].y, bgate[bj].z, bgate[bj].w};
                        const float buv[4] = {bup[bj].x, bup[bj].y, bup[bj].z, bup[bj].w};
                        f32x4 a;
#pragma unroll
                        for (int j = 0; j < 4; ++j) {
                            float gt = acc[ai][bj][m][0][j] + bgv[j]; gt = fminf(gt, 7.f);
                            float up = acc[ai][bj][m][1][j] + buv[j]; up = fminf(fmaxf(up, -7.f), 7.f);
                            a[j] = gt * (1.f / (1.f + __expf(-1.702f * gt))) * (up + 1.f);
                        }
                        *(uint2*)(act + (size_t)(u.pbase + idx) * 1024 + col) = pack4(a);
                    }
                }
            }
    }
};
struct EpiMoe2 {
    const float* b_dn; const int* la; const float* lw; u16* Y;
    DEVI void operator()(const f32x4 (&acc)[2][2][4][2], const MoeSrc<false>::U& u, int wr, int wc, int fr, int fq) const {
        const float* bd = b_dn + (size_t)u.e * 1024;
        const int* lap = la + (size_t)u.e * NTOK; const float* lwp = lw + (size_t)u.e * NTOK;
        const int cm = u.cnt - 1;
        int av[2][4]; float wv[2][4]; float4 b0[2], b1[2];
#pragma unroll
        for (int ai = 0; ai < 2; ++ai)
#pragma unroll
            for (int m = 0; m < 4; ++m) {
                const int idx = u.rt * 256 + ai * 128 + wr * 64 + m * 16 + fr;
                const int ic = idx < cm ? idx : cm;
                av[ai][m] = lap[ic]; wv[ai][m] = lwp[ic];
            }
#pragma unroll
        for (int bj = 0; bj < 2; ++bj) {
            const int col = u.pn * 256 + bj * 128 + wc * 32 + fq * 8;
            b0[bj] = *(const float4*)(bd + col); b1[bj] = *(const float4*)(bd + col + 4);
        }
        asm volatile("" :: "v"(b1[1].w), "v"(b0[0].x), "v"(av[1][3]), "v"(wv[1][3]));
#pragma unroll
        for (int ai = 0; ai < 2; ++ai)
#pragma unroll
            for (int m = 0; m < 4; ++m) {
                const int idx = u.rt * 256 + ai * 128 + wr * 64 + m * 16 + fr;
                if (idx < u.cnt) {
                    const float wgt = wv[ai][m];
#pragma unroll
                    for (int bj = 0; bj < 2; ++bj) {
                        const int col = u.pn * 256 + bj * 128 + wc * 32 + fq * 8;
                        uint4 v;
                        v.x = pack2((acc[ai][bj][m][0][0] + b0[bj].x) * wgt, (acc[ai][bj][m][0][1] + b0[bj].y) * wgt);
                        v.y = pack2((acc[ai][bj][m][0][2] + b0[bj].z) * wgt, (acc[ai][bj][m][0][3] + b0[bj].w) * wgt);
                        v.z = pack2((acc[ai][bj][m][1][0] + b1[bj].x) * wgt, (acc[ai][bj][m][1][1] + b1[bj].y) * wgt);
                        v.w = pack2((acc[ai][bj][m][1][2] + b1[bj].z) * wgt, (acc[ai][bj][m][1][3] + b1[bj].w) * wgt);
                        *(uint4*)(Y + (size_t)av[ai][m] * 1024 + col) = v;
                    }
                }
            }
    }
};
DEVI void phase_moe1_8(const Params& p, char* smem_all) {
    moe_setup8(p, smem_all, 8);
    MoeSrc<true> S; S.tab = (const LAS3 int*)(smem_all + MOE_TAB_OFF); S.Bt = p.ws + OFF_WGU; S.la = (const int*)(p.ws + OFF_LISTA); S.nrowsB = 2048; S.G = gridDim.x; S.c = blockIdx.x; S.ctn = 8;
    EpiMoe1 E; E.b_gu = p.b_gu; E.act = (u16*)(p.ws + OFF_ACT);
    g8::gemm_phase<true, false>(TIDX, (LAS3 unsigned char*)smem_all, p.ws + OFF_H1B, S, E);
}
DEVI void phase_moe2_8(const Params& p, char* smem_all) {
    moe_setup8(p, smem_all, 4);
    MoeSrc<false> S; S.tab = (const LAS3 int*)(smem_all + MOE_TAB_OFF); S.Bt = p.ws + OFF_WDN; S.la = nullptr; S.nrowsB = 1024; S.G = gridDim.x; S.c = blockIdx.x; S.ctn = 4;
    EpiMoe2 E; E.b_dn = p.b_dn; E.la = (const int*)(p.ws + OFF_LISTA); E.lw = (const float*)(p.ws + OFF_LISTW); E.Y = (u16*)(p.ws + OFF_Y);
    g8::gemm_phase<true, true>(TIDX, (LAS3 unsigned char*)smem_all, p.ws + OFF_ACT, S, E);
}

struct EpiProjT {
    char* ws; const float* lb;
    template <class F> DEVI void rows(const g8::DenseSrc::U& u, int wr, int wc, int fr, int fq, F f) const {
#pragma unroll
        for (int ai = 0; ai < 2; ++ai)
#pragma unroll
            for (int m = 0; m < 4; ++m) {
                const int tok = u.pm * 256 + ai * 128 + wr * 64 + m * 16 + fr;
#pragma unroll
                for (int bj = 0; bj < 2; ++bj) f(ai, m, bj, tok, bj * 128 + wc * 32 + fq * 8);
            }
    }
    DEVI void operator()(const f32x4 (&acc)[2][2][4][2], const g8::DenseSrc::U& u, int wr, int wc, int fr, int fq) const {
        const int mt = u.pn;
        if (mt < 2) {
            u16* Q = (u16*)(ws + OFF_Q);
            rows(u, wr, wc, fr, fq, [&](int ai, int m, int bj, int tok, int c8) {
                const f32x4 v0 = acc[ai][bj][m][0], v1 = acc[ai][bj][m][1];
                const float qs_ = 0.125f * 1.4426950408889634f;
                uint4 o; o.x = pack2(v0[0] * qs_, v0[1] * qs_); o.y = pack2(v0[2] * qs_, v0[3] * qs_); o.z = pack2(v1[0] * qs_, v1[1] * qs_); o.w = pack2(v1[2] * qs_, v1[3] * qs_);
                *(uint4*)(Q + (size_t)tok * 512 + mt * 256 + c8) = o; });
        } else if (mt < 4) {
            const int g = wc >> 1, d0 = (wc & 1) * 32 + fq * 8;
            rows(u, wr, wc, fr, fq, [&](int ai, int m, int bj, int tok, int c8) {
                const f32x4 v0 = acc[ai][bj][m][0], v1 = acc[ai][bj][m][1];
                const int b = tok >> 13, s = tok & 8191;
                uint4 o; o.x = pack2(v0[0], v0[1]); o.y = pack2(v0[2], v0[3]); o.z = pack2(v1[0], v1[1]); o.w = pack2(v1[2], v1[3]);
                u16* dst = (mt == 2) ? (u16*)(ws + (bj ? OFF_VCR : OFF_KCR)) + ((size_t)(b * 2 + g) * SP + s) * 64 + d0
                                     : (u16*)(ws + (bj ? OFF_KW : OFF_KS)) + ((size_t)(b * 2 + g) * 8192 + s) * 64 + d0;
                *(uint4*)dst = o; });
        } else if (mt < 6) {
            u16* QH = (u16*)(ws + OFF_QH);
            rows(u, wr, wc, fr, fq, [&](int ai, int m, int bj, int tok, int c8) {
                const f32x4 v0 = acc[ai][bj][m][0], v1 = acc[ai][bj][m][1];
                uint4 o; o.x = pack2(v0[0], v0[1]); o.y = pack2(v0[2], v0[3]); o.z = pack2(v1[0], v1[1]); o.w = pack2(v1[2], v1[3]);
                *(uint4*)(QH + (size_t)tok * 512 + (mt - 4) * 256 + c8) = o; });
        } else if (mt < 8) {
            float4 lb0[2], lb1[2];
#pragma unroll
            for (int bj = 0; bj < 2; ++bj) { const int hk = (mt - 6) * 256 + bj * 128 + wc * 32 + fq * 8; lb0[bj] = *(const float4*)(lb + hk); lb1[bj] = *(const float4*)(lb + hk + 4); }
            asm volatile("" :: "v"(lb0[0].x), "v"(lb1[0].x), "v"(lb0[1].x), "v"(lb1[1].w));
            float* LF = (float*)(ws + OFF_LOGF);
            rows(u, wr, wc, fr, fq, [&](int ai, int m, int bj, int tok, int c8) {
                const f32x4 v0 = acc[ai][bj][m][0], v1 = acc[ai][bj][m][1];
                const float lv[8] = {lb0[bj].x, lb0[bj].y, lb0[bj].z, lb0[bj].w, lb1[bj].x, lb1[bj].y, lb1[bj].z, lb1[bj].w};
                float r[8];
#pragma unroll
                for (int j = 0; j < 8; ++j) {
                    const float z = j < 4 ? v0[j & 3] : v1[j & 3];
                    const float fh = 1.f / (1.f + __expf(-z));
                    r[j] = __logf(lv[j] + (1.f - lv[j]) * fh);
                }
                float* dst = LF + (size_t)tok * 512 + (mt - 6) * 256 + c8;
                *(float4*)dst = make_float4(r[0], r[1], r[2], r[3]); *(float4*)(dst + 4) = make_float4(r[4], r[5], r[6], r[7]); });
        } else {
            u16* GH = (u16*)(ws + OFF_GH);
            rows(u, wr, wc, fr, fq, [&](int ai, int m, int bj, int tok, int c8) {
                const f32x4 v0 = acc[ai][bj][m][0], v1 = acc[ai][bj][m][1];
                float r[8];
#pragma unroll
                for (int j = 0; j < 8; ++j) { const float z = j < 4 ? v0[j & 3] : v1[j & 3]; r[j] = z / (1.f + __expf(-z)); }
                uint4 o; o.x = pack2(r[0], r[1]); o.y = pack2(r[2], r[3]); o.z = pack2(r[4], r[5]); o.w = pack2(r[6], r[7]);
                *(uint4*)(GH + (size_t)tok * 512 + (mt - 8) * 256 + c8) = o; });
        }
    }
};
struct EpiProjN {
    char* ws;
    DEVI void operator()(const f32x4 (&acc)[2][2][4][2], const g8::DenseSrc::U& u, int wr, int wc, int fr, int fq) const {
        const int mt = u.pn;
#pragma unroll
        for (int ai = 0; ai < 2; ++ai)
#pragma unroll
            for (int m = 0; m < 4; ++m) {
                const int tok = u.pm * 256 + ai * 128 + wr * 64 + m * 16 + fq * 4;
                const int b = tok >> 13, s = tok & 8191;
#pragma unroll
                for (int bj = 0; bj < 2; ++bj)
#pragma unroll
                    for (int n = 0; n < 2; ++n) {
                        const int c = bj * 128 + wc * 32 + n * 16 + fr;
                        u16* dst;
                        if (mt == 0) {
                            const int g = wc >> 1, d = (wc & 1) * 32 + n * 16 + fr;
                            dst = (u16*)(ws + (bj ? OFF_VWT : OFF_VST)) + (((size_t)(b * 2 + g) * 128 + (s >> 6)) * 64 + d) * 64 + (s & 63);
                        } else {
                            const int hv = (mt - 1) * 256 + c;
                            dst = (u16*)(ws + OFF_VTH) + (((size_t)(b * 4 + (hv >> 7)) * 128 + (s >> 6)) * 128 + (hv & 127)) * 64 + (s & 63);
                        }
                        *(uint2*)dst = pack4(acc[ai][bj][m][n]);
                    }
            }
    }
};
DEVI void phase_proj8(const Params& p, char* smem_all) {
    {
        g8::DenseSrc S; S.init(p.ws + OFF_WIN, NTOK, 2560, gridDim.x, blockIdx.x);
        EpiProjT E; E.ws = p.ws; E.lb = (const float*)(p.ws + OFF_MISC) + 512;
        g8::gemm_phase<true, true>(TIDX, (LAS3 unsigned char*)smem_all, p.ws + OFF_XB, S, E);
    }
    {
        g8::DenseSrc S; S.init(p.ws + OFF_WIN + (size_t)2560 * 2048, NTOK, 768, gridDim.x, blockIdx.x);
        EpiProjN E; E.ws = p.ws;
        g8::gemm_phase<false, false>(TIDX, (LAS3 unsigned char*)smem_all, p.ws + OFF_XB, S, E);
    }
}
DEVI void gates_tile(const Params& p, char* smem, int rt) {
    char* ws = p.ws;
    const int tid = VTID, lane = tid & 63, wid = tid >> 6, wr = wid >> 1, wc = wid & 1, fr = lane & 15, fq = lane >> 4;
    const u16* XB = (const u16*)(ws + OFF_XB);
    auto arow = [&](int r) { return XB + (size_t)(rt * 128 + r) * 1024; };
    f32x4 acc[4][4];
    gemm128(tid, arow, (const u16*)(ws + OFF_WIN) + (size_t)3328 * 1024, 1024, 1024, smem, acc);
    if (wc == 0) {
        float* dst = (float*)(ws + OFF_GATES);
#pragma unroll
        for (int m = 0; m < 4; ++m)
#pragma unroll
            for (int n = 0; n < 2; ++n) {
                const int cc = n * 16 + fr, tok = rt * 128 + wr * 64 + m * 16 + fq * 4;
                if (cc < 24) {
#pragma unroll
                    for (int j = 0; j < 4; ++j) dst[(size_t)(tok + j) * 24 + cc] = 1.f / (1.f + expf(-acc[m][n][j]));
                }
            }
    }
}
DEVI void rope_task(const Params& p, int task) {
    char* ws = p.ws;
    const int gid = task * 256 + VTID;
    const int tok = gid / 12, vec = gid - tok * 12;
    const int b = tok >> 13, s = tok & 8191;
    u16* ptr;
    if (vec < 8) ptr = (u16*)(ws + OFF_Q) + (size_t)tok * 512 + vec * 64;
    else { const int g = vec & 1; ptr = (u16*)(ws + (vec < 10 ? OFF_KS : OFF_KW)) + ((size_t)(b * 2 + g) * 8192 + s) * 64; }
    const float* cs = (const float*)(ws + OFF_ROPE) + (size_t)tok * 8;
    const float4 c0 = *(const float4*)cs, c1 = *(const float4*)(cs + 4), s0 = *(const float4*)(cs + (size_t)NTOK * 8), s1 = *(const float4*)(cs + (size_t)NTOK * 8 + 4);
    const uint4 a = *(const uint4*)ptr, bq = *(const uint4*)(ptr + 8);
    const float cv[8] = {c0.x, c0.y, c0.z, c0.w, c1.x, c1.y, c1.z, c1.w}, sv[8] = {s0.x, s0.y, s0.z, s0.w, s1.x, s1.y, s1.z, s1.w};
    const uint32_t aw[4] = {a.x, a.y, a.z, a.w}, bw[4] = {bq.x, bq.y, bq.z, bq.w};
    float o1[8], o2[8];
#pragma unroll
    for (int i = 0; i < 8; ++i) {
        const float x1 = (i & 1) ? __uint_as_float(aw[i >> 1] & 0xffff0000u) : __uint_as_float(aw[i >> 1] << 16);
        const float x2 = (i & 1) ? __uint_as_float(bw[i >> 1] & 0xffff0000u) : __uint_as_float(bw[i >> 1] << 16);
        o1[i] = x1 * cv[i] - x2 * sv[i]; o2[i] = x2 * cv[i] + x1 * sv[i];
    }
    uint4 oa, ob;
    oa.x = pack2(o1[0], o1[1]); oa.y = pack2(o1[2], o1[3]); oa.z = pack2(o1[4], o1[5]); oa.w = pack2(o1[6], o1[7]);
    ob.x = pack2(o2[0], o2[1]); ob.y = pack2(o2[2], o2[3]); ob.z = pack2(o2[4], o2[5]); ob.w = pack2(o2[6], o2[7]);
    *(uint4*)ptr = oa; *(uint4*)(ptr + 8) = ob;
}

DEVI void final_rows(const Params& p, int task) {
    char* ws = p.ws;
    const int tid = VTID, lane = tid & 63, w = tid >> 6;
    const u16* H1B = (const u16*)(ws + OFF_H1B); const u16* Y = (const u16*)(ws + OFF_Y);
    for (int i = 0; i < 8; ++i) {
        const size_t row = (size_t)task * 32 + w * 8 + i;
        float4 v[4];
        float s = 0.f;
#pragma unroll
        for (int q = 0; q < 4; ++q) {
            const int c = q * 256 + lane * 4;
            const uint2 hb = *(const uint2*)(H1B + row * 1024 + c);
            float4 a; a.x = DN_ALPHA * __uint_as_float(hb.x << 16); a.y = DN_ALPHA * __uint_as_float(hb.x & 0xffff0000u);
            a.z = DN_ALPHA * __uint_as_float(hb.y << 16); a.w = DN_ALPHA * __uint_as_float(hb.y & 0xffff0000u);
#pragma unroll
            for (int k = 0; k < 4; ++k) {
                const uint2 y = *(const uint2*)(Y + (row * 4 + k) * 1024 + c);
                a.x += __uint_as_float(y.x << 16); a.y += __uint_as_float(y.x & 0xffff0000u);
                a.z += __uint_as_float(y.y << 16); a.w += __uint_as_float(y.y & 0xffff0000u);
            }
            v[q] = a; s += a.x + a.y + a.z + a.w;
        }
        const float mu = wave_sum(s) * (1.f / 1024.f);
        float ss = 0.f;
#pragma unroll
        for (int q = 0; q < 4; ++q) { v[q].x -= mu; v[q].y -= mu; v[q].z -= mu; v[q].w -= mu; ss += v[q].x * v[q].x + v[q].y * v[q].y + v[q].z * v[q].z + v[q].w * v[q].w; }
        const float rs = rsqrtf(wave_sum(ss) * (1.f / 1024.f) + 1e-5f);
#pragma unroll
        for (int q = 0; q < 4; ++q) {
            const int c = q * 256 + lane * 4;
            const float4 gq = *(const float4*)(p.ln2g + c), bq = *(const float4*)(p.ln2b + c);
            float4 o; o.x = v[q].x * rs * gq.x + bq.x; o.y = v[q].y * rs * gq.y + bq.y; o.z = v[q].z * rs * gq.z + bq.z; o.w = v[q].w * rs * gq.w + bq.w;
            *(float4*)(p.out + row * 1024 + c) = o;
        }
    }
}

DEVI void run_phase(const Params& p, char* smem, char* smem_all, int ph) {
    const int G = VGRID, B0 = VBID;
#ifdef ONLY_PHASE
    if (ph != ONLY_PHASE) return;
#endif
    switch (ph) {
    case 0: phase_prep(p, smem); break;
    case 1: phase_proj8(p, smem_all); break;
    case 2: {
        int* qctr = (int*)((float*)(p.ws + OFF_MISC) + 1024) + 33;
        int* sh = (int*)(smem_all + 131072);
        const int sb = p.ph_lo >> 2;
        for (;;) {
            __syncthreads();
            if (TIDX == 0) sh[0] = atomicAdd(qctr, 1);
            __syncthreads();
            const int item = sh[0];
            if (item >= 64 + 1024 + 128 + 768) break;
            if (item < 64) cmp1_tile(p, smem, item * 2 + sb);
            else if (item < 64 + 1024) hgrn_local_tile(p, smem, (item - 64) * 2 + sb);
            else if (item < 64 + 1024 + 128) gates_tile(p, smem, (item - 1088) * 2 + sb);
            else rope_task(p, (item - 1216) * 2 + sb);
        }
    } break;
    case 3: {
        int* qctr = (int*)((float*)(p.ws + OFF_MISC) + 1024) + 34;
        int* sh = (int*)(smem_all + 131072);
        const int sb = p.ph_lo >> 2;
        for (;;) {
            __syncthreads();
            if (TIDX == 0) sh[0] = atomicAdd(qctr, 1);
            __syncthreads();
            const int item = sh[0];
            if (item >= 256 + 32) break;
            if (item < 256) hgrn_scan_task(p, item * 2 + sb);
            else cmp2_tile(p, smem, (item - 256) * 2 + sb);
        }
    } break;
    case 4: {
        int* qctr = (int*)((float*)(p.ws + OFF_MISC) + 1024) + 32;
        int* sh = (int*)(smem_all + 131072);
        for (;;) {
            __syncthreads();
            if (TIDX == 0) sh[0] = atomicAdd(qctr, 1);
            __syncthreads();
            const int item = sh[0];
            if (item >= NSA_TILES + 1024) break;
            if (item < NSA_TILES) nsa_tile(p, smem_all, item);
            else hgrn_out_tile(p, smem, (item - NSA_TILES) * 2 + (p.ph_lo >> 2));
        }
    } break;
    case 5:
        phase_wo8(p, smem_all);
        break;
    case 6:
        for (int t = B0; t < 1024; t += G) ln1_router_tile(p, smem, t);
        break;
    case 7: phase_moe1_8(p, smem_all); break;
    case 8: phase_moe2_8(p, smem_all); break;
    case 9:
        for (int t = B0; t < 1024; t += G) final_rows(p, t);
        break;
    }
}

#define XB_TMO      128
#define XB_XCNT(j)  (256  + 64 * (j))
#define XB_XSUB(j)  (1280 + 64 * (j))
#define XB_XGEN(j)  (2304 + 64 * (j))
#define XB_TOP      3328
#define XB_TOPGEN   3392
#define XCD_BAR_WORDS 3456
#define XB_SPIN_CAP (1u << 18)
#define LAS LAS3

__device__ __forceinline__ unsigned xb_ld(unsigned* p)              { return __hip_atomic_load(p, __ATOMIC_RELAXED, __HIP_MEMORY_SCOPE_AGENT); }
__device__ __forceinline__ unsigned xb_add(unsigned* p, unsigned v) { return __hip_atomic_fetch_add(p, v, __ATOMIC_RELAXED, __HIP_MEMORY_SCOPE_AGENT); }
__device__ __forceinline__ unsigned xb_xcc_id() { return (unsigned)__builtin_amdgcn_s_getreg((3 << 11) | 20) & 0xFu; }
#define XB_SPIN(cond, bar) do { unsigned _sp = 0; while (cond) { __builtin_amdgcn_s_sleep(1); \
    if ((++_sp & 255u) == 0u) { if (xb_ld(&(bar)[XB_TMO])) break; if (_sp > XB_SPIN_CAP) { atomicAdd(&(bar)[XB_TMO], 1u); break; } } } } while (0)

struct XcdBarrier {
    unsigned* bar; unsigned x;
    volatile LAS unsigned* st;
};

__device__ __forceinline__ XcdBarrier xcd_barrier_post(unsigned* bar, volatile LAS unsigned* st, const bool lead) {
    XcdBarrier b; b.bar = bar; b.x = xb_xcc_id(); b.st = st;
    if (lead) (void)xb_add(&bar[XB_XCNT(b.x)], 1u);
    return b;
}
__device__ __forceinline__ void xcd_barrier_complete(unsigned* bar, unsigned x, unsigned& nloc, unsigned& nx) {
    const unsigned G = gridDim.x * gridDim.y * gridDim.z;
    unsigned sum, cnt, mine, sp = 0u;
    for (;;) {
        sum = 0u; cnt = 0u; mine = 0u;
#pragma unroll
        for (unsigned j = 0; j < 16; ++j) { const unsigned c = xb_ld(&bar[XB_XCNT(j)]); sum += c; cnt += (c > 0u) ? 1u : 0u; mine = (j == x) ? c : mine; }
        if (sum == G) break;
        __builtin_amdgcn_s_sleep(1);
        if ((++sp & 255u) == 0u) { if (xb_ld(&bar[XB_TMO])) break; if (sp > XB_SPIN_CAP) { atomicAdd(&bar[XB_TMO], 1u); break; } }
    }
    nloc = mine > 0u ? mine : 1u; nx = cnt > 0u ? cnt : 1u;
}

__device__ __forceinline__ void xcd_barrier(const XcdBarrier& b, const bool lead) {
    asm volatile("s_waitcnt vmcnt(0)" ::: "memory");
    __syncthreads();
    if (lead) {
        unsigned* bar = b.bar;
        __builtin_amdgcn_s_waitcnt(0);
        unsigned nloc = b.st[0], nx = b.st[1];
        if (nloc == 0u) { xcd_barrier_complete(bar, b.x, nloc, nx); b.st[0] = nloc; b.st[1] = nx; }
        const unsigned old = xb_add(&bar[XB_XSUB(b.x)], 1u);
        const unsigned gen = old / nloc;
        if (old + 1u == (gen + 1u) * nloc) {
            __builtin_amdgcn_fence(__ATOMIC_RELEASE, "agent");
            asm volatile("s_waitcnt vmcnt(0)" ::: "memory");
            const unsigned og = xb_add(&bar[XB_TOP], 1u);
            const unsigned tg = og / nx;
            if (og + 1u == (tg + 1u) * nx) xb_add(&bar[XB_TOPGEN], 1u);
            else XB_SPIN(xb_ld(&bar[XB_TOPGEN]) == tg, bar);
            __builtin_amdgcn_fence(__ATOMIC_ACQUIRE, "agent");
            xb_add(&bar[XB_XGEN(b.x)], 1u);
            asm volatile("s_waitcnt vmcnt(0)" ::: "memory");
        } else {
            XB_SPIN(xb_ld(&bar[XB_XGEN(b.x)]) == gen, bar);
            __builtin_amdgcn_fence(__ATOMIC_ACQUIRE, "agent");
            asm volatile("s_waitcnt vmcnt(0)" ::: "memory");
        }
    }
    __syncthreads();
}


#if N_LAUNCH_MODE == 1
__global__ void __launch_bounds__(512, 2) fwd_kernel(Params p_in) {
    extern __shared__ __attribute__((aligned(16))) char smem_all[];
    Params p = p_in;
    p.ph_lo = __builtin_amdgcn_readfirstlane((int)(threadIdx.x >> 6));
    char* smem = smem_all + (p.ph_lo >> 2) * 65536;
    cg::grid_group grid = cg::this_grid();
#ifndef PROBE_REP
#define PROBE_REP -1
#endif
    run_phase(p, smem, smem_all, 0);
    grid.sync();
    volatile LAS3 unsigned* xst = (volatile LAS3 unsigned*)(smem_all + 131072 + 512);
    if (TIDX == 0) { xst[0] = 0u; xst[1] = 0u; }
    __syncthreads();
    const XcdBarrier xb = xcd_barrier_post((unsigned*)(p.ws + OFF_BAR), xst, TIDX == 0);
#define GSYNC() xcd_barrier(xb, TIDX == 0)
#define RP(k) run_phase(p, smem, smem_all, k); GSYNC(); if (PROBE_REP == k) { run_phase(p, smem, smem_all, k); GSYNC(); }
    RP(1) RP(2)
    run_phase(p, smem, smem_all, 3); GSYNC();
    run_phase(p, smem, smem_all, 4); GSYNC();
    RP(5)
    run_phase(p, smem, smem_all, 6); GSYNC();
    RP(7) RP(8)
    run_phase(p, smem, smem_all, 9);
    if (PROBE_REP == 9) { GSYNC(); run_phase(p, smem, smem_all, 9); }
#undef RP
}
#define KFN fwd_kernel
#else
template <int PH>
__global__ void __launch_bounds__(256, 2) phase_kernel(Params p) {
    extern __shared__ __attribute__((aligned(16))) char smem[];
    run_phase(p, smem, PH);
}
#define KFN phase_kernel<4>
#endif

extern "C" void kernel_launch(void* const* d_in, const int* in_sizes, int n_in, void* d_out, int out_size, void* d_ws, size_t ws_size,
                              hipStream_t stream) {
    static int grid = 0;
    if (grid == 0) {
        if (ws_size < WS_NEED) { fprintf(stderr, "kernel_launch: workspace too small: %zu < %zu\n", ws_size, (size_t)WS_NEED); grid = -1; return; }
        int dev = 0, cus = 0, per_cu = 0;
        (void)hipGetDevice(&dev);
        (void)hipDeviceGetAttribute(&cus, hipDeviceAttributeMultiprocessorCount, dev);
#if N_LAUNCH_MODE == 1
        (void)hipFuncSetAttribute((const void*)KFN, hipFuncAttributeMaxDynamicSharedMemorySize, SMEM_BYTES);
#else
#define SA_(PH) (void)hipFuncSetAttribute((const void*)phase_kernel<PH>, hipFuncAttributeMaxDynamicSharedMemorySize, SMEM_BYTES);
        SA_(0) SA_(1) SA_(2) SA_(3) SA_(4) SA_(5) SA_(6) SA_(7) SA_(8) SA_(9)
#undef SA_
#endif
        (void)hipOccupancyMaxActiveBlocksPerMultiprocessor(&per_cu, (const void*)KFN, 512, SMEM_BYTES);
        if (per_cu < 1) per_cu = 1;
        if (per_cu > 1) per_cu = 1;
        grid = cus * per_cu;
    }
    if (grid < 0) return;
    Params p{};
    p.x = (const float*)d_in[0]; p.pos = (const int*)d_in[1]; p.w_in = (const float*)d_in[2]; p.pe = (const float*)d_in[3];
    p.w_ck1 = (const float*)d_in[4]; p.w_ck2 = (const float*)d_in[5]; p.w_cv1 = (const float*)d_in[6]; p.w_cv2 = (const float*)d_in[7];
    p.hg_lb = (const float*)d_in[8]; p.hg_ng = (const float*)d_in[9]; p.w_o = (const float*)d_in[10]; p.ln1g = (const float*)d_in[11];
    p.ln1b = (const float*)d_in[12]; p.w_r = (const float*)d_in[13]; p.b_r = (const float*)d_in[14]; p.w_gu = (const float*)d_in[15];
    p.b_gu = (const float*)d_in[16]; p.w_dn = (const float*)d_in[17]; p.b_dn = (const float*)d_in[18]; p.ln2g = (const float*)d_in[19];
    p.ln2b = (const float*)d_in[20];
    p.out = (float*)d_out; p.ws = (char*)d_ws;
#if N_LAUNCH_MODE == 1
    p.ph_lo = 0; p.ph_hi = NPHASE;
    void* args[] = {&p};
    hipError_t e = hipLaunchCooperativeKernel((const void*)fwd_kernel, dim3(grid), dim3(512), args, SMEM_BYTES, stream);
    if (e != hipSuccess) fprintf(stderr, "cooperative launch failed: %s (grid %d)\n", hipGetErrorString(e), grid);
#else
    p.ph_lo = 0; p.ph_hi = NPHASE;
#define LP(PH) hipLaunchKernelGGL(phase_kernel<PH>, dim3(grid), dim3(256), SMEM_BYTES, stream, p);
    LP(0) LP(1) LP(2) LP(3) LP(4) LP(5) LP(6) LP(7) LP(8) LP(9)
#undef LP
#endif
}
```

```cpp
#include <hip/hip_runtime.h>
#include <hip/hip_cooperative_groups.h>
#include <stdint.h>
#include <stdio.h>
namespace cg = cooperative_groups;

typedef unsigned short u16;
typedef __attribute__((ext_vector_type(8))) short bf16x8;
typedef __attribute__((ext_vector_type(4))) float f32x4;
typedef __attribute__((ext_vector_type(16))) float f32x16;
#define DEVI __device__ __forceinline__
#define LAS3 __attribute__((address_space(3)))
static __device__ __forceinline__ int laneid_() { int r; asm volatile("v_mbcnt_lo_u32_b32 %0, -1, 0\n\tv_mbcnt_hi_u32_b32 %0, -1, %0" : "=v"(r)); return r; }
#define LANEID (laneid_())
#define TIDX (p.ph_lo * 64 + LANEID)
#define VTID ((p.ph_lo & 3) * 64 + LANEID)
#define VBID ((int)(blockIdx.x * 2 + (p.ph_lo >> 2)))
#define VGRID ((int)(gridDim.x * 2))

#ifndef N_LAUNCH_MODE
#define N_LAUNCH_MODE 1
#endif

constexpr int NTOK = 32768, SEQ = 8192, NB = 4;
constexpr int SP = 8224;
constexpr int NPHASE = 10;
constexpr int XCD_BAR_WORDS_ = 3456;
constexpr int SMEM_BYTES = 131072 + 2048;
constexpr float DN_ALPHA = 1.189207115002721f;

constexpr size_t MB = 1ull << 20;
constexpr size_t OFF_WIN = 0;
constexpr size_t OFF_WCK1 = 7 * MB;
constexpr size_t OFF_WCV1 = 8 * MB;
constexpr size_t OFF_WCK2 = 9 * MB;
constexpr size_t OFF_WCV2 = 9 * MB + 65536;
constexpr size_t OFF_WO = 10 * MB;
constexpr size_t OFF_ROPE = 12 * MB;
constexpr size_t OFF_GATES = 14 * MB;
constexpr size_t OFF_MISC = 17 * MB;
constexpr size_t OFF_BAR = 17 * MB + 32768;
constexpr size_t OFF_LISTA = 18 * MB;
constexpr size_t OFF_LISTW = 22 * MB;
constexpr size_t OFF_HID = 26 * MB;
constexpr size_t OFF_KC = 30 * MB;
constexpr size_t OFF_VCT = 30 * MB + 524288;
constexpr size_t OFF_DG = 31 * MB;
constexpr size_t OFF_WGU = 32 * MB;
constexpr size_t OFF_WDN = 160 * MB;
constexpr size_t OFF_H1 = 224 * MB;
constexpr size_t OFF_H1B = 352 * MB;
constexpr size_t OFF_X = 416 * MB;
constexpr size_t OFF_XB = OFF_X;
constexpr size_t OFF_Q = OFF_X + 64 * MB;
constexpr size_t OFF_KCR = OFF_X + 96 * MB;
constexpr size_t OFF_VCR = OFF_X + 105 * MB;
constexpr size_t OFF_KS = OFF_X + 114 * MB;
constexpr size_t OFF_KW = OFF_X + 123 * MB;
constexpr size_t OFF_VST = OFF_X + 132 * MB;
constexpr size_t OFF_VWT = OFF_X + 141 * MB;
constexpr size_t OFF_QH = OFF_X + 150 * MB;
constexpr size_t OFF_LOGF = OFF_X + 182 * MB;
constexpr size_t OFF_VTH = OFF_X + 246 * MB;
constexpr size_t OFF_GH = OFF_X + 278 * MB;
constexpr size_t OFF_LBUF = OFF_X + 310 * MB;
constexpr size_t OFF_MIX = OFF_X + 374 * MB;
constexpr size_t OFF_PRE = OFF_X;
constexpr size_t OFF_ACT = OFF_X;
constexpr size_t OFF_Y = OFF_X + 256 * MB;
constexpr size_t WS_NEED = OFF_Y + 256 * MB;

struct Params {
    const float* x; const int* pos; const float* w_in; const float* pe;
    const float* w_ck1; const float* w_ck2; const float* w_cv1; const float* w_cv2;
    const float* hg_lb; const float* hg_ng; const float* w_o; const float* ln1g; const float* ln1b;
    const float* w_r; const float* b_r; const float* w_gu; const float* b_gu; const float* w_dn; const float* b_dn;
    const float* ln2g; const float* ln2b;
    float* out; char* ws;
    int ph_lo, ph_hi;
};

DEVI u16 f2bf(float f) { uint32_t u = __float_as_uint(f); u += 0x7fffu + ((u >> 16) & 1u); return (u16)(u >> 16); }
DEVI float bf2f(u16 h) { return __uint_as_float(((uint32_t)h) << 16); }
typedef float f32x2_t __attribute__((ext_vector_type(2)));
typedef __bf16 bf16x2_t __attribute__((ext_vector_type(2)));
DEVI uint32_t pack2(float a, float b) { f32x2_t v = {a, b}; bf16x2_t r = __builtin_convertvector(v, bf16x2_t); return __builtin_bit_cast(uint32_t, r); }
DEVI bf16x8 pack8(f32x4 a, f32x4 b) {
    union { bf16x8 v; uint32_t u[4]; } r;
    r.u[0] = pack2(a[0], a[1]); r.u[1] = pack2(a[2], a[3]); r.u[2] = pack2(b[0], b[1]); r.u[3] = pack2(b[2], b[3]);
    return r.v;
}
DEVI uint2 pack4(f32x4 a) { uint2 r; r.x = pack2(a[0], a[1]); r.y = pack2(a[2], a[3]); return r; }
DEVI f32x4 mfma16(bf16x8 a, bf16x8 b, f32x4 c) { return __builtin_amdgcn_mfma_f32_16x16x32_bf16(a, b, c, 0, 0, 0); }
DEVI bf16x8 ld8(const u16* p) { return *reinterpret_cast<const bf16x8*>(p); }
DEVI bf16x8 zero8() { bf16x8 z = {0, 0, 0, 0, 0, 0, 0, 0}; return z; }
DEVI float sigmoidf_(float v) { return 1.f / (1.f + __expf(-v)); }
DEVI float xor16_max(float v) { v = fmaxf(v, __shfl_xor(v, 16)); v = fmaxf(v, __shfl_xor(v, 32)); return v; }
DEVI float xor16_sum(float v) { v += __shfl_xor(v, 16); v += __shfl_xor(v, 32); return v; }
DEVI float wave_sum(float v) {
#pragma unroll
    for (int o = 32; o > 0; o >>= 1) v += __shfl_xor(v, o);
    return v;
}
DEVI void glds16(const u16* g, u16* l) {
    __builtin_amdgcn_global_load_lds((const unsigned*)g, (__attribute__((address_space(3))) unsigned*)l, 16, 0, 0);
}

template <class AFn>
DEVI void gemm128(const int tid, AFn arow, const u16* __restrict__ Bt, size_t ldb, int K, char* smem, f32x4 (&acc)[4][4]) {
    const int lane = tid & 63, wid = tid >> 6, wr = wid >> 1, wc = wid & 1, fr = lane & 15, fq = lane >> 4;
    u16* SA = (u16*)smem; u16* SB = (u16*)(smem + 8192);
    const int r0 = tid >> 2, c0 = (tid & 3) * 8;
    const u16* a0 = arow(r0) + c0; const u16* a1 = arow(r0 + 64) + c0;
    const u16* b0 = Bt + (size_t)r0 * ldb + c0; const u16* b1 = Bt + (size_t)(r0 + 64) * ldb + c0;
#pragma unroll
    for (int m = 0; m < 4; ++m)
#pragma unroll
        for (int n = 0; n < 4; ++n) acc[m][n] = f32x4{0.f, 0.f, 0.f, 0.f};
    for (int kt = 0; kt < K; kt += 32) {
        glds16(a0 + kt, SA + tid * 8); glds16(a1 + kt, SA + 2048 + tid * 8);
        glds16(b0 + kt, SB + tid * 8); glds16(b1 + kt, SB + 2048 + tid * 8);
        asm volatile("s_waitcnt vmcnt(0)" ::: "memory");
        __syncthreads();
        bf16x8 af[4], bfr[4];
#pragma unroll
        for (int m = 0; m < 4; ++m) af[m] = ld8(SA + (wr * 64 + m * 16 + fr) * 32 + fq * 8);
#pragma unroll
        for (int n = 0; n < 4; ++n) bfr[n] = ld8(SB + (wc * 64 + n * 16 + fr) * 32 + fq * 8);
#pragma unroll
        for (int m = 0; m < 4; ++m)
#pragma unroll
            for (int n = 0; n < 4; ++n) acc[m][n] = mfma16(af[m], bfr[n], acc[m][n]);
        __syncthreads();
    }
}

template <class CM>
DEVI void tconv_quad(const int tid, const float* __restrict__ src, size_t ld, u16* __restrict__ dst, size_t ldd, int r0, int k0, CM colmap, char* smem) {
    float (*t)[65] = (float (*)[65])smem;
    const int kk = tid >> 2, nb = (tid & 3) * 16;
    const int col = colmap(r0 + nb);
    float4 v[4][4];
#pragma unroll
    for (int q = 0; q < 4; ++q)
#pragma unroll
        for (int j = 0; j < 4; ++j) v[q][j] = (col >= 0) ? *(const float4*)(src + (size_t)(k0 + 64 * q + kk) * ld + col + 4 * j) : make_float4(0.f, 0.f, 0.f, 0.f);
#pragma unroll
    for (int q = 0; q < 4; ++q) {
#pragma unroll
        for (int j = 0; j < 4; ++j) { t[nb + 4 * j + 0][kk] = v[q][j].x; t[nb + 4 * j + 1][kk] = v[q][j].y; t[nb + 4 * j + 2][kk] = v[q][j].z; t[nb + 4 * j + 3][kk] = v[q][j].w; }
        __syncthreads();
        {
            const int n = tid >> 2, kb = (tid & 3) * 16;
            uint4 o0, o1;
            o0.x = pack2(t[n][kb + 0], t[n][kb + 1]); o0.y = pack2(t[n][kb + 2], t[n][kb + 3]); o0.z = pack2(t[n][kb + 4], t[n][kb + 5]); o0.w = pack2(t[n][kb + 6], t[n][kb + 7]);
            o1.x = pack2(t[n][kb + 8], t[n][kb + 9]); o1.y = pack2(t[n][kb + 10], t[n][kb + 11]); o1.z = pack2(t[n][kb + 12], t[n][kb + 13]); o1.w = pack2(t[n][kb + 14], t[n][kb + 15]);
            u16* d = dst + (size_t)(r0 + n) * ldd + k0 + 64 * q + kb;
            *(uint4*)d = o0; *(uint4*)(d + 8) = o1;
        }
        __syncthreads();
    }
}

DEVI void phase_prep(const Params& p, char* smem) {
    char* ws = p.ws;
    constexpr int J_WIN = 54 * 4;
    constexpr int J_WCK1 = 4 * 8;
    constexpr int J_WC2 = 2 * 1;
    constexpr int J_WO = 16 * 4;
    constexpr int J_WGU = 32 * 32 * 4;
    constexpr int J_WDN = 32 * 16 * 4;
    constexpr int J_XB = 4096;
    constexpr int J_ROPE = 1024;
    constexpr int J0 = 0, J1 = J0 + J_WIN, J2 = J1 + 2 * J_WCK1, J3 = J2 + 2 * J_WC2, J4 = J3 + J_WO, J5 = J4 + J_WGU,
                  J6 = J5 + J_WDN, J7 = J6 + J_XB, J8 = J7 + J_ROPE, J9 = J8 + 1;
    for (int job = VBID; job < J9; job += VGRID) {
        const int tid = VTID;
        if (job < J1) {
            const int j = job - J0, rt = j / 4, kt = j % 4;
            auto cm = [](int r) {
                if (r < 768) return r;
                if (r < 1024) { const int rr = r - 768; return rr < 128 ? 768 + rr : 1024 + (rr - 128); }
                if (r < 1536) return 1304 + (r - 1024);
                if (r < 2048) return 1816 + (r - 1536);
                if (r < 2560) return 2840 + (r - 2048);
                if (r < 2816) { const int rr = r - 2560; return rr < 128 ? 896 + rr : 1152 + (rr - 128); }
                if (r < 3328) return 2328 + (r - 2816);
                if (r < 3352) return 1280 + (r - 3328);
                return -1; };
            tconv_quad(tid, p.w_in, 3352, (u16*)(ws + OFF_WIN), 1024, rt * 64, kt * 256, cm, smem);
        } else if (job < J2) {
            int j = job - J1; const int which = j / J_WCK1; j %= J_WCK1; const int rt = j / 8, kt = j % 8;
            auto cm = [](int r) { return r; };
            tconv_quad(tid, which ? p.w_cv1 : p.w_ck1, 256, (u16*)(ws + (which ? OFF_WCV1 : OFF_WCK1)), 2048, rt * 64, kt * 256, cm, smem);
        } else if (job < J3) {
            int j = job - J2; const int which = j / J_WC2; j %= J_WC2; const int rt = j, kt = 0;
            auto cm = [](int r) { return r < 64 ? r : -1; };
            tconv_quad(tid, which ? p.w_cv2 : p.w_ck2, 64, (u16*)(ws + (which ? OFF_WCV2 : OFF_WCK2)), 256, rt * 64, kt * 256, cm, smem);
        } else if (job < J4) {
            const int j = job - J3, rt = j / 4, kt = j % 4;
            auto cm = [](int r) { return r; };
            tconv_quad(tid, p.w_o, 1024, (u16*)(ws + OFF_WO), 1024, rt * 64, kt * 256, cm, smem);
        } else if (job < J5) {
            int j = job - J4; const int e = j / 128; j %= 128; const int rt = j / 4, kt = j % 4;
            auto cm = [](int r) { const int pn = r >> 8, bj = (r >> 7) & 1, wc = (r >> 5) & 3, n = (r >> 4) & 1, i = r & 15; return (n ? 1024 : 0) + pn * 128 + (bj * 4 + wc) * 16 + i; };
            tconv_quad(tid, p.w_gu + (size_t)e * 1024 * 2048, 2048, (u16*)(ws + OFF_WGU) + (size_t)e * 2048 * 1024, 1024, rt * 64, kt * 256, cm, smem);
        } else if (job < J6) {
            int j = job - J5; const int e = j / 64; j %= 64; const int rt = j / 4, kt = j % 4;
            auto cm = [](int r) { return r; };
            tconv_quad(tid, p.w_dn + (size_t)e * 1024 * 1024, 1024, (u16*)(ws + OFF_WDN) + (size_t)e * 1024 * 1024, 1024, rt * 64, kt * 256, cm, smem);
        } else if (job < J7) {
            const size_t base = (size_t)(job - J6) * 8192 + (size_t)tid * 8;
            float4 a[4], b[4];
#pragma unroll
            for (int i = 0; i < 4; ++i) { a[i] = *(const float4*)(p.x + base + i * 2048); b[i] = *(const float4*)(p.x + base + i * 2048 + 4); }
#pragma unroll
            for (int i = 0; i < 4; ++i) {
                uint4 o; o.x = pack2(a[i].x, a[i].y); o.y = pack2(a[i].z, a[i].w); o.z = pack2(b[i].x, b[i].y); o.w = pack2(b[i].z, b[i].w);
                *(uint4*)((u16*)(ws + OFF_XB) + base + i * 2048) = o;
            }
        } else if (job < J8) {
            const int idx = (job - J7) * 256 + tid;
            const int n = idx >> 3, i = idx & 7;
            const float inv = powf(500000.f, -(float)i / 8.f);
            const float ang = (float)p.pos[n] * inv;
            float s, c; sincosf(ang, &s, &c);
            float* ct = (float*)(ws + OFF_ROPE);
            ct[idx] = c; ct[NTOK * 8 + idx] = s;
        } else {
            float* misc = (float*)(ws + OFF_MISC);
            float sk = 0.f, sv = 0.f;
            for (int i = 0; i < 2048; ++i) { const float pe = p.pe[i]; sk += pe * p.w_ck1[(size_t)i * 256 + tid]; sv += pe * p.w_cv1[(size_t)i * 256 + tid]; }
            misc[tid] = sk; misc[256 + tid] = sv;
            for (int i = tid; i < 512; i += 256) { const float a0 = p.hg_lb[i], a1 = p.hg_lb[512 + i]; misc[512 + i] = 1.f / (1.f + expf(a1 - a0)); }
            if (tid < 64) ((int*)(misc + 1024))[tid] = 0;
            for (int i = tid; i < XCD_BAR_WORDS_; i += 256) ((unsigned*)(ws + OFF_BAR))[i] = 0u;
        }
    }
}

DEVI f32x4 rope4(f32x4 v, int fr, const float* __restrict__ cs, int i0, int i1, int i2, int i3) {
    const int i = fr & 7; const float sg = (fr & 8) ? 1.f : -1.f;
    const int idx[4] = {i0, i1, i2, i3};
    f32x4 o;
#pragma unroll
    for (int j = 0; j < 4; ++j) {
        const float partner = __shfl_xor(v[j], 8);
        const float c = cs[(size_t)idx[j] * 8 + i], s = cs[(size_t)NTOK * 8 + (size_t)idx[j] * 8 + i];
        o[j] = v[j] * c + sg * partner * s;
    }
    return o;
}

DEVI void hgrn_local_tile(const Params& p, char* smem, int tile) {
    char* ws = p.ws;
    const int bh = tile >> 7, chunk = tile & 127, b = bh >> 2, h = bh & 3;
    const int tid = VTID, lane = tid & 63, w = tid >> 6, fr = lane & 15, fq = lane >> 4;
    const size_t n0 = (size_t)b * 8192 + chunk * 64;
    const float* lfp = (const float*)(ws + OFF_LOGF) + n0 * 512 + h * 128;
    u16* khT = (u16*)(smem + 1024);
    float blast;
    float* totp = (float*)smem;
    {
        const int k = tid & 127, half = tid >> 7;
        float lf[32];
#pragma unroll
        for (int i = 0; i < 32; ++i) lf[i] = lfp[(size_t)(32 * half + i) * 512 + k];
        float run = 0.f;
#pragma unroll
        for (int i = 0; i < 32; ++i) run += lf[i];
        totp[half * 128 + k] = run;
        __syncthreads();
        const float t0 = totp[k], t1 = totp[128 + k];
        blast = t0 + t1;
        float bcur = half ? t0 : 0.f;
#pragma unroll
        for (int i = 0; i < 32; ++i) {
            bcur += lf[i];
            const float kh = (1.f - __expf(lf[i])) * __expf(blast - bcur);
            khT[k * 72 + 32 * half + i] = f2bf(kh);
        }
        if (half == 0) ((float*)(ws + OFF_DG))[(size_t)tile * 128 + k] = __expf(blast);
    }
    __syncthreads();
    const u16* vT = (const u16*)(ws + OFF_VTH) + (size_t)tile * 128 * 64;
    f32x4 acc[2][8];
#pragma unroll
    for (int m = 0; m < 2; ++m)
#pragma unroll
        for (int n = 0; n < 8; ++n) acc[m][n] = f32x4{0.f, 0.f, 0.f, 0.f};
#pragma unroll
    for (int ks = 0; ks < 2; ++ks) {
        bf16x8 a[2];
#pragma unroll
        for (int m = 0; m < 2; ++m) a[m] = ld8(khT + (32 * w + 16 * m + fr) * 72 + 32 * ks + 8 * fq);
#pragma unroll
        for (int n = 0; n < 8; ++n) {
            const bf16x8 bv = ld8(vT + (size_t)(16 * n + fr) * 64 + 32 * ks + 8 * fq);
#pragma unroll
            for (int m = 0; m < 2; ++m) acc[m][n] = mfma16(a[m], bv, acc[m][n]);
        }
    }
    u16* L = (u16*)(ws + OFF_LBUF) + (size_t)tile * 128 * 128;
#pragma unroll
    for (int m = 0; m < 2; ++m)
#pragma unroll
        for (int n = 0; n < 8; ++n) *(uint2*)(L + (size_t)(16 * n + fr) * 128 + 32 * w + 16 * m + 4 * fq) = pack4(acc[m][n]);
    __syncthreads();
}

DEVI void hgrn_scan_task(const Params& p, int task) {
    char* ws = p.ws;
    const int gid = task * 256 + VTID;
    const int bh = gid >> 13, v = (gid >> 6) & 127, kp = gid & 63;
    uint32_t* L = (uint32_t*)(ws + OFF_LBUF) + ((size_t)bh * 128 * 128 * 128 + (size_t)v * 128) / 2 + kp;
    const float2* Dg = (const float2*)(ws + OFF_DG) + (size_t)bh * 128 * 64 + kp;
    float s0 = 0.f, s1 = 0.f;
#pragma unroll 8
    for (int c = 0; c < 128; ++c) {
        const uint32_t l = L[(size_t)c * 8192];
        const float2 d = Dg[(size_t)c * 64];
        L[(size_t)c * 8192] = pack2(s0, s1);
        s0 = d.x * s0 + __uint_as_float(l << 16);
        s1 = d.y * s1 + __uint_as_float(l & 0xffff0000u);
    }
}

DEVI void hgrn_out_tile(const Params& p, char* smem, int tile) {
    char* ws = p.ws;
    const int bh = tile >> 7, chunk = tile & 127, b = bh >> 2, h = bh & 3;
    const int tid = VTID, lane = tid & 63, w = tid >> 6, fr = lane & 15, fq = lane >> 4;
    const size_t n0 = (size_t)b * 8192 + chunk * 64;
    const float* lfp = (const float*)(ws + OFF_LOGF) + n0 * 512 + h * 128;
    const u16* qh = (const u16*)(ws + OFF_QH) + n0 * 512 + h * 128;
    float* totp = (float*)smem;
    u16* qt = (u16*)(smem + 1024);
    u16* kt = qt + 64 * 136;
    {
        const int k = tid & 127, half = tid >> 7;
        float lf[32]; u16 qv[32];
#pragma unroll
        for (int i = 0; i < 32; ++i) lf[i] = lfp[(size_t)(32 * half + i) * 512 + k];
#pragma unroll
        for (int i = 0; i < 32; ++i) qv[i] = qh[(size_t)(32 * half + i) * 512 + k];
        float run = 0.f;
#pragma unroll
        for (int i = 0; i < 32; ++i) run += lf[i];
        totp[half * 128 + k] = run;
        __syncthreads();
        float bcur = half ? totp[k] : 0.f;
#pragma unroll
        for (int i = 0; i < 32; ++i) {
            const int t = 32 * half + i;
            bcur += lf[i];
            const float eb = __expf(bcur);
            qt[t * 136 + k] = f2bf(bf2f(qv[i]) * eb);
            kt[t * 136 + k] = f2bf((1.f - __expf(lf[i])) * __frcp_rn(eb));
        }
    }
    __syncthreads();
    bf16x8 qb[4];
#pragma unroll
    for (int ks = 0; ks < 4; ++ks) qb[ks] = ld8(qt + (16 * w + fr) * 136 + 32 * ks + 8 * fq);
    f32x4 at[4];
#pragma unroll
    for (int sf = 0; sf < 4; ++sf) {
        const int srow = 32 * (sf >> 1) + 8 * (fr >> 2) + 4 * (sf & 1) + (fr & 3);
        f32x4 a = f32x4{0.f, 0.f, 0.f, 0.f};
#pragma unroll
        for (int ks = 0; ks < 4; ++ks) a = mfma16(ld8(kt + srow * 136 + 32 * ks + 8 * fq), qb[ks], a);
        const int tcol = 16 * w + fr;
#pragma unroll
        for (int r = 0; r < 4; ++r) { const int s = 32 * (sf >> 1) + 8 * fq + 4 * (sf & 1) + r; if (s > tcol) a[r] = 0.f; }
        at[sf] = a;
    }
    const u16* vT = (const u16*)(ws + OFF_VTH) + (size_t)tile * 128 * 64;
    const u16* ST = (const u16*)(ws + OFF_LBUF) + (size_t)tile * 128 * 128;
    f32x4 o[8];
#pragma unroll
    for (int mf = 0; mf < 8; ++mf) o[mf] = f32x4{0.f, 0.f, 0.f, 0.f};
#pragma unroll
    for (int sc = 0; sc < 2; ++sc) {
        const bf16x8 pb = pack8(at[2 * sc], at[2 * sc + 1]);
#pragma unroll
        for (int mf = 0; mf < 8; ++mf) o[mf] = mfma16(ld8(vT + (size_t)(16 * mf + fr) * 64 + 32 * sc + 8 * fq), pb, o[mf]);
    }
#pragma unroll
    for (int ks = 0; ks < 4; ++ks)
#pragma unroll
        for (int mf = 0; mf < 8; ++mf) o[mf] = mfma16(ld8(ST + (size_t)(16 * mf + fr) * 128 + 32 * ks + 8 * fq), qb[ks], o[mf]);
    float ss = 0.f;
#pragma unroll
    for (int mf = 0; mf < 8; ++mf)
#pragma unroll
        for (int r = 0; r < 4; ++r) ss += o[mf][r] * o[mf][r];
    ss = xor16_sum(ss);
    const float rn = rsqrtf(ss * (1.f / 128.f) + 1e-6f);
    const size_t tok = n0 + 16 * w + fr;
    const u16* gh = (const u16*)(ws + OFF_GH) + tok * 512 + h * 128;
    u16* mix = (u16*)(ws + OFF_MIX) + tok * 1024 + 512 + h * 128;
#pragma unroll
    for (int mf = 0; mf < 8; ++mf) {
        const int v0 = 16 * mf + 4 * fq;
        const uint2 g2 = *(const uint2*)(gh + v0);
        const float4 ng = *(const float4*)(p.hg_ng + v0);
        f32x4 r;
        r[0] = o[mf][0] * rn * ng.x * __uint_as_float(g2.x << 16);
        r[1] = o[mf][1] * rn * ng.y * __uint_as_float(g2.x & 0xffff0000u);
        r[2] = o[mf][2] * rn * ng.z * __uint_as_float(g2.y << 16);
        r[3] = o[mf][3] * rn * ng.w * __uint_as_float(g2.y & 0xffff0000u);
        *(uint2*)(mix + v0) = pack4(r);
    }
    __syncthreads();
}

DEVI float gelu_tanh(float x) { const float u = 0.7978845608028654f * (x + 0.044715f * x * x * x); return 0.5f * x * (1.f + tanhf(u)); }

DEVI void cmp1_tile(const Params& p, char* smem, int tile) {
    char* ws = p.ws;
    const int which = tile >> 6, rt = (tile >> 1) & 31, ct = tile & 1;
    const int tid = VTID, lane = tid & 63, wid = tid >> 6, wr = wid >> 1, wc = wid & 1, fr = lane & 15, fq = lane >> 4;
    const u16* src = (const u16*)(ws + (which ? OFF_VCR : OFF_KCR));
    auto arow = [&](int r) { const int m = rt * 128 + r; return src + ((size_t)(m >> 9) * SP + 16 * (m & 511)) * 64; };
    const u16* Bt = (const u16*)(ws + (which ? OFF_WCV1 : OFF_WCK1)) + (size_t)ct * 128 * 2048;
    f32x4 acc[4][4];
    gemm128(tid, arow, Bt, 2048, 2048, smem, acc);
    const float* bias = (const float*)(ws + OFF_MISC) + which * 256;
    u16* hid = (u16*)(ws + OFF_HID) + (size_t)which * 4096 * 256;
#pragma unroll
    for (int m = 0; m < 4; ++m)
#pragma unroll
        for (int n = 0; n < 4; ++n) {
            const int row = rt * 128 + wr * 64 + m * 16 + fq * 4, col = ct * 128 + wc * 64 + n * 16 + fr;
            const float bv = bias[col];
#pragma unroll
            for (int j = 0; j < 4; ++j) hid[(size_t)(row + j) * 256 + col] = f2bf(gelu_tanh(acc[m][n][j] + bv));
        }
}

DEVI void cmp2_tile(const Params& p, char* smem, int tile) {
    char* ws = p.ws;
    const int which = tile >> 5, rt = tile & 31;
    const int tid = VTID, lane = tid & 63, wid = tid >> 6, wr = wid >> 1, wc = wid & 1, fr = lane & 15, fq = lane >> 4;
    const u16* hid = (const u16*)(ws + OFF_HID) + (size_t)which * 4096 * 256;
    auto arow = [&](int r) { return hid + (size_t)(rt * 128 + r) * 256; };
    const u16* Bt = (const u16*)(ws + (which ? OFF_WCV2 : OFF_WCK2));
    f32x4 acc[4][4];
    gemm128(tid, arow, Bt, 256, 256, smem, acc);
    if (wc == 0) {
        const float* cs = (const float*)(ws + OFF_ROPE);
#pragma unroll
        for (int m = 0; m < 4; ++m) {
            const int row = rt * 128 + wr * 64 + m * 16 + fq * 4;
            const int bg = row >> 9, c = row & 511, b = bg >> 1;
#pragma unroll
            for (int n = 0; n < 4; ++n) {
                const int d = n * 16 + fr;
                f32x4 v = acc[m][n];
                if (which == 0) {
                    if (n == 0) {
                        int ix[4];
#pragma unroll
                        for (int j = 0; j < 4; ++j) { int sp = 16 * (c + j) + 31; sp = sp > 8191 ? 8191 : sp; ix[j] = b * 8192 + sp; }
                        v = rope4(v, fr, cs, ix[0], ix[1], ix[2], ix[3]);
                    }
                    u16* kc = (u16*)(ws + OFF_KC);
#pragma unroll
                    for (int j = 0; j < 4; ++j) kc[((size_t)bg * 512 + c + j) * 64 + d] = f2bf(v[j]);
                } else {
                    u16* vct = (u16*)(ws + OFF_VCT);
                    *(uint2*)(vct + (((size_t)bg * 8 + (c >> 6)) * 64 + d) * 64 + (c & 63)) = pack4(v);
                }
            }
        }
    }
}

DEVI uint64_t lowest_bits(uint64_t mask, int n) {
    uint64_t out = 0;
    while (n > 0 && mask) { const uint64_t b = mask & (~mask + 1); out |= b; mask ^= b; --n; }
    return out;
}

constexpr int NSA_TILES = 8 * 128;
constexpr int NSA_RING = 6;
constexpr int NSA_STG = 16384;
constexpr int NSA_OFF_IMP = NSA_RING * NSA_STG;
constexpr int NSA_OFF_SEL = 131072 + 1024;
constexpr float NSA_NEG = -3.0e30f;

DEVI float ex2(float x) { return __builtin_amdgcn_exp2f(x); }
DEVI bf16x8 ones8() { bf16x8 o = {0x3F80, 0x3F80, 0x3F80, 0x3F80, 0x3F80, 0x3F80, 0x3F80, 0x3F80}; return o; }
DEVI int imax4(const f32x4& a) {
    const int x0 = __float_as_int(a[0]), x1 = __float_as_int(a[1]), x2 = __float_as_int(a[2]), x3 = __float_as_int(a[3]);
    return max(max(x0, x1), max(x2, x3));
}
template <bool WITH_O, int NF>
DEVI bool sm_update(f32x4 (&s)[2][NF], float (&R)[2], f32x4 (&lacc)[2], f32x4 (&os)[2][4], bf16x8 (&pb)[2][NF / 2], const bool force, float (&dlt)[2]) {
    int mi[2];
#pragma unroll
    for (int hh = 0; hh < 2; ++hh) {
        int m = imax4(s[hh][0]);
#pragma unroll
        for (int f = 1; f < NF; ++f) m = max(m, imax4(s[hh][f]));
        mi[hh] = m;
    }
    const bool trig = (mi[0] > 0x41000000) || (mi[1] > 0x41000000);
    bool moved = false;
    dlt[0] = 0.f; dlt[1] = 0.f;
    if (force || __ballot(trig)) {
        moved = true;
#pragma unroll
        for (int hh = 0; hh < 2; ++hh) {
            float a = NSA_NEG;
#pragma unroll
            for (int f = 0; f < NF; ++f) a = fmaxf(a, fmaxf(fmaxf(s[hh][f][0], s[hh][f][1]), fmaxf(s[hh][f][2], s[hh][f][3])));
            const float cm = xor16_max(a);
            const float dd = force ? ((cm > -1e29f) ? cm : 0.f) : fmaxf(cm, 0.f);
            dlt[hh] = dd; R[hh] += dd;
#pragma unroll
            for (int f = 0; f < NF; ++f) { s[hh][f][0] -= dd; s[hh][f][1] -= dd; s[hh][f][2] -= dd; s[hh][f][3] -= dd; }
            const float sc = ex2(-dd);
            lacc[hh][0] *= sc; lacc[hh][1] *= sc; lacc[hh][2] *= sc; lacc[hh][3] *= sc;
            if (WITH_O) {
#pragma unroll
                for (int mf = 0; mf < 4; ++mf) { os[hh][mf][0] *= sc; os[hh][mf][1] *= sc; os[hh][mf][2] *= sc; os[hh][mf][3] *= sc; }
            }
        }
    }
#pragma unroll
    for (int hh = 0; hh < 2; ++hh) {
#pragma unroll
        for (int f = 0; f < NF; ++f)
#pragma unroll
            for (int r = 0; r < 4; ++r) s[hh][f][r] = ex2(s[hh][f][r]);
#pragma unroll
        for (int k = 0; k < NF / 2; ++k) {
            pb[hh][k] = pack8(s[hh][2 * k], s[hh][2 * k + 1]);
            lacc[hh] = mfma16(ones8(), pb[hh][k], lacc[hh]);
        }
    }
    return moved;
}

DEVI bool sm_need(const f32x4 (&s)[2][4]) {
    int m0 = imax4(s[0][0]), m1 = imax4(s[1][0]);
#pragma unroll
    for (int f = 1; f < 4; ++f) { m0 = max(m0, imax4(s[0][f])); m1 = max(m1, imax4(s[1][f])); }
    return (m0 > 0x41000000) || (m1 > 0x41000000);
}
DEVI void sm_rescale(f32x4 (&s)[2][4], float (&R)[2], f32x4 (&lacc)[2], f32x4 (&os)[2][4], const bool force) {
#pragma unroll
    for (int hh = 0; hh < 2; ++hh) {
        float a = NSA_NEG;
#pragma unroll
        for (int f = 0; f < 4; ++f) a = fmaxf(a, fmaxf(fmaxf(s[hh][f][0], s[hh][f][1]), fmaxf(s[hh][f][2], s[hh][f][3])));
        const float cm = xor16_max(a);
        const float dd = force ? ((cm > -1e29f) ? cm : 0.f) : fmaxf(cm, 0.f);
        R[hh] += dd;
#pragma unroll
        for (int f = 0; f < 4; ++f) { s[hh][f][0] -= dd; s[hh][f][1] -= dd; s[hh][f][2] -= dd; s[hh][f][3] -= dd; }
        const float sc = ex2(-dd);
        lacc[hh][0] *= sc; lacc[hh][1] *= sc; lacc[hh][2] *= sc; lacc[hh][3] *= sc;
#pragma unroll
        for (int mf = 0; mf < 4; ++mf) { os[hh][mf][0] *= sc; os[hh][mf][1] *= sc; os[hh][mf][2] *= sc; os[hh][mf][3] *= sc; }
    }
}

DEVI void nsa_tile(const Params& p, char* smem, int tile) {
    char* ws = p.ws;
    const int bg = tile & 7, cur = 127 - (tile >> 3), b = bg >> 1, g = bg & 1;
    const int tid = TIDX, lane = tid & 63, w = tid >> 6, fr = lane & 15, fq = lane >> 4;
    const int tt = w >> 1, hp = w & 1;
    const int t0 = cur * 64 + tt * 16;
    const size_t n0 = (size_t)b * 8192 + t0;
    const int tok = t0 + fr;
    const u16* Qb = (const u16*)(ws + OFF_Q);
    const u16* Kc = (const u16*)(ws + OFF_KC) + (size_t)bg * 512 * 64;
    const u16* Vct = (const u16*)(ws + OFF_VCT) + (size_t)bg * 8 * 64 * 64;
    const u16* Ks = (const u16*)(ws + OFF_KS) + (size_t)bg * 8192 * 64;
    const u16* Kw = (const u16*)(ws + OFF_KW) + (size_t)bg * 8192 * 64;
    const u16* Vst = (const u16*)(ws + OFF_VST) + (size_t)bg * 128 * 64 * 64;
    const u16* Vwt = (const u16*)(ws + OFF_VWT) + (size_t)bg * 128 * 64 * 64;
    const float* gp = (const float*)(ws + OFF_GATES) + (n0 + fr) * 24 + (g * 4 + 2 * hp) * 3;
    float* imp = (float*)(smem + NSA_OFF_IMP) + tt * 2048;
    unsigned long long* selm = (unsigned long long*)(smem + NSA_OFF_SEL) + tt * 32;

    for (int i = tid; i < 4 * 2048; i += 512) ((float*)(smem + NSA_OFF_IMP))[i] = 0.f;

    bf16x8 qf[2][2];
#pragma unroll
    for (int hh = 0; hh < 2; ++hh)
#pragma unroll
        for (int ks = 0; ks < 2; ++ks) qf[hh][ks] = ld8(Qb + (n0 + fr) * 512 + (g * 4 + 2 * hp + hh) * 64 + 32 * ks + 8 * fq);
    f32x4 ot[2][4];
#pragma unroll
    for (int hh = 0; hh < 2; ++hh)
#pragma unroll
        for (int mf = 0; mf < 4; ++mf) ot[hh][mf] = f32x4{0.f, 0.f, 0.f, 0.f};

    const int lrow = 8 * w + (lane >> 3), lpos = lane & 7, lch = lpos ^ ((lrow >> 1) & 7);
    const int lkey = (lrow & 32) | ((lrow & 16) >> 2) | ((lrow & 12) << 1) | (lrow & 3);
    const int koff = lkey * 64 + 8 * lch, voff = lrow * 64 + 8 * lch;
    const int ldsoff = w * 1024 + lane * 16;
#define RING_ISSUE_K(KB, BLK, SLOT) glds16((KB) + (size_t)(BLK) * 4096 + koff, (u16*)(smem + (SLOT) * NSA_STG + ldsoff))
#define RING_ISSUE_V(VB, BLK, SLOT) glds16((VB) + (size_t)(BLK) * 4096 + voff, (u16*)(smem + (SLOT) * NSA_STG + 8192 + ldsoff))
#define RING_BAR() __builtin_amdgcn_s_barrier()
#define WAITV(N) asm volatile("s_waitcnt vmcnt(" #N ")" ::: "memory")
    const int swz = fr >> 1;
#define NSA_QKC(KL, SC, S, NR) do { _Pragma("unroll") for (int u = 0; u < 2; ++u) { const u16* kp_ = (KL) + (32 * (SC) + 16 * u + fr) * 64; \
            const bf16x8 k0_ = ld8(kp_ + ((fq ^ swz) << 3)), k1_ = ld8(kp_ + (((4 + fq) ^ swz) << 3)); \
            _Pragma("unroll") for (int hh = 0; hh < 2; ++hh) { f32x4 a_ = f32x4{NR[hh], NR[hh], NR[hh], NR[hh]}; a_ = mfma16(k0_, qf[hh][0], a_); a_ = mfma16(k1_, qf[hh][1], a_); S[hh][u] = a_; } } } while (0)
#define NSA_PVC(VL, SC, PB, KI, O) do { _Pragma("unroll") for (int mf = 0; mf < 4; ++mf) { const bf16x8 va_ = ld8((VL) + (16 * mf + fr) * 64 + (((4 * (SC) + fq) ^ swz) << 3)); \
            _Pragma("unroll") for (int hh = 0; hh < 2; ++hh) O[hh][mf] = mfma16(va_, PB[hh][KI], O[hh][mf]); } } while (0)
#define NSA_ADJ(S, D) do { _Pragma("unroll") for (int hh = 0; hh < 2; ++hh) _Pragma("unroll") for (int u = 0; u < 2; ++u) { S[hh][u][0] -= D[hh]; S[hh][u][1] -= D[hh]; S[hh][u][2] -= D[hh]; S[hh][u][3] -= D[hh]; } } while (0)

    {
        const int ncmax = 4 * cur + 3;
        const int nb = (ncmax + 63) >> 6;
        float RC[2] = {0.f, 0.f};
        f32x4 lC[2] = {f32x4{0.f, 0.f, 0.f, 0.f}, f32x4{0.f, 0.f, 0.f, 0.f}};
        f32x4 oc[2][4];
#pragma unroll
        for (int hh = 0; hh < 2; ++hh)
#pragma unroll
            for (int mf = 0; mf < 4; ++mf) oc[hh][mf] = f32x4{0.f, 0.f, 0.f, 0.f};
        __syncthreads();
        for (int i = 0; i < 4 && i < nb; ++i) RING_ISSUE_K(Kc, i, i);
        if (nb >= 4) WAITV(2); else WAITV(0);
        RING_BAR();
        {
            bool first = true; int slot = 0;
            for (int i = 0; i < nb; ++i) {
                if (i + 4 < nb) RING_ISSUE_K(Kc, i + 4, slot == 0 ? 4 : slot - 1);
                const u16* Kl = (const u16*)(smem + slot * NSA_STG);
#pragma unroll 1
                for (int sc = 0; sc < 2; ++sc) {
                    const int c0 = 64 * i + 32 * sc;
                    if (16 * c0 + 31 <= t0 + 15) {
                        f32x4 s[2][2];
                        const float nr[2] = {-RC[0], -RC[1]};
                        NSA_QKC(Kl, sc, s, nr);
                        if (16 * (c0 + 31) + 31 > t0) {
#pragma unroll
                            for (int hh = 0; hh < 2; ++hh)
#pragma unroll
                                for (int u = 0; u < 2; ++u)
#pragma unroll
                                    for (int r = 0; r < 4; ++r) { const int c = c0 + 8 * fq + 4 * u + r; if (16 * c + 31 > tok) s[hh][u][r] = NSA_NEG; }
                        }
                        bf16x8 pb[2][1]; float dl[2];
                        sm_update<false, 2>(s, RC, lC, oc, pb, first, dl);
                        first = false;
                    }
                }
                if (i + 4 < nb) WAITV(2); else WAITV(0);
                RING_BAR();
                slot = (slot == 4) ? 0 : slot + 1;
            }
        }
        float ilC[2];
#pragma unroll
        for (int hh = 0; hh < 2; ++hh) { const float l = lC[hh][0]; ilC[hh] = l > 0.f ? 1.f / l : 0.f; }
        const float nrC[2] = {-RC[0], -RC[1]};
        for (int i = 0; i < 4 && i < nb; ++i) { RING_ISSUE_K(Kc, i, i); RING_ISSUE_V(Vct, i, i); }
        if (nb >= 4) WAITV(4); else WAITV(0);
        RING_BAR();
        {
            int slot = 0;
            for (int i = 0; i < nb; ++i) {
                if (i + 4 < nb) { const int sl = slot == 0 ? 4 : slot - 1; RING_ISSUE_K(Kc, i + 4, sl); RING_ISSUE_V(Vct, i + 4, sl); }
                const u16* Kl = (const u16*)(smem + slot * NSA_STG);
                const u16* Vl = Kl + 4096;
#pragma unroll 1
                for (int sc = 0; sc < 2; ++sc) {
                    const int c0 = 64 * i + 32 * sc;
                    if (16 * c0 + 31 <= t0 + 15) {
                        f32x4 s[2][2];
                        NSA_QKC(Kl, sc, s, nrC);
                        float qs[2] = {0.f, 0.f}, p3[2] = {0.f, 0.f};
                        bf16x8 pb[2][1];
#pragma unroll
                        for (int hh = 0; hh < 2; ++hh) {
#pragma unroll
                            for (int u = 0; u < 2; ++u) {
                                float q4 = 0.f;
#pragma unroll
                                for (int r = 0; r < 4; ++r) {
                                    const int c = c0 + 8 * fq + 4 * u + r;
                                    const float pv = (16 * c + 31 <= tok) ? ex2(s[hh][u][r]) : 0.f;
                                    s[hh][u][r] = pv; q4 += pv;
                                }
                                qs[u] += q4 * ilC[hh]; p3[u] += s[hh][u][3] * ilC[hh];
                            }
                            pb[hh][0] = pack8(s[hh][0], s[hh][1]);
                        }
#pragma unroll
                        for (int u = 0; u < 2; ++u) {
                            const int j = (c0 >> 2) + 2 * fq + u;
                            const unsigned la_ = (unsigned)(size_t)(LAS3 float*)(imp + fr * 128 + j);
                            asm volatile("ds_add_f32 %0, %1" :: "v"(la_), "v"(qs[u]) : "memory");
                            if (j + 1 < 128) asm volatile("ds_add_f32 %0, %1 offset:4" :: "v"(la_), "v"(p3[u]) : "memory");
                        }
                        NSA_PVC(Vl, sc, pb, 0, oc);
                    }
                }
                if (i + 4 < nb) WAITV(4); else WAITV(0);
                RING_BAR();
                slot = (slot == 4) ? 0 : slot + 1;
            }
        }
#pragma unroll
        for (int hh = 0; hh < 2; ++hh) {
            const float gc = gp[hh * 3 + 0] * ilC[hh];
#pragma unroll
            for (int mf = 0; mf < 4; ++mf) ot[hh][mf] += oc[hh][mf] * gc;
        }
    }
    asm volatile("s_waitcnt lgkmcnt(0)" ::: "memory");
    __syncthreads();
    {
        if (cur < 16) {
            if (hp == 0 && lane < 16) { selm[lane * 2] = (2ull << cur) - 1ull; selm[lane * 2 + 1] = 0ull; }
        } else {
            for (int tau = 8 * hp; tau < 8 * hp + 8; ++tau) {
                const int j0 = lane, j1 = lane + 64;
                const bool in0 = (j0 >= 1) && (j0 <= cur - 2), in1 = (j1 <= cur - 2);
                const float v0 = in0 ? imp[tau * 128 + j0] : 0.f;
                const float v1 = in1 ? imp[tau * 128 + j1] : 0.f;
                const uint32_t u0 = __float_as_uint(v0), u1 = __float_as_uint(v1);
                uint32_t res = 0;
                uint64_t sa = 0, sb = 0;
                bool found = false;
                for (int bit = 30; bit >= 0; --bit) {
                    const uint32_t cand = res | (1u << bit);
                    const uint64_t c0 = __ballot(in0 && u0 >= cand), c1 = __ballot(in1 && u1 >= cand);
                    const int cnt = __popcll(c0) + __popcll(c1);
                    if (cnt == 13) { sa = c0; sb = c1; found = true; break; }
                    if (cnt > 13) res = cand;
                }
                if (!found) {
                    const uint64_t g0 = __ballot(in0 && u0 > res), g1 = __ballot(in1 && u1 > res);
                    const uint64_t e0 = __ballot(in0 && u0 == res), e1 = __ballot(in1 && u1 == res);
                    int need = 13 - (__popcll(g0) + __popcll(g1));
                    const int ne0 = __popcll(e0);
                    sa = g0 | lowest_bits(e0, need);
                    need -= (need < ne0 ? need : ne0);
                    sb = g1 | lowest_bits(e1, need);
                }
                sa |= 1ull;
                if (cur - 1 < 64) sa |= 1ull << (cur - 1); else sb |= 1ull << (cur - 1 - 64);
                if (cur < 64) sa |= 1ull << cur; else sb |= 1ull << (cur - 64);
                if (lane == 0) { selm[tau * 2] = sa; selm[tau * 2 + 1] = sb; }
            }
        }
    }
    {
        const int wb0 = cur >= 8 ? cur - 8 : 0, nb = cur - wb0 + 1;
        float RW[2] = {0.f, 0.f};
        f32x4 lW[2] = {f32x4{0.f, 0.f, 0.f, 0.f}, f32x4{0.f, 0.f, 0.f, 0.f}};
        f32x4 ow[2][4];
#pragma unroll
        for (int hh = 0; hh < 2; ++hh)
#pragma unroll
            for (int mf = 0; mf < 4; ++mf) ow[hh][mf] = f32x4{0.f, 0.f, 0.f, 0.f};
        __syncthreads();
        for (int i = 0; i < 4 && i < nb; ++i) { RING_ISSUE_K(Kw, wb0 + i, i); RING_ISSUE_V(Vwt, wb0 + i, i); }
        if (nb >= 4) WAITV(4); else WAITV(0);
        RING_BAR();
        bool first = true; int slot = 0;
        for (int i = 0; i < nb; ++i) {
            if (i + 4 < nb) { const int sl = slot == 0 ? 4 : slot - 1; RING_ISSUE_K(Kw, wb0 + i + 4, sl); RING_ISSUE_V(Vwt, wb0 + i + 4, sl); }
            const u16* Kl = (const u16*)(smem + slot * NSA_STG);
            const u16* Vl = Kl + 4096;
#pragma unroll 1
            for (int sc = 0; sc < 2; ++sc) {
                const int kb = 64 * (wb0 + i) + 32 * sc;
                if (kb <= t0 + 15 && kb + 31 > t0 - 512) {
                    f32x4 s[2][2];
                    const float nr[2] = {-RW[0], -RW[1]};
                    NSA_QKC(Kl, sc, s, nr);
                    if (kb + 31 > t0 || kb <= t0 + 15 - 512) {
#pragma unroll
                        for (int hh = 0; hh < 2; ++hh)
#pragma unroll
                            for (int u = 0; u < 2; ++u)
#pragma unroll
                                for (int r = 0; r < 4; ++r) { const int key = kb + 8 * fq + 4 * u + r; if (key > tok || key <= tok - 512) s[hh][u][r] = NSA_NEG; }
                    }
                    bf16x8 pb[2][1]; float dl[2];
                    sm_update<true, 2>(s, RW, lW, ow, pb, first, dl);
                    first = false;
                    NSA_PVC(Vl, sc, pb, 0, ow);
                }
            }
            if (i + 4 < nb) WAITV(4); else WAITV(0);
            RING_BAR();
            slot = (slot == 4) ? 0 : slot + 1;
        }
#pragma unroll
        for (int hh = 0; hh < 2; ++hh) {
            const float l = lW[hh][0];
            const float gw = gp[hh * 3 + 2] * (l > 0.f ? 1.f / l : 0.f);
#pragma unroll
            for (int mf = 0; mf < 4; ++mf) ot[hh][mf] += ow[hh][mf] * gw;
        }
    }
    {
        __syncthreads();
        const unsigned long long mA = selm[fr * 2], mB = selm[fr * 2 + 1];
        const int nb = cur + 1;
        for (int i = 0; i < 4 && i < nb; ++i) { RING_ISSUE_K(Ks, i, i); RING_ISSUE_V(Vst, i, i); }
        if (nb >= 4) WAITV(4); else WAITV(0);
        RING_BAR();
        float RS[2] = {0.f, 0.f};
        f32x4 lS[2] = {f32x4{0.f, 0.f, 0.f, 0.f}, f32x4{0.f, 0.f, 0.f, 0.f}};
        f32x4 os[2][4];
#pragma unroll
        for (int hh = 0; hh < 2; ++hh)
#pragma unroll
            for (int mf = 0; mf < 4; ++mf) os[hh][mf] = f32x4{0.f, 0.f, 0.f, 0.f};
#define NSA_QKB(KL, S, NR) do { _Pragma("unroll") for (int f = 0; f < 4; ++f) { const u16* kp_ = (KL) + (16 * f + fr) * 64; \
            const bf16x8 k0_ = ld8(kp_ + ((fq ^ swz) << 3)), k1_ = ld8(kp_ + (((4 + fq) ^ swz) << 3)); \
            _Pragma("unroll") for (int hh = 0; hh < 2; ++hh) { f32x4 a_ = f32x4{NR[hh], NR[hh], NR[hh], NR[hh]}; a_ = mfma16(k0_, qf[hh][0], a_); a_ = mfma16(k1_, qf[hh][1], a_); S[hh][f] = a_; } } } while (0)
#define NSA_PVB(VL, PB) do { _Pragma("unroll") for (int sc = 0; sc < 2; ++sc) { _Pragma("unroll") for (int mf = 0; mf < 4; ++mf) { \
            const bf16x8 va_ = ld8((VL) + (16 * mf + fr) * 64 + (((4 * sc + fq) ^ swz) << 3)); \
            _Pragma("unroll") for (int hh = 0; hh < 2; ++hh) os[hh][mf] = mfma16(va_, PB[hh][sc], os[hh][mf]); } \
            _Pragma("unroll") for (int hh = 0; hh < 2; ++hh) lS[hh] = mfma16(ones8(), PB[hh][sc], lS[hh]); } } while (0)
#define NSA_EXPB(S, PB) do { _Pragma("unroll") for (int hh = 0; hh < 2; ++hh) { _Pragma("unroll") for (int f = 0; f < 4; ++f) { \
            S[hh][f][0] = ex2(S[hh][f][0]); S[hh][f][1] = ex2(S[hh][f][1]); S[hh][f][2] = ex2(S[hh][f][2]); S[hh][f][3] = ex2(S[hh][f][3]); } \
            PB[hh][0] = pack8(S[hh][0], S[hh][1]); PB[hh][1] = pack8(S[hh][2], S[hh][3]); } } while (0)
        f32x4 sn[2][4];
        {
            const float nr0[2] = {0.f, 0.f};
            NSA_QKB((const u16*)smem, sn, nr0);
        }
        bf16x8 pbp[2][2];
#pragma unroll
        for (int hh = 0; hh < 2; ++hh) { pbp[hh][0] = zero8(); pbp[hh][1] = zero8(); }
        bool first = true;
        int slot = 0, pslot = 0;
#define NSA_SELSTEP(STEADY) do { \
            const int slot1 = (slot == 5) ? 0 : slot + 1; \
            if (STEADY) { const int sl = (slot >= 2) ? slot - 2 : slot + 4; RING_ISSUE_K(Ks, jb + 4, sl); RING_ISSUE_V(Vst, jb + 4, sl); } \
            const u16* Vp = (const u16*)(smem + pslot * NSA_STG) + 4096; \
            const u16* Kn = (const u16*)(smem + slot1 * NSA_STG); \
            const bool on = ((jb < 64 ? (mA >> jb) : (mB >> (jb - 64))) & 1ull) != 0ull; \
            const bool onn = (((jb + 1) < 64 ? (mA >> (jb + 1)) : (mB >> (jb + 1 - 64))) & 1ull) != 0ull; \
            const bool any = __ballot(on) != 0ull; \
            f32x4 s[2][4]; \
            _Pragma("unroll") for (int hh = 0; hh < 2; ++hh) _Pragma("unroll") for (int f = 0; f < 4; ++f) s[hh][f] = sn[hh][f]; \
            if (any) { \
                if (first || __ballot(sm_need(s))) {        \
                    NSA_PVB(Vp, pbp); \
                    _Pragma("unroll") for (int hh = 0; hh < 2; ++hh) { pbp[hh][0] = zero8(); pbp[hh][1] = zero8(); } \
                    sm_rescale(s, RS, lS, os, first); \
                } \
                first = false; \
            } \
            {     \
                const float nr[2] = {onn ? -RS[0] : NSA_NEG, onn ? -RS[1] : NSA_NEG}; \
                bf16x8 pbc[2][2]; \
                NSA_QKB(Kn, sn, nr); \
                NSA_PVB(Vp, pbp); \
                NSA_EXPB(s, pbc);                            \
                _Pragma("unroll") for (int hh = 0; hh < 2; ++hh) { pbp[hh][0] = pbc[hh][0]; pbp[hh][1] = pbc[hh][1]; } \
                _Pragma("unroll") for (int k_ = 0; k_ < 16; ++k_) { \
                    __builtin_amdgcn_sched_group_barrier(0x008, 2, 0);     \
                    __builtin_amdgcn_sched_group_barrier(0x400, 2, 0);     \
                    __builtin_amdgcn_sched_group_barrier(0x002, 2, 0);     \
                } \
                if (STEADY) WAITV(4); else WAITV(0); \
                RING_BAR(); \
            } \
            pslot = slot; slot = slot1; } while (0)
        int jb = 0;
        for (; jb + 4 < nb && jb < cur; ++jb) NSA_SELSTEP(true);
        for (; jb < cur; ++jb) NSA_SELSTEP(false);
#undef NSA_SELSTEP
        {
            const u16* Vp = (const u16*)(smem + pslot * NSA_STG) + 4096;
            const u16* Vl = (const u16*)(smem + slot * NSA_STG) + 4096;
#pragma unroll
            for (int hh = 0; hh < 2; ++hh)
#pragma unroll
                for (int f = 0; f < 4; ++f)
#pragma unroll
                    for (int r = 0; r < 4; ++r) { const int key = 64 * cur + 32 * (f >> 1) + 8 * fq + 4 * (f & 1) + r; if (key > tok) sn[hh][f][r] = NSA_NEG; }
            NSA_PVB(Vp, pbp);
            if (first || __ballot(sm_need(sn))) sm_rescale(sn, RS, lS, os, first);
            bf16x8 pbc[2][2];
            NSA_EXPB(sn, pbc);
            NSA_PVB(Vl, pbc);
        }
#undef NSA_PVB
#undef NSA_EXPB
#undef NSA_QKB
#pragma unroll
        for (int hh = 0; hh < 2; ++hh) {
            const float l = lS[hh][0];
            const float gs = gp[hh * 3 + 1] * (l > 0.f ? 1.f / l : 0.f);
#pragma unroll
            for (int mf = 0; mf < 4; ++mf) ot[hh][mf] += os[hh][mf] * gs;
        }
    }
#undef RING_ISSUE_K
#undef RING_ISSUE_V
#undef RING_BAR
#undef WAITV
#undef NSA_QKC
#undef NSA_PVC
#undef NSA_ADJ
    {
        u16* mix = (u16*)(ws + OFF_MIX) + (n0 + fr) * 1024 + (g * 4 + 2 * hp) * 64;
#pragma unroll
        for (int hh = 0; hh < 2; ++hh)
#pragma unroll
            for (int mf = 0; mf < 4; ++mf) *(uint2*)(mix + hh * 64 + 16 * mf + 4 * fq) = pack4(ot[hh][mf]);
    }
    __syncthreads();
}

namespace g8 {
constexpr int BM = 256, BK = 64, HALF = 128, HTB = HALF * BK * 2, KK = 1024, NT = KK / BK;
DEVI int lds_byte(int r, int c) { const int st = (r >> 4) * 2 + (c >> 5), rr = r & 15, cc = c & 31, ob = rr * 64 + cc * 2; return st * 1024 + (ob ^ (((ob >> 9) & 1) << 5)); }
DEVI void stage_rc(int b, int& R, int& C) { const int st = b / 1024, sb = b % 1024, swz = sb ^ (((sb >> 9) & 1) << 5); R = (st >> 1) * 16 + swz / 64; C = (st & 1) * 32 + (swz % 64) / 2; }
DEVI int perm32(int rho) { const int n = rho >> 4, i = rho & 15; return 8 * (i >> 2) + 4 * n + (i & 3); }

template <bool TRANS, bool PERM, class Src, class Epi>
DEVI void gemm_phase(int tid, LAS3 unsigned char* lds, const char* Abase, const Src& S, const Epi& E) {
    asm volatile("" : "+v"(tid));
    const int wid = __builtin_amdgcn_readfirstlane(tid >> 6), lane = tid & 63, wr = wid >> 2, wc = wid & 3, fr = lane & 15, fq = lane >> 4;
    int R0, C0, R1, C1;
    stage_rc(tid * 16, R0, C0); stage_rc(tid * 16 + 8192, R1, C1);
    unsigned voffB[2];
    voffB[0] = (unsigned)((PERM ? ((R0 & ~31) + perm32(R0 & 31)) : R0) * KK + C0) * 2u;
    voffB[1] = (unsigned)((PERM ? ((R1 & ~31) + perm32(R1 & 31)) : R1) * KK + C1) * 2u;
    constexpr size_t kstep = (size_t)(BK * 2);
    constexpr size_t hstepB = (size_t)HALF * KK * 2;
    const unsigned ldsw = (unsigned)wid * 1024u;
    const int aoff = lds_byte(wr * 64 + fr, fq * 8), boff = lds_byte(wc * 32 + fr, fq * 8);
#define G8_SA(b, h) (((b) * 2 + (h)) * HTB)
#define G8_SB(b, h) ((4 + (b) * 2 + (h)) * HTB)
#define G8_STAGE_A(bufoff, kbyte, v0, v1) do { \
        __builtin_amdgcn_global_load_lds((const unsigned*)(Abase + (kbyte) + (v0)), (LAS3 unsigned*)(lds + (bufoff) + ldsw), 16, 0, 0); \
        __builtin_amdgcn_global_load_lds((const unsigned*)(Abase + (kbyte) + (v1)), (LAS3 unsigned*)(lds + (bufoff) + ldsw + 8192), 16, 0, 0); } while (0)
#define G8_STAGE_B(bufoff, gptr) do { \
        __builtin_amdgcn_global_load_lds((const unsigned*)((gptr) + voffB[0]), (LAS3 unsigned*)(lds + (bufoff) + ldsw), 16, 0, 0); \
        __builtin_amdgcn_global_load_lds((const unsigned*)((gptr) + voffB[1]), (LAS3 unsigned*)(lds + (bufoff) + ldsw + 8192), 16, 0, 0); } while (0)
#define G8_LDA(dst, b, h) do { _Pragma("unroll") for (int m = 0; m < 4; ++m) _Pragma("unroll") for (int k = 0; k < 2; ++k) dst[m][k] = *(const LAS3 bf16x8*)(lds + G8_SA(b, h) + aoff + m * 2048 + k * 1024); } while (0)
#define G8_LDB(dst, b, h) do { _Pragma("unroll") for (int n = 0; n < 2; ++n) _Pragma("unroll") for (int k = 0; k < 2; ++k) dst[n][k] = *(const LAS3 bf16x8*)(lds + G8_SB(b, h) + boff + n * 2048 + k * 1024); } while (0)
#define G8_MMA(ai, bj, At, Bt) do { __builtin_amdgcn_s_setprio(1); _Pragma("unroll") for (int m = 0; m < 4; ++m) _Pragma("unroll") for (int n = 0; n < 2; ++n) _Pragma("unroll") for (int k = 0; k < 2; ++k) \
        acc[ai][bj][m][n] = TRANS ? __builtin_amdgcn_mfma_f32_16x16x32_bf16(Bt[n][k], At[m][k], acc[ai][bj][m][n], 0, 0, 0) \
                                  : __builtin_amdgcn_mfma_f32_16x16x32_bf16(At[m][k], Bt[n][k], acc[ai][bj][m][n], 0, 0, 0); __builtin_amdgcn_s_setprio(0); } while (0)
#define G8_WAIT_V(n) asm volatile("s_waitcnt vmcnt(" #n ")" ::: "memory")
#define G8_WAIT_L(n) asm volatile("s_waitcnt lgkmcnt(" #n ")" ::: "memory")
#define G8_BAR __builtin_amdgcn_s_barrier()
#define G8_SCHED __builtin_amdgcn_sched_barrier(0)
    typename Src::U cur, nxt; int ui = 0;
    if (!S.next(0, cur)) return;
    f32x4 acc[2][2][4][2];
#pragma unroll
    for (int a = 0; a < 2; ++a)
#pragma unroll
        for (int b = 0; b < 2; ++b)
#pragma unroll
            for (int m = 0; m < 4; ++m)
#pragma unroll
                for (int n = 0; n < 2; ++n) acc[a][b][m][n] = (f32x4){0.f, 0.f, 0.f, 0.f};
    bf16x8 At[4][2], B0[2][2], B1[2][2];
    unsigned cA00, cA01, cA10, cA11;
    S.aoff4(cur, R0, R1, cA00, cA01, cA10, cA11);
    cA00 += C0 * 2u; cA01 += C1 * 2u; cA10 += C0 * 2u; cA11 += C1 * 2u;
    const char* cB = S.bbase(cur);
    G8_STAGE_B(G8_SB(0, 0), cB); G8_STAGE_A(G8_SA(0, 0), 0, cA00, cA01); G8_STAGE_B(G8_SB(0, 1), cB + hstepB); G8_STAGE_A(G8_SA(0, 1), 0, cA10, cA11);
    if (wr == 1) G8_BAR;
    G8_WAIT_V(4); G8_BAR;
    G8_STAGE_B(G8_SB(1, 0), cB + kstep); G8_STAGE_A(G8_SA(1, 0), kstep, cA00, cA01); G8_STAGE_B(G8_SB(1, 1), cB + hstepB + kstep);
    G8_WAIT_V(6); G8_BAR;
    for (;;) {
        const bool has_next = S.next(ui + 1, nxt);
        unsigned nA00 = cA00, nA01 = cA01, nA10 = cA10, nA11 = cA11;
        const char* nB = cB;
        if (has_next) {
            S.aoff4(nxt, R0, R1, nA00, nA01, nA10, nA11);
            nA00 += C0 * 2u; nA01 += C1 * 2u; nA10 += C0 * 2u; nA11 += C1 * 2u;
            nB = S.bbase(nxt);
        }
#pragma unroll 1
        for (int t = 0; t < NT; t += 2) {
            const bool last = (t == NT - 2);
            const size_t k1 = (size_t)(t + 1) * kstep;
            const size_t k2 = last ? (size_t)0 : (size_t)(t + 2) * kstep, k3 = k2 + kstep;
            const unsigned x00 = last ? nA00 : cA00, x01 = last ? nA01 : cA01, x10 = last ? nA10 : cA10, x11 = last ? nA11 : cA11;
            const char* b2 = (last ? nB : cB) + k2; const char* b3 = b2 + kstep;
            G8_LDB(B0, 0, 0); G8_SCHED; G8_LDA(At, 0, 0); G8_STAGE_A(G8_SA(1, 1), k1, cA10, cA11);
            G8_WAIT_L(8); G8_BAR; G8_WAIT_L(0); G8_MMA(0, 0, At, B0); G8_BAR; G8_SCHED;
            G8_LDB(B1, 0, 1); G8_STAGE_B(G8_SB(0, 0), b2);
            G8_BAR; G8_WAIT_L(0); G8_MMA(0, 1, At, B1); G8_BAR;
            G8_LDA(At, 0, 1); G8_STAGE_A(G8_SA(0, 0), k2, x00, x01);
            G8_BAR; G8_WAIT_L(0); G8_MMA(1, 0, At, B0); G8_BAR; G8_SCHED;
            G8_STAGE_B(G8_SB(0, 1), b2 + hstepB);
            G8_WAIT_V(6); G8_BAR; G8_MMA(1, 1, At, B1); G8_BAR;
            G8_LDB(B0, 1, 0); G8_SCHED; G8_LDA(At, 1, 0); G8_STAGE_A(G8_SA(0, 1), k2, x10, x11);
            G8_WAIT_L(8); G8_BAR; G8_WAIT_L(0); G8_MMA(0, 0, At, B0); G8_BAR; G8_SCHED;
            G8_LDB(B1, 1, 1); G8_STAGE_B(G8_SB(1, 0), b3);
            G8_BAR; G8_WAIT_L(0); G8_MMA(0, 1, At, B1); G8_BAR;
            G8_LDA(At, 1, 1); G8_STAGE_A(G8_SA(1, 0), k3, x00, x01);
            G8_BAR; G8_WAIT_L(0); G8_MMA(1, 0, At, B0); G8_BAR; G8_SCHED;
            G8_STAGE_B(G8_SB(1, 1), b3 + hstepB);
            G8_WAIT_V(6); G8_BAR; G8_MMA(1, 1, At, B1); G8_BAR;
        }
        E(acc, cur, wr, wc, fr, fq);
        if (!has_next) break;
#pragma unroll
        for (int a = 0; a < 2; ++a)
#pragma unroll
            for (int b = 0; b < 2; ++b)
#pragma unroll
                for (int m = 0; m < 4; ++m)
#pragma unroll
                    for (int n = 0; n < 2; ++n) acc[a][b][m][n] = (f32x4){0.f, 0.f, 0.f, 0.f};
        cur = nxt; cA00 = nA00; cA01 = nA01; cA10 = nA10; cA11 = nA11; cB = nB; ++ui;
    }
    G8_WAIT_V(0);
    if (wr == 0) G8_BAR;
    G8_BAR;
#undef G8_SA
#undef G8_SB
#undef G8_STAGE_A
#undef G8_STAGE_B
#undef G8_LDA
#undef G8_LDB
#undef G8_MMA
#undef G8_WAIT_V
#undef G8_WAIT_L
#undef G8_BAR
#undef G8_SCHED
}

struct DenseSrc {
    struct U { int pm, pn; };
    const char* Bt; int nM, nN, nwg, G, c;
    DEVI void init(const void* Bt_, int M, int N, int G_, int c_) { Bt = (const char*)Bt_; nM = M / BM; nN = N / BM; nwg = nM * nN; G = G_; c = c_; }
    DEVI bool next(int i, U& u) const {
        const int L = i * G + c; if (L >= nwg) return false;
        int wgid = L; { const int q = nwg / 8, r = nwg % 8, xcd = wgid % 8, off = wgid / 8; wgid = (xcd < r ? xcd * (q + 1) : r * (q + 1) + (xcd - r) * q) + off; }
        const int nig = 8 * nN, gid = wgid / nig, fm = gid * 8, gsz = (nM - fm) < 8 ? (nM - fm) : 8;
        u.pm = fm + ((wgid % nig) % gsz); u.pn = (wgid % nig) / gsz; return true;
    }
    DEVI unsigned aoff(const U& u, int row) const { return (unsigned)(u.pm * BM + row) * (unsigned)(KK * 2); }
    DEVI void aoff4(const U& u, int r0, int r1, unsigned& a00, unsigned& a01, unsigned& a10, unsigned& a11) const { a00 = aoff(u, r0); a01 = aoff(u, r1); a10 = aoff(u, HALF + r0); a11 = aoff(u, HALF + r1); }
    DEVI const char* bbase(const U& u) const { return Bt + (size_t)u.pn * BM * KK * 2; }
};
}


struct EpiWo {
    u16* o;
    DEVI void operator()(const f32x4 (&acc)[2][2][4][2], const g8::DenseSrc::U& u, int wr, int wc, int fr, int fq) const {
#pragma unroll
        for (int ai = 0; ai < 2; ++ai)
#pragma unroll
            for (int m = 0; m < 4; ++m) {
                const size_t row = (size_t)u.pm * 256 + ai * 128 + wr * 64 + m * 16 + fr;
#pragma unroll
                for (int bj = 0; bj < 2; ++bj) {
                    uint4 v; v.x = pack2(acc[ai][bj][m][0][0], acc[ai][bj][m][0][1]); v.y = pack2(acc[ai][bj][m][0][2], acc[ai][bj][m][0][3]);
                    v.z = pack2(acc[ai][bj][m][1][0], acc[ai][bj][m][1][1]); v.w = pack2(acc[ai][bj][m][1][2], acc[ai][bj][m][1][3]);
                    *(uint4*)(o + row * 1024 + u.pn * 256 + bj * 128 + wc * 32 + fq * 8) = v;
                }
            }
    }
};
DEVI void phase_wo8(const Params& p, char* smem_all) {
    g8::DenseSrc S; S.init(p.ws + OFF_WO, NTOK, 1024, gridDim.x, blockIdx.x);
    EpiWo E; E.o = (u16*)(p.ws + OFF_PRE);
    g8::gemm_phase<true, true>(TIDX, (LAS3 unsigned char*)smem_all, p.ws + OFF_MIX, S, E);
}

DEVI void wo_tile(const Params& p, char* smem, int tile) {
    char* ws = p.ws;
    const int rt = tile >> 3, ct = tile & 7;
    const int tid = VTID, lane = tid & 63, wid = tid >> 6, wr = wid >> 1, wc = wid & 1, fr = lane & 15, fq = lane >> 4;
    const u16* MIX = (const u16*)(ws + OFF_MIX);
    auto arow = [&](int r) { return MIX + (size_t)(rt * 128 + r) * 1024; };
    f32x4 acc[4][4];
    gemm128(tid, arow, (const u16*)(ws + OFF_WO) + (size_t)ct * 128 * 1024, 1024, 1024, smem, acc);
    float* pre = (float*)(ws + OFF_PRE);
#pragma unroll
    for (int m = 0; m < 4; ++m)
#pragma unroll
        for (int n = 0; n < 4; ++n) {
            const int row = rt * 128 + wr * 64 + m * 16 + fq * 4, col = ct * 128 + wc * 64 + n * 16 + fr;
#pragma unroll
            for (int j = 0; j < 4; ++j) {
                const size_t ix = (size_t)(row + j) * 1024 + col;
                pre[ix] = DN_ALPHA * p.x[ix] + acc[m][n][j];
            }
        }
}

DEVI void ln1_router_tile(const Params& p, char* smem, int tile) {
    char* ws = p.ws;
    const int tid = VTID, lane = tid & 63, w = tid >> 6;
    const int tok0 = tile * 32;
    const u16* mixo = (const u16*)(ws + OFF_PRE);
    u16* H1B = (u16*)(ws + OFF_H1B);
    for (int i = 0; i < 8; ++i) {
        const size_t row = (size_t)tok0 + w * 8 + i;
        float4 v[4];
        float s = 0.f;
#pragma unroll
        for (int q = 0; q < 4; ++q) {
            const float4 xv = *(const float4*)(p.x + row * 1024 + q * 256 + lane * 4);
            const uint2 mv = *(const uint2*)(mixo + row * 1024 + q * 256 + lane * 4);
            v[q].x = DN_ALPHA * xv.x + __uint_as_float(mv.x << 16); v[q].y = DN_ALPHA * xv.y + __uint_as_float(mv.x & 0xffff0000u);
            v[q].z = DN_ALPHA * xv.z + __uint_as_float(mv.y << 16); v[q].w = DN_ALPHA * xv.w + __uint_as_float(mv.y & 0xffff0000u);
            s += v[q].x + v[q].y + v[q].z + v[q].w;
        }
        const float mu = wave_sum(s) * (1.f / 1024.f);
        float ss = 0.f;
#pragma unroll
        for (int q = 0; q < 4; ++q) { v[q].x -= mu; v[q].y -= mu; v[q].z -= mu; v[q].w -= mu; ss += v[q].x * v[q].x + v[q].y * v[q].y + v[q].z * v[q].z + v[q].w * v[q].w; }
        const float rs = rsqrtf(wave_sum(ss) * (1.f / 1024.f) + 1e-5f);
#pragma unroll
        for (int q = 0; q < 4; ++q) {
            const int c = q * 256 + lane * 4;
            const float4 gq = *(const float4*)(p.ln1g + c), bq = *(const float4*)(p.ln1b + c);
            float4 o; o.x = v[q].x * rs * gq.x + bq.x; o.y = v[q].y * rs * gq.y + bq.y; o.z = v[q].z * rs * gq.z + bq.z; o.w = v[q].w * rs * gq.w + bq.w;
            uint2 ob; ob.x = pack2(o.x, o.y); ob.y = pack2(o.z, o.w);
            *(uint2*)(H1B + row * 1024 + c) = ob;
        }
    }
    __builtin_amdgcn_fence(__ATOMIC_RELEASE, "workgroup");
    __syncthreads();
    float* part = (float*)smem;
    int* lcnt = (int*)(smem + 4 * 32 * 33 * 4);
    {
        f32x16 acc;
#pragma unroll
        for (int i = 0; i < 16; ++i) acc[i] = 0.f;
        const int i32 = lane & 31, hh = lane >> 5;
        const u16* ap = H1B + ((size_t)tok0 + i32) * 1024 + 256 * w + 4 * hh;
        const float* bp = p.w_r + (size_t)(256 * w + 4 * hh) * 32 + i32;
#pragma unroll 2
        for (int m = 0; m < 32; ++m) {
            const uint2 ab = *(const uint2*)(ap + 8 * m);
            float4 a; a.x = __uint_as_float(ab.x << 16); a.y = __uint_as_float(ab.x & 0xffff0000u); a.z = __uint_as_float(ab.y << 16); a.w = __uint_as_float(ab.y & 0xffff0000u);
            const float b0 = bp[(size_t)(8 * m + 0) * 32], b1 = bp[(size_t)(8 * m + 1) * 32], b2 = bp[(size_t)(8 * m + 2) * 32], b3 = bp[(size_t)(8 * m + 3) * 32];
            acc = __builtin_amdgcn_mfma_f32_32x32x2f32(a.x, b0, acc, 0, 0, 0);
            acc = __builtin_amdgcn_mfma_f32_32x32x2f32(a.y, b1, acc, 0, 0, 0);
            acc = __builtin_amdgcn_mfma_f32_32x32x2f32(a.z, b2, acc, 0, 0, 0);
            acc = __builtin_amdgcn_mfma_f32_32x32x2f32(a.w, b3, acc, 0, 0, 0);
        }
#pragma unroll
        for (int r = 0; r < 16; ++r) {
            const int row = (r & 3) + 8 * (r >> 2) + 4 * hh;
            part[(w * 32 + row) * 33 + i32] = acc[r];
        }
    }
    if (tid < 32) lcnt[tid] = 0;
    __syncthreads();
    float* lgt = (float*)(smem + 24576);
    for (int i = tid; i < 1024; i += 256) {
        const int t = i >> 5, j = i & 31;
        lgt[t * 33 + j] = part[(0 * 32 + t) * 33 + j] + part[(1 * 32 + t) * 33 + j] + part[(2 * 32 + t) * 33 + j] + part[(3 * 32 + t) * 33 + j] + p.b_r[j];
    }
    __syncthreads();
    int e_sel[4]; float w_sel[4]; int rank[4];
    if (tid < 32) {
        float v0 = -3.0e38f, v1 = -3.0e38f, v2 = -3.0e38f, v3 = -3.0e38f; int i0 = 0, i1 = 0, i2 = 0, i3 = 0;
#pragma unroll 8
        for (int j = 0; j < 32; ++j) {
            const float lg = lgt[tid * 33 + j];
            if (lg > v3) {
                if (lg > v0) { v3 = v2; i3 = i2; v2 = v1; i2 = i1; v1 = v0; i1 = i0; v0 = lg; i0 = j; }
                else if (lg > v1) { v3 = v2; i3 = i2; v2 = v1; i2 = i1; v1 = lg; i1 = j; }
                else if (lg > v2) { v3 = v2; i3 = i2; v2 = lg; i2 = j; }
                else { v3 = lg; i3 = j; }
            }
        }
        const float bestv[4] = {v0, v1, v2, v3}; const int besti[4] = {i0, i1, i2, i3};
        float den = 0.f;
#pragma unroll
        for (int k = 0; k < 4; ++k) { w_sel[k] = expf(bestv[k] - bestv[0]); den += w_sel[k]; }
#pragma unroll
        for (int k = 0; k < 4; ++k) { w_sel[k] /= den; e_sel[k] = besti[k]; rank[k] = atomicAdd(&lcnt[besti[k]], 1); }
    }
    __syncthreads();
    if (tid < 32) {
        const int c = lcnt[tid];
        int* counts = (int*)((float*)(ws + OFF_MISC) + 1024);
        lcnt[32 + tid] = c ? atomicAdd(&counts[tid], c) : 0;
    }
    __syncthreads();
    if (tid < 32) {
        int* la = (int*)(ws + OFF_LISTA); float* lw = (float*)(ws + OFF_LISTW);
#pragma unroll
        for (int k = 0; k < 4; ++k) {
            const size_t pos = (size_t)e_sel[k] * NTOK + lcnt[32 + e_sel[k]] + rank[k];
            la[pos] = (tok0 + tid) * 4 + k; lw[pos] = w_sel[k];
        }
    }
    __syncthreads();
}

struct MoeMap { int e, rt, ct, cnt, pbase; };
DEVI void moe_setup(const Params& p, int* sm  , int ctn) {
    const int tid = VTID;
    if (tid == 0) {
        const int* counts = (const int*)((const float*)(p.ws + OFF_MISC) + 1024);
        int tp = 0, cp = 0;
        for (int e = 0; e < 32; ++e) {
            const int c = counts[e];
            sm[e] = tp; sm[32 + e] = cp; sm[64 + e] = c;
            tp += ((c + 127) >> 7) * ctn; cp += c;
        }
        sm[96] = tp;
    }
    __syncthreads();
}
DEVI MoeMap moe_map(const int* sm, int tile, int ctn) {
    int e = 0;
#pragma unroll 1
    for (int i = 1; i < 32; ++i) if (sm[i] <= tile) e = i;
    MoeMap m; m.e = e; m.cnt = sm[64 + e]; m.pbase = sm[32 + e];
    const int tl = tile - sm[e], nrt = (m.cnt + 127) >> 7;
    m.ct = tl / nrt; m.rt = tl % nrt;
    return m;
}

DEVI void moe1_tile(const Params& p, char* smem, const MoeMap& mm) {
    char* ws = p.ws;
    const int tid = VTID, lane = tid & 63, wid = tid >> 6, wr = wid >> 1, wc = wid & 1, fr = lane & 15, fq = lane >> 4;
    const int* la = (const int*)(ws + OFF_LISTA) + (size_t)mm.e * NTOK;
    const u16* H1B = (const u16*)(ws + OFF_H1B);
    auto arow = [&](int r) { const int idx = mm.rt * 128 + r; const int tokn = idx < mm.cnt ? (la[idx] >> 2) : 0; return H1B + (size_t)tokn * 1024; };
    const u16* Bt = (const u16*)(ws + OFF_WGU) + ((size_t)mm.e * 2048 + (size_t)mm.ct * 128) * 1024;
    f32x4 acc[4][4];
    gemm128(tid, arow, Bt, 1024, 1024, smem, acc);
    u16* act = (u16*)(ws + OFF_ACT);
    const float* bgu = p.b_gu + (size_t)mm.e * 2048;
#pragma unroll
    for (int m = 0; m < 4; ++m) {
        const int idx0 = mm.rt * 128 + wr * 64 + m * 16 + fq * 4;
#pragma unroll
        for (int i = 0; i < 2; ++i) {
            const int col = 64 * mm.ct + 32 * wc + 16 * i + fr;
            const float bg_ = bgu[col], bu_ = bgu[1024 + col];
#pragma unroll
            for (int j = 0; j < 4; ++j) {
                if (idx0 + j < mm.cnt) {
                    float gt = acc[m][2 * i][j] + bg_; gt = fminf(gt, 7.f);
                    float up = acc[m][2 * i + 1][j] + bu_; up = fminf(fmaxf(up, -7.f), 7.f);
                    const float a = gt * (1.f / (1.f + __expf(-1.702f * gt))) * (up + 1.f);
                    act[(size_t)(mm.pbase + idx0 + j) * 1024 + col] = f2bf(a);
                }
            }
        }
    }
}

DEVI void moe2_tile(const Params& p, char* smem, const MoeMap& mm) {
    char* ws = p.ws;
    const int tid = VTID, lane = tid & 63, wid = tid >> 6, wr = wid >> 1, wc = wid & 1, fr = lane & 15, fq = lane >> 4;
    const u16* act = (const u16*)(ws + OFF_ACT);
    auto arow = [&](int r) { return act + (size_t)(mm.pbase + mm.rt * 128 + r) * 1024; };
    const u16* Bt = (const u16*)(ws + OFF_WDN) + ((size_t)mm.e * 1024 + (size_t)mm.ct * 128) * 1024;
    f32x4 acc[4][4];
    gemm128(tid, arow, Bt, 1024, 1024, smem, acc);
    const int* la = (const int*)(ws + OFF_LISTA) + (size_t)mm.e * NTOK;
    const float* lw = (const float*)(ws + OFF_LISTW) + (size_t)mm.e * NTOK;
    u16* Y = (u16*)(ws + OFF_Y);
    const float* bdn = p.b_dn + (size_t)mm.e * 1024;
#pragma unroll
    for (int m = 0; m < 4; ++m) {
        const int idx0 = mm.rt * 128 + wr * 64 + m * 16 + fq * 4;
#pragma unroll
        for (int j = 0; j < 4; ++j) {
            if (idx0 + j < mm.cnt) {
                const int a = la[idx0 + j]; const float wgt = lw[idx0 + j];
#pragma unroll
                for (int n = 0; n < 4; ++n) {
                    const int col = mm.ct * 128 + wc * 64 + n * 16 + fr;
                    Y[(size_t)a * 1024 + col] = f2bf((acc[m][n][j] + bdn[col]) * wgt);
                }
            }
        }
    }
}

constexpr int MOE_TAB_OFF = 131072;
DEVI void moe_setup8(const Params& p, char* smem_all, int ctn) {
    int* sm = (int*)(smem_all + MOE_TAB_OFF);
    if (TIDX == 0) {
        const int* counts = (const int*)((const float*)(p.ws + OFF_MISC) + 1024);
        int tp = 0, cp = 0;
        for (int e = 0; e < 32; ++e) {
            const int c = counts[e];
            sm[e] = tp; sm[33 + e] = cp; sm[65 + e] = c;
            tp += ((c + 255) >> 8) * ctn; cp += c;
        }
        sm[32] = tp;
    }
    __syncthreads();
}
template <bool GATHER>
struct MoeSrc {
    struct U { int e, rt, pn, cnt, pbase; };
    const LAS3 int* tab; const char* Bt; const int* la; int nrowsB, G, c, ctn;
    DEVI bool next(int i, U& u) const {
        const int L = i * G + c, total = tab[32]; if (L >= total) return false;
        int wg; { const int q = total / 8, r = total % 8, xcd = L % 8, off = L / 8; wg = (xcd < r ? xcd * (q + 1) : r * (q + 1) + (xcd - r) * q) + off; }
        int e = 0;
#pragma unroll 1
        for (int k = 1; k < 32; ++k) e = (tab[k] <= wg) ? k : e;
        u.e = e; u.cnt = tab[65 + e]; u.pbase = tab[33 + e];
        const int tl = wg - tab[e], nrt = (u.cnt + 255) >> 8;
        const int nig = 8 * ctn, grp = tl / nig, fm = grp * 8, gsz = (nrt - fm) < 8 ? (nrt - fm) : 8, rem = tl - grp * nig;
        u.pn = rem / gsz; u.rt = fm + (rem - u.pn * gsz);
        return true;
    }
    DEVI unsigned aoff(const U& u, int row) const {
        const int idx = u.rt * 256 + row;
        if (GATHER) { const int tokn = idx < u.cnt ? (la[(size_t)u.e * NTOK + idx] >> 2) : 0; return (unsigned)tokn * 2048u; }
        return (unsigned)(u.pbase + idx) * 2048u;
    }
    DEVI void aoff4(const U& u, int r0, int r1, unsigned& a00, unsigned& a01, unsigned& a10, unsigned& a11) const {
        const int i0 = u.rt * 256 + r0, i1 = u.rt * 256 + r1, i2 = i0 + 128, i3 = i1 + 128;
        if (GATHER) {
            const int* lp = la + (size_t)u.e * NTOK; const int cm = u.cnt - 1;
            const int t0 = lp[i0 < cm ? i0 : cm], t1 = lp[i1 < cm ? i1 : cm], t2 = lp[i2 < cm ? i2 : cm], t3 = lp[i3 < cm ? i3 : cm];
            a00 = (unsigned)(t0 >> 2) * 2048u; a01 = (unsigned)(t1 >> 2) * 2048u; a10 = (unsigned)(t2 >> 2) * 2048u; a11 = (unsigned)(t3 >> 2) * 2048u;
        } else {
            a00 = (unsigned)(u.pbase + i0) * 2048u; a01 = (unsigned)(u.pbase + i1) * 2048u; a10 = (unsigned)(u.pbase + i2) * 2048u; a11 = (unsigned)(u.pbase + i3) * 2048u;
        }
    }
    DEVI const char* bbase(const U& u) const { return Bt + ((size_t)u.e * nrowsB + (size_t)u.pn * 256) * 2048; }
};
struct EpiMoe1 {
    const float* b_gu; u16* act;
    DEVI void operator()(const f32x4 (&acc)[2][2][4][2], const MoeSrc<true>::U& u, int wr, int wc, int fr, int fq) const {
        const float* bg = b_gu + (size_t)u.e * 2048;
        float4 bgate[2], bup[2];
#pragma unroll
        for (int bj = 0; bj < 2; ++bj) {
            const int col = u.pn * 128 + (bj * 4 + wc) * 16 + 4 * fq;
            bgate[bj] = *(const float4*)(bg + col); bup[bj] = *(const float4*)(bg + 1024 + col);
        }
        asm volatile("" :: "v"(bgate[0].x), "v"(bup[0].x), "v"(bgate[1].x), "v"(bup[1].x));
#pragma unroll
        for (int ai = 0; ai < 2; ++ai)
#pragma unroll
            for (int m = 0; m < 4; ++m) {
                const int idx = u.rt * 256 + ai * 128 + wr * 64 + m * 16 + fr;
                if (idx < u.cnt) {
#pragma unroll
                    for (int bj = 0; bj < 2; ++bj) {
                        const int col = u.pn * 128 + (bj * 4 + wc) * 16 + 4 * fq;
                        const float bgv[4] = {bgate[bj].x, bgate[bj].y, bgate[bj].z, bgate[bj].w};
                        const float buv[4] = {bup[bj].x, bup[bj].y, bup[bj].z, bup[bj].w};
                        f32x4 a;
#pragma unroll
                        for (int j = 0; j < 4; ++j) {
                            float gt = acc[ai][bj][m][0][j] + bgv[j]; gt = fminf(gt, 7.f);
                            float up = acc[ai][bj][m][1][j] + buv[j]; up = fminf(fmaxf(up, -7.f), 7.f);
                            a[j] = gt * (1.f / (1.f + __expf(-1.702f * gt))) * (up + 1.f);
                        }
                        *(uint2*)(act + (size_t)(u.pbase + idx) * 1024 + col) = pack4(a);
                    }
                }
            }
    }
};
struct EpiMoe2 {
    const float* b_dn; const int* la; const float* lw; u16* Y;
    DEVI void operator()(const f32x4 (&acc)[2][2][4][2], const MoeSrc<false>::U& u, int wr, int wc, int fr, int fq) const {
        const float* bd = b_dn + (size_t)u.e * 1024;
        const int* lap = la + (size_t)u.e * NTOK; const float* lwp = lw + (size_t)u.e * NTOK;
        const int cm = u.cnt - 1;
        int av[2][4]; float wv[2][4]; float4 b0[2], b1[2];
#pragma unroll
        for (int ai = 0; ai < 2; ++ai)
#pragma unroll
            for (int m = 0; m < 4; ++m) {
                const int idx = u.rt * 256 + ai * 128 + wr * 64 + m * 16 + fr;
                const int ic = idx < cm ? idx : cm;
                av[ai][m] = lap[ic]; wv[ai][m] = lwp[ic];
            }
#pragma unroll
        for (int bj = 0; bj < 2; ++bj) {
            const int col = u.pn * 256 + bj * 128 + wc * 32 + fq * 8;
            b0[bj] = *(const float4*)(bd + col); b1[bj] = *(const float4*)(bd + col + 4);
        }
        asm volatile("" :: "v"(b1[1].w), "v"(b0[0].x), "v"(av[1][3]), "v"(wv[1][3]));
#pragma unroll
        for (int ai = 0; ai < 2; ++ai)
#pragma unroll
            for (int m = 0; m < 4; ++m) {
                const int idx = u.rt * 256 + ai * 128 + wr * 64 + m * 16 + fr;
                if (idx < u.cnt) {
                    const float wgt = wv[ai][m];
#pragma unroll
                    for (int bj = 0; bj < 2; ++bj) {
                        const int col = u.pn * 256 + bj * 128 + wc * 32 + fq * 8;
                        uint4 v;
                        v.x = pack2((acc[ai][bj][m][0][0] + b0[bj].x) * wgt, (acc[ai][bj][m][0][1] + b0[bj].y) * wgt);
                        v.y = pack2((acc[ai][bj][m][0][2] + b0[bj].z) * wgt, (acc[ai][bj][m][0][3] + b0[bj].w) * wgt);
                        v.z = pack2((acc[ai][bj][m][1][0] + b1[bj].x) * wgt, (acc[ai][bj][m][1][1] + b1[bj].y) * wgt);
                        v.w = pack2((acc[ai][bj][m][1][2] + b1[bj].z) * wgt, (acc[ai][bj][m][1][3] + b1[bj].w) * wgt);
                        *(uint4*)(Y + (size_t)av[ai][m] * 1024 + col) = v;
                    }
                }
            }
    }
};
DEVI void phase_moe1_8(const Params& p, char* smem_all) {
    moe_setup8(p, smem_all, 8);
    MoeSrc<true> S; S.tab = (const LAS3 int*)(smem_all + MOE_TAB_OFF); S.Bt = p.ws + OFF_WGU; S.la = (const int*)(p.ws + OFF_LISTA); S.nrowsB = 2048; S.G = gridDim.x; S.c = blockIdx.x; S.ctn = 8;
    EpiMoe1 E; E.b_gu = p.b_gu; E.act = (u16*)(p.ws + OFF_ACT);
    g8::gemm_phase<true, false>(TIDX, (LAS3 unsigned char*)smem_all, p.ws + OFF_H1B, S, E);
}
DEVI void phase_moe2_8(const Params& p, char* smem_all) {
    moe_setup8(p, smem_all, 4);
    MoeSrc<false> S; S.tab = (const LAS3 int*)(smem_all + MOE_TAB_OFF); S.Bt = p.ws + OFF_WDN; S.la = nullptr; S.nrowsB = 1024; S.G = gridDim.x; S.c = blockIdx.x; S.ctn = 4;
    EpiMoe2 E; E.b_dn = p.b_dn; E.la = (const int*)(p.ws + OFF_LISTA); E.lw = (const float*)(p.ws + OFF_LISTW); E.Y = (u16*)(p.ws + OFF_Y);
    g8::gemm_phase<true, true>(TIDX, (LAS3 unsigned char*)smem_all, p.ws + OFF_ACT, S, E);
}

struct EpiProjT {
    char* ws; const float* lb;
    template <class F> DEVI void rows(const g8::DenseSrc::U& u, int wr, int wc, int fr, int fq, F f) const {
#pragma unroll
        for (int ai = 0; ai < 2; ++ai)
#pragma unroll
            for (int m = 0; m < 4; ++m) {
                const int tok = u.pm * 256 + ai * 128 + wr * 64 + m * 16 + fr;
#pragma unroll
                for (int bj = 0; bj < 2; ++bj) f(ai, m, bj, tok, bj * 128 + wc * 32 + fq * 8);
            }
    }
    DEVI void operator()(const f32x4 (&acc)[2][2][4][2], const g8::DenseSrc::U& u, int wr, int wc, int fr, int fq) const {
        const int mt = u.pn;
        if (mt < 2) {
            u16* Q = (u16*)(ws + OFF_Q);
            rows(u, wr, wc, fr, fq, [&](int ai, int m, int bj, int tok, int c8) {
                const f32x4 v0 = acc[ai][bj][m][0], v1 = acc[ai][bj][m][1];
                const float qs_ = 0.125f * 1.4426950408889634f;
                uint4 o; o.x = pack2(v0[0] * qs_, v0[1] * qs_); o.y = pack2(v0[2] * qs_, v0[3] * qs_); o.z = pack2(v1[0] * qs_, v1[1] * qs_); o.w = pack2(v1[2] * qs_, v1[3] * qs_);
                *(uint4*)(Q + (size_t)tok * 512 + mt * 256 + c8) = o; });
        } else if (mt < 4) {
            const int g = wc >> 1, d0 = (wc & 1) * 32 + fq * 8;
            rows(u, wr, wc, fr, fq, [&](int ai, int m, int bj, int tok, int c8) {
                const f32x4 v0 = acc[ai][bj][m][0], v1 = acc[ai][bj][m][1];
                const int b = tok >> 13, s = tok & 8191;
                uint4 o; o.x = pack2(v0[0], v0[1]); o.y = pack2(v0[2], v0[3]); o.z = pack2(v1[0], v1[1]); o.w = pack2(v1[2], v1[3]);
                u16* dst = (mt == 2) ? (u16*)(ws + (bj ? OFF_VCR : OFF_KCR)) + ((size_t)(b * 2 + g) * SP + s) * 64 + d0
                                     : (u16*)(ws + (bj ? OFF_KW : OFF_KS)) + ((size_t)(b * 2 + g) * 8192 + s) * 64 + d0;
                *(uint4*)dst = o; });
        } else if (mt < 6) {
            u16* QH = (u16*)(ws + OFF_QH);
            rows(u, wr, wc, fr, fq, [&](int ai, int m, int bj, int tok, int c8) {
                const f32x4 v0 = acc[ai][bj][m][0], v1 = acc[ai][bj][m][1];
                uint4 o; o.x = pack2(v0[0], v0[1]); o.y = pack2(v0[2], v0[3]); o.z = pack2(v1[0], v1[1]); o.w = pack2(v1[2], v1[3]);
                *(uint4*)(QH + (size_t)tok * 512 + (mt - 4) * 256 + c8) = o; });
        } else if (mt < 8) {
            float4 lb0[2], lb1[2];
#pragma unroll
            for (int bj = 0; bj < 2; ++bj) { const int hk = (mt - 6) * 256 + bj * 128 + wc * 32 + fq * 8; lb0[bj] = *(const float4*)(lb + hk); lb1[bj] = *(const float4*)(lb + hk + 4); }
            asm volatile("" :: "v"(lb0[0].x), "v"(lb1[0].x), "v"(lb0[1].x), "v"(lb1[1].w));
            float* LF = (float*)(ws + OFF_LOGF);
            rows(u, wr, wc, fr, fq, [&](int ai, int m, int bj, int tok, int c8) {
                const f32x4 v0 = acc[ai][bj][m][0], v1 = acc[ai][bj][m][1];
                const float lv[8] = {lb0[bj].x, lb0[bj].y, lb0[bj].z, lb0[bj].w, lb1[bj].x, lb1[bj].y, lb1[bj].z, lb1[bj].w};
                float r[8];
#pragma unroll
                for (int j = 0; j < 8; ++j) {
                    const float z = j < 4 ? v0[j & 3] : v1[j & 3];
                    const float fh = 1.f / (1.f + __expf(-z));
                    r[j] = __logf(lv[j] + (1.f - lv[j]) * fh);
                }
                float* dst = LF + (size_t)tok * 512 + (mt - 6) * 256 + c8;
                *(float4*)dst = make_float4(r[0], r[1], r[2], r[3]); *(float4*)(dst + 4) = make_float4(r[4], r[5], r[6], r[7]); });
        } else {
            u16* GH = (u16*)(ws + OFF_GH);
            rows(u, wr, wc, fr, fq, [&](int ai, int m, int bj, int tok, int c8) {
                const f32x4 v0 = acc[ai][bj][m][0], v1 = acc[ai][bj][m][1];
                float r[8];
#pragma unroll
                for (int j = 0; j < 8; ++j) { const float z = j < 4 ? v0[j & 3] : v1[j & 3]; r[j] = z / (1.f + __expf(-z)); }
                uint4 o; o.x = pack2(r[0], r[1]); o.y = pack2(r[2], r[3]); o.z = pack2(r[4], r[5]); o.w = pack2(r[6], r[7]);
                *(uint4*)(GH + (size_t)tok * 512 + (mt - 8) * 256 + c8) = o; });
        }
    }
};
struct EpiProjN {
    char* ws;
    DEVI void operator()(const f32x4 (&acc)[2][2][4][2], const g8::DenseSrc::U& u, int wr, int wc, int fr, int fq) const {
        const int mt = u.pn;
#pragma unroll
        for (int ai = 0; ai < 2; ++ai)
#pragma unroll
            for (int m = 0; m < 4; ++m) {
                const int tok = u.pm * 256 + ai * 128 + wr * 64 + m * 16 + fq * 4;
                const int b = tok >> 13, s = tok & 8191;
#pragma unroll
                for (int bj = 0; bj < 2; ++bj)
#pragma unroll
                    for (int n = 0; n < 2; ++n) {
                        const int c = bj * 128 + wc * 32 + n * 16 + fr;
                        u16* dst;
                        if (mt == 0) {
                            const int g = wc >> 1, d = (wc & 1) * 32 + n * 16 + fr;
                            dst = (u16*)(ws + (bj ? OFF_VWT : OFF_VST)) + (((size_t)(b * 2 + g) * 128 + (s >> 6)) * 64 + d) * 64 + (s & 63);
                        } else {
                            const int hv = (mt - 1) * 256 + c;
                            dst = (u16*)(ws + OFF_VTH) + (((size_t)(b * 4 + (hv >> 7)) * 128 + (s >> 6)) * 128 + (hv & 127)) * 64 + (s & 63);
                        }
                        *(uint2*)dst = pack4(acc[ai][bj][m][n]);
                    }
            }
    }
};
DEVI void phase_proj8(const Params& p, char* smem_all) {
    {
        g8::DenseSrc S; S.init(p.ws + OFF_WIN, NTOK, 2560, gridDim.x, blockIdx.x);
        EpiProjT E; E.ws = p.ws; E.lb = (const float*)(p.ws + OFF_MISC) + 512;
        g8::gemm_phase<true, true>(TIDX, (LAS3 unsigned char*)smem_all, p.ws + OFF_XB, S, E);
    }
    {
        g8::DenseSrc S; S.init(p.ws + OFF_WIN + (size_t)2560 * 2048, NTOK, 768, gridDim.x, blockIdx.x);
        EpiProjN E; E.ws = p.ws;
        g8::gemm_phase<false, false>(TIDX, (LAS3 unsigned char*)smem_all, p.ws + OFF_XB, S, E);
    }
}
DEVI void gates_tile(const Params& p, char* smem, int rt) {
    char* ws = p.ws;
    const int tid = VTID, lane = tid & 63, wid = tid >> 6, wr = wid >> 1, wc = wid & 1, fr = lane & 15, fq = lane >> 4;
    const u16* XB = (const u16*)(ws + OFF_XB);
    auto arow = [&](int r) { return XB + (size_t)(rt * 128 + r) * 1024; };
    f32x4 acc[4][4];
    gemm128(tid, arow, (const u16*)(ws + OFF_WIN) + (size_t)3328 * 1024, 1024, 1024, smem, acc);
    if (wc == 0) {
        float* dst = (float*)(ws + OFF_GATES);
#pragma unroll
        for (int m = 0; m < 4; ++m)
#pragma unroll
            for (int n = 0; n < 2; ++n) {
                const int cc = n * 16 + fr, tok = rt * 128 + wr * 64 + m * 16 + fq * 4;
                if (cc < 24) {
#pragma unroll
                    for (int j = 0; j < 4; ++j) dst[(size_t)(tok + j) * 24 + cc] = 1.f / (1.f + expf(-acc[m][n][j]));
                }
            }
    }
}
DEVI void rope_task(const Params& p, int task) {
    char* ws = p.ws;
    const int gid = task * 256 + VTID;
    const int tok = gid / 12, vec = gid - tok * 12;
    const int b = tok >> 13, s = tok & 8191;
    u16* ptr;
    if (vec < 8) ptr = (u16*)(ws + OFF_Q) + (size_t)tok * 512 + vec * 64;
    else { const int g = vec & 1; ptr = (u16*)(ws + (vec < 10 ? OFF_KS : OFF_KW)) + ((size_t)(b * 2 + g) * 8192 + s) * 64; }
    const float* cs = (const float*)(ws + OFF_ROPE) + (size_t)tok * 8;
    const float4 c0 = *(const float4*)cs, c1 = *(const float4*)(cs + 4), s0 = *(const float4*)(cs + (size_t)NTOK * 8), s1 = *(const float4*)(cs + (size_t)NTOK * 8 + 4);
    const uint4 a = *(const uint4*)ptr, bq = *(const uint4*)(ptr + 8);
    const float cv[8] = {c0.x, c0.y, c0.z, c0.w, c1.x, c1.y, c1.z, c1.w}, sv[8] = {s0.x, s0.y, s0.z, s0.w, s1.x, s1.y, s1.z, s1.w};
    const uint32_t aw[4] = {a.x, a.y, a.z, a.w}, bw[4] = {bq.x, bq.y, bq.z, bq.w};
    float o1[8], o2[8];
#pragma unroll
    for (int i = 0; i < 8; ++i) {
        const float x1 = (i & 1) ? __uint_as_float(aw[i >> 1] & 0xffff0000u) : __uint_as_float(aw[i >> 1] << 16);
        const float x2 = (i & 1) ? __uint_as_float(bw[i >> 1] & 0xffff0000u) : __uint_as_float(bw[i >> 1] << 16);
        o1[i] = x1 * cv[i] - x2 * sv[i]; o2[i] = x2 * cv[i] + x1 * sv[i];
    }
    uint4 oa, ob;
    oa.x = pack2(o1[0], o1[1]); oa.y = pack2(o1[2], o1[3]); oa.z = pack2(o1[4], o1[5]); oa.w = pack2(o1[6], o1[7]);
    ob.x = pack2(o2[0], o2[1]); ob.y = pack2(o2[2], o2[3]); ob.z = pack2(o2[4], o2[5]); ob.w = pack2(o2[6], o2[7]);
    *(uint4*)ptr = oa; *(uint4*)(ptr + 8) = ob;
}

DEVI void final_rows(const Params& p, int task) {
    char* ws = p.ws;
    const int tid = VTID, lane = tid & 63, w = tid >> 6;
    const u16* H1B = (const u16*)(ws + OFF_H1B); const u16* Y = (const u16*)(ws + OFF_Y);
    for (int i = 0; i < 8; ++i) {
        const size_t row = (size_t)task * 32 + w * 8 + i;
        float4 v[4];
        float s = 0.f;
#pragma unroll
        for (int q = 0; q < 4; ++q) {
            const int c = q * 256 + lane * 4;
            const uint2 hb = *(const uint2*)(H1B + row * 1024 + c);
            float4 a; a.x = DN_ALPHA * __uint_as_float(hb.x << 16); a.y = DN_ALPHA * __uint_as_float(hb.x & 0xffff0000u);
            a.z = DN_ALPHA * __uint_as_float(hb.y << 16); a.w = DN_ALPHA * __uint_as_float(hb.y & 0xffff0000u);
#pragma unroll
            for (int k = 0; k < 4; ++k) {
                const uint2 y = *(const uint2*)(Y + (row * 4 + k) * 1024 + c);
                a.x += __uint_as_float(y.x << 16); a.y += __uint_as_float(y.x & 0xffff0000u);
                a.z += __uint_as_float(y.y << 16); a.w += __uint_as_float(y.y & 0xffff0000u);
            }
            v[q] = a; s += a.x + a.y + a.z + a.w;
        }
        const float mu = wave_sum(s) * (1.f / 1024.f);
        float ss = 0.f;
#pragma unroll
        for (int q = 0; q < 4; ++q) { v[q].x -= mu; v[q].y -= mu; v[q].z -= mu; v[q].w -= mu; ss += v[q].x * v[q].x + v[q].y * v[q].y + v[q].z * v[q].z + v[q].w * v[q].w; }
        const float rs = rsqrtf(wave_sum(ss) * (1.f / 1024.f) + 1e-5f);
#pragma unroll
        for (int q = 0; q < 4; ++q) {
            const int c = q * 256 + lane * 4;
            const float4 gq = *(const float4*)(p.ln2g + c), bq = *(const float4*)(p.ln2b + c);
            float4 o; o.x = v[q].x * rs * gq.x + bq.x; o.y = v[q].y * rs * gq.y + bq.y; o.z = v[q].z * rs * gq.z + bq.z; o.w = v[q].w * rs * gq.w + bq.w;
            *(float4*)(p.out + row * 1024 + c) = o;
        }
    }
}

#define XB_TMO      128
#define XB_XCNT(j)  (256  + 64 * (j))
#define XB_XSUB(j)  (1280 + 64 * (j))
#define XB_XGEN(j)  (2304 + 64 * (j))
#define XB_TOP      3328
#define XB_TOPGEN   3392
#define XCD_BAR_WORDS 3456
#define XB_SPIN_CAP (1u << 18)
#define LAS LAS3

__device__ __forceinline__ unsigned xb_ld(unsigned* p)              { return __hip_atomic_load(p, __ATOMIC_RELAXED, __HIP_MEMORY_SCOPE_AGENT); }
__device__ __forceinline__ unsigned xb_add(unsigned* p, unsigned v) { return __hip_atomic_fetch_add(p, v, __ATOMIC_RELAXED, __HIP_MEMORY_SCOPE_AGENT); }
__device__ __forceinline__ unsigned xb_xcc_id() { return (unsigned)__builtin_amdgcn_s_getreg((3 << 11) | 20) & 0xFu; }
#define XB_SPIN(cond, bar) do { unsigned _sp = 0; while (cond) { __builtin_amdgcn_s_sleep(1); \
    if ((++_sp & 255u) == 0u) { if (xb_ld(&(bar)[XB_TMO])) break; if (_sp > XB_SPIN_CAP) { atomicAdd(&(bar)[XB_TMO], 1u); break; } } } } while (0)

struct XcdBarrier {
    unsigned* bar; unsigned x;
    volatile LAS unsigned* st;
};

__device__ __forceinline__ XcdBarrier xcd_barrier_post(unsigned* bar, volatile LAS unsigned* st, const bool lead) {
    XcdBarrier b; b.bar = bar; b.x = xb_xcc_id(); b.st = st;
    if (lead) (void)xb_add(&bar[XB_XCNT(b.x)], 1u);
    return b;
}
__device__ __forceinline__ void xcd_barrier_complete(unsigned* bar, unsigned x, unsigned& nloc, unsigned& nx) {
    const unsigned G = gridDim.x * gridDim.y * gridDim.z;
    unsigned sum, cnt, mine, sp = 0u;
    for (;;) {
        sum = 0u; cnt = 0u; mine = 0u;
#pragma unroll
        for (unsigned j = 0; j < 16; ++j) { const unsigned c = xb_ld(&bar[XB_XCNT(j)]); sum += c; cnt += (c > 0u) ? 1u : 0u; mine = (j == x) ? c : mine; }
        if (sum == G) break;
        __builtin_amdgcn_s_sleep(1);
        if ((++sp & 255u) == 0u) { if (xb_ld(&bar[XB_TMO])) break; if (sp > XB_SPIN_CAP) { atomicAdd(&bar[XB_TMO], 1u); break; } }
    }
    nloc = mine > 0u ? mine : 1u; nx = cnt > 0u ? cnt : 1u;
}

__device__ __forceinline__ void xcd_barrier(const XcdBarrier& b, const bool lead) {
    asm volatile("s_waitcnt vmcnt(0)" ::: "memory");
    __syncthreads();
    if (lead) {
        unsigned* bar = b.bar;
        __builtin_amdgcn_s_waitcnt(0);
        unsigned nloc = b.st[0], nx = b.st[1];
        if (nloc == 0u) { xcd_barrier_complete(bar, b.x, nloc, nx); b.st[0] = nloc; b.st[1] = nx; }
        const unsigned old = xb_add(&bar[XB_XSUB(b.x)], 1u);
        const unsigned gen = old / nloc;
        if (old + 1u == (gen + 1u) * nloc) {
            __builtin_amdgcn_fence(__ATOMIC_RELEASE, "agent");
            asm volatile("s_waitcnt vmcnt(0)" ::: "memory");
            const unsigned og = xb_add(&bar[XB_TOP], 1u);
            const unsigned tg = og / nx;
            if (og + 1u == (tg + 1u) * nx) xb_add(&bar[XB_TOPGEN], 1u);
            else XB_SPIN(xb_ld(&bar[XB_TOPGEN]) == tg, bar);
            __builtin_amdgcn_fence(__ATOMIC_ACQUIRE, "agent");
            xb_add(&bar[XB_XGEN(b.x)], 1u);
            asm volatile("s_waitcnt vmcnt(0)" ::: "memory");
        } else {
            XB_SPIN(xb_ld(&bar[XB_XGEN(b.x)]) == gen, bar);
            __builtin_amdgcn_fence(__ATOMIC_ACQUIRE, "agent");
            asm volatile("s_waitcnt vmcnt(0)" ::: "memory");
        }
    }
    __syncthreads();
}


DEVI void run_phase(const Params& p, char* smem, char* smem_all, int ph) {
    const int G = VGRID, B0 = VBID;
#ifdef ONLY_PHASE
    if (ph != ONLY_PHASE) return;
#endif
    switch (ph) {
    case 0: phase_prep(p, smem); break;
    case 1: phase_proj8(p, smem_all); break;
    case 2: {
        int* qctr = (int*)((float*)(p.ws + OFF_MISC) + 1024) + 33;
        int* sh = (int*)(smem_all + 131072);
        const int sb = p.ph_lo >> 2;
        for (;;) {
            __syncthreads();
            if (TIDX == 0) sh[0] = atomicAdd(qctr, 1);
            __syncthreads();
            const int item = sh[0];
            if (item >= 64 + 1024 + 128 + 768) break;
            if (item < 64) cmp1_tile(p, smem, item * 2 + sb);
            else if (item < 64 + 1024) hgrn_local_tile(p, smem, (item - 64) * 2 + sb);
            else if (item < 64 + 1024 + 128) gates_tile(p, smem, (item - 1088) * 2 + sb);
            else rope_task(p, (item - 1216) * 2 + sb);
        }
    } break;
    case 3: {
        int* qctr = (int*)((float*)(p.ws + OFF_MISC) + 1024) + 34;
        int* sh = (int*)(smem_all + 131072);
        const int sb = p.ph_lo >> 2;
        for (;;) {
            __syncthreads();
            if (TIDX == 0) sh[0] = atomicAdd(qctr, 1);
            __syncthreads();
            const int item = sh[0];
            if (item >= 256 + 32) break;
            if (item < 256) hgrn_scan_task(p, item * 2 + sb);
            else cmp2_tile(p, smem, (item - 256) * 2 + sb);
        }
    } break;
    case 4: {
        int* qx = (int*)((float*)(p.ws + OFF_MISC) + 1024) + 40;
        int* sh = (int*)(smem_all + 131072);
        if (TIDX == 0) { sh[1] = (int)(xb_xcc_id() & 7u); sh[2] = 0; }
        for (;;) {
            __syncthreads();
            if (TIDX == 0) {
                int q = sh[1], tries = sh[2], item;
                for (;;) { item = atomicAdd(&qx[q], 1); if (item < 256 || ++tries >= 8) break; q = (q + 1) & 7; }
                sh[0] = item; sh[1] = q; sh[2] = tries;
            }
            __syncthreads();
            const int item = sh[0];
            if (item >= 256) break;
            const int q = sh[1];
            if (item < 128) nsa_tile(p, smem_all, item * 8 + q);
            else hgrn_out_tile(p, smem, ((item - 128) * 8 + q) * 2 + (p.ph_lo >> 2));
        }
    } break;
    case 5:
        phase_wo8(p, smem_all);
        break;
    case 6:
        for (int t = B0; t < 1024; t += G) ln1_router_tile(p, smem, t);
        break;
    case 7: phase_moe1_8(p, smem_all); break;
    case 8: phase_moe2_8(p, smem_all); break;
    case 9:
        for (int t = B0; t < 1024; t += G) final_rows(p, t);
        break;
    }
}

#if N_LAUNCH_MODE == 1
__global__ void __launch_bounds__(512, 2) fwd_kernel(Params p_in) {
    extern __shared__ __attribute__((aligned(16))) char smem_all[];
    Params p = p_in;
    p.ph_lo = __builtin_amdgcn_readfirstlane((int)(threadIdx.x >> 6));
    char* smem = smem_all + (p.ph_lo >> 2) * 65536;
    cg::grid_group grid = cg::this_grid();
#ifndef PROBE_REP
#define PROBE_REP -1
#endif
    run_phase(p, smem, smem_all, 0);
    grid.sync();
    volatile LAS3 unsigned* xst = (volatile LAS3 unsigned*)(smem_all + 131072 + 512);
    if (TIDX == 0) { xst[0] = 0u; xst[1] = 0u; }
    __syncthreads();
    const XcdBarrier xb = xcd_barrier_post((unsigned*)(p.ws + OFF_BAR), xst, TIDX == 0);
#define GSYNC() xcd_barrier(xb, TIDX == 0)
#define RP(k) run_phase(p, smem, smem_all, k); GSYNC(); if (PROBE_REP == k) { run_phase(p, smem, smem_all, k); GSYNC(); }
    RP(1) RP(2)
    run_phase(p, smem, smem_all, 3); GSYNC();
    run_phase(p, smem, smem_all, 4); GSYNC();
    RP(5)
    run_phase(p, smem, smem_all, 6); GSYNC();
    RP(7) RP(8)
    run_phase(p, smem, smem_all, 9);
    if (PROBE_REP == 9) { GSYNC(); run_phase(p, smem, smem_all, 9); }
#undef RP
}
#define KFN fwd_kernel
#else
template <int PH>
__global__ void __launch_bounds__(256, 2) phase_kernel(Params p) {
    extern __shared__ __attribute__((aligned(16))) char smem[];
    run_phase(p, smem, PH);
}
#define KFN phase_kernel<4>
#endif

extern "C" void kernel_launch(void* const* d_in, const int* in_sizes, int n_in, void* d_out, int out_size, void* d_ws, size_t ws_size,
                              hipStream_t stream) {
    static int grid = 0;
    if (grid == 0) {
        if (ws_size < WS_NEED) { fprintf(stderr, "kernel_launch: workspace too small: %zu < %zu\n", ws_size, (size_t)WS_NEED); grid = -1; return; }
        int dev = 0, cus = 0, per_cu = 0;
        (void)hipGetDevice(&dev);
        (void)hipDeviceGetAttribute(&cus, hipDeviceAttributeMultiprocessorCount, dev);
#if N_LAUNCH_MODE == 1
        (void)hipFuncSetAttribute((const void*)KFN, hipFuncAttributeMaxDynamicSharedMemorySize, SMEM_BYTES);
#else
#define SA_(PH) (void)hipFuncSetAttribute((const void*)phase_kernel<PH>, hipFuncAttributeMaxDynamicSharedMemorySize, SMEM_BYTES);
        SA_(0) SA_(1) SA_(2) SA_(3) SA_(4) SA_(5) SA_(6) SA_(7) SA_(8) SA_(9)
#undef SA_
#endif
        (void)hipOccupancyMaxActiveBlocksPerMultiprocessor(&per_cu, (const void*)KFN, 512, SMEM_BYTES);
        if (per_cu < 1) per_cu = 1;
        if (per_cu > 1) per_cu = 1;
        grid = cus * per_cu;
    }
    if (grid < 0) return;
    Params p{};
    p.x = (const float*)d_in[0]; p.pos = (const int*)d_in[1]; p.w_in = (const float*)d_in[2]; p.pe = (const float*)d_in[3];
    p.w_ck1 = (const float*)d_in[4]; p.w_ck2 = (const float*)d_in[5]; p.w_cv1 = (const float*)d_in[6]; p.w_cv2 = (const float*)d_in[7];
    p.hg_lb = (const float*)d_in[8]; p.hg_ng = (const float*)d_in[9]; p.w_o = (const float*)d_in[10]; p.ln1g = (const float*)d_in[11];
    p.ln1b = (const float*)d_in[12]; p.w_r = (const float*)d_in[13]; p.b_r = (const float*)d_in[14]; p.w_gu = (const float*)d_in[15];
    p.b_gu = (const float*)d_in[16]; p.w_dn = (const float*)d_in[17]; p.b_dn = (const float*)d_in[18]; p.ln2g = (const float*)d_in[19];
    p.ln2b = (const float*)d_in[20];
    p.out = (float*)d_out; p.ws = (char*)d_ws;
#if N_LAUNCH_MODE == 1
    p.ph_lo = 0; p.ph_hi = NPHASE;
    void* args[] = {&p};
    hipError_t e = hipLaunchCooperativeKernel((const void*)fwd_kernel, dim3(grid), dim3(512), args, SMEM_BYTES, stream);
    if (e != hipSuccess) fprintf(stderr, "cooperative launch failed: %s (grid %d)\n", hipGetErrorString(e), grid);
#else
    p.ph_lo = 0; p.ph_hi = NPHASE;
#define LP(PH) hipLaunchKernelGGL(phase_kernel<PH>, dim3(grid), dim3(256), SMEM_BYTES, stream, p);
    LP(0) LP(1) LP(2) LP(3) LP(4) LP(5) LP(6) LP(7) LP(8) LP(9)
#undef LP
#endif
}
```

```cpp
#include <hip/hip_runtime.h>
#include <hip/hip_cooperative_groups.h>
#include <stdint.h>
#include <stdio.h>
namespace cg = cooperative_groups;

typedef unsigned short u16;
typedef __attribute__((ext_vector_type(8))) short bf16x8;
typedef __attribute__((ext_vector_type(4))) float f32x4;
typedef __attribute__((ext_vector_type(16))) float f32x16;
#define DEVI __device__ __forceinline__
#define LAS3 __attribute__((address_space(3)))
static __device__ __forceinline__ int laneid_() { int r; asm volatile("v_mbcnt_lo_u32_b32 %0, -1, 0\n\tv_mbcnt_hi_u32_b32 %0, -1, %0" : "=v"(r)); return r; }
#define LANEID (laneid_())
#define TIDX (p.ph_lo * 64 + LANEID)
#define VTID ((p.ph_lo & 3) * 64 + LANEID)
#define VBID ((int)(blockIdx.x * 2 + (p.ph_lo >> 2)))
#define VGRID ((int)(gridDim.x * 2))

#ifndef N_LAUNCH_MODE
#define N_LAUNCH_MODE 1
#endif

constexpr int NTOK = 32768, SEQ = 8192, NB = 4;
constexpr int SP = 8224;
constexpr int NPHASE = 10;
constexpr int XCD_BAR_WORDS_ = 3456;
constexpr int SMEM_BYTES = 131072 + 2048;
constexpr float DN_ALPHA = 1.189207115002721f;

constexpr size_t MB = 1ull << 20;
constexpr size_t OFF_WIN = 0;
constexpr size_t OFF_WCK1 = 7 * MB;
constexpr size_t OFF_WCV1 = 8 * MB;
constexpr size_t OFF_WCK2 = 9 * MB;
constexpr size_t OFF_WCV2 = 9 * MB + 65536;
constexpr size_t OFF_WO = 10 * MB;
constexpr size_t OFF_ROPE = 12 * MB;
constexpr size_t OFF_GATES = 14 * MB;
constexpr size_t OFF_MISC = 17 * MB;
constexpr size_t OFF_CTRL = 17 * MB + 4096;
constexpr size_t OFF_BIASP = 17 * MB + 8192;
constexpr size_t OFF_BAR = 17 * MB + 65536;
constexpr size_t OFF_LISTA = 18 * MB;
constexpr size_t OFF_LISTW = 22 * MB;
constexpr size_t OFF_HID = 26 * MB;
constexpr size_t OFF_KC = 30 * MB;
constexpr size_t OFF_VCT = 30 * MB + 524288;
constexpr size_t OFF_DG = 31 * MB;
constexpr size_t OFF_WGU = 32 * MB;
constexpr size_t OFF_WDN = 160 * MB;
constexpr size_t OFF_H1 = 224 * MB;
constexpr size_t OFF_H1B = 352 * MB;
constexpr size_t OFF_X = 416 * MB;
constexpr size_t OFF_XB = OFF_X;
constexpr size_t OFF_Q = OFF_X + 64 * MB;
constexpr size_t OFF_KCR = OFF_X + 96 * MB;
constexpr size_t OFF_VCR = OFF_X + 105 * MB;
constexpr size_t OFF_KS = OFF_X + 114 * MB;
constexpr size_t OFF_KW = OFF_X + 123 * MB;
constexpr size_t OFF_VST = OFF_X + 132 * MB;
constexpr size_t OFF_VWT = OFF_X + 141 * MB;
constexpr size_t OFF_QH = OFF_X + 150 * MB;
constexpr size_t OFF_LOGF = OFF_X + 182 * MB;
constexpr size_t OFF_VTH = OFF_X + 246 * MB;
constexpr size_t OFF_GH = OFF_X + 278 * MB;
constexpr size_t OFF_LBUF = OFF_X + 310 * MB;
constexpr size_t OFF_MIX = OFF_X + 374 * MB;
constexpr size_t OFF_PRE = OFF_X;
constexpr size_t OFF_ACT = OFF_X;
constexpr size_t OFF_Y = OFF_X + 256 * MB;
constexpr size_t WS_NEED = OFF_Y + 256 * MB;

struct Params {
    const float* x; const int* pos; const float* w_in; const float* pe;
    const float* w_ck1; const float* w_ck2; const float* w_cv1; const float* w_cv2;
    const float* hg_lb; const float* hg_ng; const float* w_o; const float* ln1g; const float* ln1b;
    const float* w_r; const float* b_r; const float* w_gu; const float* b_gu; const float* w_dn; const float* b_dn;
    const float* ln2g; const float* ln2b;
    float* out; char* ws;
    int ph_lo, ph_hi;
};

DEVI u16 f2bf(float f) { uint32_t u = __float_as_uint(f); u += 0x7fffu + ((u >> 16) & 1u); return (u16)(u >> 16); }
DEVI float bf2f(u16 h) { return __uint_as_float(((uint32_t)h) << 16); }
typedef float f32x2_t __attribute__((ext_vector_type(2)));
typedef __bf16 bf16x2_t __attribute__((ext_vector_type(2)));
DEVI uint32_t pack2(float a, float b) { f32x2_t v = {a, b}; bf16x2_t r = __builtin_convertvector(v, bf16x2_t); return __builtin_bit_cast(uint32_t, r); }
DEVI bf16x8 pack8(f32x4 a, f32x4 b) {
    union { bf16x8 v; uint32_t u[4]; } r;
    r.u[0] = pack2(a[0], a[1]); r.u[1] = pack2(a[2], a[3]); r.u[2] = pack2(b[0], b[1]); r.u[3] = pack2(b[2], b[3]);
    return r.v;
}
DEVI uint2 pack4(f32x4 a) { uint2 r; r.x = pack2(a[0], a[1]); r.y = pack2(a[2], a[3]); return r; }
DEVI f32x4 mfma16(bf16x8 a, bf16x8 b, f32x4 c) { return __builtin_amdgcn_mfma_f32_16x16x32_bf16(a, b, c, 0, 0, 0); }
DEVI bf16x8 ld8(const u16* p) { return *reinterpret_cast<const bf16x8*>(p); }
DEVI bf16x8 zero8() { bf16x8 z = {0, 0, 0, 0, 0, 0, 0, 0}; return z; }
DEVI float sigmoidf_(float v) { return 1.f / (1.f + __expf(-v)); }
DEVI float xor16_max(float v) { v = fmaxf(v, __shfl_xor(v, 16)); v = fmaxf(v, __shfl_xor(v, 32)); return v; }
DEVI float xor16_sum(float v) { v += __shfl_xor(v, 16); v += __shfl_xor(v, 32); return v; }
DEVI float wave_sum(float v) {
#pragma unroll
    for (int o = 32; o > 0; o >>= 1) v += __shfl_xor(v, o);
    return v;
}
DEVI void glds16(const u16* g, u16* l) {
    __builtin_amdgcn_global_load_lds((const unsigned*)g, (__attribute__((address_space(3))) unsigned*)l, 16, 0, 0);
}

template <class AFn>
DEVI void gemm128(const int tid, AFn arow, const u16* __restrict__ Bt, size_t ldb, int K, char* smem, f32x4 (&acc)[4][4]) {
    const int lane = tid & 63, wid = tid >> 6, wr = wid >> 1, wc = wid & 1, fr = lane & 15, fq = lane >> 4;
    u16* SA = (u16*)smem; u16* SB = (u16*)(smem + 8192);
    const int r0 = tid >> 2, c0 = (tid & 3) * 8;
    const u16* a0 = arow(r0) + c0; const u16* a1 = arow(r0 + 64) + c0;
    const u16* b0 = Bt + (size_t)r0 * ldb + c0; const u16* b1 = Bt + (size_t)(r0 + 64) * ldb + c0;
#pragma unroll
    for (int m = 0; m < 4; ++m)
#pragma unroll
        for (int n = 0; n < 4; ++n) acc[m][n] = f32x4{0.f, 0.f, 0.f, 0.f};
    for (int kt = 0; kt < K; kt += 32) {
        glds16(a0 + kt, SA + tid * 8); glds16(a1 + kt, SA + 2048 + tid * 8);
        glds16(b0 + kt, SB + tid * 8); glds16(b1 + kt, SB + 2048 + tid * 8);
        asm volatile("s_waitcnt vmcnt(0)" ::: "memory");
        __syncthreads();
        bf16x8 af[4], bfr[4];
#pragma unroll
        for (int m = 0; m < 4; ++m) af[m] = ld8(SA + (wr * 64 + m * 16 + fr) * 32 + fq * 8);
#pragma unroll
        for (int n = 0; n < 4; ++n) bfr[n] = ld8(SB + (wc * 64 + n * 16 + fr) * 32 + fq * 8);
#pragma unroll
        for (int m = 0; m < 4; ++m)
#pragma unroll
            for (int n = 0; n < 4; ++n) acc[m][n] = mfma16(af[m], bfr[n], acc[m][n]);
        __syncthreads();
    }
}

template <class CM>
DEVI void tconv_quad(const int tid, const float* __restrict__ src, size_t ld, u16* __restrict__ dst, size_t ldd, int r0, int k0, CM colmap, char* smem) {
    float (*t)[65] = (float (*)[65])smem;
    const int kk = tid >> 2, nb = (tid & 3) * 16;
    const int col = colmap(r0 + nb);
    float4 v[4][4];
#pragma unroll
    for (int q = 0; q < 4; ++q)
#pragma unroll
        for (int j = 0; j < 4; ++j) v[q][j] = (col >= 0) ? *(const float4*)(src + (size_t)(k0 + 64 * q + kk) * ld + col + 4 * j) : make_float4(0.f, 0.f, 0.f, 0.f);
#pragma unroll
    for (int q = 0; q < 4; ++q) {
#pragma unroll
        for (int j = 0; j < 4; ++j) { t[nb + 4 * j + 0][kk] = v[q][j].x; t[nb + 4 * j + 1][kk] = v[q][j].y; t[nb + 4 * j + 2][kk] = v[q][j].z; t[nb + 4 * j + 3][kk] = v[q][j].w; }
        __syncthreads();
        {
            const int n = tid >> 2, kb = (tid & 3) * 16;
            uint4 o0, o1;
            o0.x = pack2(t[n][kb + 0], t[n][kb + 1]); o0.y = pack2(t[n][kb + 2], t[n][kb + 3]); o0.z = pack2(t[n][kb + 4], t[n][kb + 5]); o0.w = pack2(t[n][kb + 6], t[n][kb + 7]);
            o1.x = pack2(t[n][kb + 8], t[n][kb + 9]); o1.y = pack2(t[n][kb + 10], t[n][kb + 11]); o1.z = pack2(t[n][kb + 12], t[n][kb + 13]); o1.w = pack2(t[n][kb + 14], t[n][kb + 15]);
            u16* d = dst + (size_t)(r0 + n) * ldd + k0 + 64 * q + kb;
            *(uint4*)d = o0; *(uint4*)(d + 8) = o1;
        }
        __syncthreads();
    }
}

DEVI void prep_job(const Params& p, char* smem, const int job) {
    char* ws = p.ws;
    constexpr int J_WIN = 54 * 4;
    constexpr int J_WCK1 = 4 * 8;
    constexpr int J_WC2 = 2 * 1;
    constexpr int J_WO = 16 * 4;
    constexpr int J_WGU = 32 * 32 * 4;
    constexpr int J_WDN = 32 * 16 * 4;
    constexpr int J_XB = 4096;
    constexpr int J_ROPE = 1024;
    constexpr int J0 = 0, J1 = J0 + J_WIN, J2 = J1 + 2 * J_WCK1, J3 = J2 + 2 * J_WC2, J4 = J3 + J_WO, J5 = J4 + J_WGU,
                  J6 = J5 + J_WDN, J7 = J6 + J_XB, J8 = J7 + J_ROPE;
    {
        const int tid = VTID;
        if (job < J1) {
            const int j = job - J0, rt = j / 4, kt = j % 4;
            auto cm = [](int r) {
                if (r < 768) return r;
                if (r < 1024) { const int rr = r - 768; return rr < 128 ? 768 + rr : 1024 + (rr - 128); }
                if (r < 1536) return 1304 + (r - 1024);
                if (r < 2048) return 1816 + (r - 1536);
                if (r < 2560) return 2840 + (r - 2048);
                if (r < 2816) { const int rr = r - 2560; return rr < 128 ? 896 + rr : 1152 + (rr - 128); }
                if (r < 3328) return 2328 + (r - 2816);
                if (r < 3352) return 1280 + (r - 3328);
                return -1; };
            tconv_quad(tid, p.w_in, 3352, (u16*)(ws + OFF_WIN), 1024, rt * 64, kt * 256, cm, smem);
        } else if (job < J2) {
            int j = job - J1; const int which = j / J_WCK1; j %= J_WCK1; const int rt = j / 8, kt = j % 8;
            auto cm = [](int r) { return r; };
            tconv_quad(tid, which ? p.w_cv1 : p.w_ck1, 256, (u16*)(ws + (which ? OFF_WCV1 : OFF_WCK1)), 2048, rt * 64, kt * 256, cm, smem);
        } else if (job < J3) {
            int j = job - J2; const int which = j / J_WC2; j %= J_WC2; const int rt = j, kt = 0;
            auto cm = [](int r) { return r < 64 ? r : -1; };
            tconv_quad(tid, which ? p.w_cv2 : p.w_ck2, 64, (u16*)(ws + (which ? OFF_WCV2 : OFF_WCK2)), 256, rt * 64, kt * 256, cm, smem);
        } else if (job < J4) {
            const int j = job - J3, rt = j / 4, kt = j % 4;
            auto cm = [](int r) { return r; };
            tconv_quad(tid, p.w_o, 1024, (u16*)(ws + OFF_WO), 1024, rt * 64, kt * 256, cm, smem);
        } else if (job < J5) {
            int j = job - J4; const int e = j / 128; j %= 128; const int rt = j / 4, kt = j % 4;
            auto cm = [](int r) { const int pn = r >> 8, bj = (r >> 7) & 1, wc = (r >> 5) & 3, n = (r >> 4) & 1, i = r & 15; return (n ? 1024 : 0) + pn * 128 + (bj * 4 + wc) * 16 + i; };
            tconv_quad(tid, p.w_gu + (size_t)e * 1024 * 2048, 2048, (u16*)(ws + OFF_WGU) + (size_t)e * 2048 * 1024, 1024, rt * 64, kt * 256, cm, smem);
        } else if (job < J6) {
            int j = job - J5; const int e = j / 64; j %= 64; const int rt = j / 4, kt = j % 4;
            auto cm = [](int r) { return r; };
            tconv_quad(tid, p.w_dn + (size_t)e * 1024 * 1024, 1024, (u16*)(ws + OFF_WDN) + (size_t)e * 1024 * 1024, 1024, rt * 64, kt * 256, cm, smem);
        } else if (job < J7) {
            const size_t base = (size_t)(job - J6) * 8192 + (size_t)tid * 8;
            float4 a[4], b[4];
#pragma unroll
            for (int i = 0; i < 4; ++i) { a[i] = *(const float4*)(p.x + base + i * 2048); b[i] = *(const float4*)(p.x + base + i * 2048 + 4); }
#pragma unroll
            for (int i = 0; i < 4; ++i) {
                uint4 o; o.x = pack2(a[i].x, a[i].y); o.y = pack2(a[i].z, a[i].w); o.z = pack2(b[i].x, b[i].y); o.w = pack2(b[i].z, b[i].w);
                *(uint4*)((u16*)(ws + OFF_XB) + base + i * 2048) = o;
            }
        } else if (job < J8) {
            const int idx = (job - J7) * 256 + tid;
            const int n = idx >> 3, i = idx & 7;
            const float inv = powf(500000.f, -(float)i / 8.f);
            const float ang = (float)p.pos[n] * inv;
            float s, c; sincosf(ang, &s, &c);
            float* ct = (float*)(ws + OFF_ROPE);
            ct[idx] = c; ct[NTOK * 8 + idx] = s;
        } else if (job < J8 + 16) {
            const int b = job - J8;
            float sk = 0.f, sv = 0.f;
#pragma unroll 16
            for (int i = 128 * b; i < 128 * b + 128; ++i) { const float pe = p.pe[i]; sk += pe * p.w_ck1[(size_t)i * 256 + tid]; sv += pe * p.w_cv1[(size_t)i * 256 + tid]; }
            float* bp = (float*)(ws + OFF_BIASP) + b * 512;
            bp[tid] = sk; bp[256 + tid] = sv;
        } else if (job == J8 + 16) {
            float* misc = (float*)(ws + OFF_MISC);
            for (int i = tid; i < 512; i += 256) { const float a0 = p.hg_lb[i], a1 = p.hg_lb[512 + i]; misc[512 + i] = 1.f / (1.f + expf(a1 - a0)); }
        }
    }
}
constexpr int PREP_NJOBS = 6144 + 4096 + 348 + 1024 + 18;
DEVI int prep_order(int j) {
    if (j < 6144) return 348 + j;
    if (j < 10240) return 6492 + (j - 6144);
    if (j < 10588) return j - 10240;
    if (j < 11612) return 10588 + (j - 10588);
    return 11612 + (j - 11612);
}

DEVI f32x4 rope4(f32x4 v, int fr, const float* __restrict__ cs, int i0, int i1, int i2, int i3) {
    const int i = fr & 7; const float sg = (fr & 8) ? 1.f : -1.f;
    const int idx[4] = {i0, i1, i2, i3};
    f32x4 o;
#pragma unroll
    for (int j = 0; j < 4; ++j) {
        const float partner = __shfl_xor(v[j], 8);
        const float c = cs[(size_t)idx[j] * 8 + i], s = cs[(size_t)NTOK * 8 + (size_t)idx[j] * 8 + i];
        o[j] = v[j] * c + sg * partner * s;
    }
    return o;
}

DEVI void hgrn_local_tile(const Params& p, char* smem, int tile) {
    char* ws = p.ws;
    const int bh = tile >> 7, chunk = tile & 127, b = bh >> 2, h = bh & 3;
    const int tid = VTID, lane = tid & 63, w = tid >> 6, fr = lane & 15, fq = lane >> 4;
    const size_t n0 = (size_t)b * 8192 + chunk * 64;
    const float* lfp = (const float*)(ws + OFF_LOGF) + n0 * 512 + h * 128;
    u16* khT = (u16*)(smem + 1024);
    float blast;
    float* totp = (float*)smem;
    {
        const int k = tid & 127, half = tid >> 7;
        float lf[32];
#pragma unroll
        for (int i = 0; i < 32; ++i) lf[i] = lfp[(size_t)(32 * half + i) * 512 + k];
        float run = 0.f;
#pragma unroll
        for (int i = 0; i < 32; ++i) run += lf[i];
        totp[half * 128 + k] = run;
        __syncthreads();
        const float t0 = totp[k], t1 = totp[128 + k];
        blast = t0 + t1;
        float bcur = half ? t0 : 0.f;
#pragma unroll
        for (int i = 0; i < 32; ++i) {
            bcur += lf[i];
            const float kh = (1.f - __expf(lf[i])) * __expf(blast - bcur);
            khT[k * 72 + 32 * half + i] = f2bf(kh);
        }
        if (half == 0) ((float*)(ws + OFF_DG))[(size_t)tile * 128 + k] = __expf(blast);
    }
    __syncthreads();
    const u16* vT = (const u16*)(ws + OFF_VTH) + (size_t)tile * 128 * 64;
    f32x4 acc[2][8];
#pragma unroll
    for (int m = 0; m < 2; ++m)
#pragma unroll
        for (int n = 0; n < 8; ++n) acc[m][n] = f32x4{0.f, 0.f, 0.f, 0.f};
#pragma unroll
    for (int ks = 0; ks < 2; ++ks) {
        bf16x8 a[2];
#pragma unroll
        for (int m = 0; m < 2; ++m) a[m] = ld8(khT + (32 * w + 16 * m + fr) * 72 + 32 * ks + 8 * fq);
#pragma unroll
        for (int n = 0; n < 8; ++n) {
            const bf16x8 bv = ld8(vT + (size_t)(16 * n + fr) * 64 + 32 * ks + 8 * fq);
#pragma unroll
            for (int m = 0; m < 2; ++m) acc[m][n] = mfma16(a[m], bv, acc[m][n]);
        }
    }
    u16* L = (u16*)(ws + OFF_LBUF) + (size_t)tile * 128 * 128;
#pragma unroll
    for (int m = 0; m < 2; ++m)
#pragma unroll
        for (int n = 0; n < 8; ++n) *(uint2*)(L + (size_t)(16 * n + fr) * 128 + 32 * w + 16 * m + 4 * fq) = pack4(acc[m][n]);
    __syncthreads();
}

DEVI void hgrn_scan_task(const Params& p, int task) {
    char* ws = p.ws;
    const int gid = task * 256 + VTID;
    const int bh = gid >> 13, v = (gid >> 6) & 127, kp = gid & 63;
    uint32_t* L = (uint32_t*)(ws + OFF_LBUF) + ((size_t)bh * 128 * 128 * 128 + (size_t)v * 128) / 2 + kp;
    const float2* Dg = (const float2*)(ws + OFF_DG) + (size_t)bh * 128 * 64 + kp;
    float s0 = 0.f, s1 = 0.f;
#pragma unroll 8
    for (int c = 0; c < 128; ++c) {
        const uint32_t l = L[(size_t)c * 8192];
        const float2 d = Dg[(size_t)c * 64];
        L[(size_t)c * 8192] = pack2(s0, s1);
        s0 = d.x * s0 + __uint_as_float(l << 16);
        s1 = d.y * s1 + __uint_as_float(l & 0xffff0000u);
    }
}

DEVI void hgrn_out_tile(const Params& p, char* smem, int tile) {
    char* ws = p.ws;
    const int bh = tile >> 7, chunk = tile & 127, b = bh >> 2, h = bh & 3;
    const int tid = VTID, lane = tid & 63, w = tid >> 6, fr = lane & 15, fq = lane >> 4;
    const size_t n0 = (size_t)b * 8192 + chunk * 64;
    const float* lfp = (const float*)(ws + OFF_LOGF) + n0 * 512 + h * 128;
    const u16* qh = (const u16*)(ws + OFF_QH) + n0 * 512 + h * 128;
    float* totp = (float*)smem;
    u16* qt = (u16*)(smem + 1024);
    u16* kt = qt + 64 * 136;
    {
        const int k = tid & 127, half = tid >> 7;
        float lf[32]; u16 qv[32];
#pragma unroll
        for (int i = 0; i < 32; ++i) lf[i] = lfp[(size_t)(32 * half + i) * 512 + k];
#pragma unroll
        for (int i = 0; i < 32; ++i) qv[i] = qh[(size_t)(32 * half + i) * 512 + k];
        float run = 0.f;
#pragma unroll
        for (int i = 0; i < 32; ++i) run += lf[i];
        totp[half * 128 + k] = run;
        __syncthreads();
        float bcur = half ? totp[k] : 0.f;
#pragma unroll
        for (int i = 0; i < 32; ++i) {
            const int t = 32 * half + i;
            bcur += lf[i];
            const float eb = __expf(bcur);
            qt[t * 136 + k] = f2bf(bf2f(qv[i]) * eb);
            kt[t * 136 + k] = f2bf((1.f - __expf(lf[i])) * __frcp_rn(eb));
        }
    }
    __syncthreads();
    bf16x8 qb[4];
#pragma unroll
    for (int ks = 0; ks < 4; ++ks) qb[ks] = ld8(qt + (16 * w + fr) * 136 + 32 * ks + 8 * fq);
    f32x4 at[4];
#pragma unroll
    for (int sf = 0; sf < 4; ++sf) {
        const int srow = 32 * (sf >> 1) + 8 * (fr >> 2) + 4 * (sf & 1) + (fr & 3);
        f32x4 a = f32x4{0.f, 0.f, 0.f, 0.f};
#pragma unroll
        for (int ks = 0; ks < 4; ++ks) a = mfma16(ld8(kt + srow * 136 + 32 * ks + 8 * fq), qb[ks], a);
        const int tcol = 16 * w + fr;
#pragma unroll
        for (int r = 0; r < 4; ++r) { const int s = 32 * (sf >> 1) + 8 * fq + 4 * (sf & 1) + r; if (s > tcol) a[r] = 0.f; }
        at[sf] = a;
    }
    const u16* vT = (const u16*)(ws + OFF_VTH) + (size_t)tile * 128 * 64;
    const u16* ST = (const u16*)(ws + OFF_LBUF) + (size_t)tile * 128 * 128;
    f32x4 o[8];
#pragma unroll
    for (int mf = 0; mf < 8; ++mf) o[mf] = f32x4{0.f, 0.f, 0.f, 0.f};
#pragma unroll
    for (int sc = 0; sc < 2; ++sc) {
        const bf16x8 pb = pack8(at[2 * sc], at[2 * sc + 1]);
#pragma unroll
        for (int mf = 0; mf < 8; ++mf) o[mf] = mfma16(ld8(vT + (size_t)(16 * mf + fr) * 64 + 32 * sc + 8 * fq), pb, o[mf]);
    }
#pragma unroll
    for (int ks = 0; ks < 4; ++ks)
#pragma unroll
        for (int mf = 0; mf < 8; ++mf) o[mf] = mfma16(ld8(ST + (size_t)(16 * mf + fr) * 128 + 32 * ks + 8 * fq), qb[ks], o[mf]);
    float ss = 0.f;
#pragma unroll
    for (int mf = 0; mf < 8; ++mf)
#pragma unroll
        for (int r = 0; r < 4; ++r) ss += o[mf][r] * o[mf][r];
    ss = xor16_sum(ss);
    const float rn = rsqrtf(ss * (1.f / 128.f) + 1e-6f);
    const size_t tok = n0 + 16 * w + fr;
    const u16* gh = (const u16*)(ws + OFF_GH) + tok * 512 + h * 128;
    u16* mix = (u16*)(ws + OFF_MIX) + tok * 1024 + 512 + h * 128;
#pragma unroll
    for (int mf = 0; mf < 8; ++mf) {
        const int v0 = 16 * mf + 4 * fq;
        const uint2 g2 = *(const uint2*)(gh + v0);
        const float4 ng = *(const float4*)(p.hg_ng + v0);
        f32x4 r;
        r[0] = o[mf][0] * rn * ng.x * __uint_as_float(g2.x << 16);
        r[1] = o[mf][1] * rn * ng.y * __uint_as_float(g2.x & 0xffff0000u);
        r[2] = o[mf][2] * rn * ng.z * __uint_as_float(g2.y << 16);
        r[3] = o[mf][3] * rn * ng.w * __uint_as_float(g2.y & 0xffff0000u);
        *(uint2*)(mix + v0) = pack4(r);
    }
    __syncthreads();
}

DEVI float gelu_tanh(float x) { const float u = 0.7978845608028654f * (x + 0.044715f * x * x * x); return 0.5f * x * (1.f + tanhf(u)); }

DEVI void cmp1_tile(const Params& p, char* smem, int tile) {
    char* ws = p.ws;
    const int which = tile >> 6, rt = (tile >> 1) & 31, ct = tile & 1;
    const int tid = VTID, lane = tid & 63, wid = tid >> 6, wr = wid >> 1, wc = wid & 1, fr = lane & 15, fq = lane >> 4;
    const u16* src = (const u16*)(ws + (which ? OFF_VCR : OFF_KCR));
    auto arow = [&](int r) { const int m = rt * 128 + r; return src + ((size_t)(m >> 9) * SP + 16 * (m & 511)) * 64; };
    const u16* Bt = (const u16*)(ws + (which ? OFF_WCV1 : OFF_WCK1)) + (size_t)ct * 128 * 2048;
    f32x4 acc[4][4];
    gemm128(tid, arow, Bt, 2048, 2048, smem, acc);
    const float* biasp = (const float*)(ws + OFF_BIASP) + which * 256;
    u16* hid = (u16*)(ws + OFF_HID) + (size_t)which * 4096 * 256;
#pragma unroll
    for (int m = 0; m < 4; ++m)
#pragma unroll
        for (int n = 0; n < 4; ++n) {
            const int row = rt * 128 + wr * 64 + m * 16 + fq * 4, col = ct * 128 + wc * 64 + n * 16 + fr;
            float bv = 0.f;
#pragma unroll
            for (int b = 0; b < 16; ++b) bv += biasp[b * 512 + col];
#pragma unroll
            for (int j = 0; j < 4; ++j) hid[(size_t)(row + j) * 256 + col] = f2bf(gelu_tanh(acc[m][n][j] + bv));
        }
}

DEVI void cmp2_tile(const Params& p, char* smem, int tile) {
    char* ws = p.ws;
    const int which = tile >> 5, rt = tile & 31;
    const int tid = VTID, lane = tid & 63, wid = tid >> 6, wr = wid >> 1, wc = wid & 1, fr = lane & 15, fq = lane >> 4;
    const u16* hid = (const u16*)(ws + OFF_HID) + (size_t)which * 4096 * 256;
    auto arow = [&](int r) { return hid + (size_t)(rt * 128 + r) * 256; };
    const u16* Bt = (const u16*)(ws + (which ? OFF_WCV2 : OFF_WCK2));
    f32x4 acc[4][4];
    gemm128(tid, arow, Bt, 256, 256, smem, acc);
    if (wc == 0) {
        const float* cs = (const float*)(ws + OFF_ROPE);
#pragma unroll
        for (int m = 0; m < 4; ++m) {
            const int row = rt * 128 + wr * 64 + m * 16 + fq * 4;
            const int bg = row >> 9, c = row & 511, b = bg >> 1;
#pragma unroll
            for (int n = 0; n < 4; ++n) {
                const int d = n * 16 + fr;
                f32x4 v = acc[m][n];
                if (which == 0) {
                    if (n == 0) {
                        int ix[4];
#pragma unroll
                        for (int j = 0; j < 4; ++j) { int sp = 16 * (c + j) + 31; sp = sp > 8191 ? 8191 : sp; ix[j] = b * 8192 + sp; }
                        v = rope4(v, fr, cs, ix[0], ix[1], ix[2], ix[3]);
                    }
                    u16* kc = (u16*)(ws + OFF_KC);
#pragma unroll
                    for (int j = 0; j < 4; ++j) kc[((size_t)bg * 512 + c + j) * 64 + d] = f2bf(v[j]);
                } else {
                    u16* vct = (u16*)(ws + OFF_VCT);
                    *(uint2*)(vct + (((size_t)bg * 8 + (c >> 6)) * 64 + d) * 64 + (c & 63)) = pack4(v);
                }
            }
        }
    }
}

DEVI uint64_t lowest_bits(uint64_t mask, int n) {
    uint64_t out = 0;
    while (n > 0 && mask) { const uint64_t b = mask & (~mask + 1); out |= b; mask ^= b; --n; }
    return out;
}

constexpr int NSA_TILES = 8 * 128;
constexpr int NSA_RING = 6;
constexpr int NSA_STG = 16384;
constexpr int NSA_OFF_IMP = NSA_RING * NSA_STG;
constexpr int NSA_OFF_SEL = 131072 + 1024;
constexpr float NSA_NEG = -3.0e30f;

DEVI float ex2(float x) { return __builtin_amdgcn_exp2f(x); }
DEVI bf16x8 ones8() { bf16x8 o = {0x3F80, 0x3F80, 0x3F80, 0x3F80, 0x3F80, 0x3F80, 0x3F80, 0x3F80}; return o; }
DEVI int imax4(const f32x4& a) {
    const int x0 = __float_as_int(a[0]), x1 = __float_as_int(a[1]), x2 = __float_as_int(a[2]), x3 = __float_as_int(a[3]);
    return max(max(x0, x1), max(x2, x3));
}
template <bool WITH_O, int NF>
DEVI bool sm_update(f32x4 (&s)[2][NF], float (&R)[2], f32x4 (&lacc)[2], f32x4 (&os)[2][4], bf16x8 (&pb)[2][NF / 2], const bool force, float (&dlt)[2]) {
    int mi[2];
#pragma unroll
    for (int hh = 0; hh < 2; ++hh) {
        int m = imax4(s[hh][0]);
#pragma unroll
        for (int f = 1; f < NF; ++f) m = max(m, imax4(s[hh][f]));
        mi[hh] = m;
    }
    const bool trig = (mi[0] > 0x41000000) || (mi[1] > 0x41000000);
    bool moved = false;
    dlt[0] = 0.f; dlt[1] = 0.f;
    if (force || __ballot(trig)) {
        moved = true;
#pragma unroll
        for (int hh = 0; hh < 2; ++hh) {
            float a = NSA_NEG;
#pragma unroll
            for (int f = 0; f < NF; ++f) a = fmaxf(a, fmaxf(fmaxf(s[hh][f][0], s[hh][f][1]), fmaxf(s[hh][f][2], s[hh][f][3])));
            const float cm = xor16_max(a);
            const float dd = force ? ((cm > -1e29f) ? cm : 0.f) : fmaxf(cm, 0.f);
            dlt[hh] = dd; R[hh] += dd;
#pragma unroll
            for (int f = 0; f < NF; ++f) { s[hh][f][0] -= dd; s[hh][f][1] -= dd; s[hh][f][2] -= dd; s[hh][f][3] -= dd; }
            const float sc = ex2(-dd);
            lacc[hh][0] *= sc; lacc[hh][1] *= sc; lacc[hh][2] *= sc; lacc[hh][3] *= sc;
            if (WITH_O) {
#pragma unroll
                for (int mf = 0; mf < 4; ++mf) { os[hh][mf][0] *= sc; os[hh][mf][1] *= sc; os[hh][mf][2] *= sc; os[hh][mf][3] *= sc; }
            }
        }
    }
#pragma unroll
    for (int hh = 0; hh < 2; ++hh) {
#pragma unroll
        for (int f = 0; f < NF; ++f)
#pragma unroll
            for (int r = 0; r < 4; ++r) s[hh][f][r] = ex2(s[hh][f][r]);
#pragma unroll
        for (int k = 0; k < NF / 2; ++k) {
            pb[hh][k] = pack8(s[hh][2 * k], s[hh][2 * k + 1]);
            lacc[hh] = mfma16(ones8(), pb[hh][k], lacc[hh]);
        }
    }
    return moved;
}

DEVI bool sm_need(const f32x4 (&s)[2][4]) {
    int m0 = imax4(s[0][0]), m1 = imax4(s[1][0]);
#pragma unroll
    for (int f = 1; f < 4; ++f) { m0 = max(m0, imax4(s[0][f])); m1 = max(m1, imax4(s[1][f])); }
    return (m0 > 0x41000000) || (m1 > 0x41000000);
}
DEVI void sm_rescale(f32x4 (&s)[2][4], float (&R)[2], f32x4 (&lacc)[2], f32x4 (&os)[2][4], const bool force) {
#pragma unroll
    for (int hh = 0; hh < 2; ++hh) {
        float a = NSA_NEG;
#pragma unroll
        for (int f = 0; f < 4; ++f) a = fmaxf(a, fmaxf(fmaxf(s[hh][f][0], s[hh][f][1]), fmaxf(s[hh][f][2], s[hh][f][3])));
        const float cm = xor16_max(a);
        const float dd = force ? ((cm > -1e29f) ? cm : 0.f) : fmaxf(cm, 0.f);
        R[hh] += dd;
#pragma unroll
        for (int f = 0; f < 4; ++f) { s[hh][f][0] -= dd; s[hh][f][1] -= dd; s[hh][f][2] -= dd; s[hh][f][3] -= dd; }
        const float sc = ex2(-dd);
        lacc[hh][0] *= sc; lacc[hh][1] *= sc; lacc[hh][2] *= sc; lacc[hh][3] *= sc;
#pragma unroll
        for (int mf = 0; mf < 4; ++mf) { os[hh][mf][0] *= sc; os[hh][mf][1] *= sc; os[hh][mf][2] *= sc; os[hh][mf][3] *= sc; }
    }
}

DEVI void nsa_tile(const Params& p, char* smem, int tile) {
    char* ws = p.ws;
    const int bg = tile & 7, cur = 127 - (tile >> 3), b = bg >> 1, g = bg & 1;
    const int tid = TIDX, lane = tid & 63, w = tid >> 6, fr = lane & 15, fq = lane >> 4;
    const int tt = w >> 1, hp = w & 1;
    const int t0 = cur * 64 + tt * 16;
    const size_t n0 = (size_t)b * 8192 + t0;
    const int tok = t0 + fr;
    const u16* Qb = (const u16*)(ws + OFF_Q);
    const u16* Kc = (const u16*)(ws + OFF_KC) + (size_t)bg * 512 * 64;
    const u16* Vct = (const u16*)(ws + OFF_VCT) + (size_t)bg * 8 * 64 * 64;
    const u16* Ks = (const u16*)(ws + OFF_KS) + (size_t)bg * 8192 * 64;
    const u16* Kw = (const u16*)(ws + OFF_KW) + (size_t)bg * 8192 * 64;
    const u16* Vst = (const u16*)(ws + OFF_VST) + (size_t)bg * 128 * 64 * 64;
    const u16* Vwt = (const u16*)(ws + OFF_VWT) + (size_t)bg * 128 * 64 * 64;
    const float* gp = (const float*)(ws + OFF_GATES) + (n0 + fr) * 24 + (g * 4 + 2 * hp) * 3;
    float* imp = (float*)(smem + NSA_OFF_IMP) + tt * 2048;
    unsigned long long* selm = (unsigned long long*)(smem + NSA_OFF_SEL) + tt * 32;

    for (int i = tid; i < 4 * 2048; i += 512) ((float*)(smem + NSA_OFF_IMP))[i] = 0.f;

    bf16x8 qf[2][2];
#pragma unroll
    for (int hh = 0; hh < 2; ++hh)
#pragma unroll
        for (int ks = 0; ks < 2; ++ks) qf[hh][ks] = ld8(Qb + (n0 + fr) * 512 + (g * 4 + 2 * hp + hh) * 64 + 32 * ks + 8 * fq);
    f32x4 ot[2][4];
#pragma unroll
    for (int hh = 0; hh < 2; ++hh)
#pragma unroll
        for (int mf = 0; mf < 4; ++mf) ot[hh][mf] = f32x4{0.f, 0.f, 0.f, 0.f};

    const int lrow = 8 * w + (lane >> 3), lpos = lane & 7, lch = lpos ^ ((lrow >> 1) & 7);
    const int lkey = (lrow & 32) | ((lrow & 16) >> 2) | ((lrow & 12) << 1) | (lrow & 3);
    const int koff = lkey * 64 + 8 * lch, voff = lrow * 64 + 8 * lch;
    const int ldsoff = w * 1024 + lane * 16;
#define RING_ISSUE_K(KB, BLK, SLOT) glds16((KB) + (size_t)(BLK) * 4096 + koff, (u16*)(smem + (SLOT) * NSA_STG + ldsoff))
#define RING_ISSUE_V(VB, BLK, SLOT) glds16((VB) + (size_t)(BLK) * 4096 + voff, (u16*)(smem + (SLOT) * NSA_STG + 8192 + ldsoff))
#define RING_BAR() __builtin_amdgcn_s_barrier()
#define WAITV(N) asm volatile("s_waitcnt vmcnt(" #N ")" ::: "memory")
    const int swz = fr >> 1;
#define NSA_QKC(KL, SC, S, NR) do { _Pragma("unroll") for (int u = 0; u < 2; ++u) { const u16* kp_ = (KL) + (32 * (SC) + 16 * u + fr) * 64; \
            const bf16x8 k0_ = ld8(kp_ + ((fq ^ swz) << 3)), k1_ = ld8(kp_ + (((4 + fq) ^ swz) << 3)); \
            _Pragma("unroll") for (int hh = 0; hh < 2; ++hh) { f32x4 a_ = f32x4{NR[hh], NR[hh], NR[hh], NR[hh]}; a_ = mfma16(k0_, qf[hh][0], a_); a_ = mfma16(k1_, qf[hh][1], a_); S[hh][u] = a_; } } } while (0)
#define NSA_PVC(VL, SC, PB, KI, O) do { _Pragma("unroll") for (int mf = 0; mf < 4; ++mf) { const bf16x8 va_ = ld8((VL) + (16 * mf + fr) * 64 + (((4 * (SC) + fq) ^ swz) << 3)); \
            _Pragma("unroll") for (int hh = 0; hh < 2; ++hh) O[hh][mf] = mfma16(va_, PB[hh][KI], O[hh][mf]); } } while (0)
#define NSA_ADJ(S, D) do { _Pragma("unroll") for (int hh = 0; hh < 2; ++hh) _Pragma("unroll") for (int u = 0; u < 2; ++u) { S[hh][u][0] -= D[hh]; S[hh][u][1] -= D[hh]; S[hh][u][2] -= D[hh]; S[hh][u][3] -= D[hh]; } } while (0)

    {
        const int ncmax = 4 * cur + 3;
        const int nb = (ncmax + 63) >> 6;
        float RC[2] = {0.f, 0.f};
        f32x4 lC[2] = {f32x4{0.f, 0.f, 0.f, 0.f}, f32x4{0.f, 0.f, 0.f, 0.f}};
        f32x4 oc[2][4];
#pragma unroll
        for (int hh = 0; hh < 2; ++hh)
#pragma unroll
            for (int mf = 0; mf < 4; ++mf) oc[hh][mf] = f32x4{0.f, 0.f, 0.f, 0.f};
        __syncthreads();
        for (int i = 0; i < 4 && i < nb; ++i) RING_ISSUE_K(Kc, i, i);
        if (nb >= 4) WAITV(2); else WAITV(0);
        RING_BAR();
        {
            bool first = true; int slot = 0;
            for (int i = 0; i < nb; ++i) {
                if (i + 4 < nb) RING_ISSUE_K(Kc, i + 4, slot == 0 ? 4 : slot - 1);
                const u16* Kl = (const u16*)(smem + slot * NSA_STG);
#pragma unroll 1
                for (int sc = 0; sc < 2; ++sc) {
                    const int c0 = 64 * i + 32 * sc;
                    if (16 * c0 + 31 <= t0 + 15) {
                        f32x4 s[2][2];
                        const float nr[2] = {-RC[0], -RC[1]};
                        NSA_QKC(Kl, sc, s, nr);
                        if (16 * (c0 + 31) + 31 > t0) {
#pragma unroll
                            for (int hh = 0; hh < 2; ++hh)
#pragma unroll
                                for (int u = 0; u < 2; ++u)
#pragma unroll
                                    for (int r = 0; r < 4; ++r) { const int c = c0 + 8 * fq + 4 * u + r; if (16 * c + 31 > tok) s[hh][u][r] = NSA_NEG; }
                        }
                        bf16x8 pb[2][1]; float dl[2];
                        sm_update<false, 2>(s, RC, lC, oc, pb, first, dl);
                        first = false;
                    }
                }
                if (i + 4 < nb) WAITV(2); else WAITV(0);
                RING_BAR();
                slot = (slot == 4) ? 0 : slot + 1;
            }
        }
        float ilC[2];
#pragma unroll
        for (int hh = 0; hh < 2; ++hh) { const float l = lC[hh][0]; ilC[hh] = l > 0.f ? 1.f / l : 0.f; }
        const float nrC[2] = {-RC[0], -RC[1]};
        for (int i = 0; i < 4 && i < nb; ++i) { RING_ISSUE_K(Kc, i, i); RING_ISSUE_V(Vct, i, i); }
        if (nb >= 4) WAITV(4); else WAITV(0);
        RING_BAR();
        {
            int slot = 0;
            for (int i = 0; i < nb; ++i) {
                if (i + 4 < nb) { const int sl = slot == 0 ? 4 : slot - 1; RING_ISSUE_K(Kc, i + 4, sl); RING_ISSUE_V(Vct, i + 4, sl); }
                const u16* Kl = (const u16*)(smem + slot * NSA_STG);
                const u16* Vl = Kl + 4096;
#pragma unroll 1
                for (int sc = 0; sc < 2; ++sc) {
                    const int c0 = 64 * i + 32 * sc;
                    if (16 * c0 + 31 <= t0 + 15) {
                        f32x4 s[2][2];
                        NSA_QKC(Kl, sc, s, nrC);
                        float qs[2] = {0.f, 0.f}, p3[2] = {0.f, 0.f};
                        bf16x8 pb[2][1];
#pragma unroll
                        for (int hh = 0; hh < 2; ++hh) {
#pragma unroll
                            for (int u = 0; u < 2; ++u) {
                                float q4 = 0.f;
#pragma unroll
                                for (int r = 0; r < 4; ++r) {
                                    const int c = c0 + 8 * fq + 4 * u + r;
                                    const float pv = (16 * c + 31 <= tok) ? ex2(s[hh][u][r]) : 0.f;
                                    s[hh][u][r] = pv; q4 += pv;
                                }
                                qs[u] += q4 * ilC[hh]; p3[u] += s[hh][u][3] * ilC[hh];
                            }
                            pb[hh][0] = pack8(s[hh][0], s[hh][1]);
                        }
#pragma unroll
                        for (int u = 0; u < 2; ++u) {
                            const int j = (c0 >> 2) + 2 * fq + u;
                            const unsigned la_ = (unsigned)(size_t)(LAS3 float*)(imp + fr * 128 + j);
                            asm volatile("ds_add_f32 %0, %1" :: "v"(la_), "v"(qs[u]) : "memory");
                            if (j + 1 < 128) asm volatile("ds_add_f32 %0, %1 offset:4" :: "v"(la_), "v"(p3[u]) : "memory");
                        }
                        NSA_PVC(Vl, sc, pb, 0, oc);
                    }
                }
                if (i + 4 < nb) WAITV(4); else WAITV(0);
                RING_BAR();
                slot = (slot == 4) ? 0 : slot + 1;
            }
        }
#pragma unroll
        for (int hh = 0; hh < 2; ++hh) {
            const float gc = gp[hh * 3 + 0] * ilC[hh];
#pragma unroll
            for (int mf = 0; mf < 4; ++mf) ot[hh][mf] += oc[hh][mf] * gc;
        }
    }
    asm volatile("s_waitcnt lgkmcnt(0)" ::: "memory");
    __syncthreads();
    {
        if (cur < 16) {
            if (hp == 0 && lane < 16) { selm[lane * 2] = (2ull << cur) - 1ull; selm[lane * 2 + 1] = 0ull; }
        } else {
            for (int tau = 8 * hp; tau < 8 * hp + 8; ++tau) {
                const int j0 = lane, j1 = lane + 64;
                const bool in0 = (j0 >= 1) && (j0 <= cur - 2), in1 = (j1 <= cur - 2);
                const float v0 = in0 ? imp[tau * 128 + j0] : 0.f;
                const float v1 = in1 ? imp[tau * 128 + j1] : 0.f;
                const uint32_t u0 = __float_as_uint(v0), u1 = __float_as_uint(v1);
                uint32_t res = 0;
                uint64_t sa = 0, sb = 0;
                bool found = false;
                for (int bit = 30; bit >= 0; --bit) {
                    const uint32_t cand = res | (1u << bit);
                    const uint64_t c0 = __ballot(in0 && u0 >= cand), c1 = __ballot(in1 && u1 >= cand);
                    const int cnt = __popcll(c0) + __popcll(c1);
                    if (cnt == 13) { sa = c0; sb = c1; found = true; break; }
                    if (cnt > 13) res = cand;
                }
                if (!found) {
                    const uint64_t g0 = __ballot(in0 && u0 > res), g1 = __ballot(in1 && u1 > res);
                    const uint64_t e0 = __ballot(in0 && u0 == res), e1 = __ballot(in1 && u1 == res);
                    int need = 13 - (__popcll(g0) + __popcll(g1));
                    const int ne0 = __popcll(e0);
                    sa = g0 | lowest_bits(e0, need);
                    need -= (need < ne0 ? need : ne0);
                    sb = g1 | lowest_bits(e1, need);
                }
                sa |= 1ull;
                if (cur - 1 < 64) sa |= 1ull << (cur - 1); else sb |= 1ull << (cur - 1 - 64);
                if (cur < 64) sa |= 1ull << cur; else sb |= 1ull << (cur - 64);
                if (lane == 0) { selm[tau * 2] = sa; selm[tau * 2 + 1] = sb; }
            }
        }
    }
    {
        const int wb0 = cur >= 8 ? cur - 8 : 0, nb = cur - wb0 + 1;
        float RW[2] = {0.f, 0.f};
        f32x4 lW[2] = {f32x4{0.f, 0.f, 0.f, 0.f}, f32x4{0.f, 0.f, 0.f, 0.f}};
        f32x4 ow[2][4];
#pragma unroll
        for (int hh = 0; hh < 2; ++hh)
#pragma unroll
            for (int mf = 0; mf < 4; ++mf) ow[hh][mf] = f32x4{0.f, 0.f, 0.f, 0.f};
        __syncthreads();
        for (int i = 0; i < 4 && i < nb; ++i) { RING_ISSUE_K(Kw, wb0 + i, i); RING_ISSUE_V(Vwt, wb0 + i, i); }
        if (nb >= 4) WAITV(4); else WAITV(0);
        RING_BAR();
        bool first = true; int slot = 0;
        for (int i = 0; i < nb; ++i) {
            if (i + 4 < nb) { const int sl = slot == 0 ? 4 : slot - 1; RING_ISSUE_K(Kw, wb0 + i + 4, sl); RING_ISSUE_V(Vwt, wb0 + i + 4, sl); }
            const u16* Kl = (const u16*)(smem + slot * NSA_STG);
            const u16* Vl = Kl + 4096;
#pragma unroll 1
            for (int sc = 0; sc < 2; ++sc) {
                const int kb = 64 * (wb0 + i) + 32 * sc;
                if (kb <= t0 + 15 && kb + 31 > t0 - 512) {
                    f32x4 s[2][2];
                    const float nr[2] = {-RW[0], -RW[1]};
                    NSA_QKC(Kl, sc, s, nr);
                    if (kb + 31 > t0 || kb <= t0 + 15 - 512) {
#pragma unroll
                        for (int hh = 0; hh < 2; ++hh)
#pragma unroll
                            for (int u = 0; u < 2; ++u)
#pragma unroll
                                for (int r = 0; r < 4; ++r) { const int key = kb + 8 * fq + 4 * u + r; if (key > tok || key <= tok - 512) s[hh][u][r] = NSA_NEG; }
                    }
                    bf16x8 pb[2][1]; float dl[2];
                    sm_update<true, 2>(s, RW, lW, ow, pb, first, dl);
                    first = false;
                    NSA_PVC(Vl, sc, pb, 0, ow);
                }
            }
            if (i + 4 < nb) WAITV(4); else WAITV(0);
            RING_BAR();
            slot = (slot == 4) ? 0 : slot + 1;
        }
#pragma unroll
        for (int hh = 0; hh < 2; ++hh) {
            const float l = lW[hh][0];
            const float gw = gp[hh * 3 + 2] * (l > 0.f ? 1.f / l : 0.f);
#pragma unroll
            for (int mf = 0; mf < 4; ++mf) ot[hh][mf] += ow[hh][mf] * gw;
        }
    }
    {
        __syncthreads();
        const unsigned long long mA = selm[fr * 2], mB = selm[fr * 2 + 1];
        const int nb = cur + 1;
        for (int i = 0; i < 4 && i < nb; ++i) { RING_ISSUE_K(Ks, i, i); RING_ISSUE_V(Vst, i, i); }
        if (nb >= 4) WAITV(4); else WAITV(0);
        RING_BAR();
        float RS[2] = {0.f, 0.f};
        f32x4 lS[2] = {f32x4{0.f, 0.f, 0.f, 0.f}, f32x4{0.f, 0.f, 0.f, 0.f}};
        f32x4 os[2][4];
#pragma unroll
        for (int hh = 0; hh < 2; ++hh)
#pragma unroll
            for (int mf = 0; mf < 4; ++mf) os[hh][mf] = f32x4{0.f, 0.f, 0.f, 0.f};
#define NSA_QKB(KL, S, NR) do { _Pragma("unroll") for (int f = 0; f < 4; ++f) { const u16* kp_ = (KL) + (16 * f + fr) * 64; \
            const bf16x8 k0_ = ld8(kp_ + ((fq ^ swz) << 3)), k1_ = ld8(kp_ + (((4 + fq) ^ swz) << 3)); \
            _Pragma("unroll") for (int hh = 0; hh < 2; ++hh) { f32x4 a_ = f32x4{NR[hh], NR[hh], NR[hh], NR[hh]}; a_ = mfma16(k0_, qf[hh][0], a_); a_ = mfma16(k1_, qf[hh][1], a_); S[hh][f] = a_; } } } while (0)
#define NSA_PVB(VL, PB) do { _Pragma("unroll") for (int sc = 0; sc < 2; ++sc) { _Pragma("unroll") for (int mf = 0; mf < 4; ++mf) { \
            const bf16x8 va_ = ld8((VL) + (16 * mf + fr) * 64 + (((4 * sc + fq) ^ swz) << 3)); \
            _Pragma("unroll") for (int hh = 0; hh < 2; ++hh) os[hh][mf] = mfma16(va_, PB[hh][sc], os[hh][mf]); } \
            _Pragma("unroll") for (int hh = 0; hh < 2; ++hh) lS[hh] = mfma16(ones8(), PB[hh][sc], lS[hh]); } } while (0)
#define NSA_EXPB(S, PB) do { _Pragma("unroll") for (int hh = 0; hh < 2; ++hh) { _Pragma("unroll") for (int f = 0; f < 4; ++f) { \
            S[hh][f][0] = ex2(S[hh][f][0]); S[hh][f][1] = ex2(S[hh][f][1]); S[hh][f][2] = ex2(S[hh][f][2]); S[hh][f][3] = ex2(S[hh][f][3]); } \
            PB[hh][0] = pack8(S[hh][0], S[hh][1]); PB[hh][1] = pack8(S[hh][2], S[hh][3]); } } while (0)
        f32x4 sn[2][4];
        {
            const float nr0[2] = {0.f, 0.f};
            NSA_QKB((const u16*)smem, sn, nr0);
        }
        bf16x8 pbp[2][2];
#pragma unroll
        for (int hh = 0; hh < 2; ++hh) { pbp[hh][0] = zero8(); pbp[hh][1] = zero8(); }
        bool first = true;
        int slot = 0, pslot = 0;
#define NSA_SELSTEP(STEADY) do { \
            const int slot1 = (slot == 5) ? 0 : slot + 1; \
            if (STEADY) { const int sl = (slot >= 2) ? slot - 2 : slot + 4; RING_ISSUE_K(Ks, jb + 4, sl); RING_ISSUE_V(Vst, jb + 4, sl); } \
            const u16* Vp = (const u16*)(smem + pslot * NSA_STG) + 4096; \
            const u16* Kn = (const u16*)(smem + slot1 * NSA_STG); \
            const bool on = ((jb < 64 ? (mA >> jb) : (mB >> (jb - 64))) & 1ull) != 0ull; \
            const bool onn = (((jb + 1) < 64 ? (mA >> (jb + 1)) : (mB >> (jb + 1 - 64))) & 1ull) != 0ull; \
            const bool any = __ballot(on) != 0ull; \
            f32x4 s[2][4]; \
            _Pragma("unroll") for (int hh = 0; hh < 2; ++hh) _Pragma("unroll") for (int f = 0; f < 4; ++f) s[hh][f] = sn[hh][f]; \
            if (any) { \
                if (first || __ballot(sm_need(s))) {        \
                    NSA_PVB(Vp, pbp); \
                    _Pragma("unroll") for (int hh = 0; hh < 2; ++hh) { pbp[hh][0] = zero8(); pbp[hh][1] = zero8(); } \
                    sm_rescale(s, RS, lS, os, first); \
                } \
                first = false; \
            } \
            {     \
                const float nr[2] = {onn ? -RS[0] : NSA_NEG, onn ? -RS[1] : NSA_NEG}; \
                bf16x8 pbc[2][2]; \
                NSA_QKB(Kn, sn, nr); \
                NSA_PVB(Vp, pbp); \
                NSA_EXPB(s, pbc);                            \
                _Pragma("unroll") for (int hh = 0; hh < 2; ++hh) { pbp[hh][0] = pbc[hh][0]; pbp[hh][1] = pbc[hh][1]; } \
                _Pragma("unroll") for (int k_ = 0; k_ < 16; ++k_) { \
                    __builtin_amdgcn_sched_group_barrier(0x008, 2, 0);     \
                    __builtin_amdgcn_sched_group_barrier(0x400, 2, 0);     \
                    __builtin_amdgcn_sched_group_barrier(0x002, 2, 0);     \
                } \
                if (STEADY) WAITV(4); else WAITV(0); \
                RING_BAR(); \
            } \
            pslot = slot; slot = slot1; } while (0)
        int jb = 0;
        for (; jb + 4 < nb && jb < cur; ++jb) NSA_SELSTEP(true);
        for (; jb < cur; ++jb) NSA_SELSTEP(false);
#undef NSA_SELSTEP
        {
            const u16* Vp = (const u16*)(smem + pslot * NSA_STG) + 4096;
            const u16* Vl = (const u16*)(smem + slot * NSA_STG) + 4096;
#pragma unroll
            for (int hh = 0; hh < 2; ++hh)
#pragma unroll
                for (int f = 0; f < 4; ++f)
#pragma unroll
                    for (int r = 0; r < 4; ++r) { const int key = 64 * cur + 32 * (f >> 1) + 8 * fq + 4 * (f & 1) + r; if (key > tok) sn[hh][f][r] = NSA_NEG; }
            NSA_PVB(Vp, pbp);
            if (first || __ballot(sm_need(sn))) sm_rescale(sn, RS, lS, os, first);
            bf16x8 pbc[2][2];
            NSA_EXPB(sn, pbc);
            NSA_PVB(Vl, pbc);
        }
#undef NSA_PVB
#undef NSA_EXPB
#undef NSA_QKB
#pragma unroll
        for (int hh = 0; hh < 2; ++hh) {
            const float l = lS[hh][0];
            const float gs = gp[hh * 3 + 1] * (l > 0.f ? 1.f / l : 0.f);
#pragma unroll
            for (int mf = 0; mf < 4; ++mf) ot[hh][mf] += os[hh][mf] * gs;
        }
    }
#undef RING_ISSUE_K
#undef RING_ISSUE_V
#undef RING_BAR
#undef WAITV
#undef NSA_QKC
#undef NSA_PVC
#undef NSA_ADJ
    {
        u16* mix = (u16*)(ws + OFF_MIX) + (n0 + fr) * 1024 + (g * 4 + 2 * hp) * 64;
#pragma unroll
        for (int hh = 0; hh < 2; ++hh)
#pragma unroll
            for (int mf = 0; mf < 4; ++mf) *(uint2*)(mix + hh * 64 + 16 * mf + 4 * fq) = pack4(ot[hh][mf]);
    }
    __syncthreads();
}

namespace g8 {
constexpr int BM = 256, BK = 64, HALF = 128, HTB = HALF * BK * 2, KK = 1024, NT = KK / BK;
DEVI int lds_byte(int r, int c) { const int st = (r >> 4) * 2 + (c >> 5), rr = r & 15, cc = c & 31, ob = rr * 64 + cc * 2; return st * 1024 + (ob ^ (((ob >> 9) & 1) << 5)); }
DEVI void stage_rc(int b, int& R, int& C) { const int st = b / 1024, sb = b % 1024, swz = sb ^ (((sb >> 9) & 1) << 5); R = (st >> 1) * 16 + swz / 64; C = (st & 1) * 32 + (swz % 64) / 2; }
DEVI int perm32(int rho) { const int n = rho >> 4, i = rho & 15; return 8 * (i >> 2) + 4 * n + (i & 3); }

template <bool TRANS, bool PERM, class Src, class Epi>
DEVI void gemm_phase(int tid, LAS3 unsigned char* lds, const char* Abase, const Src& S, const Epi& E) {
    asm volatile("" : "+v"(tid));
    const int wid = __builtin_amdgcn_readfirstlane(tid >> 6), lane = tid & 63, wr = wid >> 2, wc = wid & 3, fr = lane & 15, fq = lane >> 4;
    int R0, C0, R1, C1;
    stage_rc(tid * 16, R0, C0); stage_rc(tid * 16 + 8192, R1, C1);
    unsigned voffB[2];
    voffB[0] = (unsigned)((PERM ? ((R0 & ~31) + perm32(R0 & 31)) : R0) * KK + C0) * 2u;
    voffB[1] = (unsigned)((PERM ? ((R1 & ~31) + perm32(R1 & 31)) : R1) * KK + C1) * 2u;
    constexpr size_t kstep = (size_t)(BK * 2);
    constexpr size_t hstepB = (size_t)HALF * KK * 2;
    const unsigned ldsw = (unsigned)wid * 1024u;
    const int aoff = lds_byte(wr * 64 + fr, fq * 8), boff = lds_byte(wc * 32 + fr, fq * 8);
#define G8_SA(b, h) (((b) * 2 + (h)) * HTB)
#define G8_SB(b, h) ((4 + (b) * 2 + (h)) * HTB)
#define G8_STAGE_A(bufoff, kbyte, v0, v1) do { \
        __builtin_amdgcn_global_load_lds((const unsigned*)(Abase + (kbyte) + (v0)), (LAS3 unsigned*)(lds + (bufoff) + ldsw), 16, 0, 0); \
        __builtin_amdgcn_global_load_lds((const unsigned*)(Abase + (kbyte) + (v1)), (LAS3 unsigned*)(lds + (bufoff) + ldsw + 8192), 16, 0, 0); } while (0)
#define G8_STAGE_B(bufoff, gptr) do { \
        __builtin_amdgcn_global_load_lds((const unsigned*)((gptr) + voffB[0]), (LAS3 unsigned*)(lds + (bufoff) + ldsw), 16, 0, 0); \
        __builtin_amdgcn_global_load_lds((const unsigned*)((gptr) + voffB[1]), (LAS3 unsigned*)(lds + (bufoff) + ldsw + 8192), 16, 0, 0); } while (0)
#define G8_LDA(dst, b, h) do { _Pragma("unroll") for (int m = 0; m < 4; ++m) _Pragma("unroll") for (int k = 0; k < 2; ++k) dst[m][k] = *(const LAS3 bf16x8*)(lds + G8_SA(b, h) + aoff + m * 2048 + k * 1024); } while (0)
#define G8_LDB(dst, b, h) do { _Pragma("unroll") for (int n = 0; n < 2; ++n) _Pragma("unroll") for (int k = 0; k < 2; ++k) dst[n][k] = *(const LAS3 bf16x8*)(lds + G8_SB(b, h) + boff + n * 2048 + k * 1024); } while (0)
#define G8_MMA(ai, bj, At, Bt) do { __builtin_amdgcn_s_setprio(1); _Pragma("unroll") for (int m = 0; m < 4; ++m) _Pragma("unroll") for (int n = 0; n < 2; ++n) _Pragma("unroll") for (int k = 0; k < 2; ++k) \
        acc[ai][bj][m][n] = TRANS ? __builtin_amdgcn_mfma_f32_16x16x32_bf16(Bt[n][k], At[m][k], acc[ai][bj][m][n], 0, 0, 0) \
                                  : __builtin_amdgcn_mfma_f32_16x16x32_bf16(At[m][k], Bt[n][k], acc[ai][bj][m][n], 0, 0, 0); __builtin_amdgcn_s_setprio(0); } while (0)
#define G8_WAIT_V(n) asm volatile("s_waitcnt vmcnt(" #n ")" ::: "memory")
#define G8_WAIT_L(n) asm volatile("s_waitcnt lgkmcnt(" #n ")" ::: "memory")
#define G8_BAR __builtin_amdgcn_s_barrier()
#define G8_SCHED __builtin_amdgcn_sched_barrier(0)
    typename Src::U cur, nxt; int ui = 0;
    if (!S.next(0, cur)) return;
    f32x4 acc[2][2][4][2];
#pragma unroll
    for (int a = 0; a < 2; ++a)
#pragma unroll
        for (int b = 0; b < 2; ++b)
#pragma unroll
            for (int m = 0; m < 4; ++m)
#pragma unroll
                for (int n = 0; n < 2; ++n) acc[a][b][m][n] = (f32x4){0.f, 0.f, 0.f, 0.f};
    bf16x8 At[4][2], B0[2][2], B1[2][2];
    unsigned cA00, cA01, cA10, cA11;
    S.aoff4(cur, R0, R1, cA00, cA01, cA10, cA11);
    cA00 += C0 * 2u; cA01 += C1 * 2u; cA10 += C0 * 2u; cA11 += C1 * 2u;
    const char* cB = S.bbase(cur);
    G8_STAGE_B(G8_SB(0, 0), cB); G8_STAGE_A(G8_SA(0, 0), 0, cA00, cA01); G8_STAGE_B(G8_SB(0, 1), cB + hstepB); G8_STAGE_A(G8_SA(0, 1), 0, cA10, cA11);
    if (wr == 1) G8_BAR;
    G8_WAIT_V(4); G8_BAR;
    G8_STAGE_B(G8_SB(1, 0), cB + kstep); G8_STAGE_A(G8_SA(1, 0), kstep, cA00, cA01); G8_STAGE_B(G8_SB(1, 1), cB + hstepB + kstep);
    G8_WAIT_V(6); G8_BAR;
    for (;;) {
        const bool has_next = S.next(ui + 1, nxt);
        unsigned nA00 = cA00, nA01 = cA01, nA10 = cA10, nA11 = cA11;
        const char* nB = cB;
        if (has_next) {
            S.aoff4(nxt, R0, R1, nA00, nA01, nA10, nA11);
            nA00 += C0 * 2u; nA01 += C1 * 2u; nA10 += C0 * 2u; nA11 += C1 * 2u;
            nB = S.bbase(nxt);
        }
#pragma unroll 1
        for (int t = 0; t < NT; t += 2) {
            const bool last = (t == NT - 2);
            const size_t k1 = (size_t)(t + 1) * kstep;
            const size_t k2 = last ? (size_t)0 : (size_t)(t + 2) * kstep, k3 = k2 + kstep;
            const unsigned x00 = last ? nA00 : cA00, x01 = last ? nA01 : cA01, x10 = last ? nA10 : cA10, x11 = last ? nA11 : cA11;
            const char* b2 = (last ? nB : cB) + k2; const char* b3 = b2 + kstep;
            G8_LDB(B0, 0, 0); G8_SCHED; G8_LDA(At, 0, 0); G8_STAGE_A(G8_SA(1, 1), k1, cA10, cA11);
            G8_WAIT_L(8); G8_BAR; G8_WAIT_L(0); G8_MMA(0, 0, At, B0); G8_BAR; G8_SCHED;
            G8_LDB(B1, 0, 1); G8_STAGE_B(G8_SB(0, 0), b2);
            G8_BAR; G8_WAIT_L(0); G8_MMA(0, 1, At, B1); G8_BAR;
            G8_LDA(At, 0, 1); G8_STAGE_A(G8_SA(0, 0), k2, x00, x01);
            G8_BAR; G8_WAIT_L(0); G8_MMA(1, 0, At, B0); G8_BAR; G8_SCHED;
            G8_STAGE_B(G8_SB(0, 1), b2 + hstepB);
            G8_WAIT_V(6); G8_BAR; G8_MMA(1, 1, At, B1); G8_BAR;
            G8_LDB(B0, 1, 0); G8_SCHED; G8_LDA(At, 1, 0); G8_STAGE_A(G8_SA(0, 1), k2, x10, x11);
            G8_WAIT_L(8); G8_BAR; G8_WAIT_L(0); G8_MMA(0, 0, At, B0); G8_BAR; G8_SCHED;
            G8_LDB(B1, 1, 1); G8_STAGE_B(G8_SB(1, 0), b3);
            G8_BAR; G8_WAIT_L(0); G8_MMA(0, 1, At, B1); G8_BAR;
            G8_LDA(At, 1, 1); G8_STAGE_A(G8_SA(1, 0), k3, x00, x01);
            G8_BAR; G8_WAIT_L(0); G8_MMA(1, 0, At, B0); G8_BAR; G8_SCHED;
            G8_STAGE_B(G8_SB(1, 1), b3 + hstepB);
            G8_WAIT_V(6); G8_BAR; G8_MMA(1, 1, At, B1); G8_BAR;
        }
        E(acc, cur, wr, wc, fr, fq);
        if (!has_next) break;
#pragma unroll
        for (int a = 0; a < 2; ++a)
#pragma unroll
            for (int b = 0; b < 2; ++b)
#pragma unroll
                for (int m = 0; m < 4; ++m)
#pragma unroll
                    for (int n = 0; n < 2; ++n) acc[a][b][m][n] = (f32x4){0.f, 0.f, 0.f, 0.f};
        cur = nxt; cA00 = nA00; cA01 = nA01; cA10 = nA10; cA11 = nA11; cB = nB; ++ui;
    }
    G8_WAIT_V(0);
    if (wr == 0) G8_BAR;
    G8_BAR;
#undef G8_SA
#undef G8_SB
#undef G8_STAGE_A
#undef G8_STAGE_B
#undef G8_LDA
#undef G8_LDB
#undef G8_MMA
#undef G8_WAIT_V
#undef G8_WAIT_L
#undef G8_BAR
#undef G8_SCHED
}

struct DenseSrc {
    struct U { int pm, pn; };
    const char* Bt; int nM, nN, nwg, G, c;
    DEVI void init(const void* Bt_, int M, int N, int G_, int c_) { Bt = (const char*)Bt_; nM = M / BM; nN = N / BM; nwg = nM * nN; G = G_; c = c_; }
    DEVI bool next(int i, U& u) const {
        const int L = i * G + c; if (L >= nwg) return false;
        int wgid = L; { const int q = nwg / 8, r = nwg % 8, xcd = wgid % 8, off = wgid / 8; wgid = (xcd < r ? xcd * (q + 1) : r * (q + 1) + (xcd - r) * q) + off; }
        const int nig = 8 * nN, gid = wgid / nig, fm = gid * 8, gsz = (nM - fm) < 8 ? (nM - fm) : 8;
        u.pm = fm + ((wgid % nig) % gsz); u.pn = (wgid % nig) / gsz; return true;
    }
    DEVI unsigned aoff(const U& u, int row) const { return (unsigned)(u.pm * BM + row) * (unsigned)(KK * 2); }
    DEVI void aoff4(const U& u, int r0, int r1, unsigned& a00, unsigned& a01, unsigned& a10, unsigned& a11) const { a00 = aoff(u, r0); a01 = aoff(u, r1); a10 = aoff(u, HALF + r0); a11 = aoff(u, HALF + r1); }
    DEVI const char* bbase(const U& u) const { return Bt + (size_t)u.pn * BM * KK * 2; }
};
}


struct EpiWo {
    u16* o;
    DEVI void operator()(const f32x4 (&acc)[2][2][4][2], const g8::DenseSrc::U& u, int wr, int wc, int fr, int fq) const {
#pragma unroll
        for (int ai = 0; ai < 2; ++ai)
#pragma unroll
            for (int m = 0; m < 4; ++m) {
                const size_t row = (size_t)u.pm * 256 + ai * 128 + wr * 64 + m * 16 + fr;
#pragma unroll
                for (int bj = 0; bj < 2; ++bj) {
                    uint4 v; v.x = pack2(acc[ai][bj][m][0][0], acc[ai][bj][m][0][1]); v.y = pack2(acc[ai][bj][m][0][2], acc[ai][bj][m][0][3]);
                    v.z = pack2(acc[ai][bj][m][1][0], acc[ai][bj][m][1][1]); v.w = pack2(acc[ai][bj][m][1][2], acc[ai][bj][m][1][3]);
                    *(uint4*)(o + row * 1024 + u.pn * 256 + bj * 128 + wc * 32 + fq * 8) = v;
                }
            }
    }
};
DEVI void phase_wo8(const Params& p, char* smem_all) {
    g8::DenseSrc S; S.init(p.ws + OFF_WO, NTOK, 1024, gridDim.x, blockIdx.x);
    EpiWo E; E.o = (u16*)(p.ws + OFF_PRE);
    g8::gemm_phase<true, true>(TIDX, (LAS3 unsigned char*)smem_all, p.ws + OFF_MIX, S, E);
}

DEVI void wo_tile(const Params& p, char* smem, int tile) {
    char* ws = p.ws;
    const int rt = tile >> 3, ct = tile & 7;
    const int tid = VTID, lane = tid & 63, wid = tid >> 6, wr = wid >> 1, wc = wid & 1, fr = lane & 15, fq = lane >> 4;
    const u16* MIX = (const u16*)(ws + OFF_MIX);
    auto arow = [&](int r) { return MIX + (size_t)(rt * 128 + r) * 1024; };
    f32x4 acc[4][4];
    gemm128(tid, arow, (const u16*)(ws + OFF_WO) + (size_t)ct * 128 * 1024, 1024, 1024, smem, acc);
    float* pre = (float*)(ws + OFF_PRE);
#pragma unroll
    for (int m = 0; m < 4; ++m)
#pragma unroll
        for (int n = 0; n < 4; ++n) {
            const int row = rt * 128 + wr * 64 + m * 16 + fq * 4, col = ct * 128 + wc * 64 + n * 16 + fr;
#pragma unroll
            for (int j = 0; j < 4; ++j) {
                const size_t ix = (size_t)(row + j) * 1024 + col;
                pre[ix] = DN_ALPHA * p.x[ix] + acc[m][n][j];
            }
        }
}

DEVI void ln1_router_tile(const Params& p, char* smem, int tile) {
    char* ws = p.ws;
    const int tid = VTID, lane = tid & 63, w = tid >> 6;
    const int tok0 = tile * 32;
    const u16* mixo = (const u16*)(ws + OFF_PRE);
    u16* H1B = (u16*)(ws + OFF_H1B);
    for (int i = 0; i < 8; ++i) {
        const size_t row = (size_t)tok0 + w * 8 + i;
        float4 v[4];
        float s = 0.f;
#pragma unroll
        for (int q = 0; q < 4; ++q) {
            const float4 xv = *(const float4*)(p.x + row * 1024 + q * 256 + lane * 4);
            const uint2 mv = *(const uint2*)(mixo + row * 1024 + q * 256 + lane * 4);
            v[q].x = DN_ALPHA * xv.x + __uint_as_float(mv.x << 16); v[q].y = DN_ALPHA * xv.y + __uint_as_float(mv.x & 0xffff0000u);
            v[q].z = DN_ALPHA * xv.z + __uint_as_float(mv.y << 16); v[q].w = DN_ALPHA * xv.w + __uint_as_float(mv.y & 0xffff0000u);
            s += v[q].x + v[q].y + v[q].z + v[q].w;
        }
        const float mu = wave_sum(s) * (1.f / 1024.f);
        float ss = 0.f;
#pragma unroll
        for (int q = 0; q < 4; ++q) { v[q].x -= mu; v[q].y -= mu; v[q].z -= mu; v[q].w -= mu; ss += v[q].x * v[q].x + v[q].y * v[q].y + v[q].z * v[q].z + v[q].w * v[q].w; }
        const float rs = rsqrtf(wave_sum(ss) * (1.f / 1024.f) + 1e-5f);
#pragma unroll
        for (int q = 0; q < 4; ++q) {
            const int c = q * 256 + lane * 4;
            const float4 gq = *(const float4*)(p.ln1g + c), bq = *(const float4*)(p.ln1b + c);
            float4 o; o.x = v[q].x * rs * gq.x + bq.x; o.y = v[q].y * rs * gq.y + bq.y; o.z = v[q].z * rs * gq.z + bq.z; o.w = v[q].w * rs * gq.w + bq.w;
            uint2 ob; ob.x = pack2(o.x, o.y); ob.y = pack2(o.z, o.w);
            *(uint2*)(H1B + row * 1024 + c) = ob;
        }
    }
    __builtin_amdgcn_fence(__ATOMIC_RELEASE, "workgroup");
    __syncthreads();
    float* part = (float*)smem;
    int* lcnt = (int*)(smem + 4 * 32 * 33 * 4);
    {
        f32x16 acc;
#pragma unroll
        for (int i = 0; i < 16; ++i) acc[i] = 0.f;
        const int i32 = lane & 31, hh = lane >> 5;
        const u16* ap = H1B + ((size_t)tok0 + i32) * 1024 + 256 * w + 4 * hh;
        const float* bp = p.w_r + (size_t)(256 * w + 4 * hh) * 32 + i32;
#pragma unroll 2
        for (int m = 0; m < 32; ++m) {
            const uint2 ab = *(const uint2*)(ap + 8 * m);
            float4 a; a.x = __uint_as_float(ab.x << 16); a.y = __uint_as_float(ab.x & 0xffff0000u); a.z = __uint_as_float(ab.y << 16); a.w = __uint_as_float(ab.y & 0xffff0000u);
            const float b0 = bp[(size_t)(8 * m + 0) * 32], b1 = bp[(size_t)(8 * m + 1) * 32], b2 = bp[(size_t)(8 * m + 2) * 32], b3 = bp[(size_t)(8 * m + 3) * 32];
            acc = __builtin_amdgcn_mfma_f32_32x32x2f32(a.x, b0, acc, 0, 0, 0);
            acc = __builtin_amdgcn_mfma_f32_32x32x2f32(a.y, b1, acc, 0, 0, 0);
            acc = __builtin_amdgcn_mfma_f32_32x32x2f32(a.z, b2, acc, 0, 0, 0);
            acc = __builtin_amdgcn_mfma_f32_32x32x2f32(a.w, b3, acc, 0, 0, 0);
        }
#pragma unroll
        for (int r = 0; r < 16; ++r) {
            const int row = (r & 3) + 8 * (r >> 2) + 4 * hh;
            part[(w * 32 + row) * 33 + i32] = acc[r];
        }
    }
    if (tid < 32) lcnt[tid] = 0;
    __syncthreads();
    float* lgt = (float*)(smem + 24576);
    for (int i = tid; i < 1024; i += 256) {
        const int t = i >> 5, j = i & 31;
        lgt[t * 33 + j] = part[(0 * 32 + t) * 33 + j] + part[(1 * 32 + t) * 33 + j] + part[(2 * 32 + t) * 33 + j] + part[(3 * 32 + t) * 33 + j] + p.b_r[j];
    }
    __syncthreads();
    int e_sel[4]; float w_sel[4]; int rank[4];
    if (tid < 32) {
        float v0 = -3.0e38f, v1 = -3.0e38f, v2 = -3.0e38f, v3 = -3.0e38f; int i0 = 0, i1 = 0, i2 = 0, i3 = 0;
#pragma unroll 8
        for (int j = 0; j < 32; ++j) {
            const float lg = lgt[tid * 33 + j];
            if (lg > v3) {
                if (lg > v0) { v3 = v2; i3 = i2; v2 = v1; i2 = i1; v1 = v0; i1 = i0; v0 = lg; i0 = j; }
                else if (lg > v1) { v3 = v2; i3 = i2; v2 = v1; i2 = i1; v1 = lg; i1 = j; }
                else if (lg > v2) { v3 = v2; i3 = i2; v2 = lg; i2 = j; }
                else { v3 = lg; i3 = j; }
            }
        }
        const float bestv[4] = {v0, v1, v2, v3}; const int besti[4] = {i0, i1, i2, i3};
        float den = 0.f;
#pragma unroll
        for (int k = 0; k < 4; ++k) { w_sel[k] = expf(bestv[k] - bestv[0]); den += w_sel[k]; }
#pragma unroll
        for (int k = 0; k < 4; ++k) { w_sel[k] /= den; e_sel[k] = besti[k]; rank[k] = atomicAdd(&lcnt[besti[k]], 1); }
    }
    __syncthreads();
    if (tid < 32) {
        const int c = lcnt[tid];
        int* counts = (int*)((float*)(ws + OFF_MISC) + 1024);
        lcnt[32 + tid] = c ? atomicAdd(&counts[tid], c) : 0;
    }
    __syncthreads();
    if (tid < 32) {
        int* la = (int*)(ws + OFF_LISTA); float* lw = (float*)(ws + OFF_LISTW);
#pragma unroll
        for (int k = 0; k < 4; ++k) {
            const size_t pos = (size_t)e_sel[k] * NTOK + lcnt[32 + e_sel[k]] + rank[k];
            la[pos] = (tok0 + tid) * 4 + k; lw[pos] = w_sel[k];
        }
    }
    __syncthreads();
}

struct MoeMap { int e, rt, ct, cnt, pbase; };
DEVI void moe_setup(const Params& p, int* sm  , int ctn) {
    const int tid = VTID;
    if (tid == 0) {
        const int* counts = (const int*)((const float*)(p.ws + OFF_MISC) + 1024);
        int tp = 0, cp = 0;
        for (int e = 0; e < 32; ++e) {
            const int c = counts[e];
            sm[e] = tp; sm[32 + e] = cp; sm[64 + e] = c;
            tp += ((c + 127) >> 7) * ctn; cp += c;
        }
        sm[96] = tp;
    }
    __syncthreads();
}
DEVI MoeMap moe_map(const int* sm, int tile, int ctn) {
    int e = 0;
#pragma unroll 1
    for (int i = 1; i < 32; ++i) if (sm[i] <= tile) e = i;
    MoeMap m; m.e = e; m.cnt = sm[64 + e]; m.pbase = sm[32 + e];
    const int tl = tile - sm[e], nrt = (m.cnt + 127) >> 7;
    m.ct = tl / nrt; m.rt = tl % nrt;
    return m;
}

DEVI void moe1_tile(const Params& p, char* smem, const MoeMap& mm) {
    char* ws = p.ws;
    const int tid = VTID, lane = tid & 63, wid = tid >> 6, wr = wid >> 1, wc = wid & 1, fr = lane & 15, fq = lane >> 4;
    const int* la = (const int*)(ws + OFF_LISTA) + (size_t)mm.e * NTOK;
    const u16* H1B = (const u16*)(ws + OFF_H1B);
    auto arow = [&](int r) { const int idx = mm.rt * 128 + r; const int tokn = idx < mm.cnt ? (la[idx] >> 2) : 0; return H1B + (size_t)tokn * 1024; };
    const u16* Bt = (const u16*)(ws + OFF_WGU) + ((size_t)mm.e * 2048 + (size_t)mm.ct * 128) * 1024;
    f32x4 acc[4][4];
    gemm128(tid, arow, Bt, 1024, 1024, smem, acc);
    u16* act = (u16*)(ws + OFF_ACT);
    const float* bgu = p.b_gu + (size_t)mm.e * 2048;
#pragma unroll
    for (int m = 0; m < 4; ++m) {
        const int idx0 = mm.rt * 128 + wr * 64 + m * 16 + fq * 4;
#pragma unroll
        for (int i = 0; i < 2; ++i) {
            const int col = 64 * mm.ct + 32 * wc + 16 * i + fr;
            const float bg_ = bgu[col], bu_ = bgu[1024 + col];
#pragma unroll
            for (int j = 0; j < 4; ++j) {
                if (idx0 + j < mm.cnt) {
                    float gt = acc[m][2 * i][j] + bg_; gt = fminf(gt, 7.f);
                    float up = acc[m][2 * i + 1][j] + bu_; up = fminf(fmaxf(up, -7.f), 7.f);
                    const float a = gt * (1.f / (1.f + __expf(-1.702f * gt))) * (up + 1.f);
                    act[(size_t)(mm.pbase + idx0 + j) * 1024 + col] = f2bf(a);
                }
            }
        }
    }
}

DEVI void moe2_tile(const Params& p, char* smem, const MoeMap& mm) {
    char* ws = p.ws;
    const int tid = VTID, lane = tid & 63, wid = tid >> 6, wr = wid >> 1, wc = wid & 1, fr = lane & 15, fq = lane >> 4;
    const u16* act = (const u16*)(ws + OFF_ACT);
    auto arow = [&](int r) { return act + (size_t)(mm.pbase + mm.rt * 128 + r) * 1024; };
    const u16* Bt = (const u16*)(ws + OFF_WDN) + ((size_t)mm.e * 1024 + (size_t)mm.ct * 128) * 1024;
    f32x4 acc[4][4];
    gemm128(tid, arow, Bt, 1024, 1024, smem, acc);
    const int* la = (const int*)(ws + OFF_LISTA) + (size_t)mm.e * NTOK;
    const float* lw = (const float*)(ws + OFF_LISTW) + (size_t)mm.e * NTOK;
    u16* Y = (u16*)(ws + OFF_Y);
    const float* bdn = p.b_dn + (size_t)mm.e * 1024;
#pragma unroll
    for (int m = 0; m < 4; ++m) {
        const int idx0 = mm.rt * 128 + wr * 64 + m * 16 + fq * 4;
#pragma unroll
        for (int j = 0; j < 4; ++j) {
            if (idx0 + j < mm.cnt) {
                const int a = la[idx0 + j]; const float wgt = lw[idx0 + j];
#pragma unroll
                for (int n = 0; n < 4; ++n) {
                    const int col = mm.ct * 128 + wc * 64 + n * 16 + fr;
                    Y[(size_t)a * 1024 + col] = f2bf((acc[m][n][j] + bdn[col]) * wgt);
                }
            }
        }
    }
}

constexpr int MOE_TAB_OFF = 131072;
DEVI void moe_setup8(const Params& p, char* smem_all, int ctn) {
    int* sm = (int*)(smem_all + MOE_TAB_OFF);
    if (TIDX == 0) {
        const int* counts = (const int*)((const float*)(p.ws + OFF_MISC) + 1024);
        int tp = 0, cp = 0;
        for (int e = 0; e < 32; ++e) {
            const int c = counts[e];
            sm[e] = tp; sm[33 + e] = cp; sm[65 + e] = c;
            tp += ((c + 255) >> 8) * ctn; cp += c;
        }
        sm[32] = tp;
    }
    __syncthreads();
}
template <bool GATHER>
struct MoeSrc {
    struct U { int e, rt, pn, cnt, pbase; };
    const LAS3 int* tab; const char* Bt; const int* la; int nrowsB, G, c, ctn;
    DEVI bool next(int i, U& u) const {
        const int L = i * G + c, total = tab[32]; if (L >= total) return false;
        int wg; { const int q = total / 8, r = total % 8, xcd = L % 8, off = L / 8; wg = (xcd < r ? xcd * (q + 1) : r * (q + 1) + (xcd - r) * q) + off; }
        int e = 0;
#pragma unroll 1
        for (int k = 1; k < 32; ++k) e = (tab[k] <= wg) ? k : e;
        u.e = e; u.cnt = tab[65 + e]; u.pbase = tab[33 + e];
        const int tl = wg - tab[e], nrt = (u.cnt + 255) >> 8;
        const int nig = 8 * ctn, grp = tl / nig, fm = grp * 8, gsz = (nrt - fm) < 8 ? (nrt - fm) : 8, rem = tl - grp * nig;
        u.pn = rem / gsz; u.rt = fm + (rem - u.pn * gsz);
        return true;
    }
    DEVI unsigned aoff(const U& u, int row) const {
        const int idx = u.rt * 256 + row;
        if (GATHER) { const int tokn = idx < u.cnt ? (la[(size_t)u.e * NTOK + idx] >> 2) : 0; return (unsigned)tokn * 2048u; }
        return (unsigned)(u.pbase + idx) * 2048u;
    }
    DEVI void aoff4(const U& u, int r0, int r1, unsigned& a00, unsigned& a01, unsigned& a10, unsigned& a11) const {
        const int i0 = u.rt * 256 + r0, i1 = u.rt * 256 + r1, i2 = i0 + 128, i3 = i1 + 128;
        if (GATHER) {
            const int* lp = la + (size_t)u.e * NTOK; const int cm = u.cnt - 1;
            const int t0 = lp[i0 < cm ? i0 : cm], t1 = lp[i1 < cm ? i1 : cm], t2 = lp[i2 < cm ? i2 : cm], t3 = lp[i3 < cm ? i3 : cm];
            a00 = (unsigned)(t0 >> 2) * 2048u; a01 = (unsigned)(t1 >> 2) * 2048u; a10 = (unsigned)(t2 >> 2) * 2048u; a11 = (unsigned)(t3 >> 2) * 2048u;
        } else {
            a00 = (unsigned)(u.pbase + i0) * 2048u; a01 = (unsigned)(u.pbase + i1) * 2048u; a10 = (unsigned)(u.pbase + i2) * 2048u; a11 = (unsigned)(u.pbase + i3) * 2048u;
        }
    }
    DEVI const char* bbase(const U& u) const { return Bt + ((size_t)u.e * nrowsB + (size_t)u.pn * 256) * 2048; }
};
struct EpiMoe1 {
    const float* b_gu; u16* act;
    DEVI void operator()(const f32x4 (&acc)[2][2][4][2], const MoeSrc<true>::U& u, int wr, int wc, int fr, int fq) const {
        const float* bg = b_gu + (size_t)u.e * 2048;
        float4 bgate[2], bup[2];
#pragma unroll
        for (int bj = 0; bj < 2; ++bj) {
            const int col = u.pn * 128 + (bj * 4 + wc) * 16 + 4 * fq;
            bgate[bj] = *(const float4*)(bg + col); bup[bj] = *(const float4*)(bg + 1024 + col);
        }
        asm volatile("" :: "v"(bgate[0].x), "v"(bup[0].x), "v"(bgate[1].x), "v"(bup[1].x));
#pragma unroll
        for (int ai = 0; ai < 2; ++ai)
#pragma unroll
            for (int m = 0; m < 4; ++m) {
                const int idx = u.rt * 256 + ai * 128 + wr * 64 + m * 16 + fr;
                if (idx < u.cnt) {
#pragma unroll
                    for (int bj = 0; bj < 2; ++bj) {
                        const int col = u.pn * 128 + (bj * 4 + wc) * 16 + 4 * fq;
                        const float bgv[4] = {bgate[bj].x, bgate[bj].y, bgate[bj].z, bgate[bj].w};
                        const float buv[4] = {bup[bj].x, bup[bj].y, bup[bj].z, bup[bj].w};
                        f32x4 a;
#pragma unroll
                        for (int j = 0; j < 4; ++j) {
                            float gt = acc[ai][bj][m][0][j] + bgv[j]; gt = fminf(gt, 7.f);
                            float up = acc[ai][bj][m][1][j] + buv[j]; up = fminf(fmaxf(up, -7.f), 7.f);
                            a[j] = gt * (1.f / (1.f + __expf(-1.702f * gt))) * (up + 1.f);
                        }
                        *(uint2*)(act + (size_t)(u.pbase + idx) * 1024 + col) = pack4(a);
                    }
                }
            }
    }
};
struct EpiMoe2 {
    const float* b_dn; const int* la; const float* lw; u16* Y;
    DEVI void operator()(const f32x4 (&acc)[2][2][4][2], const MoeSrc<false>::U& u, int wr, int wc, int fr, int fq) const {
        const float* bd = b_dn + (size_t)u.e * 1024;
        const int* lap = la + (size_t)u.e * NTOK; const float* lwp = lw + (size_t)u.e * NTOK;
        const int cm = u.cnt - 1;
        int av[2][4]; float wv[2][4]; float4 b0[2], b1[2];
#pragma unroll
        for (int ai = 0; ai < 2; ++ai)
#pragma unroll
            for (int m = 0; m < 4; ++m) {
                const int idx = u.rt * 256 + ai * 128 + wr * 64 + m * 16 + fr;
                const int ic = idx < cm ? idx : cm;
                av[ai][m] = lap[ic]; wv[ai][m] = lwp[ic];
            }
#pragma unroll
        for (int bj = 0; bj < 2; ++bj) {
            const int col = u.pn * 256 + bj * 128 + wc * 32 + fq * 8;
            b0[bj] = *(const float4*)(bd + col); b1[bj] = *(const float4*)(bd + col + 4);
        }
        asm volatile("" :: "v"(b1[1].w), "v"(b0[0].x), "v"(av[1][3]), "v"(wv[1][3]));
#pragma unroll
        for (int ai = 0; ai < 2; ++ai)
#pragma unroll
            for (int m = 0; m < 4; ++m) {
                const int idx = u.rt * 256 + ai * 128 + wr * 64 + m * 16 + fr;
                if (idx < u.cnt) {
                    const float wgt = wv[ai][m];
#pragma unroll
                    for (int bj = 0; bj < 2; ++bj) {
                        const int col = u.pn * 256 + bj * 128 + wc * 32 + fq * 8;
                        uint4 v;
                        v.x = pack2((acc[ai][bj][m][0][0] + b0[bj].x) * wgt, (acc[ai][bj][m][0][1] + b0[bj].y) * wgt);
                        v.y = pack2((acc[ai][bj][m][0][2] + b0[bj].z) * wgt, (acc[ai][bj][m][0][3] + b0[bj].w) * wgt);
                        v.z = pack2((acc[ai][bj][m][1][0] + b1[bj].x) * wgt, (acc[ai][bj][m][1][1] + b1[bj].y) * wgt);
                        v.w = pack2((acc[ai][bj][m][1][2] + b1[bj].z) * wgt, (acc[ai][bj][m][1][3] + b1[bj].w) * wgt);
                        *(uint4*)(Y + (size_t)av[ai][m] * 1024 + col) = v;
                    }
                }
            }
    }
};
DEVI void phase_moe1_8(const Params& p, char* smem_all) {
    moe_setup8(p, smem_all, 8);
    MoeSrc<true> S; S.tab = (const LAS3 int*)(smem_all + MOE_TAB_OFF); S.Bt = p.ws + OFF_WGU; S.la = (const int*)(p.ws + OFF_LISTA); S.nrowsB = 2048; S.G = gridDim.x; S.c = blockIdx.x; S.ctn = 8;
    EpiMoe1 E; E.b_gu = p.b_gu; E.act = (u16*)(p.ws + OFF_ACT);
    g8::gemm_phase<true, false>(TIDX, (LAS3 unsigned char*)smem_all, p.ws + OFF_H1B, S, E);
}
DEVI void phase_moe2_8(const Params& p, char* smem_all) {
    moe_setup8(p, smem_all, 4);
    MoeSrc<false> S; S.tab = (const LAS3 int*)(smem_all + MOE_TAB_OFF); S.Bt = p.ws + OFF_WDN; S.la = nullptr; S.nrowsB = 1024; S.G = gridDim.x; S.c = blockIdx.x; S.ctn = 4;
    EpiMoe2 E; E.b_dn = p.b_dn; E.la = (const int*)(p.ws + OFF_LISTA); E.lw = (const float*)(p.ws + OFF_LISTW); E.Y = (u16*)(p.ws + OFF_Y);
    g8::gemm_phase<true, true>(TIDX, (LAS3 unsigned char*)smem_all, p.ws + OFF_ACT, S, E);
}

struct EpiProjT {
    char* ws; const float* lb;
    template <class F> DEVI void rows(const g8::DenseSrc::U& u, int wr, int wc, int fr, int fq, F f) const {
#pragma unroll
        for (int ai = 0; ai < 2; ++ai)
#pragma unroll
            for (int m = 0; m < 4; ++m) {
                const int tok = u.pm * 256 + ai * 128 + wr * 64 + m * 16 + fr;
#pragma unroll
                for (int bj = 0; bj < 2; ++bj) f(ai, m, bj, tok, bj * 128 + wc * 32 + fq * 8);
            }
    }
    DEVI void operator()(const f32x4 (&acc)[2][2][4][2], const g8::DenseSrc::U& u, int wr, int wc, int fr, int fq) const {
        const int mt = u.pn;
        if (mt < 2) {
            u16* Q = (u16*)(ws + OFF_Q);
            rows(u, wr, wc, fr, fq, [&](int ai, int m, int bj, int tok, int c8) {
                const f32x4 v0 = acc[ai][bj][m][0], v1 = acc[ai][bj][m][1];
                const float qs_ = 0.125f * 1.4426950408889634f;
                uint4 o; o.x = pack2(v0[0] * qs_, v0[1] * qs_); o.y = pack2(v0[2] * qs_, v0[3] * qs_); o.z = pack2(v1[0] * qs_, v1[1] * qs_); o.w = pack2(v1[2] * qs_, v1[3] * qs_);
                *(uint4*)(Q + (size_t)tok * 512 + mt * 256 + c8) = o; });
        } else if (mt < 4) {
            const int g = wc >> 1, d0 = (wc & 1) * 32 + fq * 8;
            rows(u, wr, wc, fr, fq, [&](int ai, int m, int bj, int tok, int c8) {
                const f32x4 v0 = acc[ai][bj][m][0], v1 = acc[ai][bj][m][1];
                const int b = tok >> 13, s = tok & 8191;
                uint4 o; o.x = pack2(v0[0], v0[1]); o.y = pack2(v0[2], v0[3]); o.z = pack2(v1[0], v1[1]); o.w = pack2(v1[2], v1[3]);
                u16* dst = (mt == 2) ? (u16*)(ws + (bj ? OFF_VCR : OFF_KCR)) + ((size_t)(b * 2 + g) * SP + s) * 64 + d0
                                     : (u16*)(ws + (bj ? OFF_KW : OFF_KS)) + ((size_t)(b * 2 + g) * 8192 + s) * 64 + d0;
                *(uint4*)dst = o; });
        } else if (mt < 6) {
            u16* QH = (u16*)(ws + OFF_QH);
            rows(u, wr, wc, fr, fq, [&](int ai, int m, int bj, int tok, int c8) {
                const f32x4 v0 = acc[ai][bj][m][0], v1 = acc[ai][bj][m][1];
                uint4 o; o.x = pack2(v0[0], v0[1]); o.y = pack2(v0[2], v0[3]); o.z = pack2(v1[0], v1[1]); o.w = pack2(v1[2], v1[3]);
                *(uint4*)(QH + (size_t)tok * 512 + (mt - 4) * 256 + c8) = o; });
        } else if (mt < 8) {
            float4 lb0[2], lb1[2];
#pragma unroll
            for (int bj = 0; bj < 2; ++bj) { const int hk = (mt - 6) * 256 + bj * 128 + wc * 32 + fq * 8; lb0[bj] = *(const float4*)(lb + hk); lb1[bj] = *(const float4*)(lb + hk + 4); }
            asm volatile("" :: "v"(lb0[0].x), "v"(lb1[0].x), "v"(lb0[1].x), "v"(lb1[1].w));
            float* LF = (float*)(ws + OFF_LOGF);
            rows(u, wr, wc, fr, fq, [&](int ai, int m, int bj, int tok, int c8) {
                const f32x4 v0 = acc[ai][bj][m][0], v1 = acc[ai][bj][m][1];
                const float lv[8] = {lb0[bj].x, lb0[bj].y, lb0[bj].z, lb0[bj].w, lb1[bj].x, lb1[bj].y, lb1[bj].z, lb1[bj].w};
                float r[8];
#pragma unroll
                for (int j = 0; j < 8; ++j) {
                    const float z = j < 4 ? v0[j & 3] : v1[j & 3];
                    const float fh = 1.f / (1.f + __expf(-z));
                    r[j] = __logf(lv[j] + (1.f - lv[j]) * fh);
                }
                float* dst = LF + (size_t)tok * 512 + (mt - 6) * 256 + c8;
                *(float4*)dst = make_float4(r[0], r[1], r[2], r[3]); *(float4*)(dst + 4) = make_float4(r[4], r[5], r[6], r[7]); });
        } else {
            u16* GH = (u16*)(ws + OFF_GH);
            rows(u, wr, wc, fr, fq, [&](int ai, int m, int bj, int tok, int c8) {
                const f32x4 v0 = acc[ai][bj][m][0], v1 = acc[ai][bj][m][1];
                float r[8];
#pragma unroll
                for (int j = 0; j < 8; ++j) { const float z = j < 4 ? v0[j & 3] : v1[j & 3]; r[j] = z / (1.f + __expf(-z)); }
                uint4 o; o.x = pack2(r[0], r[1]); o.y = pack2(r[2], r[3]); o.z = pack2(r[4], r[5]); o.w = pack2(r[6], r[7]);
                *(uint4*)(GH + (size_t)tok * 512 + (mt - 8) * 256 + c8) = o; });
        }
    }
};
struct EpiProjN {
    char* ws;
    DEVI void operator()(const f32x4 (&acc)[2][2][4][2], const g8::DenseSrc::U& u, int wr, int wc, int fr, int fq) const {
        const int mt = u.pn;
#pragma unroll
        for (int ai = 0; ai < 2; ++ai)
#pragma unroll
            for (int m = 0; m < 4; ++m) {
                const int tok = u.pm * 256 + ai * 128 + wr * 64 + m * 16 + fq * 4;
                const int b = tok >> 13, s = tok & 8191;
#pragma unroll
                for (int bj = 0; bj < 2; ++bj)
#pragma unroll
                    for (int n = 0; n < 2; ++n) {
                        const int c = bj * 128 + wc * 32 + n * 16 + fr;
                        u16* dst;
                        if (mt == 0) {
                            const int g = wc >> 1, d = (wc & 1) * 32 + n * 16 + fr;
                            dst = (u16*)(ws + (bj ? OFF_VWT : OFF_VST)) + (((size_t)(b * 2 + g) * 128 + (s >> 6)) * 64 + d) * 64 + (s & 63);
                        } else {
                            const int hv = (mt - 1) * 256 + c;
                            dst = (u16*)(ws + OFF_VTH) + (((size_t)(b * 4 + (hv >> 7)) * 128 + (s >> 6)) * 128 + (hv & 127)) * 64 + (s & 63);
                        }
                        *(uint2*)dst = pack4(acc[ai][bj][m][n]);
                    }
            }
    }
};
DEVI void phase_proj8(const Params& p, char* smem_all) {
    {
        g8::DenseSrc S; S.init(p.ws + OFF_WIN, NTOK, 2560, gridDim.x, blockIdx.x);
        EpiProjT E; E.ws = p.ws; E.lb = (const float*)(p.ws + OFF_MISC) + 512;
        g8::gemm_phase<true, true>(TIDX, (LAS3 unsigned char*)smem_all, p.ws + OFF_XB, S, E);
    }
    {
        g8::DenseSrc S; S.init(p.ws + OFF_WIN + (size_t)2560 * 2048, NTOK, 768, gridDim.x, blockIdx.x);
        EpiProjN E; E.ws = p.ws;
        g8::gemm_phase<false, false>(TIDX, (LAS3 unsigned char*)smem_all, p.ws + OFF_XB, S, E);
    }
}
DEVI void gates_tile(const Params& p, char* smem, int rt) {
    char* ws = p.ws;
    const int tid = VTID, lane = tid & 63, wid = tid >> 6, wr = wid >> 1, wc = wid & 1, fr = lane & 15, fq = lane >> 4;
    const u16* XB = (const u16*)(ws + OFF_XB);
    auto arow = [&](int r) { return XB + (size_t)(rt * 128 + r) * 1024; };
    f32x4 acc[4][4];
    gemm128(tid, arow, (const u16*)(ws + OFF_WIN) + (size_t)3328 * 1024, 1024, 1024, smem, acc);
    if (wc == 0) {
        float* dst = (float*)(ws + OFF_GATES);
#pragma unroll
        for (int m = 0; m < 4; ++m)
#pragma unroll
            for (int n = 0; n < 2; ++n) {
                const int cc = n * 16 + fr, tok = rt * 128 + wr * 64 + m * 16 + fq * 4;
                if (cc < 24) {
#pragma unroll
                    for (int j = 0; j < 4; ++j) dst[(size_t)(tok + j) * 24 + cc] = 1.f / (1.f + expf(-acc[m][n][j]));
                }
            }
    }
}
DEVI void rope_task(const Params& p, int task) {
    char* ws = p.ws;
    const int gid = task * 256 + VTID;
    const int tok = gid / 12, vec = gid - tok * 12;
    const int b = tok >> 13, s = tok & 8191;
    u16* ptr;
    if (vec < 8) ptr = (u16*)(ws + OFF_Q) + (size_t)tok * 512 + vec * 64;
    else { const int g = vec & 1; ptr = (u16*)(ws + (vec < 10 ? OFF_KS : OFF_KW)) + ((size_t)(b * 2 + g) * 8192 + s) * 64; }
    const float* cs = (const float*)(ws + OFF_ROPE) + (size_t)tok * 8;
    const float4 c0 = *(const float4*)cs, c1 = *(const float4*)(cs + 4), s0 = *(const float4*)(cs + (size_t)NTOK * 8), s1 = *(const float4*)(cs + (size_t)NTOK * 8 + 4);
    const uint4 a = *(const uint4*)ptr, bq = *(const uint4*)(ptr + 8);
    const float cv[8] = {c0.x, c0.y, c0.z, c0.w, c1.x, c1.y, c1.z, c1.w}, sv[8] = {s0.x, s0.y, s0.z, s0.w, s1.x, s1.y, s1.z, s1.w};
    const uint32_t aw[4] = {a.x, a.y, a.z, a.w}, bw[4] = {bq.x, bq.y, bq.z, bq.w};
    float o1[8], o2[8];
#pragma unroll
    for (int i = 0; i < 8; ++i) {
        const float x1 = (i & 1) ? __uint_as_float(aw[i >> 1] & 0xffff0000u) : __uint_as_float(aw[i >> 1] << 16);
        const float x2 = (i & 1) ? __uint_as_float(bw[i >> 1] & 0xffff0000u) : __uint_as_float(bw[i >> 1] << 16);
        o1[i] = x1 * cv[i] - x2 * sv[i]; o2[i] = x2 * cv[i] + x1 * sv[i];
    }
    uint4 oa, ob;
    oa.x = pack2(o1[0], o1[1]); oa.y = pack2(o1[2], o1[3]); oa.z = pack2(o1[4], o1[5]); oa.w = pack2(o1[6], o1[7]);
    ob.x = pack2(o2[0], o2[1]); ob.y = pack2(o2[2], o2[3]); ob.z = pack2(o2[4], o2[5]); ob.w = pack2(o2[6], o2[7]);
    *(uint4*)ptr = oa; *(uint4*)(ptr + 8) = ob;
}

DEVI void final_rows(const Params& p, int task) {
    char* ws = p.ws;
    const int tid = VTID, lane = tid & 63, w = tid >> 6;
    const u16* H1B = (const u16*)(ws + OFF_H1B); const u16* Y = (const u16*)(ws + OFF_Y);
    for (int i = 0; i < 8; ++i) {
        const size_t row = (size_t)task * 32 + w * 8 + i;
        float4 v[4];
        float s = 0.f;
#pragma unroll
        for (int q = 0; q < 4; ++q) {
            const int c = q * 256 + lane * 4;
            const uint2 hb = *(const uint2*)(H1B + row * 1024 + c);
            float4 a; a.x = DN_ALPHA * __uint_as_float(hb.x << 16); a.y = DN_ALPHA * __uint_as_float(hb.x & 0xffff0000u);
            a.z = DN_ALPHA * __uint_as_float(hb.y << 16); a.w = DN_ALPHA * __uint_as_float(hb.y & 0xffff0000u);
#pragma unroll
            for (int k = 0; k < 4; ++k) {
                const uint2 y = *(const uint2*)(Y + (row * 4 + k) * 1024 + c);
                a.x += __uint_as_float(y.x << 16); a.y += __uint_as_float(y.x & 0xffff0000u);
                a.z += __uint_as_float(y.y << 16); a.w += __uint_as_float(y.y & 0xffff0000u);
            }
            v[q] = a; s += a.x + a.y + a.z + a.w;
        }
        const float mu = wave_sum(s) * (1.f / 1024.f);
        float ss = 0.f;
#pragma unroll
        for (int q = 0; q < 4; ++q) { v[q].x -= mu; v[q].y -= mu; v[q].z -= mu; v[q].w -= mu; ss += v[q].x * v[q].x + v[q].y * v[q].y + v[q].z * v[q].z + v[q].w * v[q].w; }
        const float rs = rsqrtf(wave_sum(ss) * (1.f / 1024.f) + 1e-5f);
#pragma unroll
        for (int q = 0; q < 4; ++q) {
            const int c = q * 256 + lane * 4;
            const float4 gq = *(const float4*)(p.ln2g + c), bq = *(const float4*)(p.ln2b + c);
            float4 o; o.x = v[q].x * rs * gq.x + bq.x; o.y = v[q].y * rs * gq.y + bq.y; o.z = v[q].z * rs * gq.z + bq.z; o.w = v[q].w * rs * gq.w + bq.w;
            *(float4*)(p.out + row * 1024 + c) = o;
        }
    }
}

#define XB_TMO      128
#define XB_XCNT(j)  (256  + 64 * (j))
#define XB_XSUB(j)  (1280 + 64 * (j))
#define XB_XGEN(j)  (2304 + 64 * (j))
#define XB_TOP      3328
#define XB_TOPGEN   3392
#define XCD_BAR_WORDS 3456
#define XB_SPIN_CAP (1u << 18)
#define LAS LAS3

__device__ __forceinline__ unsigned xb_ld(unsigned* p)              { return __hip_atomic_load(p, __ATOMIC_RELAXED, __HIP_MEMORY_SCOPE_AGENT); }
__device__ __forceinline__ unsigned xb_add(unsigned* p, unsigned v) { return __hip_atomic_fetch_add(p, v, __ATOMIC_RELAXED, __HIP_MEMORY_SCOPE_AGENT); }
__device__ __forceinline__ unsigned xb_xcc_id() { return (unsigned)__builtin_amdgcn_s_getreg((3 << 11) | 20) & 0xFu; }
#define XB_SPIN(cond, bar) do { unsigned _sp = 0; while (cond) { __builtin_amdgcn_s_sleep(1); \
    if ((++_sp & 255u) == 0u) { if (xb_ld(&(bar)[XB_TMO])) break; if (_sp > XB_SPIN_CAP) { atomicAdd(&(bar)[XB_TMO], 1u); break; } } } } while (0)

struct XcdBarrier {
    unsigned* bar; unsigned x;
    volatile LAS unsigned* st;
};

__device__ __forceinline__ XcdBarrier xcd_barrier_post(unsigned* bar, volatile LAS unsigned* st, const bool lead) {
    XcdBarrier b; b.bar = bar; b.x = xb_xcc_id(); b.st = st;
    if (lead) (void)xb_add(&bar[XB_XCNT(b.x)], 1u);
    return b;
}
__device__ __forceinline__ void xcd_barrier_complete(unsigned* bar, unsigned x, unsigned& nloc, unsigned& nx) {
    const unsigned G = gridDim.x * gridDim.y * gridDim.z;
    unsigned sum, cnt, mine, sp = 0u;
    for (;;) {
        sum = 0u; cnt = 0u; mine = 0u;
#pragma unroll
        for (unsigned j = 0; j < 16; ++j) { const unsigned c = xb_ld(&bar[XB_XCNT(j)]); sum += c; cnt += (c > 0u) ? 1u : 0u; mine = (j == x) ? c : mine; }
        if (sum == G) break;
        __builtin_amdgcn_s_sleep(1);
        if ((++sp & 255u) == 0u) { if (xb_ld(&bar[XB_TMO])) break; if (sp > XB_SPIN_CAP) { atomicAdd(&bar[XB_TMO], 1u); break; } }
    }
    nloc = mine > 0u ? mine : 1u; nx = cnt > 0u ? cnt : 1u;
}

__device__ __forceinline__ void xcd_barrier(const XcdBarrier& b, const bool lead) {
    asm volatile("s_waitcnt vmcnt(0)" ::: "memory");
    __syncthreads();
    if (lead) {
        unsigned* bar = b.bar;
        __builtin_amdgcn_s_waitcnt(0);
        unsigned nloc = b.st[0], nx = b.st[1];
        if (nloc == 0u) { xcd_barrier_complete(bar, b.x, nloc, nx); b.st[0] = nloc; b.st[1] = nx; }
        const unsigned old = xb_add(&bar[XB_XSUB(b.x)], 1u);
        const unsigned gen = old / nloc;
        if (old + 1u == (gen + 1u) * nloc) {
            __builtin_amdgcn_fence(__ATOMIC_RELEASE, "agent");
            asm volatile("s_waitcnt vmcnt(0)" ::: "memory");
            const unsigned og = xb_add(&bar[XB_TOP], 1u);
            const unsigned tg = og / nx;
            if (og + 1u == (tg + 1u) * nx) xb_add(&bar[XB_TOPGEN], 1u);
            else XB_SPIN(xb_ld(&bar[XB_TOPGEN]) == tg, bar);
            __builtin_amdgcn_fence(__ATOMIC_ACQUIRE, "agent");
            xb_add(&bar[XB_XGEN(b.x)], 1u);
            asm volatile("s_waitcnt vmcnt(0)" ::: "memory");
        } else {
            XB_SPIN(xb_ld(&bar[XB_XGEN(b.x)]) == gen, bar);
            __builtin_amdgcn_fence(__ATOMIC_ACQUIRE, "agent");
            asm volatile("s_waitcnt vmcnt(0)" ::: "memory");
        }
    }
    __syncthreads();
}


DEVI void run_phase(const Params& p, char* smem, char* smem_all, int ph) {
    const int G = VGRID, B0 = VBID;
#ifdef ONLY_PHASE
    if (ph != ONLY_PHASE) return;
#endif
    switch (ph) {
    case 0: {
        int* qctr = (int*)(p.ws + OFF_CTRL) + 35;
        int* sh = (int*)(smem_all + 131072);
        const int sb = p.ph_lo >> 2;
        for (;;) {
            __syncthreads();
            if (TIDX == 0) sh[0] = atomicAdd(qctr, 1);
            __syncthreads();
            const int base = sh[0] * 8;
            if (base >= PREP_NJOBS) break;
#pragma unroll 1
            for (int k = 0; k < 4; ++k) { const int j = base + 2 * k + sb; if (base + 2 * k < PREP_NJOBS) prep_job(p, smem, prep_order(j)); }
        }
    } break;
    case 1: phase_proj8(p, smem_all); break;
    case 2: {
        int* qctr = (int*)((float*)(p.ws + OFF_MISC) + 1024) + 33;
        int* sh = (int*)(smem_all + 131072);
        const int sb = p.ph_lo >> 2;
        for (;;) {
            __syncthreads();
            if (TIDX == 0) sh[0] = atomicAdd(qctr, 1);
            __syncthreads();
            const int item = sh[0];
            if (item >= 64 + 1024 + 128 + 768) break;
            if (item < 64) cmp1_tile(p, smem, item * 2 + sb);
            else if (item < 64 + 1024) hgrn_local_tile(p, smem, (item - 64) * 2 + sb);
            else if (item < 64 + 1024 + 128) gates_tile(p, smem, (item - 1088) * 2 + sb);
            else rope_task(p, (item - 1216) * 2 + sb);
        }
    } break;
    case 3: {
        int* qctr = (int*)((float*)(p.ws + OFF_MISC) + 1024) + 34;
        int* sh = (int*)(smem_all + 131072);
        const int sb = p.ph_lo >> 2;
        for (;;) {
            __syncthreads();
            if (TIDX == 0) sh[0] = atomicAdd(qctr, 1);
            __syncthreads();
            const int item = sh[0];
            if (item >= 256 + 32) break;
            if (item < 256) hgrn_scan_task(p, item * 2 + sb);
            else cmp2_tile(p, smem, (item - 256) * 2 + sb);
        }
    } break;
    case 4: {
        int* qx = (int*)((float*)(p.ws + OFF_MISC) + 1024) + 40;
        int* sh = (int*)(smem_all + 131072);
        if (TIDX == 0) { sh[1] = (int)(xb_xcc_id() & 7u); sh[2] = 0; }
        for (;;) {
            __syncthreads();
            if (TIDX == 0) {
                int q = sh[1], tries = sh[2], item;
                for (;;) { item = atomicAdd(&qx[q], 1); if (item < 256 || ++tries >= 8) break; q = (q + 1) & 7; }
                sh[0] = item; sh[1] = q; sh[2] = tries;
            }
            __syncthreads();
            const int item = sh[0];
            if (item >= 256) break;
            const int q = sh[1];
            if (item < 128) nsa_tile(p, smem_all, item * 8 + q);
            else hgrn_out_tile(p, smem, ((item - 128) * 8 + q) * 2 + (p.ph_lo >> 2));
        }
    } break;
    case 5:
        phase_wo8(p, smem_all);
        break;
    case 6:
        for (int t = B0; t < 1024; t += G) ln1_router_tile(p, smem, t);
        break;
    case 7: phase_moe1_8(p, smem_all); break;
    case 8: phase_moe2_8(p, smem_all); break;
    case 9:
        for (int t = B0; t < 1024; t += G) final_rows(p, t);
        break;
    }
}

#if N_LAUNCH_MODE == 1
__global__ void __launch_bounds__(512, 2) fwd_kernel(Params p_in) {
    extern __shared__ __attribute__((aligned(16))) char smem_all[];
    Params p = p_in;
    p.ph_lo = __builtin_amdgcn_readfirstlane((int)(threadIdx.x >> 6));
    char* smem = smem_all + (p.ph_lo >> 2) * 65536;
#ifndef PROBE_REP
#define PROBE_REP -1
#endif
    volatile LAS3 unsigned* xst = (volatile LAS3 unsigned*)(smem_all + 131072 + 512);
    if (TIDX == 0) { xst[0] = 0u; xst[1] = 0u; }
    __syncthreads();
    const XcdBarrier xb = xcd_barrier_post((unsigned*)(p.ws + OFF_BAR), xst, TIDX == 0);
    run_phase(p, smem, smem_all, 0);
    xcd_barrier(xb, TIDX == 0);
#define GSYNC() xcd_barrier(xb, TIDX == 0)
#define RP(k) run_phase(p, smem, smem_all, k); GSYNC(); if (PROBE_REP == k) { run_phase(p, smem, smem_all, k); GSYNC(); }
    RP(1) RP(2)
    run_phase(p, smem, smem_all, 3); GSYNC();
    run_phase(p, smem, smem_all, 4); GSYNC();
    RP(5)
    run_phase(p, smem, smem_all, 6); GSYNC();
    RP(7) RP(8)
    run_phase(p, smem, smem_all, 9);
    if (PROBE_REP == 9) { GSYNC(); run_phase(p, smem, smem_all, 9); }
#undef RP
}
#define KFN fwd_kernel
#else
template <int PH>
__global__ void __launch_bounds__(256, 2) phase_kernel(Params p) {
    extern __shared__ __attribute__((aligned(16))) char smem[];
    run_phase(p, smem, PH);
}
#define KFN phase_kernel<4>
#endif

extern "C" void kernel_launch(void* const* d_in, const int* in_sizes, int n_in, void* d_out, int out_size, void* d_ws, size_t ws_size,
                              hipStream_t stream) {
    static int grid = 0;
    if (grid == 0) {
        if (ws_size < WS_NEED) { fprintf(stderr, "kernel_launch: workspace too small: %zu < %zu\n", ws_size, (size_t)WS_NEED); grid = -1; return; }
        int dev = 0, cus = 0, per_cu = 0;
        (void)hipGetDevice(&dev);
        (void)hipDeviceGetAttribute(&cus, hipDeviceAttributeMultiprocessorCount, dev);
#if N_LAUNCH_MODE == 1
        (void)hipFuncSetAttribute((const void*)KFN, hipFuncAttributeMaxDynamicSharedMemorySize, SMEM_BYTES);
#else
#define SA_(PH) (void)hipFuncSetAttribute((const void*)phase_kernel<PH>, hipFuncAttributeMaxDynamicSharedMemorySize, SMEM_BYTES);
        SA_(0) SA_(1) SA_(2) SA_(3) SA_(4) SA_(5) SA_(6) SA_(7) SA_(8) SA_(9)
#undef SA_
#endif
        (void)hipOccupancyMaxActiveBlocksPerMultiprocessor(&per_cu, (const void*)KFN, 512, SMEM_BYTES);
        if (per_cu < 1) per_cu = 1;
        if (per_cu > 1) per_cu = 1;
        grid = cus * per_cu;
    }
    if (grid < 0) return;
    Params p{};
    p.x = (const float*)d_in[0]; p.pos = (const int*)d_in[1]; p.w_in = (const float*)d_in[2]; p.pe = (const float*)d_in[3];
    p.w_ck1 = (const float*)d_in[4]; p.w_ck2 = (const float*)d_in[5]; p.w_cv1 = (const float*)d_in[6]; p.w_cv2 = (const float*)d_in[7];
    p.hg_lb = (const float*)d_in[8]; p.hg_ng = (const float*)d_in[9]; p.w_o = (const float*)d_in[10]; p.ln1g = (const float*)d_in[11];
    p.ln1b = (const float*)d_in[12]; p.w_r = (const float*)d_in[13]; p.b_r = (const float*)d_in[14]; p.w_gu = (const float*)d_in[15];
    p.b_gu = (const float*)d_in[16]; p.w_dn = (const float*)d_in[17]; p.b_dn = (const float*)d_in[18]; p.ln2g = (const float*)d_in[19];
    p.ln2b = (const float*)d_in[20];
    p.out = (float*)d_out; p.ws = (char*)d_ws;
#if N_LAUNCH_MODE == 1
    (void)hipMemsetAsync((char*)d_ws + OFF_CTRL, 0, 256, stream);
    (void)hipMemsetAsync((char*)d_ws + OFF_BAR, 0, XCD_BAR_WORDS_ * 4, stream);
    p.ph_lo = 0; p.ph_hi = NPHASE;
    void* args[] = {&p};
    hipError_t e = hipLaunchCooperativeKernel((const void*)fwd_kernel, dim3(grid), dim3(512), args, SMEM_BYTES, stream);
    if (e != hipSuccess) fprintf(stderr, "cooperative launch failed: %s (grid %d)\n", hipGetErrorString(e), grid);
#else
    p.ph_lo = 0; p.ph_hi = NPHASE;
#define LP(PH) hipLaunchKernelGGL(phase_kernel<PH>, dim3(grid), dim3(256), SMEM_BYTES, stream, p);
    LP(0) LP(1) LP(2) LP(3) LP(4) LP(5) LP(6) LP(7) LP(8) LP(9)
#undef LP
#endif
}
```
